# Optimizing an MI355X kernel written in HIP

```python
import math
import jax, jax.numpy as jnp
from jax import lax
import numpy as np


D_MODEL = 1024
BATCH = 2
SEQ = 16384
DEPTH = 4

N_MIXERS = 2
HEAD_DIM = 64
MEM_LEN = 256
MEM_HEADS = 4
MIX_HEADS = D_MODEL // HEAD_DIM - MEM_HEADS
SWA_Q_HEADS = MIX_HEADS
SWA_KV_HEADS = MIX_HEADS // 4
WINDOW = 128
BLOCK = 128
DIFF_HEADS = MIX_HEADS // 2
DIFF_V_DIM = 2 * HEAD_DIM
N_EXPERTS = 64
TOP_K = 8
N_GROUPS = 8
TOPK_GROUPS = 4
EXPERT_HIDDEN = D_MODEL // 4
SHARED_HIDDEN = D_MODEL // 4
ROUTED_SCALE = 2.5
MOE_BLOCK = 256
DN_ALPHA = (2.0 * DEPTH) ** 0.25
DN_BETA = (8.0 * DEPTH) ** -0.25
LN_EPS = 1e-5
NEG = -1e30

kernel_name = 'hybrid_swa_sink_diffattn_memxattn_moe_deepnorm'


def alibi_slopes(n):
    def pow2_slopes(m):
        start = 2.0 ** (-8.0 / m)
        return [start ** (i + 1) for i in range(m)]
    if (n & (n - 1)) == 0:
        s = pow2_slopes(n)
    else:
        c = 2 ** int(math.floor(math.log2(n)))
        s = pow2_slopes(c) + pow2_slopes(2 * c)[0::2][: n - c]
    return jnp.asarray(np.array(s, dtype=np.float32))


def layer_norm(x, g, b):
    xf = x.astype(jnp.float32)
    mu = jnp.mean(xf, axis=-1, keepdims=True)
    var = jnp.mean(jnp.square(xf - mu), axis=-1, keepdims=True)
    y = (xf - mu) * lax.rsqrt(var + LN_EPS) * g.astype(jnp.float32) + b.astype(jnp.float32)
    return y.astype(x.dtype)


def rms_norm(x, g):
    xf = x.astype(jnp.float32)
    y = xf * lax.rsqrt(jnp.mean(jnp.square(xf), axis=-1, keepdims=True) + LN_EPS)
    return (y * g.astype(jnp.float32)).astype(x.dtype)


def swa_sink_attention(q, k, v, sinks, slopes):
    B, S = q.shape[:2]
    nb = S // BLOCK
    g = SWA_Q_HEADS // SWA_KV_HEADS
    qb = q.reshape(B, nb, BLOCK, SWA_KV_HEADS, g, HEAD_DIM)
    kb = k.reshape(B, nb, BLOCK, SWA_KV_HEADS, HEAD_DIM)
    vb = v.reshape(B, nb, BLOCK, SWA_KV_HEADS, HEAD_DIM)
    shift = lambda t: jnp.concatenate([jnp.zeros_like(t[:, :1]), t[:, :-1]], axis=1)
    kk = jnp.concatenate([shift(kb), kb], axis=2)
    vv = jnp.concatenate([shift(vb), vb], axis=2)
    qi = jnp.arange(BLOCK)[:, None]
    kj = jnp.arange(2 * BLOCK)[None, :]
    dist = qi - kj + BLOCK
    kpos = (jnp.arange(nb)[:, None] - 1) * BLOCK + jnp.arange(2 * BLOCK)[None, :]
    valid = ((dist >= 0) & (dist < WINDOW))[None] & (kpos >= 0)[:, None, :]
    s = jnp.einsum('bnqhgd,bnkhd->bnhgqk', qb, kk).astype(jnp.float32) * (HEAD_DIM ** -0.5)
    s = s - slopes.reshape(SWA_KV_HEADS, g)[:, :, None, None] * dist.astype(jnp.float32)
    s = jnp.where(valid[None, :, None, None], s, NEG)
    sink = sinks.astype(jnp.float32).reshape(SWA_KV_HEADS, g)[None, None, :, :, None, None]
    m = jnp.maximum(jnp.max(s, axis=-1, keepdims=True), sink)
    p = jnp.exp(s - m)
    p = p / (jnp.sum(p, axis=-1, keepdims=True) + jnp.exp(sink - m))
    out = jnp.einsum('bnhgqk,bnkhd->bnqhgd', p.astype(v.dtype), vv)
    return out.reshape(B, S, SWA_Q_HEADS * HEAD_DIM)


def diff_attention(q, k, v, lam, slopes):
    B, S = q.shape[:2]
    nb = S // BLOCK
    qblocks = jnp.swapaxes(q.reshape(B, nb, BLOCK, DIFF_HEADS, 2, HEAD_DIM), 0, 1)
    kpos = jnp.arange(S)

    def one_block(args):
        qblk, n = args
        qpos = n * BLOCK + jnp.arange(BLOCK)
        dist = qpos[:, None] - kpos[None, :]
        s = jnp.einsum('bqhcd,bkhcd->bhcqk', qblk, k).astype(jnp.float32) * (HEAD_DIM ** -0.5)
        s = s - slopes[None, :, None, None, None] * dist.astype(jnp.float32)
        s = jnp.where(dist >= 0, s, NEG)
        p = jax.nn.softmax(s, axis=-1)
        a = p[:, :, 0] - lam * p[:, :, 1]
        return jnp.einsum('bhqk,bkhe->bqhe', a.astype(v.dtype), v)

    out = lax.map(one_block, (qblocks, jnp.arange(nb)))
    return jnp.swapaxes(out, 0, 1).reshape(B, S, DIFF_HEADS, DIFF_V_DIM)


def memory_attention(q, mem, w_kv):
    B, S = q.shape[:2]
    kv = mem @ w_kv
    km, vm = jnp.split(kv, 2, axis=-1)
    km = km.reshape(B, MEM_LEN, MEM_HEADS, HEAD_DIM)
    vm = vm.reshape(B, MEM_LEN, MEM_HEADS, HEAD_DIM)
    s = jnp.einsum('bshd,bmhd->bhsm', q, km).astype(jnp.float32) * (HEAD_DIM ** -0.5)
    p = jax.nn.softmax(s, axis=-1)
    out = jnp.einsum('bhsm,bmhd->bshd', p.astype(vm.dtype), vm)
    return out.reshape(B, S, MEM_HEADS * HEAD_DIM)


def moe_ffn(x, w_router, router_bias, w_gate, w_up, w_down, ws_gate, ws_up, ws_down):
    B, S, D = x.shape
    n = B * S
    xt = x.reshape(n, D)
    aff = jax.nn.sigmoid((xt @ w_router).astype(jnp.float32))
    sel = aff + router_bias.astype(jnp.float32)
    per_group = N_EXPERTS // N_GROUPS
    gscore = jnp.sum(lax.top_k(sel.reshape(n, N_GROUPS, per_group), 2)[0], axis=-1)
    gidx = lax.top_k(gscore, TOPK_GROUPS)[1]
    gmask = jnp.sum(jax.nn.one_hot(gidx, N_GROUPS, dtype=jnp.float32), axis=1) > 0
    emask = jnp.repeat(gmask, per_group, axis=1)
    eidx = lax.top_k(jnp.where(emask, sel, -jnp.inf), TOP_K)[1]
    gates = jnp.take_along_axis(aff, eidx, axis=-1)
    gates = gates / jnp.sum(gates, axis=-1, keepdims=True) * ROUTED_SCALE

    nk = n * TOP_K
    flat_e = eidx.reshape(-1)
    flat_t = jnp.repeat(jnp.arange(n, dtype=jnp.int32), TOP_K)
    flat_g = gates.reshape(-1)
    order = jnp.argsort(flat_e)
    se, st, sg = flat_e[order], flat_t[order], flat_g[order]
    counts = jnp.bincount(flat_e, length=N_EXPERTS)
    padded = (counts + MOE_BLOCK - 1) // MOE_BLOCK * MOE_BLOCK
    starts = jnp.cumsum(counts) - counts
    pends = jnp.cumsum(padded)
    pstarts = pends - padded
    dest = pstarts[se] + (jnp.arange(nk) - starts[se])
    n_rows = (nk + N_EXPERTS * (MOE_BLOCK - 1) + MOE_BLOCK - 1) // MOE_BLOCK * MOE_BLOCK
    n_blocks = n_rows // MOE_BLOCK
    row_t = jnp.full((n_rows,), n, jnp.int32).at[dest].set(st)
    row_g = jnp.zeros((n_rows,), jnp.float32).at[dest].set(sg)
    block_e = jnp.clip(jnp.searchsorted(pends, jnp.arange(n_blocks) * MOE_BLOCK, side='right'), 0, N_EXPERTS - 1)
    x_pad = jnp.concatenate([xt, jnp.zeros((1, D), xt.dtype)], axis=0)

    def expert_block(args):
        rows, e = args
        xb = x_pad[rows]
        h = jax.nn.silu(xb @ w_gate[e]) * (xb @ w_up[e])
        return h @ w_down[e]

    yb = lax.map(expert_block, (row_t.reshape(n_blocks, MOE_BLOCK), block_e)).reshape(n_rows, D)
    routed = jax.ops.segment_sum(yb * row_g[:, None].astype(yb.dtype), row_t, num_segments=n + 1)[:n]
    shared = (jax.nn.silu(xt @ ws_gate) * (xt @ ws_up)) @ ws_down
    return (routed + shared).reshape(B, S, D)


def setup_inputs(seed: int = 0) -> dict:
    key = jax.random.key(seed)
    ks = jax.random.split(key, 24)
    D = D_MODEL
    n_a = (DEPTH + 1) // 2
    n_b = DEPTH // 2
    sd = D ** -0.5
    nrm = lambda k, shape, scale: jax.random.normal(k, shape, jnp.float32) * scale
    qa, kva = SWA_Q_HEADS * HEAD_DIM, SWA_KV_HEADS * HEAD_DIM
    qb, vb = DIFF_HEADS * 2 * HEAD_DIM, DIFF_HEADS * DIFF_V_DIM
    mq = MEM_HEADS * HEAD_DIM
    w_in_a = jnp.concatenate([nrm(ks[0], (n_a, D, qa + kva), sd),
                              nrm(ks[1], (n_a, D, kva), sd * DN_BETA),
                              nrm(ks[2], (n_a, D, mq), sd)], axis=-1)
    w_in_b = jnp.concatenate([nrm(ks[3], (n_b, D, 2 * qb), sd),
                              nrm(ks[4], (n_b, D, vb), sd * DN_BETA),
                              nrm(ks[5], (n_b, D, mq), sd)], axis=-1)
    w_mem_kv = jnp.concatenate([nrm(ks[6], (DEPTH, D, mq), sd),
                                nrm(ks[7], (DEPTH, D, mq), sd * DN_BETA)], axis=-1)
    return {
        'x': nrm(ks[8], (BATCH, SEQ, D), 1.0),
        'mem': nrm(ks[9], (BATCH, MEM_LEN, D), 1.0),
        'w_in_a': w_in_a,
        'sinks': nrm(ks[10], (n_a, SWA_Q_HEADS), 0.5),
        'w_in_b': w_in_b,
        'lambda_qk': nrm(ks[11], (n_b, 4, HEAD_DIM), 0.1),
        'subln_g': 1.0 + nrm(ks[12], (n_b, DIFF_V_DIM), 0.02),
        'w_mem_kv': w_mem_kv,
        'w_out': nrm(ks[13], (DEPTH, D, D), sd * DN_BETA),
        'ln_g': 1.0 + nrm(ks[14], (DEPTH, 2, D), 0.02),
        'ln_b': nrm(ks[15], (DEPTH, 2, D), 0.02),
        'w_router': nrm(ks[16], (DEPTH, D, N_EXPERTS), sd),
        'router_bias': nrm(ks[17], (DEPTH, N_EXPERTS), 0.01),
        'w_gate': nrm(ks[18], (DEPTH, N_EXPERTS, D, EXPERT_HIDDEN), sd),
        'w_up': nrm(ks[19], (DEPTH, N_EXPERTS, D, EXPERT_HIDDEN), sd),
        'w_down': nrm(ks[20], (DEPTH, N_EXPERTS, EXPERT_HIDDEN, D), EXPERT_HIDDEN ** -0.5 * DN_BETA),
        'w_shared_gate': nrm(ks[21], (DEPTH, D, SHARED_HIDDEN), sd),
        'w_shared_up': nrm(ks[22], (DEPTH, D, SHARED_HIDDEN), sd),
        'w_shared_down': nrm(ks[23], (DEPTH, SHARED_HIDDEN, D), SHARED_HIDDEN ** -0.5 * DN_BETA),
    }


def reference(x, mem, w_in_a, sinks, w_in_b, lambda_qk, subln_g, w_mem_kv, w_out, ln_g, ln_b,
              w_router, router_bias, w_gate, w_up, w_down, w_shared_gate, w_shared_up, w_shared_down):
    B, S, D = x.shape
    slopes_a = alibi_slopes(SWA_Q_HEADS)
    slopes_b = alibi_slopes(DIFF_HEADS)
    qa, kva = SWA_Q_HEADS * HEAD_DIM, SWA_KV_HEADS * HEAD_DIM
    qb, vb = DIFF_HEADS * 2 * HEAD_DIM, DIFF_HEADS * DIFF_V_DIM
    for i in range(DEPTH):
        j = i // N_MIXERS
        if i % N_MIXERS == 0:
            h = x @ w_in_a[j]
            q, k, v, q_mem = jnp.split(h, [qa, qa + kva, qa + 2 * kva], axis=-1)
            mix = swa_sink_attention(q.reshape(B, S, SWA_Q_HEADS, HEAD_DIM),
                                     k.reshape(B, S, SWA_KV_HEADS, HEAD_DIM),
                                     v.reshape(B, S, SWA_KV_HEADS, HEAD_DIM),
                                     sinks[j], slopes_a)
        else:
            h = x @ w_in_b[j]
            q, k, v, q_mem = jnp.split(h, [qb, 2 * qb, 2 * qb + vb], axis=-1)
            lam_init = 0.8 - 0.6 * math.exp(-0.3 * i)
            lp = lambda_qk[j].astype(jnp.float32)
            lam = jnp.exp(jnp.sum(lp[0] * lp[1])) - jnp.exp(jnp.sum(lp[2] * lp[3])) + lam_init
            o = diff_attention(q.reshape(B, S, DIFF_HEADS, 2, HEAD_DIM),
                               k.reshape(B, S, DIFF_HEADS, 2, HEAD_DIM),
                               v.reshape(B, S, DIFF_HEADS, DIFF_V_DIM), lam, slopes_b)
            mix = (rms_norm(o, subln_g[j]) * (1.0 - lam_init)).reshape(B, S, vb)
        mem_out = memory_attention(q_mem.reshape(B, S, MEM_HEADS, HEAD_DIM), mem, w_mem_kv[i])
        y = jnp.concatenate([mix, mem_out], axis=-1) @ w_out[i]
        x = layer_norm(DN_ALPHA * x + y, ln_g[i, 0], ln_b[i, 0])
        f = moe_ffn(x, w_router[i], router_bias[i], w_gate[i], w_up[i], w_down[i],
                    w_shared_gate[i], w_shared_up[i], w_shared_down[i])
        x = layer_norm(DN_ALPHA * x + f, ln_g[i, 1], ln_b[i, 1])
    return x
```

```cpp
#include <hip/hip_runtime.h>
#include <hip/hip_bf16.h>
#include <cstdio>
#include <cstdint>
#include <cmath>

namespace pg8 {
#define PG8_LAS __attribute__((address_space(3)))
typedef unsigned short bf16_t;
typedef short bf16x8 __attribute__((ext_vector_type(8)));
typedef float f32x4 __attribute__((ext_vector_type(4)));
typedef unsigned u32x4 __attribute__((ext_vector_type(4)));
constexpr int BM = 256, BK = 64, HALF = 128, HTB = HALF * BK * 2  , STAGE_BYTES = 8 * HTB, NXCD = 8, WGM = 8;
constexpr int EXPERT_BYTES = 3 * 1024 * 256 * 2;
constexpr int EXPERT_DOWN_OFF = 2 * 1024 * 256 * 2;

__host__ __device__ __forceinline__ int lds_byte(int r, int c) { const int st = (r >> 4) * 2 + (c >> 5), rr = r & 15, cc = c & 31, ob = rr * 64 + cc * 2; return st * 1024 + (ob ^ (((ob >> 9) & 1) << 5)); }
__host__ __device__ __forceinline__ void stage_rc(int b, int& R, int& C) { const int st = b / 1024, sb = b % 1024, swz = sb ^ (((sb >> 9) & 1) << 5); R = (st >> 1) * 16 + swz / 64; C = (st & 1) * 32 + (swz % 64) / 2; }
__host__ __device__ __forceinline__ int perm32(int rho) { const int n = rho >> 4, i = rho & 15; return 8 * (i >> 2) + 4 * n + (i & 3); }

struct Unit { int pm, pn, e, nvalid, lbase, pos0, slot; };

struct StaticOrder {
    int nM, nN, nwg, G, c;
    __device__ __forceinline__ void init(int M, int N, int G_, int c_) { nM = M / BM; nN = N / BM; nwg = nM * nN; G = G_; c = c_; }
    __device__ __forceinline__ bool next(int i, Unit& u) const {
        const long L = (long)i * G + c; if (L >= nwg) return false;
        int wgid = (int)L; { const int q = nwg / NXCD, r = nwg % NXCD, xcd = wgid % NXCD, off = wgid / NXCD; wgid = (xcd < r ? xcd * (q + 1) : r * (q + 1) + (xcd - r) * q) + off; }
        const int nig = WGM * nN, gid = wgid / nig, fm = gid * WGM, gsz = (nM - fm) < WGM ? (nM - fm) : WGM;
        u.pm = fm + ((wgid % nig) % gsz); u.pn = (wgid % nig) / gsz; return true;
    }
};
struct DenseSched {
    StaticOrder o; const char* Bt; int K;
    __device__ __forceinline__ void init(int M, int N, int K_, int G, int c, const bf16_t* Bt_) { o.init(M, N, G, c); Bt = (const char*)Bt_; K = K_; }
    __device__ __forceinline__ bool next(int i, Unit& u) const { u.e = 0; u.nvalid = 256; u.lbase = 0; u.pos0 = 0; u.slot = 0; return o.next(i, u); }
    __device__ __forceinline__ const char* bptr(const Unit& u) const { return Bt + (size_t)u.pn * (BM * 2) * K; }
    __device__ __forceinline__ void avoff(const Unit& u, int tid, unsigned (&v)[2][2]) const {
#pragma unroll
        for (int i = 0; i < 2; ++i) { int R, C; stage_rc(tid * 16 + i * 8192, R, C);
#pragma unroll
            for (int h = 0; h < 2; ++h) v[h][i] = (unsigned)((u.pm * BM + h * HALF + R) * K + C) * 2u; }
    }
};
template <bool GATHER> struct GroupSched {
    const PG8_LAS int* utab; const PG8_LAS int* idx; int nmine, K; const char* W;
    __device__ __forceinline__ bool next(int i, Unit& u) const {
        if (i >= nmine) return false; const PG8_LAS int* t = utab + i * 8;
        u.e = __builtin_amdgcn_readfirstlane(t[0]); u.pm = __builtin_amdgcn_readfirstlane(t[1]); u.pn = __builtin_amdgcn_readfirstlane(t[2]);
        u.nvalid = __builtin_amdgcn_readfirstlane(t[3]); u.lbase = __builtin_amdgcn_readfirstlane(t[4]); u.pos0 = __builtin_amdgcn_readfirstlane(t[5]); u.slot = i; return true;
    }
    __device__ __forceinline__ const char* bptr(const Unit& u) const { return W + (size_t)u.e * EXPERT_BYTES + (size_t)u.pn * (BM * 2) * K; }
    __device__ __forceinline__ void avoff(const Unit& u, int tid, unsigned (&v)[2][2]) const {
#pragma unroll
        for (int i = 0; i < 2; ++i) { int R, C; stage_rc(tid * 16 + i * 8192, R, C);
#pragma unroll
            for (int h = 0; h < 2; ++h) {
                const int row = GATHER ? idx[u.slot * 256 + h * HALF + R] : (u.pm * BM + h * HALF + R);
                v[h][i] = (unsigned)(row * K + C) * 2u; } }
    }
};

typedef float f32x2v __attribute__((ext_vector_type(2))); typedef __bf16 bf16x2v __attribute__((ext_vector_type(2)));
__device__ __forceinline__ unsigned cvt_pk_bf16(float lo, float hi) { f32x2v v = {lo, hi}; bf16x2v b = __builtin_convertvector(v, bf16x2v); return __builtin_bit_cast(unsigned, b); }

struct EpiBf16 {
    static constexpr bool PERM = true;
    bf16_t* O; int ldc; int nsc; float scale;
    __device__ __forceinline__ void operator()(const f32x4 (&acc)[2][2][4][2], const Unit& u, int wr, int wc, int fr, int fq) const {
        const int row0 = u.pm * BM + wr * 64 + fr; const int col0 = u.pn * BM + wc * 32 + 8 * fq; const float sc = (u.pn < nsc) ? scale : 1.f;
#pragma unroll
        for (int ai = 0; ai < 2; ++ai)
#pragma unroll
            for (int m = 0; m < 4; ++m) { bf16_t* rowp = O + (size_t)(row0 + ai * HALF + m * 16) * ldc + col0;
#pragma unroll
                for (int bj = 0; bj < 2; ++bj) { const f32x4 v0 = acc[ai][bj][m][0] * sc, v1 = acc[ai][bj][m][1] * sc;
                    u32x4 w; w.x = cvt_pk_bf16(v0[0], v0[1]); w.y = cvt_pk_bf16(v0[2], v0[3]); w.z = cvt_pk_bf16(v1[0], v1[1]); w.w = cvt_pk_bf16(v1[2], v1[3]);
                    *(u32x4*)(rowp + bj * HALF) = w; } }
    }
};
struct EpiRouter {
    static constexpr bool PERM = false;
    float* L;
    __device__ __forceinline__ void operator()(const f32x4 (&acc)[2][2][4][2], const Unit& u, int wr, int wc, int fr, int fq) const {
        if (wc >= 2) return;
        const int row0 = u.pm * BM + wr * 64 + fr;
#pragma unroll
        for (int ai = 0; ai < 2; ++ai)
#pragma unroll
            for (int m = 0; m < 4; ++m) { float* rowp = L + (size_t)(row0 + ai * HALF + m * 16) * 64 + wc * 32 + 4 * fq;
#pragma unroll
                for (int n = 0; n < 2; ++n) *(f32x4*)(rowp + 16 * n) = acc[ai][0][m][n]; }
    }
};
__device__ __forceinline__ float silu_f(float x) { return x * __builtin_amdgcn_rcpf(1.0f + __builtin_amdgcn_exp2f(-1.4426950408889634f * x)); }
struct EpiM1 {
    static constexpr bool PERM = true;
    bf16_t* H; const PG8_LAS float* lgate;
    __device__ __forceinline__ void operator()(const f32x4 (&acc)[2][2][4][2], const Unit& u, int wr, int wc, int fr, int fq) const {
        const int col0 = u.pn * HALF + wc * 32 + 8 * fq; const PG8_LAS float* lg = lgate + u.slot * 256;
#pragma unroll
        for (int ai = 0; ai < 2; ++ai)
#pragma unroll
            for (int m = 0; m < 4; ++m) { const int r = ai * HALF + wr * 64 + m * 16 + fr;
                const float g = lg[r];
                const f32x4 ga = acc[ai][0][m][0], gb = acc[ai][0][m][1], ua = acc[ai][1][m][0], ub = acc[ai][1][m][1];
                f32x4 v0, v1;
#pragma unroll
                for (int j = 0; j < 4; ++j) { v0[j] = silu_f(ga[j]) * ua[j] * g; v1[j] = silu_f(gb[j]) * ub[j] * g; }
                u32x4 w; w.x = cvt_pk_bf16(v0[0], v0[1]); w.y = cvt_pk_bf16(v0[2], v0[3]); w.z = cvt_pk_bf16(v1[0], v1[1]); w.w = cvt_pk_bf16(v1[2], v1[3]);
                *(u32x4*)(H + (size_t)(u.pm * BM + r) * 256 + col0) = w; }
    }
};
constexpr float Y8_SCALE = 16.f;
typedef unsigned u32x2e __attribute__((ext_vector_type(2)));
struct EpiM2 {
    static constexpr bool PERM = true;
    unsigned char* Y; const PG8_LAS int* ldst;
    __device__ __forceinline__ void operator()(const f32x4 (&acc)[2][2][4][2], const Unit& u, int wr, int wc, int fr, int fq) const {
        const int col0 = u.pn * BM + wc * 32 + 8 * fq; const PG8_LAS int* ld = ldst + u.slot * 256;
#pragma unroll
        for (int ai = 0; ai < 2; ++ai)
#pragma unroll
            for (int m = 0; m < 4; ++m) { const int r = ai * HALF + wr * 64 + m * 16 + fr;
                const int dst = ld[r];
                if (dst >= 0) {
                    unsigned char* rowp = Y + (size_t)dst * 1024 + col0;
#pragma unroll
                    for (int bj = 0; bj < 2; ++bj) { const f32x4 v0 = acc[ai][bj][m][0] * Y8_SCALE, v1 = acc[ai][bj][m][1] * Y8_SCALE;
                        int w0 = __builtin_amdgcn_cvt_pk_fp8_f32(v0[0], v0[1], 0, false); w0 = __builtin_amdgcn_cvt_pk_fp8_f32(v0[2], v0[3], w0, true);
                        int w1 = __builtin_amdgcn_cvt_pk_fp8_f32(v1[0], v1[1], 0, false); w1 = __builtin_amdgcn_cvt_pk_fp8_f32(v1[2], v1[3], w1, true);
                        *(u32x2e*)(rowp + bj * HALF) = (u32x2e){(unsigned)w0, (unsigned)w1}; } } }
    }
};

template <class Epi, class Sched>
__device__ __forceinline__ void gemm_phase(PG8_LAS unsigned char* lds, const bf16_t* Abase, const int K, const Sched& S, const Epi& E) {
    int tid = threadIdx.x; asm volatile("" : "+v"(tid));
    const int wid = __builtin_amdgcn_readfirstlane(tid >> 6), lane = tid & 63, wr = wid >> 2, wc = wid & 3, fr = lane & 15, fq = lane >> 4;
    const int nt = K / BK;
    unsigned voffB[2];
#pragma unroll
    for (int i = 0; i < 2; ++i) { int R, C; stage_rc(tid * 16 + i * 8192, R, C); const int Rb = Epi::PERM ? ((R & ~31) + perm32(R & 31)) : R; voffB[i] = (unsigned)(Rb * K + C) * 2u; }
    const size_t kstep = (size_t)(BK * 2);
    const size_t hstep = (size_t)HALF * K * 2;
    const unsigned ldsw = (unsigned)wid * 1024u;
    const int aoff = lds_byte(wr * 64 + fr, fq * 8), boff = lds_byte(wc * 32 + fr, fq * 8);
    const char* Ab = (const char*)Abase;
#define PG8_SA(b, h) (((b) * 2 + (h)) * HTB)
#define PG8_SB(b, h) ((4 + (b) * 2 + (h)) * HTB)
#define PG8_STAGE(bufoff, gbase, voff) do { _Pragma("unroll") for (int _i = 0; _i < 2; ++_i) \
        __builtin_amdgcn_global_load_lds((const unsigned*)((const char*)(gbase) + (voff)[_i]), (PG8_LAS unsigned*)(lds + (bufoff) + ldsw + _i * 8192), 16, 0, 0); } while (0)
#define PG8_STAGEA(bufoff, kb, V, h) do { _Pragma("unroll") for (int _i = 0; _i < 2; ++_i) \
        __builtin_amdgcn_global_load_lds((const unsigned*)(Ab + (kb) + (V)[h][_i]), (PG8_LAS unsigned*)(lds + (bufoff) + ldsw + _i * 8192), 16, 0, 0); } while (0)
#define PG8_LDA(dst, b, h) do { _Pragma("unroll") for (int m = 0; m < 4; ++m) _Pragma("unroll") for (int k = 0; k < 2; ++k) dst[m][k] = *(const PG8_LAS bf16x8*)(lds + PG8_SA(b, h) + aoff + m * 2048 + k * 1024); } while (0)
#define PG8_LDB(dst, b, h) do { _Pragma("unroll") for (int n = 0; n < 2; ++n) _Pragma("unroll") for (int k = 0; k < 2; ++k) dst[n][k] = *(const PG8_LAS bf16x8*)(lds + PG8_SB(b, h) + boff + n * 2048 + k * 1024); } while (0)
#define PG8_MMA(ai, bj, At, Bt) do { __builtin_amdgcn_s_setprio(1); _Pragma("unroll") for (int m = 0; m < 4; ++m) _Pragma("unroll") for (int n = 0; n < 2; ++n) _Pragma("unroll") for (int k = 0; k < 2; ++k) \
        acc[ai][bj][m][n] = __builtin_amdgcn_mfma_f32_16x16x32_bf16(Bt[n][k], At[m][k], acc[ai][bj][m][n], 0, 0, 0); __builtin_amdgcn_s_setprio(0); } while (0)
#define PG8_WAIT_V(n) asm volatile("s_waitcnt vmcnt(" #n ")" ::: "memory")
#define PG8_WAIT_L(n) asm volatile("s_waitcnt lgkmcnt(" #n ")" ::: "memory")
#define PG8_BAR __builtin_amdgcn_s_barrier()
#define PG8_SCHED __builtin_amdgcn_sched_barrier(0)
    Unit cur, nxt; int ui = 0;
    if (!S.next(0, cur)) return;
    nxt = cur;
    f32x4 acc[2][2][4][2];
#pragma unroll
    for (int a = 0; a < 2; ++a)
#pragma unroll
        for (int b = 0; b < 2; ++b)
#pragma unroll
            for (int m = 0; m < 4; ++m)
#pragma unroll
                for (int n = 0; n < 2; ++n) acc[a][b][m][n] = (f32x4){0.f, 0.f, 0.f, 0.f};
    bf16x8 At[4][2], B0[2][2], B1[2][2];
    unsigned vA[2][2];
    S.avoff(cur, tid, vA);
    const char* cB = S.bptr(cur);
    PG8_STAGE(PG8_SB(0, 0), cB, voffB); PG8_STAGE(PG8_SB(0, 1), cB + hstep, voffB); PG8_STAGEA(PG8_SA(0, 0), 0, vA, 0); PG8_STAGEA(PG8_SA(0, 1), 0, vA, 1);
    if (wr == 1) PG8_BAR;
    PG8_WAIT_V(2); PG8_BAR;
    PG8_STAGE(PG8_SB(1, 0), cB + kstep, voffB); PG8_STAGEA(PG8_SA(1, 0), kstep, vA, 0); PG8_STAGE(PG8_SB(1, 1), cB + hstep + kstep, voffB);
    PG8_WAIT_V(6); PG8_BAR;
    for (;;) {
        const bool has_next = S.next(ui + 1, nxt);
        const char* nB = cB;
        if (has_next) nB = S.bptr(nxt);
#pragma unroll 1
        for (int t = 0; t < nt; t += 2) {
            const bool last = (t == nt - 2);
            const size_t kb1 = (size_t)(t + 1) * kstep;
            const size_t kb2 = last ? (size_t)0 : (size_t)(t + 2) * kstep; const char* b2 = last ? nB : cB + (size_t)(t + 2) * kstep;
            const size_t kb3 = kb2 + kstep; const char* b3 = b2 + kstep;
            PG8_LDB(B0, 0, 0); PG8_LDB(B1, 0, 1); PG8_SCHED; PG8_LDA(At, 0, 0); PG8_STAGEA(PG8_SA(1, 1), kb1, vA, 1);
            if (last && has_next) S.avoff(nxt, tid, vA);
            PG8_WAIT_V(8); PG8_WAIT_L(0); PG8_BAR; PG8_MMA(0, 0, At, B0); PG8_MMA(0, 1, At, B1); PG8_BAR; PG8_SCHED;
            PG8_LDA(At, 0, 1); PG8_STAGE(PG8_SB(0, 0), b2, voffB); PG8_STAGE(PG8_SB(0, 1), b2 + hstep, voffB); PG8_STAGEA(PG8_SA(0, 0), kb2, vA, 0);
            PG8_WAIT_V(8); PG8_WAIT_L(0); PG8_BAR; PG8_MMA(1, 0, At, B0); PG8_MMA(1, 1, At, B1); PG8_BAR; PG8_SCHED;
            PG8_LDB(B0, 1, 0); PG8_LDB(B1, 1, 1); PG8_SCHED; PG8_LDA(At, 1, 0); PG8_STAGEA(PG8_SA(0, 1), kb2, vA, 1);
            PG8_WAIT_V(8); PG8_WAIT_L(0); PG8_BAR; PG8_MMA(0, 0, At, B0); PG8_MMA(0, 1, At, B1); PG8_BAR; PG8_SCHED;
            PG8_LDA(At, 1, 1); PG8_STAGE(PG8_SB(1, 0), b3, voffB); PG8_STAGE(PG8_SB(1, 1), b3 + hstep, voffB); PG8_STAGEA(PG8_SA(1, 0), kb3, vA, 0);
            PG8_WAIT_V(8); PG8_WAIT_L(0); PG8_BAR; PG8_MMA(1, 0, At, B0); PG8_MMA(1, 1, At, B1); PG8_BAR; PG8_SCHED;
        }
        if (wr == 0) PG8_BAR;
        E(acc, cur, wr, wc, fr, fq);
        if (!has_next) break;
#pragma unroll
        for (int a = 0; a < 2; ++a)
#pragma unroll
            for (int b = 0; b < 2; ++b)
#pragma unroll
                for (int m = 0; m < 4; ++m)
#pragma unroll
                    for (int n = 0; n < 2; ++n) acc[a][b][m][n] = (f32x4){0.f, 0.f, 0.f, 0.f};
        cur = nxt; cB = nB; ++ui;
        if (wr == 1) PG8_BAR;
    }
    PG8_WAIT_V(0);
    PG8_BAR;
#undef PG8_SA
#undef PG8_SB
#undef PG8_STAGE
#undef PG8_STAGEA
#undef PG8_LDA
#undef PG8_LDB
#undef PG8_MMA
#undef PG8_WAIT_V
#undef PG8_WAIT_L
#undef PG8_BAR
#undef PG8_SCHED
}
}
namespace attn_body {
using bf16=__hip_bfloat16;
using bf16x8=__attribute__((ext_vector_type(8)))short;
using s16x4=__attribute__((ext_vector_type(4)))short;
using f32x16=__attribute__((ext_vector_type(16)))float;
using u32x4=__attribute__((ext_vector_type(4)))unsigned;
constexpr int D=64,NW=8,QBLK=32,QB=QBLK*NW,KVBLK=64;
__device__ __forceinline__ int crow(int r,int hi){return (r&3)+8*(r>>2)+4*hi;}
#define SBAR() __builtin_amdgcn_sched_barrier(0)
constexpr int NSLOT=3, SLOTB=8192;
constexpr int LDS_K=0, LDS_V=NSLOT*SLOTB, LDS_WS=2*NSLOT*SLOTB, LDS_OST=LDS_WS+NW*64*4, LDS_BYTES=LDS_OST+NW*4096;
constexpr float LOG2E=1.4426950408889634f;
constexpr float C2=0.125f*LOG2E;
__device__ __forceinline__ void glds16(const void*gsrc,unsigned lds_dst){unsigned keep;
  asm volatile("s_mov_b32 %0, m0\n\ts_mov_b32 m0, %2\n\ts_nop 0\n\tglobal_load_lds_dwordx4 %1, off\n\ts_mov_b32 m0, %0":"=&s"(keep):"v"(gsrc),"s"(lds_dst):"memory");}
__device__ __forceinline__ float max3f(float a,float b,float c){float r;asm("v_max3_f32 %0, %1, %2, %3":"=v"(r):"v"(a),"v"(b),"v"(c));return r;}
__device__ __forceinline__ float max2f(float a,float b){float r;asm("v_max_f32_e32 %0, %1, %2":"=v"(r):"v"(a),"v"(b));return r;}
__device__ __forceinline__ float fadd_s(float a,float b){float r;asm("v_add_f32_e32 %0, %1, %2":"=v"(r):"v"(a),"v"(b));return r;}
__device__ __forceinline__ float fsub_s(float a,float b){float r;asm("v_sub_f32_e32 %0, %1, %2":"=v"(r):"v"(a),"v"(b));return r;}
typedef float f32x2_t __attribute__((ext_vector_type(2))); typedef __bf16 bf16x2_t __attribute__((ext_vector_type(2)));
__device__ __forceinline__ unsigned cvtpk_s(float lo,float hi){f32x2_t v={lo,hi};bf16x2_t b=__builtin_convertvector(v,bf16x2_t);return __builtin_bit_cast(unsigned,b);}
#define WAIT_BAR(N) asm volatile("s_waitcnt vmcnt(" #N ") lgkmcnt(0)\n\ts_barrier":::"memory")

template<int MODE> __device__ __forceinline__ void maskbias(f32x16&p0,f32x16&p1,int kb,int qrel,float slope2,float mhat,bool band,bool tile_ok){
  if(MODE==0)return;
  const float NEG=-INFINITY; const float lb=slope2*(float)(kb-qrel)-mhat;
  #pragma unroll
  for(int r=0;r<16;++r){const int c=(r&3)+8*(r>>2); p0[r]=__builtin_fmaf(slope2,(float)c,p0[r]+lb); p1[r]=__builtin_fmaf(slope2,(float)(c+32),p1[r]+lb);}
  if(MODE==1){ if(band){
    #pragma unroll
    for(int r=0;r<16;++r){const int kv=kb+(r&3)+8*(r>>2); if(kv>qrel)p0[r]=NEG; if(kv+32>qrel)p1[r]=NEG;} } }
  if(MODE==2){
    #pragma unroll
    for(int r=0;r<16;++r){const int d=qrel-kb-((r&3)+8*(r>>2)); if((unsigned)d>=128u||!tile_ok)p0[r]=NEG; if((unsigned)(d-32)>=128u||!tile_ok)p1[r]=NEG;} }
}

__device__ __forceinline__ void qkt(f32x16&p0,f32x16&p1,const char*Kslot,const bf16x8*qr,const f32x16&negm,int r32,int hi){
  const char*kb=Kslot+hi*1024+r32*16;
  #pragma unroll
  for(int d0=0;d0<4;++d0){
    const bf16x8 b0=*reinterpret_cast<const bf16x8*>(kb+d0*2048);
    const bf16x8 b1=*reinterpret_cast<const bf16x8*>(kb+d0*2048+512);
    if(d0==0){p0=__builtin_amdgcn_mfma_f32_32x32x16_bf16(b0,qr[0],negm,0,0,0);p1=__builtin_amdgcn_mfma_f32_32x32x16_bf16(b1,qr[0],negm,0,0,0);}
    else{p0=__builtin_amdgcn_mfma_f32_32x32x16_bf16(b0,qr[d0],p0,0,0,0);p1=__builtin_amdgcn_mfma_f32_32x32x16_bf16(b1,qr[d0],p1,0,0,0);}}
}
typedef __attribute__((address_space(3))) const char* lds_cptr;
typedef short v4i16_t __attribute__((ext_vector_type(4)));
__device__ __forceinline__ void kload8(bf16x8*kf,lds_cptr kp){
  kf[0]=*(const __attribute__((address_space(3))) bf16x8*)(kp);      kf[1]=*(const __attribute__((address_space(3))) bf16x8*)(kp+512);
  kf[2]=*(const __attribute__((address_space(3))) bf16x8*)(kp+2048); kf[3]=*(const __attribute__((address_space(3))) bf16x8*)(kp+2560);
  kf[4]=*(const __attribute__((address_space(3))) bf16x8*)(kp+4096); kf[5]=*(const __attribute__((address_space(3))) bf16x8*)(kp+4608);
  kf[6]=*(const __attribute__((address_space(3))) bf16x8*)(kp+6144); kf[7]=*(const __attribute__((address_space(3))) bf16x8*)(kp+6656);
}
__device__ __forceinline__ void kload2(bf16x8*kf,lds_cptr kp,int j){ kf[2*j]=*(const __attribute__((address_space(3))) bf16x8*)(kp+j*2048); kf[2*j+1]=*(const __attribute__((address_space(3))) bf16x8*)(kp+j*2048+512); }
__device__ __forceinline__ s16x4 vtr(lds_cptr p){ return __builtin_bit_cast(s16x4,__builtin_amdgcn_ds_read_tr16_b64_v4i16((__attribute__((address_space(3))) v4i16_t*)p)); }
__device__ __forceinline__ float rowmax(const f32x16&p0,const f32x16&p1){
  float a=max3f(p0[0],p0[1],p1[0]),b=max3f(p0[2],p0[3],p1[1]);a=max3f(a,p1[2],p1[3]);
  #pragma unroll
  for(int r=4;r<16;r+=4){a=max3f(a,p0[r],p0[r+1]);b=max3f(b,p0[r+2],p0[r+3]);a=max3f(a,p1[r],p1[r+1]);b=max3f(b,p1[r+2],p1[r+3]);}
  const float m=max2f(a,b);
  auto rr=__builtin_amdgcn_permlane32_swap(__float_as_uint(m),__float_as_uint(m),false,false);
  return max2f(__uint_as_float(rr[0]),__uint_as_float(rr[1]));
}
__device__ __forceinline__ void pv(f32x16*o,int vb,bf16x8 pa0,bf16x8 pa1,bf16x8 pa2,bf16x8 pa3){
  #pragma unroll
  for(int d0=0;d0<2;++d0){s16x4 lo[4],hi[4];
    #pragma unroll
    for(int ks=0;ks<4;++ks){
      asm volatile("ds_read_b64_tr_b16 %0,%1 offset:%c2":"=&v"(lo[ks]):"v"(vb),"i"(d0*4096+ks*1024):"memory");
      asm volatile("ds_read_b64_tr_b16 %0,%1 offset:%c2":"=&v"(hi[ks]):"v"(vb),"i"(d0*4096+ks*1024+512):"memory");}
    asm volatile("s_waitcnt lgkmcnt(0)":::"memory");SBAR();
    #define PK(k) (bf16x8){lo[k][0],lo[k][1],lo[k][2],lo[k][3],hi[k][0],hi[k][1],hi[k][2],hi[k][3]}
    o[d0]=__builtin_amdgcn_mfma_f32_32x32x16_bf16(pa0,PK(0),o[d0],0,0,0);
    o[d0]=__builtin_amdgcn_mfma_f32_32x32x16_bf16(pa1,PK(1),o[d0],0,0,0);
    o[d0]=__builtin_amdgcn_mfma_f32_32x32x16_bf16(pa2,PK(2),o[d0],0,0,0);
    o[d0]=__builtin_amdgcn_mfma_f32_32x32x16_bf16(pa3,PK(3),o[d0],0,0,0);
    #undef PK
  }
}
struct AttnArgs {
  const bf16* Qw;
  const bf16* K0; const bf16* V0;
  int NT;
  int tmax;
  bf16* Ow;
  int qrel;
  float slope2, sink2;
};
#define ATTN_STORE16(p,v) (*(u32x4*)(p)=(v))
template<int MODE,int THRL,int QP,int KVP,int OP> __device__ __forceinline__ void attn_unit(const AttnArgs&a,char*shm){
  int tid=threadIdx.x; asm volatile("":"+v"(tid)); const int lane=tid&63,r32=lane&31,hi=lane>>5; const int wid=__builtin_amdgcn_readfirstlane(tid>>6);
  const bf16*Qw=a.Qw; constexpr int qp=QP; constexpr long kvp=KVP;
  const unsigned lds0=(unsigned)(uintptr_t)shm;
  float*wsf=(float*)(shm+LDS_WS)+wid*64;
  const bf16*ksrc=a.K0+(long)lane*kvp+wid*8;
  const bf16*vsrc=a.V0+(long)(16*(wid&3)+(lane>>2))*kvp+(wid>>2)*32+(lane&3)*8;
  const unsigned kdst=lds0+LDS_K+wid*1024, vdst=lds0+LDS_V+wid*1024;
  const int tmax=a.tmax;
  #define TROW(t) ((MODE==2)?(-64*(((t)<tmax)?(t):tmax)):(64*(t)))
  #define DMA_K(t,slot) glds16(ksrc+(long)TROW(t)*kvp,(unsigned)__builtin_amdgcn_readfirstlane(kdst+(slot)))
  #define DMA_V(t,slot) glds16(vsrc+(long)TROW(t)*kvp,(unsigned)__builtin_amdgcn_readfirstlane(vdst+(slot)))
  const int vb0=(int)(lds0+LDS_V)+((lane>>4)&1)*32+(lane&3)*8+(4*hi+((lane&15)>>2))*64;
  const char*Kbase=shm+LDS_K; bf16x8 kf[8];
  const lds_cptr shm3=(lds_cptr)shm; const lds_cptr kp0=shm3+LDS_K+hi*1024+r32*16; const lds_cptr vp0=shm3+LDS_V+((lane>>4)&1)*32+(lane&3)*8+(4*hi+((lane&15)>>2))*64;
  const int NT=a.NT;
  DMA_K(0,0);DMA_V(0,0);DMA_K(1,SLOTB);
  bf16x8 qr[4];
  #pragma unroll
  for(int d0=0;d0<4;++d0)qr[d0]=*reinterpret_cast<const bf16x8*>(&Qw[(long)r32*qp+d0*16+hi*8]);
  float mhat=0.f,l_reg=0.f;f32x16 o[2];o[0]=f32x16{};o[1]=f32x16{};f32x16 negm=f32x16{};if(MODE==0)asm volatile("":"+v"(negm));
  const int qrel=a.qrel; const float slope2=a.slope2;
  #define KBREL(t) ((MODE==2)?(-64*(t)):(64*((t)-(NT-4))))
  #define MBIAS(P0,P1,t,BAND) maskbias<MODE>(P0,P1,KBREL(t)+4*hi,qrel,slope2,mhat,(BAND)&&((t)>=NT-4),(t)<=tmax)
  #define CINIT ((MODE==0)?negm:(f32x16{}))
  #define CMASK(P0,P1,t) MBIAS(P0,P1,t,true)
  bool resc=false;
  #define START(P0,P1) do{ const float rm=rowmax(P0,P1); resc=false; \
    { const float dl=rm; mhat=fadd_s(mhat,dl); \
      _Pragma("unroll") for(int r=0;r<16;++r){P0[r]=fsub_s(P0[r],dl);P1[r]=fsub_s(P1[r],dl);} \
      if(MODE==0){ _Pragma("unroll") for(int r=0;r<16;++r)negm[r]=-mhat; asm volatile("":"+v"(negm)); } } \
    _Pragma("unroll") for(int r=0;r<16;++r)P0[r]=__builtin_amdgcn_exp2f(P0[r]); }while(0)
  #define RESC() do{ if(resc){ asm volatile("s_waitcnt lgkmcnt(0)":::"memory"); \
      _Pragma("unroll") for(int d_=0;d_<2;++d_) _Pragma("unroll") for(int r=0;r<16;++r)o[d_][r]*=wsf[crow(r,hi)]; } }while(0)
  f32x16 pA0,pA1,pB0,pB1;
  int sl_prev=0,sl_cur=0,sl_next=SLOTB;
  #define ROT() do{sl_prev=sl_cur;sl_cur=sl_next;sl_next=(sl_next==(NSLOT-1)*SLOTB)?0:sl_next+SLOTB;}while(0)
  DMA_K(2,2*SLOTB);
  WAIT_BAR(3);
  qkt(pA0,pA1,Kbase,qr,negm,r32,hi);asm volatile("s_nop 15\n\ts_nop 7":"+v"(pA0),"+v"(pA1));CMASK(pA0,pA1,0);
  START(pA0,pA1);
  _Pragma("unroll") for(int r=0;r<16;++r)pA1[r]=__builtin_amdgcn_exp2f(pA1[r]);
  WAIT_BAR(0);
  DMA_K(3,0);DMA_V(1,SLOTB);
  ROT();
  kload8(kf,kp0+sl_cur);
  WAIT_BAR(2);
  s16x4 vlo[8],vhi[8]; u32x4 pw0,pw1,pw2,pw3;
  #define PKW(P,B) cvtpk_s(P[B],P[B+1])
  #define PAF(k) __builtin_bit_cast(bf16x8,pw##k)
  #define VFR(i) (bf16x8){vlo[i][0],vlo[i][1],vlo[i][2],vlo[i][3],vhi[i][0],vhi[i][1],vhi[i][2],vhi[i][3]}
  #define PIN(x) asm volatile("":"+v"(x))
  #define MX3(a,b,c) __builtin_fmaxf(__builtin_fmaxf((a),(b)),(c))
  #define GAPA(MF,A0,A1,A2,A3,W0,W1,PW) do{ MF; sacc+=A0; sacc+=A1; sacc+=A2; sacc+=A3; PIN(sacc); W0; W1; PIN(PW); SBAR(); }while(0)
  #define EX(v) __builtin_amdgcn_exp2f(v)
  #define GAPB(MF,X,B) do{ MF; X[B]=EX(X[B]); X[B+1]=EX(X[B+1]); X[B+2]=EX(X[B+2]); X[B+3]=EX(X[B+3]); PIN(X); SBAR(); }while(0)
  #define VRD(i) do{ vlo[i]=vtr(vp_+(((i)>>2)*4096+((i)&3)*1024)); vhi[i]=vtr(vp_+(((i)>>2)*4096+((i)&3)*1024+512)); }while(0)
  #define KRD(G,j) do{ if(G){ kload2(kf,kp0+sl_next,j); SBAR(); } }while(0)
  #define STEP(C0,C1,P0,P1,t,GK,GV,GL) do{ SBAR(); \
    const lds_cptr vp_=vp0+sl_prev; \
    VRD(0); SBAR(); float sacc=(P0[0]+P0[1]); \
    GAPA(C0=__builtin_amdgcn_mfma_f32_32x32x16_bf16(kf[0],qr[0],CINIT,0,0,0), P0[2],P0[3],P0[4],P0[5],     pw0[0]=PKW(P0,0), pw0[1]=PKW(P0,2), pw0); \
    VRD(4); SBAR(); GAPA(C1=__builtin_amdgcn_mfma_f32_32x32x16_bf16(kf[1],qr[0],CINIT,0,0,0), P0[6],P0[7],P0[8],P0[9],     pw0[2]=PKW(P0,4), pw0[3]=PKW(P0,6), pw0); \
    VRD(1); SBAR(); GAPA(C0=__builtin_amdgcn_mfma_f32_32x32x16_bf16(kf[2],qr[1],C0,0,0,0),   P0[10],P0[11],P0[12],P0[13], pw1[0]=PKW(P0,8), pw1[1]=PKW(P0,10), pw1); \
    VRD(5); SBAR(); GAPA(C1=__builtin_amdgcn_mfma_f32_32x32x16_bf16(kf[3],qr[1],C1,0,0,0),   P0[14],P0[15],P1[0],P1[1],   pw1[2]=PKW(P0,12),pw1[3]=PKW(P0,14), pw1); \
    VRD(2); SBAR(); GAPA(C0=__builtin_amdgcn_mfma_f32_32x32x16_bf16(kf[4],qr[2],C0,0,0,0),   P1[2],P1[3],P1[4],P1[5],     pw2[0]=PKW(P1,0), pw2[1]=PKW(P1,2), pw2); \
    VRD(6); SBAR(); GAPA(C1=__builtin_amdgcn_mfma_f32_32x32x16_bf16(kf[5],qr[2],C1,0,0,0),   P1[6],P1[7],P1[8],P1[9],     pw2[2]=PKW(P1,4), pw2[3]=PKW(P1,6), pw2); \
    VRD(3); SBAR(); GAPA(C0=__builtin_amdgcn_mfma_f32_32x32x16_bf16(kf[6],qr[3],C0,0,0,0),   P1[10],P1[11],P1[12],P1[13], pw3[0]=PKW(P1,8), pw3[1]=PKW(P1,10), pw3); \
    VRD(7); SBAR(); GAPA(C1=__builtin_amdgcn_mfma_f32_32x32x16_bf16(kf[7],qr[3],C1,0,0,0),   P1[14],P1[15],0.f,0.f,       pw3[2]=PKW(P1,12),pw3[3]=PKW(P1,14), pw3); \
    l_reg+=sacc; \
    if(GK){DMA_K((t)+3,sl_cur);} if(GV){DMA_V((t)+1,sl_next);} \
    CMASK(C0,C1,t); \
    { float a_=MX3(C0[0],C0[1],C1[0]),b_=MX3(C0[2],C0[3],C1[1]); a_=MX3(a_,C1[2],C1[3]); \
      _Pragma("unroll") for(int r=4;r<16;r+=4){a_=MX3(a_,C0[r],C0[r+1]);b_=MX3(b_,C0[r+2],C0[r+3]);a_=MX3(a_,C1[r],C1[r+1]);b_=MX3(b_,C1[r+2],C1[r+3]);} \
      float rm=__builtin_fmaxf(a_,b_); { auto rr=__builtin_amdgcn_permlane32_swap(__float_as_uint(rm),__float_as_uint(rm),false,false); rm=__builtin_fmaxf(__uint_as_float(rr[0]),__uint_as_float(rr[1])); } \
      resc=false; \
      if(__builtin_expect(__any(rm>(float)THRL),0)){ const float dl=__builtin_fmaxf(rm,0.f); mhat+=dl; \
        _Pragma("unroll") for(int r=0;r<16;++r){C0[r]-=dl;C1[r]-=dl;} \
        if(MODE==0){ _Pragma("unroll") for(int r=0;r<16;++r)negm[r]=-mhat; asm volatile("":"+v"(negm)); } \
        const float f=__builtin_amdgcn_exp2f(-dl); l_reg*=f; if(hi==0)wsf[r32]=f; resc=true; } } \
    SBAR(); \
    GAPB(o[0]=__builtin_amdgcn_mfma_f32_32x32x16_bf16(PAF(0),VFR(0),o[0],0,0,0), C0,0); \
    GAPB(o[1]=__builtin_amdgcn_mfma_f32_32x32x16_bf16(PAF(0),VFR(4),o[1],0,0,0), C0,4); \
    KRD(GL,0); GAPB(o[0]=__builtin_amdgcn_mfma_f32_32x32x16_bf16(PAF(1),VFR(1),o[0],0,0,0), C0,8); \
    KRD(GL,1); GAPB(o[1]=__builtin_amdgcn_mfma_f32_32x32x16_bf16(PAF(1),VFR(5),o[1],0,0,0), C0,12); \
    KRD(GL,2); GAPB(o[0]=__builtin_amdgcn_mfma_f32_32x32x16_bf16(PAF(2),VFR(2),o[0],0,0,0), C1,0); \
    KRD(GL,3); GAPB(o[1]=__builtin_amdgcn_mfma_f32_32x32x16_bf16(PAF(2),VFR(6),o[1],0,0,0), C1,4); \
    GAPB(o[0]=__builtin_amdgcn_mfma_f32_32x32x16_bf16(PAF(3),VFR(3),o[0],0,0,0), C1,8); \
    GAPB(o[1]=__builtin_amdgcn_mfma_f32_32x32x16_bf16(PAF(3),VFR(7),o[1],0,0,0), C1,12); \
    }while(0)
  int t=1;
  #undef CMASK
  #define CMASK(P0,P1,t) MBIAS(P0,P1,t,false)
  for(;t+5<NT;t+=2){
    STEP(pB0,pB1,pA0,pA1,t,true,true,true);     WAIT_BAR(2); RESC(); ROT();
    STEP(pA0,pA1,pB0,pB1,t+1,true,true,true);   WAIT_BAR(2); RESC(); ROT();
  }
  #undef CMASK
  #define CMASK(P0,P1,t) MBIAS(P0,P1,t,true)
  #define ENDW(tt) do{ if((tt)+3<NT){WAIT_BAR(2);} else if((tt)+2<NT){WAIT_BAR(1);} else {WAIT_BAR(0);} }while(0)
  for(;t+1<NT;t+=2){
    STEP(pB0,pB1,pA0,pA1,t,(t+3<NT),(t+1<NT),(t+1<NT));       ENDW(t);   RESC(); ROT();
    STEP(pA0,pA1,pB0,pB1,t+1,(t+4<NT),(t+2<NT),(t+2<NT));     ENDW(t+1); RESC(); ROT();
  }
  STEP(pB0,pB1,pA0,pA1,NT-1,false,false,false); RESC();
  { float sacc=pB0[0]+pB0[1]; _Pragma("unroll") for(int r=2;r<16;++r)sacc+=pB0[r]; _Pragma("unroll") for(int r=0;r<16;++r)sacc+=pB1[r]; l_reg+=sacc;
    pw0=(u32x4){PKW(pB0,0),PKW(pB0,2),PKW(pB0,4),PKW(pB0,6)};pw1=(u32x4){PKW(pB0,8),PKW(pB0,10),PKW(pB0,12),PKW(pB0,14)};pw2=(u32x4){PKW(pB1,0),PKW(pB1,2),PKW(pB1,4),PKW(pB1,6)};pw3=(u32x4){PKW(pB1,8),PKW(pB1,10),PKW(pB1,12),PKW(pB1,14)};
    SBAR(); pv(o,vb0+sl_cur,PAF(0),PAF(1),PAF(2),PAF(3)); }
  #undef PKW
  #undef PAF
  #undef VFR
  #undef PIN
  #undef MX3
  #undef GAPA
  #undef GAPB
  #undef EX
  #undef VRD
  #undef KRD
  #undef STEP
  #undef ENDW
  {auto rr=__builtin_amdgcn_permlane32_swap(__float_as_uint(l_reg),__float_as_uint(l_reg),false,false);l_reg=__uint_as_float(rr[0])+__uint_as_float(rr[1]);}
  if(MODE==2)l_reg+=__builtin_amdgcn_exp2f(a.sink2-mhat);
  if(hi==0)wsf[32+r32]=l_reg;asm volatile("s_waitcnt lgkmcnt(0)":::"memory");
  float rli[16];
  #pragma unroll
  for(int r=0;r<16;++r)rli[r]=__builtin_amdgcn_rcpf(wsf[32+crow(r,hi)]);
  bf16*Ow=a.Ow; constexpr long op=OP;
  { bf16*stg=(bf16*)(shm+LDS_OST)+wid*2048;
    #pragma unroll
    for(int r=0;r<16;++r){const int orow=crow(r,hi);
      #pragma unroll
      for(int d0=0;d0<2;++d0)stg[orow*64+d0*32+r32]=__float2bfloat16(o[d0][r]*rli[r]);}
    asm volatile("s_waitcnt lgkmcnt(0)":::"memory");
    #pragma unroll
    for(int i=0;i<4;++i){const int row=i*8+(lane>>3),ch=lane&7; const u32x4 v=*(const u32x4*)(stg+row*64+ch*8); ATTN_STORE16(Ow+(long)row*op+ch*8,v);} }
  asm volatile("s_waitcnt lgkmcnt(0)\n\ts_barrier":::"memory");
  #undef DMA_K
  #undef DMA_V
  #undef TROW
  #undef KBREL
  #undef MBIAS
  #undef CINIT
  #undef CMASK
  #undef START
  #undef RESC
  #undef ROT
}

constexpr int DP_K=0, DP_V=3*8192, DP_WS=DP_V+3*16384, DP_BYTES=DP_WS+NW*256;
template<int THRL,int QP,int KVP,int OP> __device__ __forceinline__ void diff_unit(const AttnArgs&a,char*shm){
  int tid=threadIdx.x; asm volatile("":"+v"(tid)); const int lane=tid&63,r32=lane&31,hi=lane>>5; const int wid=__builtin_amdgcn_readfirstlane(tid>>6);
  const bf16*Qw=a.Qw; constexpr int qp=QP; constexpr long kvp=KVP;
  const unsigned lds0=(unsigned)(uintptr_t)shm;
  float*wsf=(float*)(shm+DP_WS)+wid*64;
  const bf16*ksrc=a.K0+(long)lane*kvp+wid*8;
  const bf16*vsrc=a.V0+(long)(16*(wid&3)+(lane>>2))*kvp+(wid>>2)*32+(lane&3)*8;
  const unsigned kdst=lds0+DP_K+wid*1024, vdst=lds0+DP_V+wid*1024;
  #define DMA_K(t,slot) glds16(ksrc+(long)(64*(t))*kvp,(unsigned)__builtin_amdgcn_readfirstlane(kdst+(slot)))
  #define DMA_V(t,slot) do{ glds16(vsrc+(long)(64*(t))*kvp,(unsigned)__builtin_amdgcn_readfirstlane(vdst+2*(slot))); glds16(vsrc+(long)(64*(t))*kvp+64,(unsigned)__builtin_amdgcn_readfirstlane(vdst+2*(slot)+8192)); }while(0)
  const int vb0=(int)(lds0+DP_V)+((lane>>4)&1)*32+(lane&3)*8+(4*hi+((lane&15)>>2))*64;
  const char*Kbase=shm+DP_K; bf16x8 kf[8];
  const lds_cptr shm3=(lds_cptr)shm; const lds_cptr kp0=shm3+DP_K+hi*1024+r32*16; const lds_cptr vp0=shm3+DP_V+((lane>>4)&1)*32+(lane&3)*8+(4*hi+((lane&15)>>2))*64;
  const int NT=a.NT;
  DMA_K(0,0);DMA_V(0,0);DMA_K(1,SLOTB);
  bf16x8 qr[4];
  #pragma unroll
  for(int d0=0;d0<4;++d0)qr[d0]=*reinterpret_cast<const bf16x8*>(&Qw[(long)r32*qp+d0*16+hi*8]);
  float mhat=0.f,l_reg=0.f;f32x16 o[4];o[0]=f32x16{};o[1]=f32x16{};o[2]=f32x16{};o[3]=f32x16{};
  const int qrel=a.qrel; const float slope2=a.slope2;
  #define KBREL(t) (64*((t)-(NT-4)))
  #define MBIAS(P0,P1,t,BAND) maskbias<1>(P0,P1,KBREL(t)+4*hi,qrel,slope2,mhat,(BAND)&&((t)>=NT-4),true)
  #define CMASK(P0,P1,t) MBIAS(P0,P1,t,true)
  bool resc=false;
  #define START(P0,P1) do{ const float rm=rowmax(P0,P1); resc=false; \
    { const float dl=rm; mhat=fadd_s(mhat,dl); \
      _Pragma("unroll") for(int r=0;r<16;++r){P0[r]=fsub_s(P0[r],dl);P1[r]=fsub_s(P1[r],dl);} } \
    _Pragma("unroll") for(int r=0;r<16;++r)P0[r]=__builtin_amdgcn_exp2f(P0[r]); }while(0)
  #define RESC() do{ if(resc){ asm volatile("s_waitcnt lgkmcnt(0)":::"memory"); \
      _Pragma("unroll") for(int d_=0;d_<4;++d_) _Pragma("unroll") for(int r=0;r<16;++r)o[d_][r]*=wsf[crow(r,hi)]; } }while(0)
  f32x16 pA0,pA1,pB0,pB1;
  int sl_prev=0,sl_cur=0,sl_next=SLOTB;
  #define ROT() do{sl_prev=sl_cur;sl_cur=sl_next;sl_next=(sl_next==(NSLOT-1)*SLOTB)?0:sl_next+SLOTB;}while(0)
  DMA_K(2,2*SLOTB);
  WAIT_BAR(4);
  qkt(pA0,pA1,Kbase,qr,f32x16{},r32,hi);asm volatile("s_nop 15\n\ts_nop 7":"+v"(pA0),"+v"(pA1));CMASK(pA0,pA1,0);
  START(pA0,pA1);
  _Pragma("unroll") for(int r=0;r<16;++r)pA1[r]=__builtin_amdgcn_exp2f(pA1[r]);
  WAIT_BAR(0);
  DMA_K(3,0);DMA_V(1,SLOTB);
  ROT();
  kload8(kf,kp0+sl_cur);
  WAIT_BAR(0);
  s16x4 vlo[8],vhi[8]; u32x4 pw0,pw1,pw2,pw3;
  #define PKW(P,B) cvtpk_s(P[B],P[B+1])
  #define PAF(k) __builtin_bit_cast(bf16x8,pw##k)
  #define VFR(i) (bf16x8){vlo[i][0],vlo[i][1],vlo[i][2],vlo[i][3],vhi[i][0],vhi[i][1],vhi[i][2],vhi[i][3]}
  #define PIN(x) asm volatile("":"+v"(x))
  #define MX3(a,b,c) __builtin_fmaxf(__builtin_fmaxf((a),(b)),(c))
  #define GAPA(MF,A0,A1,A2,A3,W0,W1,PW) do{ MF; sacc+=A0; sacc+=A1; sacc+=A2; sacc+=A3; PIN(sacc); W0; W1; PIN(PW); SBAR(); }while(0)
  #define EX(v) __builtin_amdgcn_exp2f(v)
  #define GAPB(MF,X,B) do{ MF; X[B]=EX(X[B]); X[B+1]=EX(X[B+1]); X[B+2]=EX(X[B+2]); X[B+3]=EX(X[B+3]); PIN(X); SBAR(); }while(0)
  #define GAPC(MF) do{ MF; SBAR(); }while(0)
  #define VRD(i) do{ vlo[i]=vtr(vp_+(((i)>>2)*4096+((i)&3)*1024)); vhi[i]=vtr(vp_+(((i)>>2)*4096+((i)&3)*1024+512)); SBAR(); }while(0)
  #define VRD2(i) do{ vlo[i]=vtr(vp_+(8192+((i)>>2)*4096+((i)&3)*1024)); vhi[i]=vtr(vp_+(8192+((i)>>2)*4096+((i)&3)*1024+512)); SBAR(); }while(0)
  #define KRD(G,j) do{ if(G){ kload2(kf,kp0+sl_next,j); SBAR(); } }while(0)
  #define STEP(C0,C1,P0,P1,t,GK,GV,GL) do{ SBAR(); \
    const lds_cptr vp_=vp0+2*sl_prev; \
    float sacc=(P0[0]+P0[1]); \
    GAPA(C0=__builtin_amdgcn_mfma_f32_32x32x16_bf16(kf[0],qr[0],f32x16{},0,0,0), P0[2],P0[3],P0[4],P0[5],     pw0[0]=PKW(P0,0), pw0[1]=PKW(P0,2), pw0); \
    GAPA(C1=__builtin_amdgcn_mfma_f32_32x32x16_bf16(kf[1],qr[0],f32x16{},0,0,0), P0[6],P0[7],P0[8],P0[9],     pw0[2]=PKW(P0,4), pw0[3]=PKW(P0,6), pw0); \
    GAPA(C0=__builtin_amdgcn_mfma_f32_32x32x16_bf16(kf[2],qr[1],C0,0,0,0),   P0[10],P0[11],P0[12],P0[13], pw1[0]=PKW(P0,8), pw1[1]=PKW(P0,10), pw1); \
    GAPA(C1=__builtin_amdgcn_mfma_f32_32x32x16_bf16(kf[3],qr[1],C1,0,0,0),   P0[14],P0[15],P1[0],P1[1],   pw1[2]=PKW(P0,12),pw1[3]=PKW(P0,14), pw1); \
    GAPA(C0=__builtin_amdgcn_mfma_f32_32x32x16_bf16(kf[4],qr[2],C0,0,0,0),   P1[2],P1[3],P1[4],P1[5],     pw2[0]=PKW(P1,0), pw2[1]=PKW(P1,2), pw2); \
    GAPA(C1=__builtin_amdgcn_mfma_f32_32x32x16_bf16(kf[5],qr[2],C1,0,0,0),   P1[6],P1[7],P1[8],P1[9],     pw2[2]=PKW(P1,4), pw2[3]=PKW(P1,6), pw2); \
    GAPA(C0=__builtin_amdgcn_mfma_f32_32x32x16_bf16(kf[6],qr[3],C0,0,0,0),   P1[10],P1[11],P1[12],P1[13], pw3[0]=PKW(P1,8), pw3[1]=PKW(P1,10), pw3); \
    VRD(0); GAPA(C1=__builtin_amdgcn_mfma_f32_32x32x16_bf16(kf[7],qr[3],C1,0,0,0),   P1[14],P1[15],0.f,0.f,       pw3[2]=PKW(P1,12),pw3[3]=PKW(P1,14), pw3); \
    l_reg+=sacc; \
    if(GK){DMA_K((t)+3,sl_cur);} if(GV){DMA_V((t)+1,sl_next);} \
    VRD(4); VRD(1); VRD(5); \
    CMASK(C0,C1,t); \
    { float a_=MX3(C0[0],C0[1],C1[0]),b_=MX3(C0[2],C0[3],C1[1]); a_=MX3(a_,C1[2],C1[3]); \
      _Pragma("unroll") for(int r=4;r<16;r+=4){a_=MX3(a_,C0[r],C0[r+1]);b_=MX3(b_,C0[r+2],C0[r+3]);a_=MX3(a_,C1[r],C1[r+1]);b_=MX3(b_,C1[r+2],C1[r+3]);} \
      float rm=__builtin_fmaxf(a_,b_); { auto rr=__builtin_amdgcn_permlane32_swap(__float_as_uint(rm),__float_as_uint(rm),false,false); rm=__builtin_fmaxf(__uint_as_float(rr[0]),__uint_as_float(rr[1])); } \
      resc=false; \
      if(__builtin_expect(__any(rm>(float)THRL),0)){ const float dl=__builtin_fmaxf(rm,0.f); mhat+=dl; \
        _Pragma("unroll") for(int r=0;r<16;++r){C0[r]-=dl;C1[r]-=dl;} \
        const float f=__builtin_amdgcn_exp2f(-dl); l_reg*=f; if(hi==0)wsf[r32]=f; resc=true; } } \
    SBAR(); \
    VRD(2); GAPB(o[0]=__builtin_amdgcn_mfma_f32_32x32x16_bf16(PAF(0),VFR(0),o[0],0,0,0), C0,0);  VRD2(0); \
    VRD(6); GAPB(o[1]=__builtin_amdgcn_mfma_f32_32x32x16_bf16(PAF(0),VFR(4),o[1],0,0,0), C0,4);  VRD2(4); \
    VRD(3); GAPB(o[0]=__builtin_amdgcn_mfma_f32_32x32x16_bf16(PAF(1),VFR(1),o[0],0,0,0), C0,8);  VRD2(1); \
    VRD(7); GAPB(o[1]=__builtin_amdgcn_mfma_f32_32x32x16_bf16(PAF(1),VFR(5),o[1],0,0,0), C0,12); VRD2(5); \
    GAPB(o[0]=__builtin_amdgcn_mfma_f32_32x32x16_bf16(PAF(2),VFR(2),o[0],0,0,0), C1,0);  VRD2(2); \
    GAPB(o[1]=__builtin_amdgcn_mfma_f32_32x32x16_bf16(PAF(2),VFR(6),o[1],0,0,0), C1,4);  VRD2(6); \
    GAPB(o[0]=__builtin_amdgcn_mfma_f32_32x32x16_bf16(PAF(3),VFR(3),o[0],0,0,0), C1,8);  VRD2(3); \
    GAPB(o[1]=__builtin_amdgcn_mfma_f32_32x32x16_bf16(PAF(3),VFR(7),o[1],0,0,0), C1,12); VRD2(7); \
    KRD(GL,0); GAPC(o[2]=__builtin_amdgcn_mfma_f32_32x32x16_bf16(PAF(0),VFR(0),o[2],0,0,0)); \
    KRD(GL,1); GAPC(o[3]=__builtin_amdgcn_mfma_f32_32x32x16_bf16(PAF(0),VFR(4),o[3],0,0,0)); \
    KRD(GL,2); GAPC(o[2]=__builtin_amdgcn_mfma_f32_32x32x16_bf16(PAF(1),VFR(1),o[2],0,0,0)); \
    KRD(GL,3); GAPC(o[3]=__builtin_amdgcn_mfma_f32_32x32x16_bf16(PAF(1),VFR(5),o[3],0,0,0)); \
    GAPC(o[2]=__builtin_amdgcn_mfma_f32_32x32x16_bf16(PAF(2),VFR(2),o[2],0,0,0)); \
    GAPC(o[3]=__builtin_amdgcn_mfma_f32_32x32x16_bf16(PAF(2),VFR(6),o[3],0,0,0)); \
    GAPC(o[2]=__builtin_amdgcn_mfma_f32_32x32x16_bf16(PAF(3),VFR(3),o[2],0,0,0)); \
    GAPC(o[3]=__builtin_amdgcn_mfma_f32_32x32x16_bf16(PAF(3),VFR(7),o[3],0,0,0)); \
    }while(0)
  int t=1;
  #undef CMASK
  #define CMASK(P0,P1,t) MBIAS(P0,P1,t,false)
  for(;t+5<NT;t+=2){
    STEP(pB0,pB1,pA0,pA1,t,true,true,true);     WAIT_BAR(0); RESC(); ROT();
    STEP(pA0,pA1,pB0,pB1,t+1,true,true,true);   WAIT_BAR(0); RESC(); ROT();
  }
  #undef CMASK
  #define CMASK(P0,P1,t) MBIAS(P0,P1,t,true)
  #define ENDW(tt) do{ WAIT_BAR(0); }while(0)
  for(;t+1<NT;t+=2){
    STEP(pB0,pB1,pA0,pA1,t,(t+3<NT),(t+1<NT),(t+1<NT));       ENDW(t);   RESC(); ROT();
    STEP(pA0,pA1,pB0,pB1,t+1,(t+4<NT),(t+2<NT),(t+2<NT));     ENDW(t+1); RESC(); ROT();
  }
  STEP(pB0,pB1,pA0,pA1,NT-1,false,false,false); RESC();
  { float sacc=pB0[0]+pB0[1]; _Pragma("unroll") for(int r=2;r<16;++r)sacc+=pB0[r]; _Pragma("unroll") for(int r=0;r<16;++r)sacc+=pB1[r]; l_reg+=sacc;
    pw0=(u32x4){PKW(pB0,0),PKW(pB0,2),PKW(pB0,4),PKW(pB0,6)};pw1=(u32x4){PKW(pB0,8),PKW(pB0,10),PKW(pB0,12),PKW(pB0,14)};pw2=(u32x4){PKW(pB1,0),PKW(pB1,2),PKW(pB1,4),PKW(pB1,6)};pw3=(u32x4){PKW(pB1,8),PKW(pB1,10),PKW(pB1,12),PKW(pB1,14)};
    SBAR(); pv(o,vb0+2*sl_cur,PAF(0),PAF(1),PAF(2),PAF(3)); pv(o+2,vb0+2*sl_cur+8192,PAF(0),PAF(1),PAF(2),PAF(3)); }
  #undef PKW
  #undef PAF
  #undef VFR
  #undef PIN
  #undef MX3
  #undef GAPA
  #undef GAPB
  #undef GAPC
  #undef EX
  #undef VRD
  #undef VRD2
  #undef KRD
  #undef STEP
  #undef ENDW
  {auto rr=__builtin_amdgcn_permlane32_swap(__float_as_uint(l_reg),__float_as_uint(l_reg),false,false);l_reg=__uint_as_float(rr[0])+__uint_as_float(rr[1]);}
  if(hi==0)wsf[32+r32]=l_reg;asm volatile("s_waitcnt lgkmcnt(0)":::"memory");
  float rli[16];
  #pragma unroll
  for(int r=0;r<16;++r)rli[r]=__builtin_amdgcn_rcpf(wsf[32+crow(r,hi)]);
  asm volatile("s_waitcnt lgkmcnt(0)\n\ts_barrier":::"memory");
  { bf16*stg=(bf16*)(shm)+wid*4096;
    #pragma unroll
    for(int r=0;r<16;++r){const int orow=crow(r,hi);
      #pragma unroll
      for(int dq=0;dq<4;++dq)stg[orow*128+dq*32+r32]=__float2bfloat16(o[dq][r]*rli[r]);}
    asm volatile("s_waitcnt lgkmcnt(0)":::"memory");
    #pragma unroll
    for(int i=0;i<8;++i){const int row=i*4+(lane>>4),ch=lane&15; const u32x4 v=*(const u32x4*)(stg+row*128+ch*8); *(u32x4*)(a.Ow+(long)row*OP+ch*8)=v;} }
  asm volatile("s_waitcnt lgkmcnt(0)\n\ts_barrier":::"memory");
  #undef DMA_K
  #undef DMA_V
  #undef KBREL
  #undef MBIAS
  #undef CMASK
  #undef START
  #undef RESC
  #undef ROT
}
constexpr int ATTN_LDS_BYTES=LDS_BYTES;
#undef SBAR
#undef WAIT_BAR
}
constexpr int NWAVES = 8;
constexpr int BATCH = 2, SEQ = 16384, D = 1024, M = BATCH * SEQ, DEPTH = 4, MEMLEN = 256;
constexpr int NPA = 1536, NPB = 2560;
constexpr int NEXP = 64, CAP = 32768, HID = 256;
constexpr int HROWS = (M * 8 / 256 + NEXP + M / 256) * 256;
constexpr float LN_EPS = 1e-5f;
constexpr float DN_ALPHA = 1.681792830507429f;
__device__ const float SLOPES_A[12] = {0.5f, 0.25f, 0.125f, 0.0625f, 0.03125f, 0.015625f, 0.0078125f, 0.00390625f, 0.7071067811865476f, 0.35355339059327384f, 0.17677669529663695f, 0.08838834764831849f};
__device__ const float SLOPES_B[6] = {0.25f, 0.0625f, 0.015625f, 0.00390625f, 0.5f, 0.125f};

constexpr size_t MiB = 1u << 20;
constexpr size_t WS_CTL = 0, CTL_ZERO_BYTES = 1 * MiB;
constexpr size_t WS_MEMKV = 2 * MiB;
constexpr size_t WS_WROUT = 4 * MiB;
constexpr size_t WS_WINA = 6 * MiB, WS_WINB = 12 * MiB;
constexpr size_t WS_WOUT = 22 * MiB;
constexpr size_t WS_WMKV = 30 * MiB;
constexpr size_t WS_MEMB = 34 * MiB;
constexpr size_t WS_LOGIT = 36 * MiB;
constexpr size_t WS_ROWTOK = 44 * MiB, WS_ROWGATE = 52 * MiB;
constexpr size_t WS_WEXP = 60 * MiB;
constexpr size_t WS_XB = 158 * MiB;
constexpr size_t WS_HB = 222 * MiB;
constexpr size_t WS_BIG = 374 * MiB;
constexpr size_t WS_QKV = WS_BIG, WS_OTMP = WS_BIG + 160 * MiB, WS_CAT = WS_BIG + 256 * MiB, WS_Y = WS_BIG + 320 * MiB;
constexpr size_t WS_END = WS_BIG + 576 * MiB;
static_assert(WS_WEXP + 65 * (size_t)pg8::EXPERT_BYTES <= WS_XB && WS_HB + (size_t)HROWS * 512 <= WS_BIG, "d_ws map");
constexpr int CW_TMO = 0;
constexpr int CW_BAR = 4096;
constexpr int CW_CNT = 16384;
constexpr int CW_Q = CW_CNT + DEPTH * 64 * 64;
constexpr int CW_NORM = CW_Q + 64 * DEPTH;
static_assert((CW_NORM + 64 * DEPTH) * 4 <= (int)CTL_ZERO_BYTES, "CTL words inside the memset region");

constexpr int RING_OFF = 0, RING_BYTES = 131072;
constexpr int LDSCTL_OFF = RING_BYTES;
constexpr int TAB_OFF = RING_BYTES + 512;
constexpr int IDX_OFF = RING_BYTES + 2560;
constexpr int GATE_OFF = IDX_OFF + 10 * 1024;
constexpr int LDS_BYTES = 163840;
static_assert(IDX_OFF + 20 * 1024 <= LDS_BYTES, "LDS map");

#define GAS __attribute__((address_space(1)))
#define LAS __attribute__((address_space(3)))
typedef unsigned short bf16;
typedef unsigned v4u __attribute__((ext_vector_type(4)));
typedef unsigned v2u __attribute__((ext_vector_type(2)));
typedef float f32x4 __attribute__((ext_vector_type(4)));
typedef GAS unsigned gu32;
#define RLX_AGENT __ATOMIC_RELAXED, __HIP_MEMORY_SCOPE_AGENT
#define LDS_WAIT() asm volatile("s_waitcnt lgkmcnt(0)" ::: "memory")
__device__ __forceinline__ unsigned f2bf(float f) { unsigned u = __builtin_bit_cast(unsigned, f); return (u + 0x7fffu + ((u >> 16) & 1u)) >> 16; }
__device__ __forceinline__ unsigned pk2(float lo, float hi) { return f2bf(lo) | (f2bf(hi) << 16); }
__device__ __forceinline__ float bflo(unsigned u) { return __builtin_bit_cast(float, u << 16); }
__device__ __forceinline__ float bfhi(unsigned u) { return __builtin_bit_cast(float, u & 0xffff0000u); }

#define XB_TMO      128
#define XB_XCNT(j)  (256  + 64 * (j))
#define XB_XSUB(j)  (1280 + 64 * (j))
#define XB_XGEN(j)  (2304 + 64 * (j))
#define XB_TOP      3328
#define XB_TOPGEN   3392
#define XCD_BAR_WORDS 3456
#define XB_SPIN_CAP (1u << 18)
__device__ __forceinline__ unsigned xb_ld(unsigned* p)              { return __hip_atomic_load(p, __ATOMIC_RELAXED, __HIP_MEMORY_SCOPE_AGENT); }
__device__ __forceinline__ unsigned xb_add(unsigned* p, unsigned v) { return __hip_atomic_fetch_add(p, v, __ATOMIC_RELAXED, __HIP_MEMORY_SCOPE_AGENT); }
__device__ __forceinline__ unsigned xb_xcc_id() { return (unsigned)__builtin_amdgcn_s_getreg((3 << 11) | 20) & 0xFu; }
#define XB_SPIN(cond, bar) do { unsigned _sp = 0; while (cond) { __builtin_amdgcn_s_sleep(1); \
    if ((++_sp & 255u) == 0u) { if (xb_ld(&(bar)[XB_TMO])) break; if (_sp > XB_SPIN_CAP) { atomicAdd(&(bar)[XB_TMO], 1u); break; } } } } while (0)
struct XcdBarrier { unsigned* bar; unsigned x; volatile LAS unsigned* st; };
__device__ __forceinline__ XcdBarrier xcd_barrier_post(unsigned* bar, volatile LAS unsigned* st) {
    XcdBarrier b; b.bar = bar; b.x = xb_xcc_id(); b.st = st;
    if (threadIdx.x == 0) (void)xb_add(&bar[XB_XCNT(b.x)], 1u);
    return b;
}
__device__ __forceinline__ void xcd_barrier_complete(unsigned* bar, unsigned x, unsigned& nloc, unsigned& nx) {
    const unsigned G = gridDim.x * gridDim.y * gridDim.z;
    unsigned sum, cnt, mine, sp = 0u;
    for (;;) {
        sum = 0u; cnt = 0u; mine = 0u;
#pragma unroll
        for (unsigned j = 0; j < 16; ++j) { const unsigned c = xb_ld(&bar[XB_XCNT(j)]); sum += c; cnt += (c > 0u) ? 1u : 0u; mine = (j == x) ? c : mine; }
        if (sum == G) break;
        __builtin_amdgcn_s_sleep(1);
        if ((++sp & 255u) == 0u) { if (xb_ld(&bar[XB_TMO])) break; if (sp > XB_SPIN_CAP) { atomicAdd(&bar[XB_TMO], 1u); break; } }
    }
    nloc = mine > 0u ? mine : 1u; nx = cnt > 0u ? cnt : 1u;
}
__device__ __forceinline__ void xcd_barrier(const XcdBarrier& b) {
    asm volatile("s_waitcnt vmcnt(0)" ::: "memory");
    __syncthreads();
    if (threadIdx.x == 0) {
        unsigned* bar = b.bar;
        __builtin_amdgcn_s_waitcnt(0);
        unsigned nloc = b.st[0], nx = b.st[1];
        if (nloc == 0u) { xcd_barrier_complete(bar, b.x, nloc, nx); b.st[0] = nloc; b.st[1] = nx; }
        const unsigned old = xb_add(&bar[XB_XSUB(b.x)], 1u);
        const unsigned gen = old / nloc;
        if (old + 1u == (gen + 1u) * nloc) {
            __builtin_amdgcn_fence(__ATOMIC_RELEASE, "agent");
            asm volatile("s_waitcnt vmcnt(0)" ::: "memory");
            const unsigned og = xb_add(&bar[XB_TOP], 1u);
            const unsigned tg = og / nx;
            if (og + 1u == (tg + 1u) * nx) xb_add(&bar[XB_TOPGEN], 1u);
            else XB_SPIN(xb_ld(&bar[XB_TOPGEN]) == tg, bar);
            __builtin_amdgcn_fence(__ATOMIC_ACQUIRE, "agent");
            xb_add(&bar[XB_XGEN(b.x)], 1u);
            asm volatile("s_waitcnt vmcnt(0)" ::: "memory");
        } else {
            XB_SPIN(xb_ld(&bar[XB_XGEN(b.x)]) == gen, bar);
            __builtin_amdgcn_fence(__ATOMIC_ACQUIRE, "agent");
            asm volatile("s_waitcnt vmcnt(0)" ::: "memory");
        }
    }
    __syncthreads();
}

struct Frame {
    LAS unsigned char* lds;
    volatile LAS unsigned* MISC;
    gu32* ctl;
    int wave;
    int vcu, G, gw, ngw;
};
__device__ __forceinline__ int fresh_tid() { int t = threadIdx.x; asm volatile("" : "+v"(t)); return t; }
__device__ __forceinline__ float wave_sum(float v) {
#pragma unroll
    for (int o = 1; o < 64; o <<= 1) v += __shfl_xor(v, o);
    return v;
}
__device__ __forceinline__ void transpose_item64(const float* W, int N, bf16* WT, int ldt, int k0, int n0, int drow0, LAS float* scr, int lane) {
    const int rr = lane >> 4, cc = (lane & 15) * 4;
#pragma unroll 8
    for (int i = 0; i < 16; ++i) { const int kk = 4 * i + rr; const f32x4 v = *(const GAS f32x4*)(W + (size_t)(k0 + kk) * N + n0 + cc);
        LAS float* d = scr + kk * 65 + cc; d[0] = v.x; d[1] = v.y; d[2] = v.z; d[3] = v.w; }
    LDS_WAIT(); asm volatile("" ::: "memory");
    const int c = lane & 7;
#pragma unroll
    for (int j = 0; j < 8; ++j) { const int n = (lane >> 3) + 8 * j; const LAS float* s = scr + (8 * c) * 65 + n;
        v4u o; o.x = pk2(s[0 * 65], s[1 * 65]); o.y = pk2(s[2 * 65], s[3 * 65]); o.z = pk2(s[4 * 65], s[5 * 65]); o.w = pk2(s[6 * 65], s[7 * 65]);
        *(GAS v4u*)(WT + (size_t)(drow0 + n) * ldt + k0 + 8 * c) = o; }
    LDS_WAIT(); asm volatile("" ::: "memory");
}
__device__ __forceinline__ int map_in_a(int n) { return n < 768 ? n : (n < 960 ? n + 256 : (n < 1152 ? n + 256 : n - 384)); }
__device__ __forceinline__ int map_in_b(int n) { return n < 768 ? n : (n < 2304 ? n + 256 : n - 1536); }

struct Args { const float* in[19]; float* out; unsigned char* ws; };
typedef const __attribute__((address_space(4))) Args* ArgsP;
__device__ __forceinline__ ArgsP fresh_args() { ArgsP p = (ArgsP)__builtin_amdgcn_kernarg_segment_ptr(); asm volatile("" : "+s"(p)); return p; }

__device__ __forceinline__ void p0_small_weights(Frame& F, ArgsP A) {
    const int tid_ = fresh_tid(), lane_ = tid_ & 63; (void)tid_; (void)lane_;
    LAS float* scr = (LAS float*)(F.lds + (F.wave < 7 ? RING_OFF + F.wave * 16640 : IDX_OFF));
    unsigned char* ws = A->ws;
    constexpr int I_A = 16 * 22, I_B = 16 * 40, I_M = 16 * 8, I_O = 16 * 16, I_R = 16;
    constexpr int NITEMS = 2 * I_A + 2 * I_B + 4 * I_M + 4 * I_O + 4 * I_R;
    for (int it = F.gw; it < NITEMS; it += F.ngw) {
        int r = it;
        if (r < 2 * I_A) { const int j = r / I_A; r %= I_A; const int kb = r / 22, nb = r % 22;
            transpose_item64(A->in[2] + (size_t)j * D * 1408, 1408, (bf16*)(ws + WS_WINA) + (size_t)j * NPA * D, D, 64 * kb, 64 * nb, map_in_a(64 * nb), scr, lane_); continue; } r -= 2 * I_A;
        if (r < 2 * I_B) { const int j = r / I_B; r %= I_B; const int kb = r / 40, nb = r % 40;
            transpose_item64(A->in[4] + (size_t)j * D * 2560, 2560, (bf16*)(ws + WS_WINB) + (size_t)j * NPB * D, D, 64 * kb, 64 * nb, map_in_b(64 * nb), scr, lane_); continue; } r -= 2 * I_B;
        if (r < 4 * I_M) { const int l = r / I_M; r %= I_M; const int kb = r / 8, nb = r % 8;
            transpose_item64(A->in[7] + (size_t)l * D * 512, 512, (bf16*)(ws + WS_WMKV), D, 64 * kb, 64 * nb, l * 512 + 64 * nb, scr, lane_); continue; } r -= 4 * I_M;
        if (r < 4 * I_O) { const int l = r / I_O; r %= I_O; const int kb = r / 16, nb = r % 16;
            transpose_item64(A->in[8] + (size_t)l * D * D, D, (bf16*)(ws + WS_WOUT) + (size_t)l * D * D, D, 64 * kb, 64 * nb, 64 * nb, scr, lane_); continue; } r -= 4 * I_O;
        { const int l = r / I_R; const int kb = r % I_R;
            transpose_item64(A->in[11] + (size_t)l * D * 64, 64, (bf16*)(ws + WS_WROUT) + (size_t)l * 256 * D, D, 64 * kb, 0, 0, scr, lane_); }
    }
    for (int it = F.gw; it < 2 * 128 + 4 * 192; it += F.ngw) {
        bf16* row = it < 256 ? (bf16*)(ws + WS_WINA) + ((size_t)(it >> 7) * NPA + 1408 + (it & 127)) * D
                             : (bf16*)(ws + WS_WROUT) + ((size_t)((it - 256) / 192) * 256 + 64 + (it - 256) % 192) * D;
        GAS v4u* o = (GAS v4u*)row + lane_;
        o[0] = (v4u){0u, 0u, 0u, 0u}; o[64] = (v4u){0u, 0u, 0u, 0u};
    }
    for (int m = F.gw; m < 512 + M; m += F.ngw) {
        const float* src = m < 512 ? A->in[1] + (size_t)m * D : A->in[0] + (size_t)(m - 512) * D;
        bf16* dst = m < 512 ? (bf16*)(ws + WS_MEMB) + (size_t)m * D : (bf16*)(ws + WS_XB) + (size_t)(m - 512) * D;
        const GAS f32x4* xr = (const GAS f32x4*)src + lane_; GAS v2u* o8 = (GAS v2u*)dst + lane_;
#pragma unroll
        for (int j = 0; j < 4; ++j) { const f32x4 v = xr[64 * j]; o8[64 * j] = (v2u){pk2(v.x, v.y), pk2(v.z, v.w)}; }
    }
}
constexpr int CONV_ITEMS = 65 * 192, CONV_UNITS = CONV_ITEMS / 8;
__device__ __forceinline__ void convert_item(ArgsP A, int layer, int it, LAS float* scr, int lane_) {
    bf16* wexp = (bf16*)(A->ws + WS_WEXP);
    const int e = it / 192, mat = (it % 192) >> 6, r = it & 63;
    bf16* dst = wexp + (size_t)e * (pg8::EXPERT_BYTES / 2);
    if (mat < 2) { const float* W = (e < 64) ? A->in[13 + mat] + ((size_t)layer * 64 + e) * (D * HID) : A->in[16 + mat] + (size_t)layer * (D * HID);
        const int kb = r >> 2, nb = r & 3, n0 = 64 * nb;
        transpose_item64(W, HID, dst, D, 64 * kb, n0, (n0 >> 7) * 256 + mat * 128 + (n0 & 127), scr, lane_); }
    else { const float* W = (e < 64) ? A->in[15] + ((size_t)layer * 64 + e) * (HID * D) : A->in[18] + (size_t)layer * (HID * D);
        const int kb = r >> 4, nb = r & 15;
        transpose_item64(W, D, dst + pg8::EXPERT_DOWN_OFF / 2, HID, 64 * kb, 64 * nb, 64 * nb, scr, lane_); }
}
__device__ __forceinline__ void convert_unit(Frame& F, ArgsP A, int layer, int cu) {
    const int tid_ = fresh_tid(), lane_ = tid_ & 63; (void)tid_;
    LAS float* scr = (LAS float*)(F.lds + (F.wave < 7 ? RING_OFF + F.wave * 16640 : IDX_OFF));
    const int it = 8 * cu + F.wave;
    if (it < CONV_ITEMS) convert_item(A, layer, it, scr, lane_);
    asm volatile("s_waitcnt vmcnt(0) lgkmcnt(0)\n\ts_barrier" ::: "memory");
}
template <bool LAST> __device__ __forceinline__ void ph_combine_ln2(Frame& F, float* xout, const unsigned char* yt, const float* g, const float* b, bf16* xb) {
    typedef float f32x2c __attribute__((ext_vector_type(2)));
    const int tid_ = fresh_tid(), lane_ = tid_ & 63; (void)tid_;
    for (int m = F.gw; m < M; m += F.ngw) {
        GAS v4u* o8 = (GAS v4u*)(xb + (size_t)m * D) + 2 * lane_; const GAS v4u* yr = (const GAS v4u*)(yt + (size_t)m * 9 * D) + lane_;
        float v[16];
#pragma unroll
        for (int i = 0; i < 16; ++i) v[i] = 0.f;
#pragma unroll
        for (int k = 0; k < 9; ++k) { const v4u w = yr[k * 64];
#pragma unroll
            for (int q = 0; q < 4; ++q) { const f32x2c lo = __builtin_amdgcn_cvt_pk_f32_fp8((int)w[q], false), hi = __builtin_amdgcn_cvt_pk_f32_fp8((int)w[q], true);
                v[4 * q] += lo.x; v[4 * q + 1] += lo.y; v[4 * q + 2] += hi.x; v[4 * q + 3] += hi.y; } }
        float s = 0.f;
#pragma unroll
        for (int h = 0; h < 2; ++h) { const v4u xw = o8[h];
#pragma unroll
            for (int q = 0; q < 4; ++q) { v[8 * h + 2 * q] = v[8 * h + 2 * q] * (1.f / pg8::Y8_SCALE) + DN_ALPHA * bflo(xw[q]); v[8 * h + 2 * q + 1] = v[8 * h + 2 * q + 1] * (1.f / pg8::Y8_SCALE) + DN_ALPHA * bfhi(xw[q]); } }
#pragma unroll
        for (int i = 0; i < 16; ++i) s += v[i];
        const float mean = wave_sum(s) * (1.f / D); float s2 = 0.f;
#pragma unroll
        for (int i = 0; i < 16; ++i) { v[i] -= mean; s2 += v[i] * v[i]; }
        const float rstd = 1.f / sqrtf(wave_sum(s2) * (1.f / D) + LN_EPS);
        const GAS f32x4* gp = (const GAS f32x4*)g + 4 * lane_; const GAS f32x4* bp = (const GAS f32x4*)b + 4 * lane_;
        GAS f32x4* xo = (GAS f32x4*)(xout + (size_t)m * D) + 4 * lane_;
        float o[16];
#pragma unroll
        for (int q = 0; q < 4; ++q) { const f32x4 gv = gp[q], bv = bp[q];
            o[4 * q] = v[4 * q] * rstd * gv.x + bv.x; o[4 * q + 1] = v[4 * q + 1] * rstd * gv.y + bv.y; o[4 * q + 2] = v[4 * q + 2] * rstd * gv.z + bv.z; o[4 * q + 3] = v[4 * q + 3] * rstd * gv.w + bv.w;
            if (LAST) xo[q] = (f32x4){o[4 * q], o[4 * q + 1], o[4 * q + 2], o[4 * q + 3]}; }
        if (!LAST) { o8[0] = (v4u){pk2(o[0], o[1]), pk2(o[2], o[3]), pk2(o[4], o[5]), pk2(o[6], o[7])}; o8[1] = (v4u){pk2(o[8], o[9]), pk2(o[10], o[11]), pk2(o[12], o[13]), pk2(o[14], o[15])}; }
    }
}
__device__ __forceinline__ void ph_diff_combine(Frame& F, const bf16* otmp, const float* lq, const float* subg, float lam_init, bf16* cat) {
    const int tid_ = fresh_tid(), lane_ = tid_ & 63; (void)tid_; (void)lane_;
    float lam;
    { const float a = lq[lane_] * lq[64 + lane_], c = lq[128 + lane_] * lq[192 + lane_]; lam = expf(wave_sum(a)) - expf(wave_sum(c)) + lam_init; }
    const int l32 = lane_ & 31, hh = lane_ >> 5;
    const f32x4 gv = ((const GAS f32x4*)subg)[l32]; const float post = 1.f - lam_init;
    for (int m = F.gw; m < M; m += F.ngw) {
#pragma unroll
        for (int hp = 0; hp < 3; ++hp) { const int h = 2 * hp + hh;
            const v2u a0 = *((const GAS v2u*)(otmp + (size_t)m * 1536 + h * 256) + l32), a1 = *((const GAS v2u*)(otmp + (size_t)m * 1536 + h * 256 + 128) + l32);
            f32x4 o; o.x = bflo(a0.x) - lam * bflo(a1.x); o.y = bfhi(a0.x) - lam * bfhi(a1.x); o.z = bflo(a0.y) - lam * bflo(a1.y); o.w = bfhi(a0.y) - lam * bfhi(a1.y);
            float s2 = (o.x * o.x + o.y * o.y) + (o.z * o.z + o.w * o.w);
#pragma unroll
            for (int sft = 1; sft < 32; sft <<= 1) s2 += __shfl_xor(s2, sft);
            const float r = post / sqrtf(s2 * (1.f / 128.f) + LN_EPS);
            o = o * r * gv;
            *((GAS v2u*)(cat + (size_t)m * D + h * 128) + l32) = (v2u){pk2(o.x, o.y), pk2(o.z, o.w)}; }
    }
}
__device__ __forceinline__ float ss8(v4u a) { float s = 0.f;
#pragma unroll
    for (int i = 0; i < 4; ++i) { const float lo = bflo(a[i]), hi = bfhi(a[i]); s += lo * lo + hi * hi; } return s; }
__device__ __forceinline__ void ph_qknorm(Frame& F, const bf16* qkv, gu32* gmax) {
    const int tid_ = fresh_tid(), lane_ = tid_ & 63;
    LAS unsigned* lmax = (LAS unsigned*)(F.lds + LDSCTL_OFF) + 32;
    if (tid_ < 24) lmax[tid_] = 0u;
    __syncthreads();
    float mq0 = 0.f, mq1 = 0.f, mk0 = 0.f, mk1 = 0.f;
    const v4u zero = (v4u){0u, 0u, 0u, 0u};
    for (int m = F.gw; m < M; m += F.ngw) {
        const bf16* row = qkv + (size_t)m * NPB;
        const v4u a = *(const GAS v4u*)(row + 8 * lane_), c = *(const GAS v4u*)(row + 1024 + 8 * lane_);
        v4u b = zero, d = zero; if (lane_ < 32) { b = *(const GAS v4u*)(row + 512 + 8 * lane_); d = *(const GAS v4u*)(row + 1536 + 8 * lane_); }
        float sa = ss8(a), sb = ss8(b), sc = ss8(c), sd = ss8(d);
#pragma unroll
        for (int o = 1; o < 8; o <<= 1) { sa += __shfl_xor(sa, o); sb += __shfl_xor(sb, o); sc += __shfl_xor(sc, o); sd += __shfl_xor(sd, o); }
        mq0 = fmaxf(mq0, sa); mq1 = fmaxf(mq1, sb); mk0 = fmaxf(mk0, sc); mk1 = fmaxf(mk1, sd);
    }
    if ((lane_ & 7) == 0) { const int g = lane_ >> 3;
        __hip_atomic_fetch_max(lmax + g, __float_as_uint(mq0), __ATOMIC_RELAXED, __HIP_MEMORY_SCOPE_WORKGROUP); __hip_atomic_fetch_max(lmax + 12 + g, __float_as_uint(mk0), __ATOMIC_RELAXED, __HIP_MEMORY_SCOPE_WORKGROUP);
        if (lane_ < 32) { __hip_atomic_fetch_max(lmax + 8 + g, __float_as_uint(mq1), __ATOMIC_RELAXED, __HIP_MEMORY_SCOPE_WORKGROUP); __hip_atomic_fetch_max(lmax + 20 + g, __float_as_uint(mk1), __ATOMIC_RELAXED, __HIP_MEMORY_SCOPE_WORKGROUP); } }
    __syncthreads();
    if (tid_ < 24) __hip_atomic_fetch_max(gmax + tid_, lmax[tid_], RLX_AGENT);
}
typedef short bf16x8r __attribute__((ext_vector_type(8)));
constexpr int RT_SC_OFF = TAB_OFF, RT_GB_OFF = TAB_OFF + 16384;
static_assert(RT_GB_OFF + 8192 <= LDS_BYTES, "LDS map (route phase)");
template <bool XF32> __device__ __forceinline__ void ph_ln_route(Frame& F, const float* xin, const bf16* y, const float* g, const float* b, bf16* xb, const bf16* wrt, const float* rbias, gu32* cnt, int* rowtok, float* rowgate, float* gtmp) {
    const int tid_ = fresh_tid(), lane_ = tid_ & 63;
    for (int i = tid_; i < 64 * 128; i += NWAVES * 64) { const int e = i >> 7, c = i & 127;
        const v4u v = *(const GAS v4u*)(wrt + (size_t)e * D + c * 8); *(LAS v4u*)(F.lds + e * 2048 + ((c ^ (e & 15)) << 4)) = v; }
    LAS float* lgb = (LAS float*)(F.lds + RT_GB_OFF);
    if (tid_ < 256) { ((LAS f32x4*)lgb)[tid_] = ((const GAS f32x4*)g)[tid_]; ((LAS f32x4*)lgb)[256 + tid_] = ((const GAS f32x4*)b)[tid_]; }
    __syncthreads();
    LAS float* sc = (LAS float*)(F.lds + RT_SC_OFF) + F.wave * 512;
    const int r = lane_ & 15, kq = lane_ >> 4; const float bias = rbias[lane_]; const float NINF = -INFINITY;
    for (int base = F.gw * 16; base < M; base += F.ngw * 16) {
        const size_t roff = (size_t)(base + r) * D + 8 * kq;
        float s1 = 0.f, s2 = 0.f;
#pragma unroll 8
        for (int s = 0; s < 32; ++s) { const v4u yw = *(const GAS v4u*)(y + roff + 32 * s); float xv[8];
            if (XF32) { const f32x4 a0 = *(const GAS f32x4*)(xin + roff + 32 * s), a1 = *(const GAS f32x4*)(xin + roff + 32 * s + 4); xv[0] = a0.x; xv[1] = a0.y; xv[2] = a0.z; xv[3] = a0.w; xv[4] = a1.x; xv[5] = a1.y; xv[6] = a1.z; xv[7] = a1.w; }
            else { const v4u xw = *(const GAS v4u*)(xb + roff + 32 * s);
#pragma unroll
                for (int q = 0; q < 4; ++q) { xv[2 * q] = bflo(xw[q]); xv[2 * q + 1] = bfhi(xw[q]); } }
#pragma unroll
            for (int q = 0; q < 4; ++q) { const float z0 = DN_ALPHA * xv[2 * q] + bflo(yw[q]), z1 = DN_ALPHA * xv[2 * q + 1] + bfhi(yw[q]); s1 += z0 + z1; s2 += z0 * z0 + z1 * z1; } }
        s1 += __shfl_xor(s1, 16); s1 += __shfl_xor(s1, 32); s2 += __shfl_xor(s2, 16); s2 += __shfl_xor(s2, 32);
        const float mean = s1 * (1.f / D); const float rstd = 1.f / sqrtf(fmaxf(s2 * (1.f / D) - mean * mean, 0.f) + LN_EPS);
        f32x4 acc[4];
#pragma unroll
        for (int nt = 0; nt < 4; ++nt) acc[nt] = (f32x4){0.f, 0.f, 0.f, 0.f};
#pragma unroll 4
        for (int s = 0; s < 32; ++s) { const v4u yw = *(const GAS v4u*)(y + roff + 32 * s); float xv[8];
            if (XF32) { const f32x4 a0 = *(const GAS f32x4*)(xin + roff + 32 * s), a1 = *(const GAS f32x4*)(xin + roff + 32 * s + 4); xv[0] = a0.x; xv[1] = a0.y; xv[2] = a0.z; xv[3] = a0.w; xv[4] = a1.x; xv[5] = a1.y; xv[6] = a1.z; xv[7] = a1.w; }
            else { const v4u xw = *(const GAS v4u*)(xb + roff + 32 * s);
#pragma unroll
                for (int q = 0; q < 4; ++q) { xv[2 * q] = bflo(xw[q]); xv[2 * q + 1] = bfhi(xw[q]); } }
            const LAS f32x4* gp = (const LAS f32x4*)(lgb + 32 * s + 8 * kq); const f32x4 g0 = gp[0], g1 = gp[1], b0 = gp[256], b1 = gp[257];
            const float gg[8] = {g0.x, g0.y, g0.z, g0.w, g1.x, g1.y, g1.z, g1.w}, bb[8] = {b0.x, b0.y, b0.z, b0.w, b1.x, b1.y, b1.z, b1.w};
            v4u ow;
#pragma unroll
            for (int q = 0; q < 4; ++q) { const float z0 = DN_ALPHA * xv[2 * q] + bflo(yw[q]), z1 = DN_ALPHA * xv[2 * q + 1] + bfhi(yw[q]);
                ow[q] = pk2((z0 - mean) * rstd * gg[2 * q] + bb[2 * q], (z1 - mean) * rstd * gg[2 * q + 1] + bb[2 * q + 1]); }
            *(GAS v4u*)(xb + roff + 32 * s) = ow;
            const bf16x8r af = __builtin_bit_cast(bf16x8r, ow);
#pragma unroll
            for (int nt = 0; nt < 4; ++nt) { const int e = 16 * nt + r, c = 4 * s + kq;
                const bf16x8r bfr = *(const LAS bf16x8r*)(F.lds + e * 2048 + ((c ^ (e & 15)) << 4));
                acc[nt] = __builtin_amdgcn_mfma_f32_16x16x32_bf16(bfr, af, acc[nt], 0, 0, 0); } }
        unsigned selmask = 0u; unsigned long long slots = 0ull; unsigned mycount = 0u;
#pragma unroll 1
        for (int half = 0; half < 2; ++half) {
            if ((r >> 3) == half) {
#pragma unroll
                for (int nt = 0; nt < 4; ++nt) *(LAS f32x4*)(sc + (r & 7) * 64 + 16 * nt + 4 * kq) = acc[nt]; }
            LDS_WAIT(); asm volatile("" ::: "memory");
#pragma unroll 1
            for (int j8 = 0; j8 < 8; ++j8) { const int j = half * 8 + j8;
                const float logit = sc[j8 * 64 + lane_];
                const float aff = 1.f / (1.f + expf(-logit)); const float sel = aff + bias;
                float m1 = sel; m1 = fmaxf(m1, __shfl_xor(m1, 1)); m1 = fmaxf(m1, __shfl_xor(m1, 2)); m1 = fmaxf(m1, __shfl_xor(m1, 4));
                const unsigned long long bm = __ballot(sel == m1); const unsigned gb = (unsigned)(bm >> (lane_ & 56)) & 0xffu; const int first = __builtin_ctz(gb | 0x100u);
                float m2 = ((lane_ & 7) == first) ? NINF : sel; m2 = fmaxf(m2, __shfl_xor(m2, 1)); m2 = fmaxf(m2, __shfl_xor(m2, 2)); m2 = fmaxf(m2, __shfl_xor(m2, 4));
                const float gs = m1 + m2; int grank = 0;
#pragma unroll
                for (int g2 = 0; g2 < 8; ++g2) { const float o = __builtin_bit_cast(float, __builtin_amdgcn_readlane(__builtin_bit_cast(int, gs), 8 * g2)); grank += (o > gs || (o == gs && g2 < (lane_ >> 3))) ? 1 : 0; }
                const bool gok = grank < 4; const float v = gok ? sel : NINF; int er = 0;
#pragma unroll 8
                for (int e2 = 0; e2 < 64; ++e2) { const float o = __builtin_bit_cast(float, __builtin_amdgcn_readlane(__builtin_bit_cast(int, v), e2)); er += (o > v || (o == v && e2 < lane_)) ? 1 : 0; }
                const bool chosen = gok && er < 8;
                const float ssum = wave_sum(chosen ? aff : 0.f);
                const unsigned long long bal = __ballot(chosen); const unsigned slot = (unsigned)__builtin_popcountll(bal & ((1ull << lane_) - 1ull));
                if (chosen) { selmask |= 1u << j; slots |= (unsigned long long)slot << (4 * j); ++mycount; gtmp[(size_t)(base + j) * 64 + lane_] = aff / ssum * 2.5f; }
            }
            LDS_WAIT(); asm volatile("" ::: "memory");
        }
        unsigned pos = 0u; if (mycount) pos = __hip_atomic_fetch_add(cnt + 64 * lane_, mycount, RLX_AGENT);
#pragma unroll 1
        for (int j = 0; j < 16; ++j) if ((selmask >> j) & 1u) { const size_t at = (size_t)lane_ * CAP + pos; ++pos;
            rowtok[at] = (base + j) | ((int)((slots >> (4 * j)) & 15ull) << 16); rowgate[at] = gtmp[(size_t)(base + j) * 64 + lane_]; }
    }
}
template <bool M1> __device__ __forceinline__ int build_units(Frame& F, gu32* cnt, const int* rowtok, const float* rowgate) {
    const int tid_ = fresh_tid();
    LAS int* tcnt = (LAS int*)(F.lds + TAB_OFF); LAS int* bst = tcnt + 80; LAS int* utab = tcnt + 160; LAS int* idx = (LAS int*)(F.lds + IDX_OFF); LAS float* lgate = (LAS float*)(F.lds + GATE_OFF);
    if (tid_ < 65) tcnt[tid_] = (tid_ < 64) ? (int)__hip_atomic_load(cnt + 64 * tid_, RLX_AGENT) : M;
    __syncthreads();
    if (tid_ == 0) { int run = 0; for (int e = 0; e < 65; ++e) { bst[e] = run; run += (tcnt[e] + 255) >> 8; } bst[65] = run; }
    __syncthreads();
    const int nblk = bst[65]; const int bx = blockIdx.x;
    const int per = M1 ? 128 : 64, blk0 = M1 ? (16 * (bx & 7) + (bx >> 4)) : (8 * (bx & 7) + (bx >> 5)), pn = M1 ? ((bx >> 3) & 1) : ((bx >> 3) & 3);
    int nmine = (nblk > blk0) ? (nblk - blk0 + per - 1) / per : 0; if (nmine > (M1 ? 10 : 20)) nmine = M1 ? 10 : 20;
    if (tid_ < nmine) { const int blk = tid_ * per + blk0;
        int e = 0; for (int q = 1; q < 65; ++q) if (bst[q] <= blk) e = q;
        const int j = blk - bst[e]; int nv = tcnt[e] - 256 * j; if (nv > 256) nv = 256;
        LAS int* t = utab + tid_ * 8; t[0] = e; t[1] = blk; t[2] = pn; t[3] = nv; t[4] = e * CAP + 256 * j; t[5] = 256 * j; }
    __syncthreads();
    for (int g = 0; g < nmine; ++g) if (tid_ < 256) { const LAS int* t = utab + g * 8; const int e = t[0], nv = t[3];
        if (M1) { int tok = 0; float gt = 0.f;
            if (e == 64) { tok = t[5] + tid_; gt = 1.f; } else if (tid_ < nv) { tok = rowtok[t[4] + tid_] & 0xffff; gt = rowgate[t[4] + tid_]; }
            idx[g * 256 + tid_] = tok; lgate[g * 256 + tid_] = gt; }
        else { int dst = -1;
            if (e == 64) dst = (t[5] + tid_) * 9 + 8; else if (tid_ < nv) { const int v = rowtok[t[4] + tid_]; dst = (v & 0xffff) * 9 + (v >> 16); }
            idx[g * 256 + tid_] = dst; } }
    __syncthreads();
    return nmine;
}
#define WSP(T, off) ((T*)(A->ws + (off)))
#ifndef REP_P1
#define REP_P1 1
#endif
#ifndef REP_P2
#define REP_P2 1
#endif
#ifndef REP_P3
#define REP_P3 1
#endif
#ifndef REP_P5
#define REP_P5 1
#endif
#ifndef REP_P7
#define REP_P7 1
#endif
#ifndef REP_P8
#define REP_P8 1
#endif
#define REPEAT(n) _Pragma("unroll 1") for (int rep_ = 0; rep_ < (n); ++rep_)
#define OPQ(x) asm volatile("" : "+s"(x))
#define FCTL() ({ gu32* c_ = F.ctl; asm volatile("" : "+s"(c_)); c_; })
#define FRESH_GB() int G = F.G, bx = blockIdx.x; OPQ(G); OPQ(bx); (void)G; (void)bx
__global__ void __launch_bounds__(NWAVES * 64, 2) mega_fwd(Args args_unused) {
    extern __shared__ __attribute__((aligned(16))) unsigned char lds[];
    Frame F;
    F.lds = (LAS unsigned char*)lds;
    F.MISC = (volatile LAS unsigned*)(F.lds + LDSCTL_OFF);
    F.wave = __builtin_amdgcn_readfirstlane((int)threadIdx.x >> 6);
    F.G = gridDim.x; { const int bx = blockIdx.x; F.vcu = (F.G % 8 == 0) ? (bx % 8) * (F.G / 8) + bx / 8 : bx; }
    F.gw = F.vcu * NWAVES + F.wave; F.ngw = F.G * NWAVES;
    { ArgsP A = fresh_args(); F.ctl = (gu32*)(A->ws + WS_CTL); }
    for (int u = fresh_tid(); u < 512 / 4; u += NWAVES * 64) ((LAS unsigned*)(F.lds + LDSCTL_OFF))[u] = 0u;
    __syncthreads();
    XcdBarrier bar = xcd_barrier_post((unsigned*)(F.ctl + CW_BAR), F.MISC + 8);
#define GRID_BAR() xcd_barrier(bar)

    { ArgsP A = fresh_args(); FRESH_GB(); p0_small_weights(F, A); }
    GRID_BAR();
    {   ArgsP A = fresh_args(); FRESH_GB();
        pg8::DenseSched S; S.init(512, 2048, D, G, bx, WSP(const bf16, WS_WMKV));
        pg8::EpiBf16 E{WSP(bf16, WS_MEMKV), 2048, 0, 1.f};
        pg8::gemm_phase<pg8::EpiBf16, pg8::DenseSched>(F.lds + RING_OFF, WSP(const bf16, WS_MEMB), D, S, E); }

    for (int layer = 0; layer < DEPTH; ++layer) {
        const int jm = layer >> 1; const bool isB = (layer & 1) != 0;
        REPEAT(REP_P1) {
        if (!isB) { ArgsP A = fresh_args(); FRESH_GB();
            pg8::DenseSched S; S.init(M, NPA, D, G, bx, WSP(const bf16, WS_WINA) + (size_t)jm * NPA * D);
            pg8::EpiBf16 E{WSP(bf16, WS_QKV), NPA, 4, attn_body::C2};
            pg8::gemm_phase<pg8::EpiBf16, pg8::DenseSched>(F.lds + RING_OFF, WSP(const bf16, WS_XB), D, S, E); }
        else { ArgsP A = fresh_args(); FRESH_GB();
            pg8::DenseSched S; S.init(M, NPB, D, G, bx, WSP(const bf16, WS_WINB) + (size_t)jm * NPB * D);
            pg8::EpiBf16 E{WSP(bf16, WS_QKV), NPB, 4, attn_body::C2};
            pg8::gemm_phase<pg8::EpiBf16, pg8::DenseSched>(F.lds + RING_OFF, WSP(const bf16, WS_XB), D, S, E); }
        GRID_BAR();
        }
        if (isB) {
            ArgsP A = fresh_args();
            ph_qknorm(F, WSP(const bf16, WS_QKV), FCTL() + CW_NORM + 64 * layer);
            GRID_BAR();
        }
        REPEAT(REP_P2) {
        if (!isB) {
            { FRESH_GB();
            for (int L = bx; L < 1536; L += G) {
                ArgsP A = fresh_args(); const bf16* qkv = WSP(const bf16, WS_QKV); const int wave = F.wave;
                const int b = L / 768, rem = L % 768, qblk = rem / 3, kvh = rem % 3;
                const int q0u = qblk * 64, head = kvh * 4 + (wave >> 1); const size_t rowq = (size_t)b * SEQ + q0u + 32 * (wave & 1);
                attn_body::AttnArgs a;
                a.Qw = (const attn_body::bf16*)(qkv + rowq * NPA + head * 64);
                a.K0 = (const attn_body::bf16*)(qkv + ((size_t)b * SEQ + q0u) * NPA + 1024 + kvh * 64); a.V0 = a.K0 + 192;
                a.NT = 4; a.tmax = qblk; a.Ow = (attn_body::bf16*)(WSP(bf16, WS_CAT) + rowq * D + head * 64);
                a.qrel = 32 * (wave & 1) + (fresh_tid() & 31); a.slope2 = SLOPES_A[head] * attn_body::LOG2E; a.sink2 = A->in[3][jm * 12 + head] * attn_body::LOG2E;
                attn_body::attn_unit<2, 8, NPA, NPA, D>(a, (char*)lds + RING_OFF);
                convert_unit(F, A, layer, L);
            }
            for (int cu = 1536 + bx; cu < CONV_UNITS; cu += G) { ArgsP A = fresh_args(); convert_unit(F, A, layer, cu); } }
            { FRESH_GB();
            for (int L = bx; L < 512; L += G) {
                ArgsP A = fresh_args(); const int wave = F.wave;
                const int b = L / 256, rem = L % 256, qb = rem >> 2, hm = rem & 3;
                const size_t rowq = (size_t)b * SEQ + qb * 256 + 32 * wave;
                attn_body::AttnArgs a;
                a.Qw = (const attn_body::bf16*)(WSP(const bf16, WS_QKV) + rowq * NPA + 768 + hm * 64);
                a.K0 = (const attn_body::bf16*)(WSP(const bf16, WS_MEMKV) + (size_t)b * MEMLEN * 2048 + layer * 512 + hm * 64); a.V0 = a.K0 + 256;
                a.NT = 4; a.tmax = 1 << 30; a.Ow = (attn_body::bf16*)(WSP(bf16, WS_CAT) + rowq * D + 768 + hm * 64);
                a.qrel = 32 * wave + (fresh_tid() & 31); a.slope2 = 0.f; a.sink2 = 0.f;
                attn_body::attn_unit<0, 8, NPA, 2048, D>(a, (char*)lds + RING_OFF);
            } }
        } else {
            {
                unsigned nextL = 0u;
                if (fresh_tid() == 0) nextL = __hip_atomic_fetch_add(FCTL() + CW_Q + 64 * layer + 16 * rep_, 1u, RLX_AGENT);
                for (;;) {
                    if (fresh_tid() == 0) F.MISC[16] = nextL;
                    __syncthreads();
                    const int Lq = __builtin_amdgcn_readfirstlane((int)F.MISC[16]);
                    __syncthreads();
                    if (Lq >= 1536 + CONV_UNITS) break;
                    if (fresh_tid() == 0) nextL = __hip_atomic_fetch_add(FCTL() + CW_Q + 64 * layer + 16 * rep_, 1u, RLX_AGENT);
                    ArgsP A = fresh_args(); const bf16* qkv = WSP(const bf16, WS_QKV); const int wave = F.wave;
                    const bool isconv = (Lq < 2 * 1536) ? (Lq & 1) : true; const int L = (Lq < 2 * 1536) ? (Lq >> 1) : (Lq - 1536);
                    if (isconv) { convert_unit(F, A, layer, L); continue; }
                    const int qb = 63 - L / 24, rem = L % 24, b = rem / 12, hc = rem % 12, h = hc >> 1, c = hc & 1;
                    const size_t rowq = (size_t)b * SEQ + qb * 256 + 32 * wave;
                    const float slope2 = SLOPES_B[h] * attn_body::LOG2E;
                    const float q2m = __uint_as_float(__hip_atomic_load(FCTL() + CW_NORM + 64 * layer + hc, RLX_AGENT)), k2m = __uint_as_float(__hip_atomic_load(FCTL() + CW_NORM + 64 * layer + 12 + hc, RLX_AGENT));
                    const float B2 = sqrtf(q2m * k2m) * 1.03f + 0.5f, dcut = (160.f + 2.f * B2) / slope2;
                    int t0 = (int)floorf(((float)(qb * 256 - 63) - dcut) * (1.f / 64.f)); t0 = __builtin_amdgcn_readfirstlane(t0 > 0 ? (t0 & ~1) : 0);
                    attn_body::AttnArgs a;
                    a.Qw = (const attn_body::bf16*)(qkv + rowq * NPB + hc * 64);
                    a.K0 = (const attn_body::bf16*)(qkv + ((size_t)b * SEQ + 64 * t0) * NPB + 1024 + hc * 64); a.V0 = (const attn_body::bf16*)(qkv + ((size_t)b * SEQ + 64 * t0) * NPB + 1792 + h * 128);
                    a.NT = 4 * (qb + 1) - t0; a.tmax = 1 << 30; a.Ow = (attn_body::bf16*)(WSP(bf16, WS_OTMP) + rowq * 1536 + hc * 128);
                    a.qrel = 32 * wave + (fresh_tid() & 31); a.slope2 = slope2; a.sink2 = 0.f;
                    attn_body::diff_unit<16, NPB, NPB, 1536>(a, (char*)lds + RING_OFF);
                }
            }
            { FRESH_GB();
            for (int L = bx; L < 512; L += G) {
                ArgsP A = fresh_args(); const int wave = F.wave;
                const int b = L / 256, rem = L % 256, qb = rem >> 2, hm = rem & 3;
                const size_t rowq = (size_t)b * SEQ + qb * 256 + 32 * wave;
                attn_body::AttnArgs a;
                a.Qw = (const attn_body::bf16*)(WSP(const bf16, WS_QKV) + rowq * NPB + 768 + hm * 64);
                a.K0 = (const attn_body::bf16*)(WSP(const bf16, WS_MEMKV) + (size_t)b * MEMLEN * 2048 + layer * 512 + hm * 64); a.V0 = a.K0 + 256;
                a.NT = 4; a.tmax = 1 << 30; a.Ow = (attn_body::bf16*)(WSP(bf16, WS_CAT) + rowq * D + 768 + hm * 64);
                a.qrel = 32 * wave + (fresh_tid() & 31); a.slope2 = 0.f; a.sink2 = 0.f;
                attn_body::attn_unit<0, 8, NPB, 2048, D>(a, (char*)lds + RING_OFF);
            } }
        }
        GRID_BAR();
        }
        if (isB) {
            ArgsP A = fresh_args(); FRESH_GB();
            ph_diff_combine(F, WSP(const bf16, WS_OTMP), A->in[5] + jm * 256, A->in[6] + jm * 128, 0.8f - 0.6f * expf(-0.3f * (float)layer), WSP(bf16, WS_CAT));
            GRID_BAR();
        }
        REPEAT(REP_P3) {
        {   ArgsP A = fresh_args(); FRESH_GB();
            pg8::DenseSched S; S.init(M, D, D, G, bx, WSP(const bf16, WS_WOUT) + (size_t)layer * D * D);
            pg8::EpiBf16 E{WSP(bf16, WS_Y), D, 0, 1.f};
            pg8::gemm_phase<pg8::EpiBf16, pg8::DenseSched>(F.lds + RING_OFF, WSP(const bf16, WS_CAT), D, S, E); }
        GRID_BAR();
        }
        {   ArgsP A = fresh_args();
            if (layer == 0) ph_ln_route<true>(F, A->in[0], WSP(const bf16, WS_Y), A->in[9] + (size_t)(layer * 2) * D, A->in[10] + (size_t)(layer * 2) * D, WSP(bf16, WS_XB), WSP(const bf16, WS_WROUT) + (size_t)layer * 256 * D, A->in[12] + layer * 64, FCTL() + CW_CNT + layer * 64 * 64, WSP(int, WS_ROWTOK), WSP(float, WS_ROWGATE), WSP(float, WS_LOGIT));
            else ph_ln_route<false>(F, nullptr, WSP(const bf16, WS_Y), A->in[9] + (size_t)(layer * 2) * D, A->in[10] + (size_t)(layer * 2) * D, WSP(bf16, WS_XB), WSP(const bf16, WS_WROUT) + (size_t)layer * 256 * D, A->in[12] + layer * 64, FCTL() + CW_CNT + layer * 64 * 64, WSP(int, WS_ROWTOK), WSP(float, WS_ROWGATE), WSP(float, WS_LOGIT)); }
        GRID_BAR();
        REPEAT(REP_P7) {
        {   ArgsP A = fresh_args(); FRESH_GB();
            const int nmine = build_units<true>(F, FCTL() + CW_CNT + layer * 64 * 64, WSP(const int, WS_ROWTOK), WSP(const float, WS_ROWGATE));
            pg8::GroupSched<true> S{(const LAS int*)(F.lds + TAB_OFF) + 160, (const LAS int*)(F.lds + IDX_OFF), nmine, D, (const char*)(A->ws + WS_WEXP)};
            pg8::EpiM1 E{WSP(bf16, WS_HB), (const LAS float*)(F.lds + GATE_OFF)};
            pg8::gemm_phase<pg8::EpiM1, pg8::GroupSched<true>>(F.lds + RING_OFF, WSP(const bf16, WS_XB), D, S, E); }
        GRID_BAR();
        }
        REPEAT(REP_P8) {
        {   ArgsP A = fresh_args(); FRESH_GB();
            const int nmine = build_units<false>(F, FCTL() + CW_CNT + layer * 64 * 64, WSP(const int, WS_ROWTOK), WSP(const float, WS_ROWGATE));
            pg8::GroupSched<false> S{(const LAS int*)(F.lds + TAB_OFF) + 160, (const LAS int*)(F.lds + IDX_OFF), nmine, HID, (const char*)(A->ws + WS_WEXP) + pg8::EXPERT_DOWN_OFF};
            pg8::EpiM2 E{WSP(unsigned char, WS_BIG), (const LAS int*)(F.lds + IDX_OFF)};
            pg8::gemm_phase<pg8::EpiM2, pg8::GroupSched<false>>(F.lds + RING_OFF, WSP(const bf16, WS_HB), HID, S, E); }
        GRID_BAR();
        }
        {   ArgsP A = fresh_args(); FRESH_GB();
            if (layer + 1 < DEPTH) ph_combine_ln2<false>(F, A->out, WSP(const unsigned char, WS_BIG), A->in[9] + (size_t)(layer * 2 + 1) * D, A->in[10] + (size_t)(layer * 2 + 1) * D, WSP(bf16, WS_XB));
            else ph_combine_ln2<true>(F, A->out, WSP(const unsigned char, WS_BIG), A->in[9] + (size_t)(layer * 2 + 1) * D, A->in[10] + (size_t)(layer * 2 + 1) * D, WSP(bf16, WS_XB));
            }
        if (layer + 1 < DEPTH) GRID_BAR();
    }
    if (__hip_atomic_load(FCTL() + CW_BAR + XB_TMO, RLX_AGENT) != 0u) {
        __syncthreads();
        ArgsP A = fresh_args(); FRESH_GB(); float* xf = A->out;
        const float q = __builtin_nanf("");
        for (int m = F.gw; m < M; m += F.ngw) { GAS f32x4* o = (GAS f32x4*)(xf + (size_t)m * D) + (fresh_tid() & 63);
#pragma unroll
            for (int j = 0; j < 4; ++j) o[64 * j] = (f32x4){q, q, q, q}; }
    }
}

extern "C" void kernel_launch(void* const* d_in, const int* in_sizes, int n_in, void* d_out, int out_size, void* d_ws, size_t ws_size, hipStream_t stream) {
    static int grid = 0;
    if (grid == 0) {
        if (n_in != 19 || in_sizes[0] != M * D || out_size != M * D || ws_size < WS_END) { fprintf(stderr, "kernel_launch: shape / workspace mismatch (n_in %d, in0 %d, out %d, ws %zu, need %zu); nothing launched\n", n_in, n_in > 0 ? in_sizes[0] : -1, out_size, ws_size, (size_t)WS_END); grid = -1; return; }
        int dev = 0, cus = 0, per_cu = 0;
        if (hipGetDevice(&dev) != hipSuccess || hipDeviceGetAttribute(&cus, hipDeviceAttributeMultiprocessorCount, dev) != hipSuccess) { grid = -1; return; }
        if (hipFuncSetAttribute((const void*)mega_fwd, hipFuncAttributeMaxDynamicSharedMemorySize, LDS_BYTES) != hipSuccess) { fprintf(stderr, "kernel_launch: hipFuncSetAttribute failed\n"); grid = -1; return; }
        if (hipOccupancyMaxActiveBlocksPerMultiprocessor(&per_cu, (const void*)mega_fwd, NWAVES * 64, LDS_BYTES) != hipSuccess || per_cu < 1) { fprintf(stderr, "kernel_launch: occupancy query reports %d\n", per_cu); }
        (void)hipGetLastError();
        grid = cus;
        if (grid != 256) { fprintf(stderr, "kernel_launch: built for 256 CUs, device has %d; nothing launched\n", cus); grid = -1; return; }
    }
    if (grid < 0) return;
    if (hipMemsetAsync((char*)d_ws + WS_CTL, 0, CTL_ZERO_BYTES, stream) != hipSuccess) return;
    Args a{};
    for (int i = 0; i < 19; ++i) a.in[i] = (const float*)d_in[i];
    a.out = (float*)d_out; a.ws = (unsigned char*)d_ws;
    hipLaunchKernelGGL(mega_fwd, dim3(grid), dim3(NWAVES * 64), LDS_BYTES, stream, a);
}
```

```cpp
#include <hip/hip_runtime.h>
#include <hip/hip_bf16.h>
#include <cstdio>
#include <cstdint>
#include <cmath>

namespace pg8 {
#define PG8_LAS __attribute__((address_space(3)))
typedef unsigned short bf16_t;
typedef short bf16x8 __attribute__((ext_vector_type(8)));
typedef float f32x4 __attribute__((ext_vector_type(4)));
typedef unsigned u32x4 __attribute__((ext_vector_type(4)));
constexpr int BM = 256, BK = 64, HALF = 128, HTB = HALF * BK * 2  , STAGE_BYTES = 8 * HTB, NXCD = 8, WGM = 8;
constexpr int EXPERT_BYTES = 3 * 1024 * 256 * 2;
constexpr int EXPERT_DOWN_OFF = 2 * 1024 * 256 * 2;

__host__ __device__ __forceinline__ int lds_byte(int r, int c) { const int st = (r >> 4) * 2 + (c >> 5), rr = r & 15, cc = c & 31, ob = rr * 64 + cc * 2; return st * 1024 + (ob ^ (((ob >> 9) & 1) << 5)); }
__host__ __device__ __forceinline__ void stage_rc(int b, int& R, int& C) { const int st = b / 1024, sb = b % 1024, swz = sb ^ (((sb >> 9) & 1) << 5); R = (st >> 1) * 16 + swz / 64; C = (st & 1) * 32 + (swz % 64) / 2; }
__host__ __device__ __forceinline__ int perm32(int rho) { const int n = rho >> 4, i = rho & 15; return 8 * (i >> 2) + 4 * n + (i & 3); }

struct Unit { int pm, pn, e, nvalid, lbase, pos0, slot; };

struct StaticOrder {
    int nM, nN, nwg, G, c;
    __device__ __forceinline__ void init(int M, int N, int G_, int c_) { nM = M / BM; nN = N / BM; nwg = nM * nN; G = G_; c = c_; }
    __device__ __forceinline__ bool next(int i, Unit& u) const {
        const long L = (long)i * G + c; if (L >= nwg) return false;
        int wgid = (int)L; { const int q = nwg / NXCD, r = nwg % NXCD, xcd = wgid % NXCD, off = wgid / NXCD; wgid = (xcd < r ? xcd * (q + 1) : r * (q + 1) + (xcd - r) * q) + off; }
        const int nig = WGM * nN, gid = wgid / nig, fm = gid * WGM, gsz = (nM - fm) < WGM ? (nM - fm) : WGM;
        u.pm = fm + ((wgid % nig) % gsz); u.pn = (wgid % nig) / gsz; return true;
    }
};
struct DenseSched {
    StaticOrder o; const char* Bt; int K;
    __device__ __forceinline__ void init(int M, int N, int K_, int G, int c, const bf16_t* Bt_) { o.init(M, N, G, c); Bt = (const char*)Bt_; K = K_; }
    __device__ __forceinline__ bool next(int i, Unit& u) const { u.e = 0; u.nvalid = 256; u.lbase = 0; u.pos0 = 0; u.slot = 0; return o.next(i, u); }
    __device__ __forceinline__ const char* bptr(const Unit& u) const { return Bt + (size_t)u.pn * (BM * 2) * K; }
    __device__ __forceinline__ void avoff(const Unit& u, int tid, unsigned (&v)[2][2]) const {
#pragma unroll
        for (int i = 0; i < 2; ++i) { int R, C; stage_rc(tid * 16 + i * 8192, R, C);
#pragma unroll
            for (int h = 0; h < 2; ++h) v[h][i] = (unsigned)((u.pm * BM + h * HALF + R) * K + C) * 2u; }
    }
};
template <bool GATHER> struct GroupSched {
    const PG8_LAS int* utab; const PG8_LAS int* idx; int nmine, K; const char* W;
    __device__ __forceinline__ bool next(int i, Unit& u) const {
        if (i >= nmine) return false; const PG8_LAS int* t = utab + i * 8;
        u.e = __builtin_amdgcn_readfirstlane(t[0]); u.pm = __builtin_amdgcn_readfirstlane(t[1]); u.pn = __builtin_amdgcn_readfirstlane(t[2]);
        u.nvalid = __builtin_amdgcn_readfirstlane(t[3]); u.lbase = __builtin_amdgcn_readfirstlane(t[4]); u.pos0 = __builtin_amdgcn_readfirstlane(t[5]); u.slot = i; return true;
    }
    __device__ __forceinline__ const char* bptr(const Unit& u) const { return W + (size_t)u.e * EXPERT_BYTES + (size_t)u.pn * (BM * 2) * K; }
    __device__ __forceinline__ void avoff(const Unit& u, int tid, unsigned (&v)[2][2]) const {
#pragma unroll
        for (int i = 0; i < 2; ++i) { int R, C; stage_rc(tid * 16 + i * 8192, R, C);
#pragma unroll
            for (int h = 0; h < 2; ++h) {
                const int row = GATHER ? idx[u.slot * 256 + h * HALF + R] : (u.pm * BM + h * HALF + R);
                v[h][i] = (unsigned)(row * K + C) * 2u; } }
    }
};

typedef float f32x2v __attribute__((ext_vector_type(2))); typedef __bf16 bf16x2v __attribute__((ext_vector_type(2)));
__device__ __forceinline__ unsigned cvt_pk_bf16(float lo, float hi) { f32x2v v = {lo, hi}; bf16x2v b = __builtin_convertvector(v, bf16x2v); return __builtin_bit_cast(unsigned, b); }

struct EpiBf16 {
    static constexpr bool PERM = true; static constexpr int NST = 16;
    bf16_t* O; int ldc; int nsc; float scale;
    __device__ __forceinline__ void operator()(const f32x4 (&acc)[2][2][4][2], const Unit& u, int wr, int wc, int fr, int fq) const {
        const int row0 = u.pm * BM + wr * 64 + fr; const int col0 = u.pn * BM + wc * 32 + 8 * fq; const float sc = (u.pn < nsc) ? scale : 1.f;
#pragma unroll
        for (int ai = 0; ai < 2; ++ai)
#pragma unroll
            for (int m = 0; m < 4; ++m) { bf16_t* rowp = O + (size_t)(row0 + ai * HALF + m * 16) * ldc + col0;
#pragma unroll
                for (int bj = 0; bj < 2; ++bj) { const f32x4 v0 = acc[ai][bj][m][0] * sc, v1 = acc[ai][bj][m][1] * sc;
                    u32x4 w; w.x = cvt_pk_bf16(v0[0], v0[1]); w.y = cvt_pk_bf16(v0[2], v0[3]); w.z = cvt_pk_bf16(v1[0], v1[1]); w.w = cvt_pk_bf16(v1[2], v1[3]);
                    *(u32x4*)(rowp + bj * HALF) = w; } }
    }
};
__device__ __forceinline__ float silu_f(float x) { return x * __builtin_amdgcn_rcpf(1.0f + __builtin_amdgcn_exp2f(-1.4426950408889634f * x)); }
struct EpiM1 {
    static constexpr bool PERM = true; static constexpr int NST = 8;
    bf16_t* H; const PG8_LAS float* lgate;
    __device__ __forceinline__ void operator()(const f32x4 (&acc)[2][2][4][2], const Unit& u, int wr, int wc, int fr, int fq) const {
        const int col0 = u.pn * HALF + wc * 32 + 8 * fq; const PG8_LAS float* lg = lgate + u.slot * 256;
#pragma unroll
        for (int ai = 0; ai < 2; ++ai)
#pragma unroll
            for (int m = 0; m < 4; ++m) { const int r = ai * HALF + wr * 64 + m * 16 + fr;
                const float g = lg[r];
                const f32x4 ga = acc[ai][0][m][0], gb = acc[ai][0][m][1], ua = acc[ai][1][m][0], ub = acc[ai][1][m][1];
                f32x4 v0, v1;
#pragma unroll
                for (int j = 0; j < 4; ++j) { v0[j] = silu_f(ga[j]) * ua[j] * g; v1[j] = silu_f(gb[j]) * ub[j] * g; }
                u32x4 w; w.x = cvt_pk_bf16(v0[0], v0[1]); w.y = cvt_pk_bf16(v0[2], v0[3]); w.z = cvt_pk_bf16(v1[0], v1[1]); w.w = cvt_pk_bf16(v1[2], v1[3]);
                *(u32x4*)(H + (size_t)(u.pm * BM + r) * 256 + col0) = w; }
    }
};
constexpr float Y8_SCALE = 16.f;
typedef unsigned u32x2e __attribute__((ext_vector_type(2)));
struct EpiM2 {
    static constexpr bool PERM = true; static constexpr int NST = 16;
    unsigned char* Y; const PG8_LAS int* ldst;
    __device__ __forceinline__ void operator()(const f32x4 (&acc)[2][2][4][2], const Unit& u, int wr, int wc, int fr, int fq) const {
        const int col0 = u.pn * BM + wc * 32 + 8 * fq; const PG8_LAS int* ld = ldst + u.slot * 256;
#pragma unroll
        for (int ai = 0; ai < 2; ++ai)
#pragma unroll
            for (int m = 0; m < 4; ++m) { const int r = ai * HALF + wr * 64 + m * 16 + fr;
                const int dst = ld[r];
                {
                    unsigned char* rowp = Y + (size_t)dst * 1024 + col0;
#pragma unroll
                    for (int bj = 0; bj < 2; ++bj) { const f32x4 v0 = acc[ai][bj][m][0] * Y8_SCALE, v1 = acc[ai][bj][m][1] * Y8_SCALE;
                        int w0 = __builtin_amdgcn_cvt_pk_fp8_f32(v0[0], v0[1], 0, false); w0 = __builtin_amdgcn_cvt_pk_fp8_f32(v0[2], v0[3], w0, true);
                        int w1 = __builtin_amdgcn_cvt_pk_fp8_f32(v1[0], v1[1], 0, false); w1 = __builtin_amdgcn_cvt_pk_fp8_f32(v1[2], v1[3], w1, true);
                        *(u32x2e*)(rowp + bj * HALF) = (u32x2e){(unsigned)w0, (unsigned)w1}; } } }
    }
};

template <class Epi, class Sched>
__device__ __forceinline__ void gemm_phase(PG8_LAS unsigned char* lds, const bf16_t* Abase, const int K, const Sched& S, const Epi& E) {
    int tid = threadIdx.x; asm volatile("" : "+v"(tid));
    const int wid = __builtin_amdgcn_readfirstlane(tid >> 6), lane = tid & 63, wr = wid >> 2, wc = wid & 3, fr = lane & 15, fq = lane >> 4;
    const int nt = K / BK;
    unsigned voffB[2];
#pragma unroll
    for (int i = 0; i < 2; ++i) { int R, C; stage_rc(tid * 16 + i * 8192, R, C); const int Rb = Epi::PERM ? ((R & ~31) + perm32(R & 31)) : R; voffB[i] = (unsigned)(Rb * K + C) * 2u; }
    const size_t kstep = (size_t)(BK * 2);
    const size_t hstep = (size_t)HALF * K * 2;
    const unsigned ldsw = (unsigned)wid * 1024u;
    const int aoff = lds_byte(wr * 64 + fr, fq * 8), boff = lds_byte(wc * 32 + fr, fq * 8);
    const char* Ab = (const char*)Abase;
#define PG8_SA(b, h) (((b) * 2 + (h)) * HTB)
#define PG8_SB(b, h) ((4 + (b) * 2 + (h)) * HTB)
#define PG8_STAGE(bufoff, gbase, voff) do { _Pragma("unroll") for (int _i = 0; _i < 2; ++_i) \
        __builtin_amdgcn_global_load_lds((const unsigned*)((const char*)(gbase) + (voff)[_i]), (PG8_LAS unsigned*)(lds + (bufoff) + ldsw + _i * 8192), 16, 0, 0); } while (0)
#define PG8_STAGEA(bufoff, kb, V, h) do { _Pragma("unroll") for (int _i = 0; _i < 2; ++_i) \
        __builtin_amdgcn_global_load_lds((const unsigned*)(Ab + (kb) + (V)[h][_i]), (PG8_LAS unsigned*)(lds + (bufoff) + ldsw + _i * 8192), 16, 0, 0); } while (0)
#define PG8_LDA(dst, b, h) do { _Pragma("unroll") for (int m = 0; m < 4; ++m) _Pragma("unroll") for (int k = 0; k < 2; ++k) dst[m][k] = *(const PG8_LAS bf16x8*)(lds + PG8_SA(b, h) + aoff + m * 2048 + k * 1024); } while (0)
#define PG8_LDB(dst, b, h) do { _Pragma("unroll") for (int n = 0; n < 2; ++n) _Pragma("unroll") for (int k = 0; k < 2; ++k) dst[n][k] = *(const PG8_LAS bf16x8*)(lds + PG8_SB(b, h) + boff + n * 2048 + k * 1024); } while (0)
#define PG8_MMA(ai, bj, At, Bt) do { __builtin_amdgcn_s_setprio(1); _Pragma("unroll") for (int m = 0; m < 4; ++m) _Pragma("unroll") for (int n = 0; n < 2; ++n) _Pragma("unroll") for (int k = 0; k < 2; ++k) \
        acc[ai][bj][m][n] = __builtin_amdgcn_mfma_f32_16x16x32_bf16(Bt[n][k], At[m][k], acc[ai][bj][m][n], 0, 0, 0); __builtin_amdgcn_s_setprio(0); } while (0)
#define PG8_WAIT_V(n) asm volatile("s_waitcnt vmcnt(" #n ")" ::: "memory")
#define PG8_WAIT_VR(rl) do { if (rl) asm volatile("s_waitcnt vmcnt(%0)" :: "n"(8 + Epi::NST) : "memory"); else asm volatile("s_waitcnt vmcnt(8)" ::: "memory"); } while (0)
#define PG8_WAIT_L(n) asm volatile("s_waitcnt lgkmcnt(" #n ")" ::: "memory")
#define PG8_BAR __builtin_amdgcn_s_barrier()
#define PG8_SCHED __builtin_amdgcn_sched_barrier(0)
    Unit cur, nxt; int ui = 0;
    if (!S.next(0, cur)) return;
    nxt = cur;
    f32x4 acc[2][2][4][2];
#pragma unroll
    for (int a = 0; a < 2; ++a)
#pragma unroll
        for (int b = 0; b < 2; ++b)
#pragma unroll
            for (int m = 0; m < 4; ++m)
#pragma unroll
                for (int n = 0; n < 2; ++n) acc[a][b][m][n] = (f32x4){0.f, 0.f, 0.f, 0.f};
    bf16x8 At[4][2], B0[2][2], B1[2][2];
    unsigned vA[2][2];
    S.avoff(cur, tid, vA);
    const char* cB = S.bptr(cur);
    PG8_STAGE(PG8_SB(0, 0), cB, voffB); PG8_STAGE(PG8_SB(0, 1), cB + hstep, voffB); PG8_STAGEA(PG8_SA(0, 0), 0, vA, 0); PG8_STAGEA(PG8_SA(0, 1), 0, vA, 1);
    if (wr == 1) PG8_BAR;
    PG8_WAIT_V(2); PG8_BAR;
    PG8_STAGE(PG8_SB(1, 0), cB + kstep, voffB); PG8_STAGEA(PG8_SA(1, 0), kstep, vA, 0); PG8_STAGE(PG8_SB(1, 1), cB + hstep + kstep, voffB);
    PG8_WAIT_V(6); PG8_BAR;
    bool relax = false;
    for (;;) {
        const bool has_next = S.next(ui + 1, nxt);
        const char* nB = cB;
        if (has_next) nB = S.bptr(nxt);
#pragma unroll 1
        for (int t = 0; t < nt; t += 2) {
            const bool last = (t == nt - 2); const bool rl = relax && (t == 0);
            const size_t kb1 = (size_t)(t + 1) * kstep;
            const size_t kb2 = last ? (size_t)0 : (size_t)(t + 2) * kstep; const char* b2 = last ? nB : cB + (size_t)(t + 2) * kstep;
            const size_t kb3 = kb2 + kstep; const char* b3 = b2 + kstep;
            PG8_LDB(B0, 0, 0); PG8_LDB(B1, 0, 1); PG8_SCHED; PG8_LDA(At, 0, 0); if (!rl) PG8_STAGEA(PG8_SA(1, 1), kb1, vA, 1);
            if (last && has_next) S.avoff(nxt, tid, vA);
            PG8_WAIT_VR(rl); PG8_WAIT_L(0); PG8_BAR; PG8_MMA(0, 0, At, B0); PG8_MMA(0, 1, At, B1); PG8_BAR; PG8_SCHED;
            PG8_LDA(At, 0, 1); PG8_STAGE(PG8_SB(0, 0), b2, voffB); PG8_STAGE(PG8_SB(0, 1), b2 + hstep, voffB); PG8_STAGEA(PG8_SA(0, 0), kb2, vA, 0);
            PG8_WAIT_VR(rl); PG8_WAIT_L(0); PG8_BAR; PG8_MMA(1, 0, At, B0); PG8_MMA(1, 1, At, B1); PG8_BAR; PG8_SCHED;
            PG8_LDB(B0, 1, 0); PG8_LDB(B1, 1, 1); PG8_SCHED; PG8_LDA(At, 1, 0); PG8_STAGEA(PG8_SA(0, 1), kb2, vA, 1);
            PG8_WAIT_VR(rl); PG8_WAIT_L(0); PG8_BAR; PG8_MMA(0, 0, At, B0); PG8_MMA(0, 1, At, B1); PG8_BAR; PG8_SCHED;
            PG8_LDA(At, 1, 1); PG8_STAGE(PG8_SB(1, 0), b3, voffB); PG8_STAGE(PG8_SB(1, 1), b3 + hstep, voffB); PG8_STAGEA(PG8_SA(1, 0), kb3, vA, 0);
            PG8_WAIT_V(8); PG8_WAIT_L(0); PG8_BAR; PG8_MMA(1, 0, At, B0); PG8_MMA(1, 1, At, B1); PG8_BAR; PG8_SCHED;
        }
        if (wr == 0) PG8_BAR;
        if (has_next) PG8_STAGEA(PG8_SA(1, 1), kstep, vA, 1);
        E(acc, cur, wr, wc, fr, fq);
        if (!has_next) break;
#pragma unroll
        for (int a = 0; a < 2; ++a)
#pragma unroll
            for (int b = 0; b < 2; ++b)
#pragma unroll
                for (int m = 0; m < 4; ++m)
#pragma unroll
                    for (int n = 0; n < 2; ++n) acc[a][b][m][n] = (f32x4){0.f, 0.f, 0.f, 0.f};
        cur = nxt; cB = nB; ++ui; relax = true;
        if (wr == 1) PG8_BAR;
    }
    PG8_WAIT_V(0);
    PG8_BAR;
#undef PG8_SA
#undef PG8_SB
#undef PG8_STAGE
#undef PG8_STAGEA
#undef PG8_LDA
#undef PG8_LDB
#undef PG8_MMA
#undef PG8_WAIT_V
#undef PG8_WAIT_VR
#undef PG8_WAIT_L
#undef PG8_BAR
#undef PG8_SCHED
}
}
namespace attn_body {
using bf16=__hip_bfloat16;
using bf16x8=__attribute__((ext_vector_type(8)))short;
using s16x4=__attribute__((ext_vector_type(4)))short;
using f32x16=__attribute__((ext_vector_type(16)))float;
using u32x4=__attribute__((ext_vector_type(4)))unsigned;
constexpr int D=64,NW=8,QBLK=32,QB=QBLK*NW,KVBLK=64;
__device__ __forceinline__ int crow(int r,int hi){return (r&3)+8*(r>>2)+4*hi;}
#define SBAR() __builtin_amdgcn_sched_barrier(0)
constexpr int NSLOT=3, SLOTB=8192;
constexpr int LDS_K=0, LDS_V=NSLOT*SLOTB, LDS_WS=2*NSLOT*SLOTB, LDS_OST=LDS_WS+NW*64*4, LDS_BYTES=LDS_OST+NW*4096;
constexpr float LOG2E=1.4426950408889634f;
constexpr float C2=0.125f*LOG2E;
__device__ __forceinline__ void glds16(const void*gsrc,unsigned lds_dst){unsigned keep;
  asm volatile("s_mov_b32 %0, m0\n\ts_mov_b32 m0, %2\n\ts_nop 0\n\tglobal_load_lds_dwordx4 %1, off\n\ts_mov_b32 m0, %0":"=&s"(keep):"v"(gsrc),"s"(lds_dst):"memory");}
__device__ __forceinline__ float max3f(float a,float b,float c){float r;asm("v_max3_f32 %0, %1, %2, %3":"=v"(r):"v"(a),"v"(b),"v"(c));return r;}
__device__ __forceinline__ float max2f(float a,float b){float r;asm("v_max_f32_e32 %0, %1, %2":"=v"(r):"v"(a),"v"(b));return r;}
__device__ __forceinline__ float fadd_s(float a,float b){float r;asm("v_add_f32_e32 %0, %1, %2":"=v"(r):"v"(a),"v"(b));return r;}
__device__ __forceinline__ float fsub_s(float a,float b){float r;asm("v_sub_f32_e32 %0, %1, %2":"=v"(r):"v"(a),"v"(b));return r;}
typedef float f32x2_t __attribute__((ext_vector_type(2))); typedef __bf16 bf16x2_t __attribute__((ext_vector_type(2)));
__device__ __forceinline__ unsigned cvtpk_s(float lo,float hi){f32x2_t v={lo,hi};bf16x2_t b=__builtin_convertvector(v,bf16x2_t);return __builtin_bit_cast(unsigned,b);}
#define WAIT_BAR(N) asm volatile("s_waitcnt vmcnt(" #N ") lgkmcnt(0)\n\ts_barrier":::"memory")

template<int MODE> __device__ __forceinline__ void maskbias(f32x16&p0,f32x16&p1,int kb,int qrel,float slope2,float mhat,bool band,bool tile_ok){
  if(MODE==0)return;
  const float NEG=-INFINITY; const float lb=slope2*(float)(kb-qrel)-mhat;
  #pragma unroll
  for(int r=0;r<16;++r){const int c=(r&3)+8*(r>>2); p0[r]=__builtin_fmaf(slope2,(float)c,p0[r]+lb); p1[r]=__builtin_fmaf(slope2,(float)(c+32),p1[r]+lb);}
  if(MODE==1){ if(band){
    #pragma unroll
    for(int r=0;r<16;++r){const int kv=kb+(r&3)+8*(r>>2); if(kv>qrel)p0[r]=NEG; if(kv+32>qrel)p1[r]=NEG;} } }
  if(MODE==2){
    #pragma unroll
    for(int r=0;r<16;++r){const int d=qrel-kb-((r&3)+8*(r>>2)); if((unsigned)d>=128u||!tile_ok)p0[r]=NEG; if((unsigned)(d-32)>=128u||!tile_ok)p1[r]=NEG;} }
}

__device__ __forceinline__ void qkt(f32x16&p0,f32x16&p1,const char*Kslot,const bf16x8*qr,const f32x16&negm,int r32,int hi){
  const char*kb=Kslot+hi*1024+r32*16;
  #pragma unroll
  for(int d0=0;d0<4;++d0){
    const bf16x8 b0=*reinterpret_cast<const bf16x8*>(kb+d0*2048);
    const bf16x8 b1=*reinterpret_cast<const bf16x8*>(kb+d0*2048+512);
    if(d0==0){p0=__builtin_amdgcn_mfma_f32_32x32x16_bf16(b0,qr[0],negm,0,0,0);p1=__builtin_amdgcn_mfma_f32_32x32x16_bf16(b1,qr[0],negm,0,0,0);}
    else{p0=__builtin_amdgcn_mfma_f32_32x32x16_bf16(b0,qr[d0],p0,0,0,0);p1=__builtin_amdgcn_mfma_f32_32x32x16_bf16(b1,qr[d0],p1,0,0,0);}}
}
typedef __attribute__((address_space(3))) const char* lds_cptr;
typedef short v4i16_t __attribute__((ext_vector_type(4)));
__device__ __forceinline__ void kload8(bf16x8*kf,lds_cptr kp){
  kf[0]=*(const __attribute__((address_space(3))) bf16x8*)(kp);      kf[1]=*(const __attribute__((address_space(3))) bf16x8*)(kp+512);
  kf[2]=*(const __attribute__((address_space(3))) bf16x8*)(kp+2048); kf[3]=*(const __attribute__((address_space(3))) bf16x8*)(kp+2560);
  kf[4]=*(const __attribute__((address_space(3))) bf16x8*)(kp+4096); kf[5]=*(const __attribute__((address_space(3))) bf16x8*)(kp+4608);
  kf[6]=*(const __attribute__((address_space(3))) bf16x8*)(kp+6144); kf[7]=*(const __attribute__((address_space(3))) bf16x8*)(kp+6656);
}
__device__ __forceinline__ void kload2(bf16x8*kf,lds_cptr kp,int j){ kf[2*j]=*(const __attribute__((address_space(3))) bf16x8*)(kp+j*2048); kf[2*j+1]=*(const __attribute__((address_space(3))) bf16x8*)(kp+j*2048+512); }
__device__ __forceinline__ s16x4 vtr(lds_cptr p){ return __builtin_bit_cast(s16x4,__builtin_amdgcn_ds_read_tr16_b64_v4i16((__attribute__((address_space(3))) v4i16_t*)p)); }
__device__ __forceinline__ float rowmax(const f32x16&p0,const f32x16&p1){
  float a=max3f(p0[0],p0[1],p1[0]),b=max3f(p0[2],p0[3],p1[1]);a=max3f(a,p1[2],p1[3]);
  #pragma unroll
  for(int r=4;r<16;r+=4){a=max3f(a,p0[r],p0[r+1]);b=max3f(b,p0[r+2],p0[r+3]);a=max3f(a,p1[r],p1[r+1]);b=max3f(b,p1[r+2],p1[r+3]);}
  const float m=max2f(a,b);
  auto rr=__builtin_amdgcn_permlane32_swap(__float_as_uint(m),__float_as_uint(m),false,false);
  return max2f(__uint_as_float(rr[0]),__uint_as_float(rr[1]));
}
__device__ __forceinline__ void pv(f32x16*o,int vb,bf16x8 pa0,bf16x8 pa1,bf16x8 pa2,bf16x8 pa3){
  #pragma unroll
  for(int d0=0;d0<2;++d0){s16x4 lo[4],hi[4];
    #pragma unroll
    for(int ks=0;ks<4;++ks){
      asm volatile("ds_read_b64_tr_b16 %0,%1 offset:%c2":"=&v"(lo[ks]):"v"(vb),"i"(d0*4096+ks*1024):"memory");
      asm volatile("ds_read_b64_tr_b16 %0,%1 offset:%c2":"=&v"(hi[ks]):"v"(vb),"i"(d0*4096+ks*1024+512):"memory");}
    asm volatile("s_waitcnt lgkmcnt(0)":::"memory");SBAR();
    #define PK(k) (bf16x8){lo[k][0],lo[k][1],lo[k][2],lo[k][3],hi[k][0],hi[k][1],hi[k][2],hi[k][3]}
    o[d0]=__builtin_amdgcn_mfma_f32_32x32x16_bf16(pa0,PK(0),o[d0],0,0,0);
    o[d0]=__builtin_amdgcn_mfma_f32_32x32x16_bf16(pa1,PK(1),o[d0],0,0,0);
    o[d0]=__builtin_amdgcn_mfma_f32_32x32x16_bf16(pa2,PK(2),o[d0],0,0,0);
    o[d0]=__builtin_amdgcn_mfma_f32_32x32x16_bf16(pa3,PK(3),o[d0],0,0,0);
    #undef PK
  }
}
struct AttnArgs {
  const bf16* Qw;
  const bf16* K0; const bf16* V0;
  int NT;
  int tmax;
  bf16* Ow;
  int qrel;
  float slope2, sink2;
};
#define ATTN_STORE16(p,v) (*(u32x4*)(p)=(v))
template<int MODE,int THRL,int QP,int KVP,int OP> __device__ __forceinline__ void attn_unit(const AttnArgs&a,char*shm){
  int tid=threadIdx.x; asm volatile("":"+v"(tid)); const int lane=tid&63,r32=lane&31,hi=lane>>5; const int wid=__builtin_amdgcn_readfirstlane(tid>>6);
  const bf16*Qw=a.Qw; constexpr int qp=QP; constexpr long kvp=KVP;
  const unsigned lds0=(unsigned)(uintptr_t)shm;
  float*wsf=(float*)(shm+LDS_WS)+wid*64;
  const bf16*ksrc=a.K0+(long)lane*kvp+wid*8;
  const bf16*vsrc=a.V0+(long)(16*(wid&3)+(lane>>2))*kvp+(wid>>2)*32+(lane&3)*8;
  const unsigned kdst=lds0+LDS_K+wid*1024, vdst=lds0+LDS_V+wid*1024;
  const int tmax=a.tmax;
  #define TROW(t) ((MODE==2)?(-64*(((t)<tmax)?(t):tmax)):(64*(t)))
  #define DMA_K(t,slot) glds16(ksrc+(long)TROW(t)*kvp,(unsigned)__builtin_amdgcn_readfirstlane(kdst+(slot)))
  #define DMA_V(t,slot) glds16(vsrc+(long)TROW(t)*kvp,(unsigned)__builtin_amdgcn_readfirstlane(vdst+(slot)))
  const int vb0=(int)(lds0+LDS_V)+((lane>>4)&1)*32+(lane&3)*8+(4*hi+((lane&15)>>2))*64;
  const char*Kbase=shm+LDS_K; bf16x8 kf[8];
  const lds_cptr shm3=(lds_cptr)shm; const lds_cptr kp0=shm3+LDS_K+hi*1024+r32*16; const lds_cptr vp0=shm3+LDS_V+((lane>>4)&1)*32+(lane&3)*8+(4*hi+((lane&15)>>2))*64;
  const int NT=a.NT;
  DMA_K(0,0);DMA_V(0,0);DMA_K(1,SLOTB);
  bf16x8 qr[4];
  #pragma unroll
  for(int d0=0;d0<4;++d0)qr[d0]=*reinterpret_cast<const bf16x8*>(&Qw[(long)r32*qp+d0*16+hi*8]);
  float z0_; asm volatile("v_mov_b32 %0, 0":"=v"(z0_));
  f32x16 zv_; _Pragma("unroll") for(int r=0;r<16;++r)zv_[r]=z0_;
  float mhat=0.f,l_reg=0.f;f32x16 o[2];o[0]=zv_;o[1]=zv_;f32x16 negm=zv_;if(MODE==0)asm volatile("":"+v"(negm));
  const int qrel=a.qrel; const float slope2=a.slope2;
  #define KBREL(t) ((MODE==2)?(-64*(t)):(64*((t)-(NT-4))))
  #define MBIAS(P0,P1,t,BAND) maskbias<MODE>(P0,P1,KBREL(t)+4*hi,qrel,slope2,mhat,(BAND)&&((t)>=NT-4),(t)<=tmax)
  #define CINIT ((MODE==0)?negm:(f32x16{}))
  #define CMASK(P0,P1,t) MBIAS(P0,P1,t,true)
  bool resc=false;
  #define START(P0,P1) do{ const float rm=rowmax(P0,P1); resc=false; \
    { const float dl=rm; mhat=fadd_s(mhat,dl); \
      _Pragma("unroll") for(int r=0;r<16;++r){P0[r]=fsub_s(P0[r],dl);P1[r]=fsub_s(P1[r],dl);} \
      if(MODE==0){ _Pragma("unroll") for(int r=0;r<16;++r)negm[r]=-mhat; asm volatile("":"+v"(negm)); } } \
    _Pragma("unroll") for(int r=0;r<16;++r)P0[r]=__builtin_amdgcn_exp2f(P0[r]); }while(0)
  #define RESC() do{ if(resc){ asm volatile("s_waitcnt lgkmcnt(0)":::"memory"); \
      _Pragma("unroll") for(int d_=0;d_<2;++d_) _Pragma("unroll") for(int r=0;r<16;++r)o[d_][r]*=wsf[crow(r,hi)]; } }while(0)
  f32x16 pA0,pA1,pB0,pB1;
  int sl_prev=0,sl_cur=0,sl_next=SLOTB;
  #define ROT() do{sl_prev=sl_cur;sl_cur=sl_next;sl_next=(sl_next==(NSLOT-1)*SLOTB)?0:sl_next+SLOTB;}while(0)
  DMA_K(2,2*SLOTB);
  WAIT_BAR(3);
  qkt(pA0,pA1,Kbase,qr,negm,r32,hi);asm volatile("s_nop 15\n\ts_nop 7":"+v"(pA0),"+v"(pA1));CMASK(pA0,pA1,0);
  START(pA0,pA1);
  _Pragma("unroll") for(int r=0;r<16;++r)pA1[r]=__builtin_amdgcn_exp2f(pA1[r]);
  WAIT_BAR(0);
  DMA_K(3,0);DMA_V(1,SLOTB);
  ROT();
  kload8(kf,kp0+sl_cur);
  WAIT_BAR(2);
  s16x4 vlo[8],vhi[8]; u32x4 pw0,pw1,pw2,pw3;
  #define PKW(P,B) cvtpk_s(P[B],P[B+1])
  #define PAF(k) __builtin_bit_cast(bf16x8,pw##k)
  #define VFR(i) (bf16x8){vlo[i][0],vlo[i][1],vlo[i][2],vlo[i][3],vhi[i][0],vhi[i][1],vhi[i][2],vhi[i][3]}
  #define PIN(x) asm volatile("":"+v"(x))
  #define MX3(a,b,c) __builtin_fmaxf(__builtin_fmaxf((a),(b)),(c))
  #define GAPA(MF,A0,A1,A2,A3,W0,W1,PW) do{ MF; sacc+=A0; sacc+=A1; sacc+=A2; sacc+=A3; PIN(sacc); W0; W1; PIN(PW); SBAR(); }while(0)
  #define EX(v) __builtin_amdgcn_exp2f(v)
  #define GAPB(MF,X,B) do{ MF; X[B]=EX(X[B]); X[B+1]=EX(X[B+1]); X[B+2]=EX(X[B+2]); X[B+3]=EX(X[B+3]); PIN(X); SBAR(); }while(0)
  #define VRD(i) do{ vlo[i]=vtr(vp_+(((i)>>2)*4096+((i)&3)*1024)); vhi[i]=vtr(vp_+(((i)>>2)*4096+((i)&3)*1024+512)); }while(0)
  #define KRD(G,j) do{ if(G){ kload2(kf,kp0+sl_next,j); SBAR(); } }while(0)
  #define STEP(C0,C1,P0,P1,t,GK,GV,GL) do{ SBAR(); \
    const lds_cptr vp_=vp0+sl_prev; \
    VRD(0); SBAR(); float sacc=(P0[0]+P0[1]); \
    GAPA(C0=__builtin_amdgcn_mfma_f32_32x32x16_bf16(kf[0],qr[0],CINIT,0,0,0), P0[2],P0[3],P0[4],P0[5],     pw0[0]=PKW(P0,0), pw0[1]=PKW(P0,2), pw0); \
    VRD(4); SBAR(); GAPA(C1=__builtin_amdgcn_mfma_f32_32x32x16_bf16(kf[1],qr[0],CINIT,0,0,0), P0[6],P0[7],P0[8],P0[9],     pw0[2]=PKW(P0,4), pw0[3]=PKW(P0,6), pw0); \
    VRD(1); SBAR(); GAPA(C0=__builtin_amdgcn_mfma_f32_32x32x16_bf16(kf[2],qr[1],C0,0,0,0),   P0[10],P0[11],P0[12],P0[13], pw1[0]=PKW(P0,8), pw1[1]=PKW(P0,10), pw1); \
    VRD(5); SBAR(); GAPA(C1=__builtin_amdgcn_mfma_f32_32x32x16_bf16(kf[3],qr[1],C1,0,0,0),   P0[14],P0[15],P1[0],P1[1],   pw1[2]=PKW(P0,12),pw1[3]=PKW(P0,14), pw1); \
    VRD(2); SBAR(); GAPA(C0=__builtin_amdgcn_mfma_f32_32x32x16_bf16(kf[4],qr[2],C0,0,0,0),   P1[2],P1[3],P1[4],P1[5],     pw2[0]=PKW(P1,0), pw2[1]=PKW(P1,2), pw2); \
    VRD(6); SBAR(); GAPA(C1=__builtin_amdgcn_mfma_f32_32x32x16_bf16(kf[5],qr[2],C1,0,0,0),   P1[6],P1[7],P1[8],P1[9],     pw2[2]=PKW(P1,4), pw2[3]=PKW(P1,6), pw2); \
    VRD(3); SBAR(); GAPA(C0=__builtin_amdgcn_mfma_f32_32x32x16_bf16(kf[6],qr[3],C0,0,0,0),   P1[10],P1[11],P1[12],P1[13], pw3[0]=PKW(P1,8), pw3[1]=PKW(P1,10), pw3); \
    VRD(7); SBAR(); GAPA(C1=__builtin_amdgcn_mfma_f32_32x32x16_bf16(kf[7],qr[3],C1,0,0,0),   P1[14],P1[15],0.f,0.f,       pw3[2]=PKW(P1,12),pw3[3]=PKW(P1,14), pw3); \
    l_reg+=sacc; \
    if(GK){DMA_K((t)+3,sl_cur);} if(GV){DMA_V((t)+1,sl_next);} \
    CMASK(C0,C1,t); \
    { float a_=MX3(C0[0],C0[1],C1[0]),b_=MX3(C0[2],C0[3],C1[1]); a_=MX3(a_,C1[2],C1[3]); \
      _Pragma("unroll") for(int r=4;r<16;r+=4){a_=MX3(a_,C0[r],C0[r+1]);b_=MX3(b_,C0[r+2],C0[r+3]);a_=MX3(a_,C1[r],C1[r+1]);b_=MX3(b_,C1[r+2],C1[r+3]);} \
      float rm=__builtin_fmaxf(a_,b_); { auto rr=__builtin_amdgcn_permlane32_swap(__float_as_uint(rm),__float_as_uint(rm),false,false); rm=__builtin_fmaxf(__uint_as_float(rr[0]),__uint_as_float(rr[1])); } \
      resc=false; \
      if(__builtin_expect(__any(rm>(float)THRL),0)){ const float dl=__builtin_fmaxf(rm,0.f); mhat+=dl; \
        _Pragma("unroll") for(int r=0;r<16;++r){C0[r]-=dl;C1[r]-=dl;} \
        if(MODE==0){ _Pragma("unroll") for(int r=0;r<16;++r)negm[r]=-mhat; asm volatile("":"+v"(negm)); } \
        const float f=__builtin_amdgcn_exp2f(-dl); l_reg*=f; if(hi==0)wsf[r32]=f; resc=true; } } \
    SBAR(); \
    GAPB(o[0]=__builtin_amdgcn_mfma_f32_32x32x16_bf16(PAF(0),VFR(0),o[0],0,0,0), C0,0); \
    GAPB(o[1]=__builtin_amdgcn_mfma_f32_32x32x16_bf16(PAF(0),VFR(4),o[1],0,0,0), C0,4); \
    KRD(GL,0); GAPB(o[0]=__builtin_amdgcn_mfma_f32_32x32x16_bf16(PAF(1),VFR(1),o[0],0,0,0), C0,8); \
    KRD(GL,1); GAPB(o[1]=__builtin_amdgcn_mfma_f32_32x32x16_bf16(PAF(1),VFR(5),o[1],0,0,0), C0,12); \
    KRD(GL,2); GAPB(o[0]=__builtin_amdgcn_mfma_f32_32x32x16_bf16(PAF(2),VFR(2),o[0],0,0,0), C1,0); \
    KRD(GL,3); GAPB(o[1]=__builtin_amdgcn_mfma_f32_32x32x16_bf16(PAF(2),VFR(6),o[1],0,0,0), C1,4); \
    GAPB(o[0]=__builtin_amdgcn_mfma_f32_32x32x16_bf16(PAF(3),VFR(3),o[0],0,0,0), C1,8); \
    GAPB(o[1]=__builtin_amdgcn_mfma_f32_32x32x16_bf16(PAF(3),VFR(7),o[1],0,0,0), C1,12); \
    }while(0)
  int t=1;
  #undef CMASK
  #define CMASK(P0,P1,t) MBIAS(P0,P1,t,false)
  for(;t+5<NT;t+=2){
    STEP(pB0,pB1,pA0,pA1,t,true,true,true);     WAIT_BAR(2); RESC(); ROT();
    STEP(pA0,pA1,pB0,pB1,t+1,true,true,true);   WAIT_BAR(2); RESC(); ROT();
  }
  #undef CMASK
  #define CMASK(P0,P1,t) MBIAS(P0,P1,t,true)
  #define ENDW(tt) do{ if((tt)+3<NT){WAIT_BAR(2);} else if((tt)+2<NT){WAIT_BAR(1);} else {WAIT_BAR(0);} }while(0)
  for(;t+1<NT;t+=2){
    STEP(pB0,pB1,pA0,pA1,t,(t+3<NT),(t+1<NT),(t+1<NT));       ENDW(t);   RESC(); ROT();
    STEP(pA0,pA1,pB0,pB1,t+1,(t+4<NT),(t+2<NT),(t+2<NT));     ENDW(t+1); RESC(); ROT();
  }
  STEP(pB0,pB1,pA0,pA1,NT-1,false,false,false); RESC();
  { float sacc=pB0[0]+pB0[1]; _Pragma("unroll") for(int r=2;r<16;++r)sacc+=pB0[r]; _Pragma("unroll") for(int r=0;r<16;++r)sacc+=pB1[r]; l_reg+=sacc;
    pw0=(u32x4){PKW(pB0,0),PKW(pB0,2),PKW(pB0,4),PKW(pB0,6)};pw1=(u32x4){PKW(pB0,8),PKW(pB0,10),PKW(pB0,12),PKW(pB0,14)};pw2=(u32x4){PKW(pB1,0),PKW(pB1,2),PKW(pB1,4),PKW(pB1,6)};pw3=(u32x4){PKW(pB1,8),PKW(pB1,10),PKW(pB1,12),PKW(pB1,14)};
    SBAR(); pv(o,vb0+sl_cur,PAF(0),PAF(1),PAF(2),PAF(3)); }
  #undef PKW
  #undef PAF
  #undef VFR
  #undef PIN
  #undef MX3
  #undef GAPA
  #undef GAPB
  #undef EX
  #undef VRD
  #undef KRD
  #undef STEP
  #undef ENDW
  {auto rr=__builtin_amdgcn_permlane32_swap(__float_as_uint(l_reg),__float_as_uint(l_reg),false,false);l_reg=__uint_as_float(rr[0])+__uint_as_float(rr[1]);}
  if(MODE==2)l_reg+=__builtin_amdgcn_exp2f(a.sink2-mhat);
  if(hi==0)wsf[32+r32]=l_reg;asm volatile("s_waitcnt lgkmcnt(0)":::"memory");
  float rli[16];
  #pragma unroll
  for(int r=0;r<16;++r)rli[r]=__builtin_amdgcn_rcpf(wsf[32+crow(r,hi)]);
  bf16*Ow=a.Ow; constexpr long op=OP;
  { bf16*stg=(bf16*)(shm+LDS_OST)+wid*2048;
    #pragma unroll
    for(int r=0;r<16;++r){const int orow=crow(r,hi);
      #pragma unroll
      for(int d0=0;d0<2;++d0)stg[orow*64+d0*32+r32]=__float2bfloat16(o[d0][r]*rli[r]);}
    asm volatile("s_waitcnt lgkmcnt(0)":::"memory");
    #pragma unroll
    for(int i=0;i<4;++i){const int row=i*8+(lane>>3),ch=lane&7; const u32x4 v=*(const u32x4*)(stg+row*64+ch*8); ATTN_STORE16(Ow+(long)row*op+ch*8,v);} }
  asm volatile("s_waitcnt lgkmcnt(0)\n\ts_barrier":::"memory");
  #undef DMA_K
  #undef DMA_V
  #undef TROW
  #undef KBREL
  #undef MBIAS
  #undef CINIT
  #undef CMASK
  #undef START
  #undef RESC
  #undef ROT
}

constexpr int DP_K=0, DP_V=3*8192, DP_WS=DP_V+3*16384, DP_BYTES=DP_WS+NW*256;
template<int THRL,int QP,int KVP,int OP> __device__ __forceinline__ void diff_unit(const AttnArgs&a,char*shm){
  int tid=threadIdx.x; asm volatile("":"+v"(tid)); const int lane=tid&63,r32=lane&31,hi=lane>>5; const int wid=__builtin_amdgcn_readfirstlane(tid>>6);
  const bf16*Qw=a.Qw; constexpr int qp=QP; constexpr long kvp=KVP;
  const unsigned lds0=(unsigned)(uintptr_t)shm;
  float*wsf=(float*)(shm+DP_WS)+wid*64;
  const bf16*ksrc=a.K0+(long)lane*kvp+wid*8;
  const bf16*vsrc=a.V0+(long)(16*(wid&3)+(lane>>2))*kvp+(wid>>2)*32+(lane&3)*8;
  const unsigned kdst=lds0+DP_K+wid*1024, vdst=lds0+DP_V+wid*1024;
  #define DMA_K(t,slot) glds16(ksrc+(long)(64*(t))*kvp,(unsigned)__builtin_amdgcn_readfirstlane(kdst+(slot)))
  #define DMA_V(t,slot) do{ glds16(vsrc+(long)(64*(t))*kvp,(unsigned)__builtin_amdgcn_readfirstlane(vdst+2*(slot))); glds16(vsrc+(long)(64*(t))*kvp+64,(unsigned)__builtin_amdgcn_readfirstlane(vdst+2*(slot)+8192)); }while(0)
  const int vb0=(int)(lds0+DP_V)+((lane>>4)&1)*32+(lane&3)*8+(4*hi+((lane&15)>>2))*64;
  const char*Kbase=shm+DP_K; bf16x8 kf[8];
  const lds_cptr shm3=(lds_cptr)shm; const lds_cptr kp0=shm3+DP_K+hi*1024+r32*16; const lds_cptr vp0=shm3+DP_V+((lane>>4)&1)*32+(lane&3)*8+(4*hi+((lane&15)>>2))*64;
  const int NT=a.NT;
  DMA_K(0,0);DMA_V(0,0);DMA_K(1,SLOTB);
  bf16x8 qr[4];
  #pragma unroll
  for(int d0=0;d0<4;++d0)qr[d0]=*reinterpret_cast<const bf16x8*>(&Qw[(long)r32*qp+d0*16+hi*8]);
  float z0_; asm volatile("v_mov_b32 %0, 0":"=v"(z0_));
  f32x16 zv_; _Pragma("unroll") for(int r=0;r<16;++r)zv_[r]=z0_;
  float mhat=0.f,l_reg=0.f;f32x16 o[4];o[0]=zv_;o[1]=zv_;o[2]=zv_;o[3]=zv_;
  const int qrel=a.qrel; const float slope2=a.slope2;
  #define KBREL(t) (64*((t)-(NT-4)))
  #define MBIAS(P0,P1,t,BAND) maskbias<1>(P0,P1,KBREL(t)+4*hi,qrel,slope2,mhat,(BAND)&&((t)>=NT-4),true)
  #define CMASK(P0,P1,t) MBIAS(P0,P1,t,true)
  bool resc=false;
  #define START(P0,P1) do{ const float rm=rowmax(P0,P1); resc=false; \
    { const float dl=rm; mhat=fadd_s(mhat,dl); \
      _Pragma("unroll") for(int r=0;r<16;++r){P0[r]=fsub_s(P0[r],dl);P1[r]=fsub_s(P1[r],dl);} } \
    _Pragma("unroll") for(int r=0;r<16;++r)P0[r]=__builtin_amdgcn_exp2f(P0[r]); }while(0)
  #define RESC() do{ if(resc){ asm volatile("s_waitcnt lgkmcnt(0)":::"memory"); \
      _Pragma("unroll") for(int d_=0;d_<4;++d_) _Pragma("unroll") for(int r=0;r<16;++r)o[d_][r]*=wsf[crow(r,hi)]; } }while(0)
  f32x16 pA0,pA1,pB0,pB1;
  int sl_prev=0,sl_cur=0,sl_next=SLOTB;
  #define ROT() do{sl_prev=sl_cur;sl_cur=sl_next;sl_next=(sl_next==(NSLOT-1)*SLOTB)?0:sl_next+SLOTB;}while(0)
  DMA_K(2,2*SLOTB);
  WAIT_BAR(4);
  qkt(pA0,pA1,Kbase,qr,zv_,r32,hi);asm volatile("s_nop 15\n\ts_nop 7":"+v"(pA0),"+v"(pA1));CMASK(pA0,pA1,0);
  START(pA0,pA1);
  _Pragma("unroll") for(int r=0;r<16;++r)pA1[r]=__builtin_amdgcn_exp2f(pA1[r]);
  WAIT_BAR(0);
  DMA_K(3,0);DMA_V(1,SLOTB);
  ROT();
  kload8(kf,kp0+sl_cur);
  WAIT_BAR(0);
  s16x4 vlo[8],vhi[8]; u32x4 pw0,pw1,pw2,pw3;
  #define PKW(P,B) cvtpk_s(P[B],P[B+1])
  #define PAF(k) __builtin_bit_cast(bf16x8,pw##k)
  #define VFR(i) (bf16x8){vlo[i][0],vlo[i][1],vlo[i][2],vlo[i][3],vhi[i][0],vhi[i][1],vhi[i][2],vhi[i][3]}
  #define PIN(x) asm volatile("":"+v"(x))
  #define MX3(a,b,c) __builtin_fmaxf(__builtin_fmaxf((a),(b)),(c))
  #define GAPA(MF,A0,A1,A2,A3,W0,W1,PW) do{ MF; sacc+=A0; sacc+=A1; sacc+=A2; sacc+=A3; PIN(sacc); W0; W1; PIN(PW); SBAR(); }while(0)
  #define EX(v) __builtin_amdgcn_exp2f(v)
  #define GAPB(MF,X,B) do{ MF; X[B]=EX(X[B]); X[B+1]=EX(X[B+1]); X[B+2]=EX(X[B+2]); X[B+3]=EX(X[B+3]); PIN(X); SBAR(); }while(0)
  #define GAPC(MF) do{ MF; SBAR(); }while(0)
  #define VRD(i) do{ vlo[i]=vtr(vp_+(((i)>>2)*4096+((i)&3)*1024)); vhi[i]=vtr(vp_+(((i)>>2)*4096+((i)&3)*1024+512)); SBAR(); }while(0)
  #define VRD2(i) do{ vlo[i]=vtr(vp_+(8192+((i)>>2)*4096+((i)&3)*1024)); vhi[i]=vtr(vp_+(8192+((i)>>2)*4096+((i)&3)*1024+512)); SBAR(); }while(0)
  #define KRD(G,j) do{ if(G){ kload2(kf,kp0+sl_next,j); SBAR(); } }while(0)
  #define STEP(C0,C1,P0,P1,t,GK,GV,GL) do{ SBAR(); \
    const lds_cptr vp_=vp0+2*sl_prev; \
    float sacc=(P0[0]+P0[1]); \
    GAPA(C0=__builtin_amdgcn_mfma_f32_32x32x16_bf16(kf[0],qr[0],f32x16{},0,0,0), P0[2],P0[3],P0[4],P0[5],     pw0[0]=PKW(P0,0), pw0[1]=PKW(P0,2), pw0); \
    GAPA(C1=__builtin_amdgcn_mfma_f32_32x32x16_bf16(kf[1],qr[0],f32x16{},0,0,0), P0[6],P0[7],P0[8],P0[9],     pw0[2]=PKW(P0,4), pw0[3]=PKW(P0,6), pw0); \
    GAPA(C0=__builtin_amdgcn_mfma_f32_32x32x16_bf16(kf[2],qr[1],C0,0,0,0),   P0[10],P0[11],P0[12],P0[13], pw1[0]=PKW(P0,8), pw1[1]=PKW(P0,10), pw1); \
    GAPA(C1=__builtin_amdgcn_mfma_f32_32x32x16_bf16(kf[3],qr[1],C1,0,0,0),   P0[14],P0[15],P1[0],P1[1],   pw1[2]=PKW(P0,12),pw1[3]=PKW(P0,14), pw1); \
    GAPA(C0=__builtin_amdgcn_mfma_f32_32x32x16_bf16(kf[4],qr[2],C0,0,0,0),   P1[2],P1[3],P1[4],P1[5],     pw2[0]=PKW(P1,0), pw2[1]=PKW(P1,2), pw2); \
    GAPA(C1=__builtin_amdgcn_mfma_f32_32x32x16_bf16(kf[5],qr[2],C1,0,0,0),   P1[6],P1[7],P1[8],P1[9],     pw2[2]=PKW(P1,4), pw2[3]=PKW(P1,6), pw2); \
    GAPA(C0=__builtin_amdgcn_mfma_f32_32x32x16_bf16(kf[6],qr[3],C0,0,0,0),   P1[10],P1[11],P1[12],P1[13], pw3[0]=PKW(P1,8), pw3[1]=PKW(P1,10), pw3); \
    VRD(0); GAPA(C1=__builtin_amdgcn_mfma_f32_32x32x16_bf16(kf[7],qr[3],C1,0,0,0),   P1[14],P1[15],0.f,0.f,       pw3[2]=PKW(P1,12),pw3[3]=PKW(P1,14), pw3); \
    l_reg+=sacc; \
    if(GK){DMA_K((t)+3,sl_cur);} if(GV){DMA_V((t)+1,sl_next);} \
    VRD(4); VRD(1); VRD(5); \
    CMASK(C0,C1,t); \
    { float a_=MX3(C0[0],C0[1],C1[0]),b_=MX3(C0[2],C0[3],C1[1]); a_=MX3(a_,C1[2],C1[3]); \
      _Pragma("unroll") for(int r=4;r<16;r+=4){a_=MX3(a_,C0[r],C0[r+1]);b_=MX3(b_,C0[r+2],C0[r+3]);a_=MX3(a_,C1[r],C1[r+1]);b_=MX3(b_,C1[r+2],C1[r+3]);} \
      float rm=__builtin_fmaxf(a_,b_); { auto rr=__builtin_amdgcn_permlane32_swap(__float_as_uint(rm),__float_as_uint(rm),false,false); rm=__builtin_fmaxf(__uint_as_float(rr[0]),__uint_as_float(rr[1])); } \
      resc=false; \
      if(__builtin_expect(__any(rm>(float)THRL),0)){ const float dl=__builtin_fmaxf(rm,0.f); mhat+=dl; \
        _Pragma("unroll") for(int r=0;r<16;++r){C0[r]-=dl;C1[r]-=dl;} \
        const float f=__builtin_amdgcn_exp2f(-dl); l_reg*=f; if(hi==0)wsf[r32]=f; resc=true; } } \
    SBAR(); \
    VRD(2); GAPB(o[0]=__builtin_amdgcn_mfma_f32_32x32x16_bf16(PAF(0),VFR(0),o[0],0,0,0), C0,0);  VRD2(0); \
    VRD(6); GAPB(o[1]=__builtin_amdgcn_mfma_f32_32x32x16_bf16(PAF(0),VFR(4),o[1],0,0,0), C0,4);  VRD2(4); \
    VRD(3); GAPB(o[0]=__builtin_amdgcn_mfma_f32_32x32x16_bf16(PAF(1),VFR(1),o[0],0,0,0), C0,8);  VRD2(1); \
    VRD(7); GAPB(o[1]=__builtin_amdgcn_mfma_f32_32x32x16_bf16(PAF(1),VFR(5),o[1],0,0,0), C0,12); VRD2(5); \
    GAPB(o[0]=__builtin_amdgcn_mfma_f32_32x32x16_bf16(PAF(2),VFR(2),o[0],0,0,0), C1,0);  VRD2(2); \
    GAPB(o[1]=__builtin_amdgcn_mfma_f32_32x32x16_bf16(PAF(2),VFR(6),o[1],0,0,0), C1,4);  VRD2(6); \
    GAPB(o[0]=__builtin_amdgcn_mfma_f32_32x32x16_bf16(PAF(3),VFR(3),o[0],0,0,0), C1,8);  VRD2(3); \
    GAPB(o[1]=__builtin_amdgcn_mfma_f32_32x32x16_bf16(PAF(3),VFR(7),o[1],0,0,0), C1,12); VRD2(7); \
    KRD(GL,0); GAPC(o[2]=__builtin_amdgcn_mfma_f32_32x32x16_bf16(PAF(0),VFR(0),o[2],0,0,0)); \
    KRD(GL,1); GAPC(o[3]=__builtin_amdgcn_mfma_f32_32x32x16_bf16(PAF(0),VFR(4),o[3],0,0,0)); \
    KRD(GL,2); GAPC(o[2]=__builtin_amdgcn_mfma_f32_32x32x16_bf16(PAF(1),VFR(1),o[2],0,0,0)); \
    KRD(GL,3); GAPC(o[3]=__builtin_amdgcn_mfma_f32_32x32x16_bf16(PAF(1),VFR(5),o[3],0,0,0)); \
    GAPC(o[2]=__builtin_amdgcn_mfma_f32_32x32x16_bf16(PAF(2),VFR(2),o[2],0,0,0)); \
    GAPC(o[3]=__builtin_amdgcn_mfma_f32_32x32x16_bf16(PAF(2),VFR(6),o[3],0,0,0)); \
    GAPC(o[2]=__builtin_amdgcn_mfma_f32_32x32x16_bf16(PAF(3),VFR(3),o[2],0,0,0)); \
    GAPC(o[3]=__builtin_amdgcn_mfma_f32_32x32x16_bf16(PAF(3),VFR(7),o[3],0,0,0)); \
    }while(0)
  int t=1;
  #undef CMASK
  #define CMASK(P0,P1,t) MBIAS(P0,P1,t,false)
  for(;t+5<NT;t+=2){
    STEP(pB0,pB1,pA0,pA1,t,true,true,true);     WAIT_BAR(0); RESC(); ROT();
    STEP(pA0,pA1,pB0,pB1,t+1,true,true,true);   WAIT_BAR(0); RESC(); ROT();
  }
  #undef CMASK
  #define CMASK(P0,P1,t) MBIAS(P0,P1,t,true)
  #define ENDW(tt) do{ WAIT_BAR(0); }while(0)
  for(;t+1<NT;t+=2){
    STEP(pB0,pB1,pA0,pA1,t,(t+3<NT),(t+1<NT),(t+1<NT));       ENDW(t);   RESC(); ROT();
    STEP(pA0,pA1,pB0,pB1,t+1,(t+4<NT),(t+2<NT),(t+2<NT));     ENDW(t+1); RESC(); ROT();
  }
  STEP(pB0,pB1,pA0,pA1,NT-1,false,false,false); RESC();
  { float sacc=pB0[0]+pB0[1]; _Pragma("unroll") for(int r=2;r<16;++r)sacc+=pB0[r]; _Pragma("unroll") for(int r=0;r<16;++r)sacc+=pB1[r]; l_reg+=sacc;
    pw0=(u32x4){PKW(pB0,0),PKW(pB0,2),PKW(pB0,4),PKW(pB0,6)};pw1=(u32x4){PKW(pB0,8),PKW(pB0,10),PKW(pB0,12),PKW(pB0,14)};pw2=(u32x4){PKW(pB1,0),PKW(pB1,2),PKW(pB1,4),PKW(pB1,6)};pw3=(u32x4){PKW(pB1,8),PKW(pB1,10),PKW(pB1,12),PKW(pB1,14)};
    SBAR(); pv(o,vb0+2*sl_cur,PAF(0),PAF(1),PAF(2),PAF(3)); pv(o+2,vb0+2*sl_cur+8192,PAF(0),PAF(1),PAF(2),PAF(3)); }
  #undef PKW
  #undef PAF
  #undef VFR
  #undef PIN
  #undef MX3
  #undef GAPA
  #undef GAPB
  #undef GAPC
  #undef EX
  #undef VRD
  #undef VRD2
  #undef KRD
  #undef STEP
  #undef ENDW
  {auto rr=__builtin_amdgcn_permlane32_swap(__float_as_uint(l_reg),__float_as_uint(l_reg),false,false);l_reg=__uint_as_float(rr[0])+__uint_as_float(rr[1]);}
  if(hi==0)wsf[32+r32]=l_reg;asm volatile("s_waitcnt lgkmcnt(0)":::"memory");
  float rli[16];
  #pragma unroll
  for(int r=0;r<16;++r)rli[r]=__builtin_amdgcn_rcpf(wsf[32+crow(r,hi)]);
  asm volatile("s_waitcnt lgkmcnt(0)\n\ts_barrier":::"memory");
  { bf16*stg=(bf16*)(shm)+wid*4096;
    #pragma unroll
    for(int r=0;r<16;++r){const int orow=crow(r,hi);
      #pragma unroll
      for(int dq=0;dq<4;++dq)stg[orow*128+dq*32+r32]=__float2bfloat16(o[dq][r]*rli[r]);}
    asm volatile("s_waitcnt lgkmcnt(0)":::"memory");
    #pragma unroll
    for(int i=0;i<8;++i){const int row=i*4+(lane>>4),ch=lane&15; const u32x4 v=*(const u32x4*)(stg+row*128+ch*8); *(u32x4*)(a.Ow+(long)row*OP+ch*8)=v;} }
  asm volatile("s_waitcnt lgkmcnt(0)\n\ts_barrier":::"memory");
  #undef DMA_K
  #undef DMA_V
  #undef KBREL
  #undef MBIAS
  #undef CMASK
  #undef START
  #undef RESC
  #undef ROT
}
constexpr int ATTN_LDS_BYTES=LDS_BYTES;
#undef SBAR
#undef WAIT_BAR
}
constexpr int NWAVES = 8;
constexpr int BATCH = 2, SEQ = 16384, D = 1024, M = BATCH * SEQ, DEPTH = 4, MEMLEN = 256;
constexpr int NPA = 1536, NPB = 2560;
constexpr int NEXP = 64, CAP = 32768, HID = 256;
constexpr int HROWS = (M * 8 / 256 + NEXP + M / 256) * 256;
constexpr float LN_EPS = 1e-5f;
constexpr float DN_ALPHA = 1.681792830507429f;
__device__ const float SLOPES_A[12] = {0.5f, 0.25f, 0.125f, 0.0625f, 0.03125f, 0.015625f, 0.0078125f, 0.00390625f, 0.7071067811865476f, 0.35355339059327384f, 0.17677669529663695f, 0.08838834764831849f};
__device__ const float SLOPES_B[6] = {0.25f, 0.0625f, 0.015625f, 0.00390625f, 0.5f, 0.125f};

constexpr size_t MiB = 1u << 20;
constexpr size_t WS_CTL = 0, CTL_ZERO_BYTES = 1 * MiB;
constexpr size_t WS_MEMKV = 2 * MiB;
constexpr size_t WS_WROUT = 4 * MiB;
constexpr size_t WS_WINA = 6 * MiB, WS_WINB = 12 * MiB;
constexpr size_t WS_WOUT = 22 * MiB;
constexpr size_t WS_WMKV = 30 * MiB;
constexpr size_t WS_MEMB = 34 * MiB;
constexpr size_t WS_LOGIT = 36 * MiB;
constexpr size_t WS_ROWTOK = 44 * MiB, WS_ROWGATE = 52 * MiB;
constexpr size_t WS_WEXP = 60 * MiB;
constexpr size_t WS_XB = 158 * MiB;
constexpr size_t WS_HB = 222 * MiB;
constexpr size_t WS_BIG = 374 * MiB;
constexpr size_t WS_QKV = WS_BIG, WS_OTMP = WS_BIG + 160 * MiB, WS_CAT = WS_BIG + 256 * MiB, WS_Y = WS_BIG + 320 * MiB;
constexpr size_t WS_END = WS_BIG + 576 * MiB;
static_assert(WS_WEXP + 65 * (size_t)pg8::EXPERT_BYTES <= WS_XB && WS_HB + (size_t)HROWS * 512 <= WS_BIG, "d_ws map");
constexpr int CW_TMO = 0;
constexpr int CW_BAR = 4096;
constexpr int CW_CNT = 16384;
constexpr int CW_Q = CW_CNT + DEPTH * 64 * 64;
constexpr int CW_NORM = CW_Q + 64 * DEPTH;
static_assert((CW_NORM + 64 * DEPTH) * 4 <= (int)CTL_ZERO_BYTES, "CTL words inside the memset region");

constexpr int RING_OFF = 0, RING_BYTES = 131072;
constexpr int LDSCTL_OFF = RING_BYTES;
constexpr int TAB_OFF = RING_BYTES + 512;
constexpr int IDX_OFF = RING_BYTES + 2560;
constexpr int GATE_OFF = IDX_OFF + 10 * 1024;
constexpr int LDS_BYTES = 163840;
static_assert(IDX_OFF + 20 * 1024 <= LDS_BYTES, "LDS map");

#define GAS __attribute__((address_space(1)))
#define LAS __attribute__((address_space(3)))
typedef unsigned short bf16;
typedef unsigned v4u __attribute__((ext_vector_type(4)));
typedef unsigned v2u __attribute__((ext_vector_type(2)));
typedef float f32x4 __attribute__((ext_vector_type(4)));
typedef GAS unsigned gu32;
#define RLX_AGENT __ATOMIC_RELAXED, __HIP_MEMORY_SCOPE_AGENT
#define LDS_WAIT() asm volatile("s_waitcnt lgkmcnt(0)" ::: "memory")
__device__ __forceinline__ unsigned f2bf(float f) { unsigned u = __builtin_bit_cast(unsigned, f); return (u + 0x7fffu + ((u >> 16) & 1u)) >> 16; }
__device__ __forceinline__ unsigned pk2(float lo, float hi) { return f2bf(lo) | (f2bf(hi) << 16); }
__device__ __forceinline__ float bflo(unsigned u) { return __builtin_bit_cast(float, u << 16); }
__device__ __forceinline__ float bfhi(unsigned u) { return __builtin_bit_cast(float, u & 0xffff0000u); }

#define XB_TMO      128
#define XB_XCNT(j)  (256  + 64 * (j))
#define XB_XSUB(j)  (1280 + 64 * (j))
#define XB_XGEN(j)  (2304 + 64 * (j))
#define XB_TOP      3328
#define XB_TOPGEN   3392
#define XCD_BAR_WORDS 3456
#define XB_SPIN_CAP (1u << 18)
__device__ __forceinline__ unsigned xb_ld(unsigned* p)              { return __hip_atomic_load(p, __ATOMIC_RELAXED, __HIP_MEMORY_SCOPE_AGENT); }
__device__ __forceinline__ unsigned xb_add(unsigned* p, unsigned v) { return __hip_atomic_fetch_add(p, v, __ATOMIC_RELAXED, __HIP_MEMORY_SCOPE_AGENT); }
__device__ __forceinline__ unsigned xb_xcc_id() { return (unsigned)__builtin_amdgcn_s_getreg((3 << 11) | 20) & 0xFu; }
#define XB_SPIN(cond, bar) do { unsigned _sp = 0; while (cond) { __builtin_amdgcn_s_sleep(1); \
    if ((++_sp & 255u) == 0u) { if (xb_ld(&(bar)[XB_TMO])) break; if (_sp > XB_SPIN_CAP) { atomicAdd(&(bar)[XB_TMO], 1u); break; } } } } while (0)
struct XcdBarrier { unsigned* bar; unsigned x; volatile LAS unsigned* st; };
__device__ __forceinline__ XcdBarrier xcd_barrier_post(unsigned* bar, volatile LAS unsigned* st) {
    XcdBarrier b; b.bar = bar; b.x = xb_xcc_id(); b.st = st;
    if (threadIdx.x == 0) (void)xb_add(&bar[XB_XCNT(b.x)], 1u);
    return b;
}
__device__ __forceinline__ void xcd_barrier_complete(unsigned* bar, unsigned x, unsigned& nloc, unsigned& nx) {
    const unsigned G = gridDim.x * gridDim.y * gridDim.z;
    unsigned sum, cnt, mine, sp = 0u;
    for (;;) {
        sum = 0u; cnt = 0u; mine = 0u;
#pragma unroll
        for (unsigned j = 0; j < 16; ++j) { const unsigned c = xb_ld(&bar[XB_XCNT(j)]); sum += c; cnt += (c > 0u) ? 1u : 0u; mine = (j == x) ? c : mine; }
        if (sum == G) break;
        __builtin_amdgcn_s_sleep(1);
        if ((++sp & 255u) == 0u) { if (xb_ld(&bar[XB_TMO])) break; if (sp > XB_SPIN_CAP) { atomicAdd(&bar[XB_TMO], 1u); break; } }
    }
    nloc = mine > 0u ? mine : 1u; nx = cnt > 0u ? cnt : 1u;
}
__device__ __forceinline__ void xcd_barrier(const XcdBarrier& b) {
    asm volatile("s_waitcnt vmcnt(0)" ::: "memory");
    __syncthreads();
    if (threadIdx.x == 0) {
        unsigned* bar = b.bar;
        __builtin_amdgcn_s_waitcnt(0);
        unsigned nloc = b.st[0], nx = b.st[1];
        if (nloc == 0u) { xcd_barrier_complete(bar, b.x, nloc, nx); b.st[0] = nloc; b.st[1] = nx; }
        const unsigned old = xb_add(&bar[XB_XSUB(b.x)], 1u);
        const unsigned gen = old / nloc;
        if (old + 1u == (gen + 1u) * nloc) {
            __builtin_amdgcn_fence(__ATOMIC_RELEASE, "agent");
            asm volatile("s_waitcnt vmcnt(0)" ::: "memory");
            const unsigned og = xb_add(&bar[XB_TOP], 1u);
            const unsigned tg = og / nx;
            if (og + 1u == (tg + 1u) * nx) xb_add(&bar[XB_TOPGEN], 1u);
            else XB_SPIN(xb_ld(&bar[XB_TOPGEN]) == tg, bar);
            __builtin_amdgcn_fence(__ATOMIC_ACQUIRE, "agent");
            xb_add(&bar[XB_XGEN(b.x)], 1u);
            asm volatile("s_waitcnt vmcnt(0)" ::: "memory");
        } else {
            XB_SPIN(xb_ld(&bar[XB_XGEN(b.x)]) == gen, bar);
            __builtin_amdgcn_fence(__ATOMIC_ACQUIRE, "agent");
            asm volatile("s_waitcnt vmcnt(0)" ::: "memory");
        }
    }
    __syncthreads();
}

struct Frame { LAS unsigned char* lds; int wave; };
__device__ __forceinline__ int f_G() { int g = (int)gridDim.x; asm volatile("" : "+s"(g)); return g; }
__device__ __forceinline__ int f_bx() { int b = (int)blockIdx.x; asm volatile("" : "+s"(b)); return b; }
__device__ __forceinline__ int f_gw(const Frame& F) { const int g = f_G(), b = f_bx(); return ((g % 8 == 0) ? (b % 8) * (g / 8) + b / 8 : b) * NWAVES + F.wave; }
__device__ __forceinline__ int f_ngw() { return f_G() * NWAVES; }
__device__ __forceinline__ volatile LAS unsigned* f_misc(const Frame& F) { return (volatile LAS unsigned*)(F.lds + LDSCTL_OFF); }
__device__ __forceinline__ int fresh_tid() { int t = threadIdx.x; asm volatile("" : "+v"(t)); return t; }
__device__ __forceinline__ float wave_sum(float v) {
#pragma unroll
    for (int o = 1; o < 64; o <<= 1) v += __shfl_xor(v, o);
    return v;
}
__device__ __forceinline__ void transpose_item64(const float* W, int N, bf16* WT, int ldt, int k0, int n0, int drow0, LAS float* scr, int lane) {
    const int rr = lane >> 4, cc = (lane & 15) * 4;
#pragma unroll 8
    for (int i = 0; i < 16; ++i) { const int kk = 4 * i + rr; const f32x4 v = *(const GAS f32x4*)(W + (size_t)(k0 + kk) * N + n0 + cc);
        LAS float* d = scr + kk * 65 + cc; d[0] = v.x; d[1] = v.y; d[2] = v.z; d[3] = v.w; }
    LDS_WAIT(); asm volatile("" ::: "memory");
    const int c = lane & 7;
#pragma unroll
    for (int j = 0; j < 8; ++j) { const int n = (lane >> 3) + 8 * j; const LAS float* s = scr + (8 * c) * 65 + n;
        v4u o; o.x = pk2(s[0 * 65], s[1 * 65]); o.y = pk2(s[2 * 65], s[3 * 65]); o.z = pk2(s[4 * 65], s[5 * 65]); o.w = pk2(s[6 * 65], s[7 * 65]);
        *(GAS v4u*)(WT + (size_t)(drow0 + n) * ldt + k0 + 8 * c) = o; }
    LDS_WAIT(); asm volatile("" ::: "memory");
}
__device__ __forceinline__ int map_in_a(int n) { return n < 768 ? n : (n < 960 ? n + 256 : (n < 1152 ? n + 256 : n - 384)); }
__device__ __forceinline__ int map_in_b(int n) { return n < 768 ? n : (n < 2304 ? n + 256 : n - 1536); }

struct Args { const float* in[19]; float* out; unsigned char* ws; };
typedef const __attribute__((address_space(4))) Args* ArgsP;
__device__ __forceinline__ ArgsP fresh_args() { ArgsP p = (ArgsP)__builtin_amdgcn_kernarg_segment_ptr(); asm volatile("" : "+s"(p)); return p; }
__device__ __forceinline__ gu32* f_ctl() { return (gu32*)(fresh_args()->ws + WS_CTL); }

__device__ __forceinline__ void p0_small_weights(Frame& F, ArgsP A) {
    const int tid_ = fresh_tid(), lane_ = tid_ & 63; (void)tid_; (void)lane_;
    LAS float* scr = (LAS float*)(F.lds + (F.wave < 7 ? RING_OFF + F.wave * 16640 : IDX_OFF));
    unsigned char* ws = A->ws;
    constexpr int I_A = 16 * 22, I_B = 16 * 40, I_M = 16 * 8, I_O = 16 * 16, I_R = 16;
    constexpr int NITEMS = 2 * I_A + 2 * I_B + 4 * I_M + 4 * I_O + 4 * I_R;
    for (int it = f_gw(F); it < NITEMS; it += f_ngw()) {
        int r = it;
        if (r < 2 * I_A) { const int j = r / I_A; r %= I_A; const int kb = r / 22, nb = r % 22;
            transpose_item64(A->in[2] + (size_t)j * D * 1408, 1408, (bf16*)(ws + WS_WINA) + (size_t)j * NPA * D, D, 64 * kb, 64 * nb, map_in_a(64 * nb), scr, lane_); continue; } r -= 2 * I_A;
        if (r < 2 * I_B) { const int j = r / I_B; r %= I_B; const int kb = r / 40, nb = r % 40;
            transpose_item64(A->in[4] + (size_t)j * D * 2560, 2560, (bf16*)(ws + WS_WINB) + (size_t)j * NPB * D, D, 64 * kb, 64 * nb, map_in_b(64 * nb), scr, lane_); continue; } r -= 2 * I_B;
        if (r < 4 * I_M) { const int l = r / I_M; r %= I_M; const int kb = r / 8, nb = r % 8;
            transpose_item64(A->in[7] + (size_t)l * D * 512, 512, (bf16*)(ws + WS_WMKV), D, 64 * kb, 64 * nb, l * 512 + 64 * nb, scr, lane_); continue; } r -= 4 * I_M;
        if (r < 4 * I_O) { const int l = r / I_O; r %= I_O; const int kb = r / 16, nb = r % 16;
            transpose_item64(A->in[8] + (size_t)l * D * D, D, (bf16*)(ws + WS_WOUT) + (size_t)l * D * D, D, 64 * kb, 64 * nb, 64 * nb, scr, lane_); continue; } r -= 4 * I_O;
        { const int l = r / I_R; const int kb = r % I_R;
            transpose_item64(A->in[11] + (size_t)l * D * 64, 64, (bf16*)(ws + WS_WROUT) + (size_t)l * 256 * D, D, 64 * kb, 0, 0, scr, lane_); }
    }
    for (int it = f_gw(F); it < 2 * 128 + 4 * 192; it += f_ngw()) {
        bf16* row = it < 256 ? (bf16*)(ws + WS_WINA) + ((size_t)(it >> 7) * NPA + 1408 + (it & 127)) * D
                             : (bf16*)(ws + WS_WROUT) + ((size_t)((it - 256) / 192) * 256 + 64 + (it - 256) % 192) * D;
        GAS v4u* o = (GAS v4u*)row + lane_;
        o[0] = (v4u){0u, 0u, 0u, 0u}; o[64] = (v4u){0u, 0u, 0u, 0u};
    }
    for (int m = f_gw(F); m < 512 + M; m += f_ngw()) {
        const float* src = m < 512 ? A->in[1] + (size_t)m * D : A->in[0] + (size_t)(m - 512) * D;
        bf16* dst = m < 512 ? (bf16*)(ws + WS_MEMB) + (size_t)m * D : (bf16*)(ws + WS_XB) + (size_t)(m - 512) * D;
        const GAS f32x4* xr = (const GAS f32x4*)src + lane_; GAS v2u* o8 = (GAS v2u*)dst + lane_;
#pragma unroll
        for (int j = 0; j < 4; ++j) { const f32x4 v = xr[64 * j]; o8[64 * j] = (v2u){pk2(v.x, v.y), pk2(v.z, v.w)}; }
    }
}
constexpr int CONV_ITEMS = 65 * 192, CONV_UNITS = CONV_ITEMS / 8;
__device__ __forceinline__ void convert_item(ArgsP A, int layer, int it, LAS float* scr, int lane_) {
    bf16* wexp = (bf16*)(A->ws + WS_WEXP);
    const int e = it / 192, mat = (it % 192) >> 6, r = it & 63;
    bf16* dst = wexp + (size_t)e * (pg8::EXPERT_BYTES / 2);
    if (mat < 2) { const float* W = (e < 64) ? A->in[13 + mat] + ((size_t)layer * 64 + e) * (D * HID) : A->in[16 + mat] + (size_t)layer * (D * HID);
        const int kb = r >> 2, nb = r & 3, n0 = 64 * nb;
        transpose_item64(W, HID, dst, D, 64 * kb, n0, (n0 >> 7) * 256 + mat * 128 + (n0 & 127), scr, lane_); }
    else { const float* W = (e < 64) ? A->in[15] + ((size_t)layer * 64 + e) * (HID * D) : A->in[18] + (size_t)layer * (HID * D);
        const int kb = r >> 4, nb = r & 15;
        transpose_item64(W, D, dst + pg8::EXPERT_DOWN_OFF / 2, HID, 64 * kb, 64 * nb, 64 * nb, scr, lane_); }
}
__device__ __forceinline__ void convert_unit(Frame& F, ArgsP A, int layer, int cu) {
    const int tid_ = fresh_tid(), lane_ = tid_ & 63; (void)tid_;
    LAS float* scr = (LAS float*)(F.lds + (F.wave < 7 ? RING_OFF + F.wave * 16640 : IDX_OFF));
    const int it = 8 * cu + F.wave;
    if (it < CONV_ITEMS) convert_item(A, layer, it, scr, lane_);
    asm volatile("s_waitcnt vmcnt(0) lgkmcnt(0)\n\ts_barrier" ::: "memory");
}
template <bool LAST> __device__ __forceinline__ void ph_combine_ln2(Frame& F, float* xout, const unsigned char* yt, const float* g, const float* b, bf16* xb) {
    typedef float f32x2c __attribute__((ext_vector_type(2)));
    const int tid_ = fresh_tid(), lane_ = tid_ & 63; (void)tid_;
    for (int m = f_gw(F); m < M; m += f_ngw()) {
        GAS v4u* o8 = (GAS v4u*)(xb + (size_t)m * D) + 2 * lane_; const GAS v4u* yr = (const GAS v4u*)(yt + (size_t)m * 9 * D) + lane_;
        float v[16];
#pragma unroll
        for (int i = 0; i < 16; ++i) v[i] = 0.f;
#pragma unroll
        for (int k = 0; k < 9; ++k) { const v4u w = yr[k * 64];
#pragma unroll
            for (int q = 0; q < 4; ++q) { const f32x2c lo = __builtin_amdgcn_cvt_pk_f32_fp8((int)w[q], false), hi = __builtin_amdgcn_cvt_pk_f32_fp8((int)w[q], true);
                v[4 * q] += lo.x; v[4 * q + 1] += lo.y; v[4 * q + 2] += hi.x; v[4 * q + 3] += hi.y; } }
        float s = 0.f;
#pragma unroll
        for (int h = 0; h < 2; ++h) { const v4u xw = o8[h];
#pragma unroll
            for (int q = 0; q < 4; ++q) { v[8 * h + 2 * q] = v[8 * h + 2 * q] * (1.f / pg8::Y8_SCALE) + DN_ALPHA * bflo(xw[q]); v[8 * h + 2 * q + 1] = v[8 * h + 2 * q + 1] * (1.f / pg8::Y8_SCALE) + DN_ALPHA * bfhi(xw[q]); } }
#pragma unroll
        for (int i = 0; i < 16; ++i) s += v[i];
        const float mean = wave_sum(s) * (1.f / D); float s2 = 0.f;
#pragma unroll
        for (int i = 0; i < 16; ++i) { v[i] -= mean; s2 += v[i] * v[i]; }
        const float rstd = 1.f / sqrtf(wave_sum(s2) * (1.f / D) + LN_EPS);
        const GAS f32x4* gp = (const GAS f32x4*)g + 4 * lane_; const GAS f32x4* bp = (const GAS f32x4*)b + 4 * lane_;
        GAS f32x4* xo = (GAS f32x4*)(xout + (size_t)m * D) + 4 * lane_;
        float o[16];
#pragma unroll
        for (int q = 0; q < 4; ++q) { const f32x4 gv = gp[q], bv = bp[q];
            o[4 * q] = v[4 * q] * rstd * gv.x + bv.x; o[4 * q + 1] = v[4 * q + 1] * rstd * gv.y + bv.y; o[4 * q + 2] = v[4 * q + 2] * rstd * gv.z + bv.z; o[4 * q + 3] = v[4 * q + 3] * rstd * gv.w + bv.w;
            if (LAST) xo[q] = (f32x4){o[4 * q], o[4 * q + 1], o[4 * q + 2], o[4 * q + 3]}; }
        if (!LAST) { o8[0] = (v4u){pk2(o[0], o[1]), pk2(o[2], o[3]), pk2(o[4], o[5]), pk2(o[6], o[7])}; o8[1] = (v4u){pk2(o[8], o[9]), pk2(o[10], o[11]), pk2(o[12], o[13]), pk2(o[14], o[15])}; }
    }
}
__device__ __forceinline__ void ph_diff_combine(Frame& F, const bf16* otmp, const float* lq, const float* subg, float lam_init, bf16* cat) {
    const int tid_ = fresh_tid(), lane_ = tid_ & 63; (void)tid_; (void)lane_;
    float lam;
    { const float a = lq[lane_] * lq[64 + lane_], c = lq[128 + lane_] * lq[192 + lane_]; lam = expf(wave_sum(a)) - expf(wave_sum(c)) + lam_init; }
    const int l32 = lane_ & 31, hh = lane_ >> 5;
    const f32x4 gv = ((const GAS f32x4*)subg)[l32]; const float post = 1.f - lam_init;
    for (int m = f_gw(F); m < M; m += f_ngw()) {
#pragma unroll
        for (int hp = 0; hp < 3; ++hp) { const int h = 2 * hp + hh;
            const v2u a0 = *((const GAS v2u*)(otmp + (size_t)m * 1536 + h * 256) + l32), a1 = *((const GAS v2u*)(otmp + (size_t)m * 1536 + h * 256 + 128) + l32);
            f32x4 o; o.x = bflo(a0.x) - lam * bflo(a1.x); o.y = bfhi(a0.x) - lam * bfhi(a1.x); o.z = bflo(a0.y) - lam * bflo(a1.y); o.w = bfhi(a0.y) - lam * bfhi(a1.y);
            float s2 = (o.x * o.x + o.y * o.y) + (o.z * o.z + o.w * o.w);
#pragma unroll
            for (int sft = 1; sft < 32; sft <<= 1) s2 += __shfl_xor(s2, sft);
            const float r = post / sqrtf(s2 * (1.f / 128.f) + LN_EPS);
            o = o * r * gv;
            *((GAS v2u*)(cat + (size_t)m * D + h * 128) + l32) = (v2u){pk2(o.x, o.y), pk2(o.z, o.w)}; }
    }
}
__device__ __forceinline__ float ss8(v4u a) { float s = 0.f;
#pragma unroll
    for (int i = 0; i < 4; ++i) { const float lo = bflo(a[i]), hi = bfhi(a[i]); s += lo * lo + hi * hi; } return s; }
__device__ __forceinline__ void ph_qknorm(Frame& F, const bf16* qkv, gu32* gmax) {
    const int tid_ = fresh_tid(), lane_ = tid_ & 63;
    LAS unsigned* lmax = (LAS unsigned*)(F.lds + LDSCTL_OFF) + 32;
    if (tid_ < 24) lmax[tid_] = 0u;
    __syncthreads();
    float mq0 = 0.f, mq1 = 0.f, mk0 = 0.f, mk1 = 0.f;
    const v4u zero = (v4u){0u, 0u, 0u, 0u};
    for (int m = f_gw(F); m < M; m += f_ngw()) {
        const bf16* row = qkv + (size_t)m * NPB;
        const v4u a = *(const GAS v4u*)(row + 8 * lane_), c = *(const GAS v4u*)(row + 1024 + 8 * lane_);
        v4u b = zero, d = zero; if (lane_ < 32) { b = *(const GAS v4u*)(row + 512 + 8 * lane_); d = *(const GAS v4u*)(row + 1536 + 8 * lane_); }
        float sa = ss8(a), sb = ss8(b), sc = ss8(c), sd = ss8(d);
#pragma unroll
        for (int o = 1; o < 8; o <<= 1) { sa += __shfl_xor(sa, o); sb += __shfl_xor(sb, o); sc += __shfl_xor(sc, o); sd += __shfl_xor(sd, o); }
        mq0 = fmaxf(mq0, sa); mq1 = fmaxf(mq1, sb); mk0 = fmaxf(mk0, sc); mk1 = fmaxf(mk1, sd);
    }
    if ((lane_ & 7) == 0) { const int g = lane_ >> 3;
        __hip_atomic_fetch_max(lmax + g, __float_as_uint(mq0), __ATOMIC_RELAXED, __HIP_MEMORY_SCOPE_WORKGROUP); __hip_atomic_fetch_max(lmax + 12 + g, __float_as_uint(mk0), __ATOMIC_RELAXED, __HIP_MEMORY_SCOPE_WORKGROUP);
        if (lane_ < 32) { __hip_atomic_fetch_max(lmax + 8 + g, __float_as_uint(mq1), __ATOMIC_RELAXED, __HIP_MEMORY_SCOPE_WORKGROUP); __hip_atomic_fetch_max(lmax + 20 + g, __float_as_uint(mk1), __ATOMIC_RELAXED, __HIP_MEMORY_SCOPE_WORKGROUP); } }
    __syncthreads();
    if (tid_ < 24) __hip_atomic_fetch_max(gmax + tid_, lmax[tid_], RLX_AGENT);
}
typedef short bf16x8r __attribute__((ext_vector_type(8)));
constexpr int RT_SC_OFF = TAB_OFF, RT_GB_OFF = TAB_OFF + 16384;
static_assert(RT_GB_OFF + 8192 <= LDS_BYTES, "LDS map (route phase)");
template <bool XF32> __device__ __forceinline__ void ph_ln_route(Frame& F, const float* xin, const bf16* y, const float* g, const float* b, bf16* xb, const bf16* wrt, const float* rbias, gu32* cnt, int* rowtok, float* rowgate, float* gtmp) {
    const int tid_ = fresh_tid(), lane_ = tid_ & 63;
    for (int i = tid_; i < 64 * 128; i += NWAVES * 64) { const int e = i >> 7, c = i & 127;
        const v4u v = *(const GAS v4u*)(wrt + (size_t)e * D + c * 8); *(LAS v4u*)(F.lds + e * 2048 + ((c ^ (e & 15)) << 4)) = v; }
    LAS float* lgb = (LAS float*)(F.lds + RT_GB_OFF);
    if (tid_ < 256) { ((LAS f32x4*)lgb)[tid_] = ((const GAS f32x4*)g)[tid_]; ((LAS f32x4*)lgb)[256 + tid_] = ((const GAS f32x4*)b)[tid_]; }
    __syncthreads();
    LAS float* sc = (LAS float*)(F.lds + RT_SC_OFF) + F.wave * 512;
    const int r = lane_ & 15, kq = lane_ >> 4; const float bias = rbias[lane_]; const float NINF = -INFINITY;
    for (int base = f_gw(F) * 16; base < M; base += f_ngw() * 16) {
        const size_t roff = (size_t)(base + r) * D + 8 * kq;
        float s1 = 0.f, s2 = 0.f;
#pragma unroll 8
        for (int s = 0; s < 32; ++s) { const v4u yw = *(const GAS v4u*)(y + roff + 32 * s); float xv[8];
            if (XF32) { const f32x4 a0 = *(const GAS f32x4*)(xin + roff + 32 * s), a1 = *(const GAS f32x4*)(xin + roff + 32 * s + 4); xv[0] = a0.x; xv[1] = a0.y; xv[2] = a0.z; xv[3] = a0.w; xv[4] = a1.x; xv[5] = a1.y; xv[6] = a1.z; xv[7] = a1.w; }
            else { const v4u xw = *(const GAS v4u*)(xb + roff + 32 * s);
#pragma unroll
                for (int q = 0; q < 4; ++q) { xv[2 * q] = bflo(xw[q]); xv[2 * q + 1] = bfhi(xw[q]); } }
#pragma unroll
            for (int q = 0; q < 4; ++q) { const float z0 = DN_ALPHA * xv[2 * q] + bflo(yw[q]), z1 = DN_ALPHA * xv[2 * q + 1] + bfhi(yw[q]); s1 += z0 + z1; s2 += z0 * z0 + z1 * z1; } }
        s1 += __shfl_xor(s1, 16); s1 += __shfl_xor(s1, 32); s2 += __shfl_xor(s2, 16); s2 += __shfl_xor(s2, 32);
        const float mean = s1 * (1.f / D); const float rstd = 1.f / sqrtf(fmaxf(s2 * (1.f / D) - mean * mean, 0.f) + LN_EPS);
        f32x4 acc[4];
#pragma unroll
        for (int nt = 0; nt < 4; ++nt) acc[nt] = (f32x4){0.f, 0.f, 0.f, 0.f};
#pragma unroll 4
        for (int s = 0; s < 32; ++s) { const v4u yw = *(const GAS v4u*)(y + roff + 32 * s); float xv[8];
            if (XF32) { const f32x4 a0 = *(const GAS f32x4*)(xin + roff + 32 * s), a1 = *(const GAS f32x4*)(xin + roff + 32 * s + 4); xv[0] = a0.x; xv[1] = a0.y; xv[2] = a0.z; xv[3] = a0.w; xv[4] = a1.x; xv[5] = a1.y; xv[6] = a1.z; xv[7] = a1.w; }
            else { const v4u xw = *(const GAS v4u*)(xb + roff + 32 * s);
#pragma unroll
                for (int q = 0; q < 4; ++q) { xv[2 * q] = bflo(xw[q]); xv[2 * q + 1] = bfhi(xw[q]); } }
            const LAS f32x4* gp = (const LAS f32x4*)(lgb + 32 * s + 8 * kq); const f32x4 g0 = gp[0], g1 = gp[1], b0 = gp[256], b1 = gp[257];
            const float gg[8] = {g0.x, g0.y, g0.z, g0.w, g1.x, g1.y, g1.z, g1.w}, bb[8] = {b0.x, b0.y, b0.z, b0.w, b1.x, b1.y, b1.z, b1.w};
            v4u ow;
#pragma unroll
            for (int q = 0; q < 4; ++q) { const float z0 = DN_ALPHA * xv[2 * q] + bflo(yw[q]), z1 = DN_ALPHA * xv[2 * q + 1] + bfhi(yw[q]);
                ow[q] = pk2((z0 - mean) * rstd * gg[2 * q] + bb[2 * q], (z1 - mean) * rstd * gg[2 * q + 1] + bb[2 * q + 1]); }
            *(GAS v4u*)(xb + roff + 32 * s) = ow;
            const bf16x8r af = __builtin_bit_cast(bf16x8r, ow);
#pragma unroll
            for (int nt = 0; nt < 4; ++nt) { const int e = 16 * nt + r, c = 4 * s + kq;
                const bf16x8r bfr = *(const LAS bf16x8r*)(F.lds + e * 2048 + ((c ^ (e & 15)) << 4));
                acc[nt] = __builtin_amdgcn_mfma_f32_16x16x32_bf16(bfr, af, acc[nt], 0, 0, 0); } }
        unsigned selmask = 0u; unsigned long long slots = 0ull; unsigned mycount = 0u;
#pragma unroll 1
        for (int half = 0; half < 2; ++half) {
            if ((r >> 3) == half) {
#pragma unroll
                for (int nt = 0; nt < 4; ++nt) *(LAS f32x4*)(sc + (r & 7) * 64 + 16 * nt + 4 * kq) = acc[nt]; }
            LDS_WAIT(); asm volatile("" ::: "memory");
#pragma unroll 1
            for (int j8 = 0; j8 < 8; ++j8) { const int j = half * 8 + j8;
                const float logit = sc[j8 * 64 + lane_];
                const float aff = 1.f / (1.f + expf(-logit)); const float sel = aff + bias;
                float m1 = sel; m1 = fmaxf(m1, __shfl_xor(m1, 1)); m1 = fmaxf(m1, __shfl_xor(m1, 2)); m1 = fmaxf(m1, __shfl_xor(m1, 4));
                const unsigned long long bm = __ballot(sel == m1); const unsigned gb = (unsigned)(bm >> (lane_ & 56)) & 0xffu; const int first = __builtin_ctz(gb | 0x100u);
                float m2 = ((lane_ & 7) == first) ? NINF : sel; m2 = fmaxf(m2, __shfl_xor(m2, 1)); m2 = fmaxf(m2, __shfl_xor(m2, 2)); m2 = fmaxf(m2, __shfl_xor(m2, 4));
                const float gs = m1 + m2; int grank = 0;
#pragma unroll
                for (int g2 = 0; g2 < 8; ++g2) { const float o = __builtin_bit_cast(float, __builtin_amdgcn_readlane(__builtin_bit_cast(int, gs), 8 * g2)); grank += (o > gs || (o == gs && g2 < (lane_ >> 3))) ? 1 : 0; }
                const bool gok = grank < 4; const float v = gok ? sel : NINF; int er = 0;
#pragma unroll 8
                for (int e2 = 0; e2 < 64; ++e2) { const float o = __builtin_bit_cast(float, __builtin_amdgcn_readlane(__builtin_bit_cast(int, v), e2)); er += (o > v || (o == v && e2 < lane_)) ? 1 : 0; }
                const bool chosen = gok && er < 8;
                const float ssum = wave_sum(chosen ? aff : 0.f);
                const unsigned long long bal = __ballot(chosen); const unsigned slot = __builtin_amdgcn_mbcnt_hi((unsigned)(bal >> 32), __builtin_amdgcn_mbcnt_lo((unsigned)bal, 0u));
                if (chosen) { selmask |= 1u << j; slots |= (unsigned long long)slot << (4 * j); ++mycount; gtmp[(size_t)(base + j) * 64 + lane_] = aff / ssum * 2.5f; }
            }
            LDS_WAIT(); asm volatile("" ::: "memory");
        }
        unsigned pos = 0u; if (mycount) pos = __hip_atomic_fetch_add(cnt + 64 * lane_, mycount, RLX_AGENT);
#pragma unroll 1
        for (int j = 0; j < 16; ++j) if ((selmask >> j) & 1u) { const size_t at = (size_t)lane_ * CAP + pos; ++pos;
            rowtok[at] = (base + j) | ((int)((slots >> (4 * j)) & 15ull) << 16); rowgate[at] = gtmp[(size_t)(base + j) * 64 + lane_]; }
    }
}
template <bool M1> __device__ __forceinline__ int build_units(Frame& F, gu32* cnt, const int* rowtok, const float* rowgate) {
    const int tid_ = fresh_tid();
    LAS int* tcnt = (LAS int*)(F.lds + TAB_OFF); LAS int* bst = tcnt + 80; LAS int* utab = tcnt + 160; LAS int* idx = (LAS int*)(F.lds + IDX_OFF); LAS float* lgate = (LAS float*)(F.lds + GATE_OFF);
    if (tid_ < 65) tcnt[tid_] = (tid_ < 64) ? (int)__hip_atomic_load(cnt + 64 * tid_, RLX_AGENT) : M;
    __syncthreads();
    if (tid_ == 0) { int run = 0; for (int e = 0; e < 65; ++e) { bst[e] = run; run += (tcnt[e] + 255) >> 8; } bst[65] = run; }
    __syncthreads();
    const int nblk = bst[65]; const int bx = blockIdx.x;
    const int per = M1 ? 128 : 64, blk0 = M1 ? (16 * (bx & 7) + (bx >> 4)) : (8 * (bx & 7) + (bx >> 5)), pn = M1 ? ((bx >> 3) & 1) : ((bx >> 3) & 3);
    int nmine = (nblk > blk0) ? (nblk - blk0 + per - 1) / per : 0; if (nmine > (M1 ? 10 : 20)) nmine = M1 ? 10 : 20;
    if (tid_ < nmine) { const int blk = tid_ * per + blk0;
        int e = 0; for (int q = 1; q < 65; ++q) if (bst[q] <= blk) e = q;
        const int j = blk - bst[e]; int nv = tcnt[e] - 256 * j; if (nv > 256) nv = 256;
        LAS int* t = utab + tid_ * 8; t[0] = e; t[1] = blk; t[2] = pn; t[3] = nv; t[4] = e * CAP + 256 * j; t[5] = 256 * j; }
    __syncthreads();
    for (int g = 0; g < nmine; ++g) if (tid_ < 256) { const LAS int* t = utab + g * 8; const int e = t[0], nv = t[3];
        if (M1) { int tok = 0; float gt = 0.f;
            if (e == 64) { tok = t[5] + tid_; gt = 1.f; } else if (tid_ < nv) { tok = rowtok[t[4] + tid_] & 0xffff; gt = rowgate[t[4] + tid_]; }
            idx[g * 256 + tid_] = tok; lgate[g * 256 + tid_] = gt; }
        else { int dst = M * 9;
            if (e == 64) dst = (t[5] + tid_) * 9 + 8; else if (tid_ < nv) { const int v = rowtok[t[4] + tid_]; dst = (v & 0xffff) * 9 + (v >> 16); }
            idx[g * 256 + tid_] = dst; } }
    __syncthreads();
    return nmine;
}
#define WSP(T, off) ((T*)(A->ws + (off)))
#ifndef REP_P1
#define REP_P1 1
#endif
#ifndef REP_P2
#define REP_P2 1
#endif
#ifndef REP_P3
#define REP_P3 1
#endif
#ifndef REP_P5
#define REP_P5 1
#endif
#ifndef REP_P7
#define REP_P7 1
#endif
#ifndef REP_P8
#define REP_P8 1
#endif
#define REPEAT(n) _Pragma("unroll 1") for (int rep_ = 0; rep_ < (n); ++rep_)
#define OPQ(x) asm volatile("" : "+s"(x))
#define FCTL() f_ctl()
#define FRESH_GB() const int G = f_G(), bx = f_bx(); (void)G; (void)bx
__global__ void __launch_bounds__(NWAVES * 64, 2) mega_fwd(Args args_unused) {
    extern __shared__ __attribute__((aligned(16))) unsigned char lds[];
    Frame F;
    F.lds = (LAS unsigned char*)lds;
    F.wave = __builtin_amdgcn_readfirstlane((int)threadIdx.x >> 6);
    for (int u = fresh_tid(); u < 512 / 4; u += NWAVES * 64) ((LAS unsigned*)(F.lds + LDSCTL_OFF))[u] = 0u;
    __syncthreads();
    (void)xcd_barrier_post((unsigned*)(f_ctl() + CW_BAR), f_misc(F) + 8);
#define GRID_BAR() do { XcdBarrier bar_; bar_.bar = (unsigned*)(f_ctl() + CW_BAR); bar_.x = xb_xcc_id(); bar_.st = f_misc(F) + 8; xcd_barrier(bar_); } while (0)

    { ArgsP A = fresh_args(); FRESH_GB(); p0_small_weights(F, A); }
    GRID_BAR();
    {   ArgsP A = fresh_args(); FRESH_GB();
        pg8::DenseSched S; S.init(512, 2048, D, G, bx, WSP(const bf16, WS_WMKV));
        pg8::EpiBf16 E{WSP(bf16, WS_MEMKV), 2048, 0, 1.f};
        pg8::gemm_phase<pg8::EpiBf16, pg8::DenseSched>(F.lds + RING_OFF, WSP(const bf16, WS_MEMB), D, S, E); }

    for (int layer = 0; layer < DEPTH; ++layer) {
        const int jm = layer >> 1; const bool isB = (layer & 1) != 0;
        REPEAT(REP_P1) {
        if (!isB) { ArgsP A = fresh_args(); FRESH_GB();
            pg8::DenseSched S; S.init(M, NPA, D, G, bx, WSP(const bf16, WS_WINA) + (size_t)jm * NPA * D);
            pg8::EpiBf16 E{WSP(bf16, WS_QKV), NPA, 4, attn_body::C2};
            pg8::gemm_phase<pg8::EpiBf16, pg8::DenseSched>(F.lds + RING_OFF, WSP(const bf16, WS_XB), D, S, E); }
        else { ArgsP A = fresh_args(); FRESH_GB();
            pg8::DenseSched S; S.init(M, NPB, D, G, bx, WSP(const bf16, WS_WINB) + (size_t)jm * NPB * D);
            pg8::EpiBf16 E{WSP(bf16, WS_QKV), NPB, 4, attn_body::C2};
            pg8::gemm_phase<pg8::EpiBf16, pg8::DenseSched>(F.lds + RING_OFF, WSP(const bf16, WS_XB), D, S, E); }
        GRID_BAR();
        }
        if (isB) {
            ArgsP A = fresh_args();
            ph_qknorm(F, WSP(const bf16, WS_QKV), FCTL() + CW_NORM + 64 * layer);
            GRID_BAR();
        }
        REPEAT(REP_P2) {
        if (!isB) {
            { FRESH_GB();
            for (int L = bx; L < 1536; L += G) {
                ArgsP A = fresh_args(); const bf16* qkv = WSP(const bf16, WS_QKV); const int wave = F.wave;
                const int b = L / 768, rem = L % 768, qblk = rem / 3, kvh = rem % 3;
                const int q0u = qblk * 64, head = kvh * 4 + (wave >> 1); const size_t rowq = (size_t)b * SEQ + q0u + 32 * (wave & 1);
                attn_body::AttnArgs a;
                a.Qw = (const attn_body::bf16*)(qkv + rowq * NPA + head * 64);
                a.K0 = (const attn_body::bf16*)(qkv + ((size_t)b * SEQ + q0u) * NPA + 1024 + kvh * 64); a.V0 = a.K0 + 192;
                a.NT = 4; a.tmax = qblk; a.Ow = (attn_body::bf16*)(WSP(bf16, WS_CAT) + rowq * D + head * 64);
                a.qrel = 32 * (wave & 1) + (fresh_tid() & 31); a.slope2 = SLOPES_A[head] * attn_body::LOG2E; a.sink2 = A->in[3][jm * 12 + head] * attn_body::LOG2E;
                attn_body::attn_unit<2, 8, NPA, NPA, D>(a, (char*)lds + RING_OFF);
                convert_unit(F, A, layer, L);
            }
            for (int cu = 1536 + bx; cu < CONV_UNITS; cu += G) { ArgsP A = fresh_args(); convert_unit(F, A, layer, cu); } }
            { FRESH_GB();
            for (int L = bx; L < 512; L += G) {
                ArgsP A = fresh_args(); const int wave = F.wave;
                const int b = L / 256, rem = L % 256, qb = rem >> 2, hm = rem & 3;
                const size_t rowq = (size_t)b * SEQ + qb * 256 + 32 * wave;
                attn_body::AttnArgs a;
                a.Qw = (const attn_body::bf16*)(WSP(const bf16, WS_QKV) + rowq * NPA + 768 + hm * 64);
                a.K0 = (const attn_body::bf16*)(WSP(const bf16, WS_MEMKV) + (size_t)b * MEMLEN * 2048 + layer * 512 + hm * 64); a.V0 = a.K0 + 256;
                a.NT = 4; a.tmax = 1 << 30; a.Ow = (attn_body::bf16*)(WSP(bf16, WS_CAT) + rowq * D + 768 + hm * 64);
                a.qrel = 32 * wave + (fresh_tid() & 31); a.slope2 = 0.f; a.sink2 = 0.f;
                attn_body::attn_unit<0, 8, NPA, 2048, D>(a, (char*)lds + RING_OFF);
            } }
        } else {
            {
                unsigned nextL = 0u;
                if (fresh_tid() == 0) nextL = __hip_atomic_fetch_add(FCTL() + CW_Q + 64 * layer + 16 * rep_, 1u, RLX_AGENT);
                for (;;) {
                    if (fresh_tid() == 0) f_misc(F)[16] = nextL;
                    __syncthreads();
                    const int Lq = __builtin_amdgcn_readfirstlane((int)f_misc(F)[16]);
                    __syncthreads();
                    if (Lq >= 1536 + CONV_UNITS) break;
                    if (fresh_tid() == 0) nextL = __hip_atomic_fetch_add(FCTL() + CW_Q + 64 * layer + 16 * rep_, 1u, RLX_AGENT);
                    ArgsP A = fresh_args(); const bf16* qkv = WSP(const bf16, WS_QKV); const int wave = F.wave;
                    const bool isconv = (Lq < 2 * 1536) ? (Lq & 1) : true; const int L = (Lq < 2 * 1536) ? (Lq >> 1) : (Lq - 1536);
                    if (isconv) { convert_unit(F, A, layer, L); continue; }
                    const int qb = 63 - L / 24, rem = L % 24, b = rem / 12, hc = rem % 12, h = hc >> 1, c = hc & 1;
                    const size_t rowq = (size_t)b * SEQ + qb * 256 + 32 * wave;
                    const float slope2 = SLOPES_B[h] * attn_body::LOG2E;
                    const float q2m = __uint_as_float(__hip_atomic_load(FCTL() + CW_NORM + 64 * layer + hc, RLX_AGENT)), k2m = __uint_as_float(__hip_atomic_load(FCTL() + CW_NORM + 64 * layer + 12 + hc, RLX_AGENT));
                    const float B2 = sqrtf(q2m * k2m) * 1.03f + 0.5f, dcut = (160.f + 2.f * B2) / slope2;
                    int t0 = (int)floorf(((float)(qb * 256 - 63) - dcut) * (1.f / 64.f)); t0 = __builtin_amdgcn_readfirstlane(t0 > 0 ? (t0 & ~1) : 0);
                    attn_body::AttnArgs a;
                    a.Qw = (const attn_body::bf16*)(qkv + rowq * NPB + hc * 64);
                    a.K0 = (const attn_body::bf16*)(qkv + ((size_t)b * SEQ + 64 * t0) * NPB + 1024 + hc * 64); a.V0 = (const attn_body::bf16*)(qkv + ((size_t)b * SEQ + 64 * t0) * NPB + 1792 + h * 128);
                    a.NT = 4 * (qb + 1) - t0; a.tmax = 1 << 30; a.Ow = (attn_body::bf16*)(WSP(bf16, WS_OTMP) + rowq * 1536 + hc * 128);
                    a.qrel = 32 * wave + (fresh_tid() & 31); a.slope2 = slope2; a.sink2 = 0.f;
                    attn_body::diff_unit<16, NPB, NPB, 1536>(a, (char*)lds + RING_OFF);
                }
            }
            { FRESH_GB();
            for (int L = bx; L < 512; L += G) {
                ArgsP A = fresh_args(); const int wave = F.wave;
                const int b = L / 256, rem = L % 256, qb = rem >> 2, hm = rem & 3;
                const size_t rowq = (size_t)b * SEQ + qb * 256 + 32 * wave;
                attn_body::AttnArgs a;
                a.Qw = (const attn_body::bf16*)(WSP(const bf16, WS_QKV) + rowq * NPB + 768 + hm * 64);
                a.K0 = (const attn_body::bf16*)(WSP(const bf16, WS_MEMKV) + (size_t)b * MEMLEN * 2048 + layer * 512 + hm * 64); a.V0 = a.K0 + 256;
                a.NT = 4; a.tmax = 1 << 30; a.Ow = (attn_body::bf16*)(WSP(bf16, WS_CAT) + rowq * D + 768 + hm * 64);
                a.qrel = 32 * wave + (fresh_tid() & 31); a.slope2 = 0.f; a.sink2 = 0.f;
                attn_body::attn_unit<0, 8, NPB, 2048, D>(a, (char*)lds + RING_OFF);
            } }
        }
        GRID_BAR();
        }
        if (isB) {
            ArgsP A = fresh_args(); FRESH_GB();
            ph_diff_combine(F, WSP(const bf16, WS_OTMP), A->in[5] + jm * 256, A->in[6] + jm * 128, 0.8f - 0.6f * expf(-0.3f * (float)layer), WSP(bf16, WS_CAT));
            GRID_BAR();
        }
        REPEAT(REP_P3) {
        {   ArgsP A = fresh_args(); FRESH_GB();
            pg8::DenseSched S; S.init(M, D, D, G, bx, WSP(const bf16, WS_WOUT) + (size_t)layer * D * D);
            pg8::EpiBf16 E{WSP(bf16, WS_Y), D, 0, 1.f};
            pg8::gemm_phase<pg8::EpiBf16, pg8::DenseSched>(F.lds + RING_OFF, WSP(const bf16, WS_CAT), D, S, E); }
        GRID_BAR();
        }
        {   ArgsP A = fresh_args();
            if (layer == 0) ph_ln_route<true>(F, A->in[0], WSP(const bf16, WS_Y), A->in[9] + (size_t)(layer * 2) * D, A->in[10] + (size_t)(layer * 2) * D, WSP(bf16, WS_XB), WSP(const bf16, WS_WROUT) + (size_t)layer * 256 * D, A->in[12] + layer * 64, FCTL() + CW_CNT + layer * 64 * 64, WSP(int, WS_ROWTOK), WSP(float, WS_ROWGATE), WSP(float, WS_LOGIT));
            else ph_ln_route<false>(F, nullptr, WSP(const bf16, WS_Y), A->in[9] + (size_t)(layer * 2) * D, A->in[10] + (size_t)(layer * 2) * D, WSP(bf16, WS_XB), WSP(const bf16, WS_WROUT) + (size_t)layer * 256 * D, A->in[12] + layer * 64, FCTL() + CW_CNT + layer * 64 * 64, WSP(int, WS_ROWTOK), WSP(float, WS_ROWGATE), WSP(float, WS_LOGIT)); }
        GRID_BAR();
        REPEAT(REP_P7) {
        {   ArgsP A = fresh_args(); FRESH_GB();
            const int nmine = build_units<true>(F, FCTL() + CW_CNT + layer * 64 * 64, WSP(const int, WS_ROWTOK), WSP(const float, WS_ROWGATE));
            pg8::GroupSched<true> S{(const LAS int*)(F.lds + TAB_OFF) + 160, (const LAS int*)(F.lds + IDX_OFF), nmine, D, (const char*)(A->ws + WS_WEXP)};
            pg8::EpiM1 E{WSP(bf16, WS_HB), (const LAS float*)(F.lds + GATE_OFF)};
            pg8::gemm_phase<pg8::EpiM1, pg8::GroupSched<true>>(F.lds + RING_OFF, WSP(const bf16, WS_XB), D, S, E); }
        GRID_BAR();
        }
        REPEAT(REP_P8) {
        {   ArgsP A = fresh_args(); FRESH_GB();
            const int nmine = build_units<false>(F, FCTL() + CW_CNT + layer * 64 * 64, WSP(const int, WS_ROWTOK), WSP(const float, WS_ROWGATE));
            pg8::GroupSched<false> S{(const LAS int*)(F.lds + TAB_OFF) + 160, (const LAS int*)(F.lds + IDX_OFF), nmine, HID, (const char*)(A->ws + WS_WEXP) + pg8::EXPERT_DOWN_OFF};
            pg8::EpiM2 E{WSP(unsigned char, WS_BIG), (const LAS int*)(F.lds + IDX_OFF)};
            pg8::gemm_phase<pg8::EpiM2, pg8::GroupSched<false>>(F.lds + RING_OFF, WSP(const bf16, WS_HB), HID, S, E); }
        GRID_BAR();
        }
        {   ArgsP A = fresh_args(); FRESH_GB();
            if (layer + 1 < DEPTH) ph_combine_ln2<false>(F, A->out, WSP(const unsigned char, WS_BIG), A->in[9] + (size_t)(layer * 2 + 1) * D, A->in[10] + (size_t)(layer * 2 + 1) * D, WSP(bf16, WS_XB));
            else ph_combine_ln2<true>(F, A->out, WSP(const unsigned char, WS_BIG), A->in[9] + (size_t)(layer * 2 + 1) * D, A->in[10] + (size_t)(layer * 2 + 1) * D, WSP(bf16, WS_XB));
            }
        if (layer + 1 < DEPTH) GRID_BAR();
    }
    if (__hip_atomic_load(FCTL() + CW_BAR + XB_TMO, RLX_AGENT) != 0u) {
        __syncthreads();
        ArgsP A = fresh_args(); FRESH_GB(); float* xf = A->out;
        const float q = __builtin_nanf("");
        for (int m = f_gw(F); m < M; m += f_ngw()) { GAS f32x4* o = (GAS f32x4*)(xf + (size_t)m * D) + (fresh_tid() & 63);
#pragma unroll
            for (int j = 0; j < 4; ++j) o[64 * j] = (f32x4){q, q, q, q}; }
    }
}

extern "C" void kernel_launch(void* const* d_in, const int* in_sizes, int n_in, void* d_out, int out_size, void* d_ws, size_t ws_size, hipStream_t stream) {
    static int grid = 0;
    if (grid == 0) {
        if (n_in != 19 || in_sizes[0] != M * D || out_size != M * D || ws_size < WS_END) { fprintf(stderr, "kernel_launch: shape / workspace mismatch (n_in %d, in0 %d, out %d, ws %zu, need %zu); nothing launched\n", n_in, n_in > 0 ? in_sizes[0] : -1, out_size, ws_size, (size_t)WS_END); grid = -1; return; }
        int dev = 0, cus = 0, per_cu = 0;
        if (hipGetDevice(&dev) != hipSuccess || hipDeviceGetAttribute(&cus, hipDeviceAttributeMultiprocessorCount, dev) != hipSuccess) { grid = -1; return; }
        if (hipFuncSetAttribute((const void*)mega_fwd, hipFuncAttributeMaxDynamicSharedMemorySize, LDS_BYTES) != hipSuccess) { fprintf(stderr, "kernel_launch: hipFuncSetAttribute failed\n"); grid = -1; return; }
        if (hipOccupancyMaxActiveBlocksPerMultiprocessor(&per_cu, (const void*)mega_fwd, NWAVES * 64, LDS_BYTES) != hipSuccess || per_cu < 1) { fprintf(stderr, "kernel_launch: occupancy query reports %d\n", per_cu); }
        (void)hipGetLastError();
        grid = cus;
        if (grid != 256) { fprintf(stderr, "kernel_launch: built for 256 CUs, device has %d; nothing launched\n", cus); grid = -1; return; }
    }
    if (grid < 0) return;
    if (hipMemsetAsync((char*)d_ws + WS_CTL, 0, CTL_ZERO_BYTES, stream) != hipSuccess) return;
    Args a{};
    for (int i = 0; i < 19; ++i) a.in[i] = (const float*)d_in[i];
    a.out = (float*)d_out; a.ws = (unsigned char*)d_ws;
    hipLaunchKernelGGL(mega_fwd, dim3(grid), dim3(NWAVES * 64), LDS_BYTES, stream, a);
}
```

```cpp
#include <hip/hip_runtime.h>
#include <hip/hip_bf16.h>
#include <cstdio>
#include <cstdint>
#include <cmath>

namespace pg8 {
#define PG8_LAS __attribute__((address_space(3)))
typedef unsigned short bf16_t;
typedef short bf16x8 __attribute__((ext_vector_type(8)));
typedef float f32x4 __attribute__((ext_vector_type(4)));
typedef unsigned u32x4 __attribute__((ext_vector_type(4)));
constexpr int BM = 256, BK = 64, HALF = 128, HTB = HALF * BK * 2  , STAGE_BYTES = 8 * HTB, NXCD = 8, WGM = 8;
constexpr int EXPERT_BYTES = 3 * 1024 * 256 * 2;
constexpr int EXPERT_DOWN_OFF = 2 * 1024 * 256 * 2;

__host__ __device__ __forceinline__ int lds_byte(int r, int c) { const int st = (r >> 4) * 2 + (c >> 5), rr = r & 15, cc = c & 31, ob = rr * 64 + cc * 2; return st * 1024 + (ob ^ (((ob >> 9) & 1) << 5)); }
__host__ __device__ __forceinline__ void stage_rc(int b, int& R, int& C) { const int st = b / 1024, sb = b % 1024, swz = sb ^ (((sb >> 9) & 1) << 5); R = (st >> 1) * 16 + swz / 64; C = (st & 1) * 32 + (swz % 64) / 2; }
__host__ __device__ __forceinline__ int perm32(int rho) { const int n = rho >> 4, i = rho & 15; return 8 * (i >> 2) + 4 * n + (i & 3); }

struct Unit { int pm, pn, e, nvalid, lbase, pos0, slot; };

struct StaticOrder {
    int nM, nN, nwg, G, c;
    __device__ __forceinline__ void init(int M, int N, int G_, int c_) { nM = M / BM; nN = N / BM; nwg = nM * nN; G = G_; c = c_; }
    __device__ __forceinline__ bool next(int i, Unit& u) const {
        const long L = (long)i * G + c; if (L >= nwg) return false;
        int wgid = (int)L; { const int q = nwg / NXCD, r = nwg % NXCD, xcd = wgid % NXCD, off = wgid / NXCD; wgid = (xcd < r ? xcd * (q + 1) : r * (q + 1) + (xcd - r) * q) + off; }
        const int nig = WGM * nN, gid = wgid / nig, fm = gid * WGM, gsz = (nM - fm) < WGM ? (nM - fm) : WGM;
        u.pm = fm + ((wgid % nig) % gsz); u.pn = (wgid % nig) / gsz; return true;
    }
};
struct DenseSched {
    StaticOrder o; const char* Bt; int K;
    __device__ __forceinline__ void init(int M, int N, int K_, int G, int c, const bf16_t* Bt_) { o.init(M, N, G, c); Bt = (const char*)Bt_; K = K_; }
    __device__ __forceinline__ bool next(int i, Unit& u) const { u.e = 0; u.nvalid = 256; u.lbase = 0; u.pos0 = 0; u.slot = 0; return o.next(i, u); }
    __device__ __forceinline__ const char* bptr(const Unit& u) const { return Bt + (size_t)u.pn * (BM * 2) * K; }
    __device__ __forceinline__ void avoff(const Unit& u, int tid, unsigned (&v)[2][2]) const {
#pragma unroll
        for (int i = 0; i < 2; ++i) { int R, C; stage_rc(tid * 16 + i * 8192, R, C);
#pragma unroll
            for (int h = 0; h < 2; ++h) v[h][i] = (unsigned)((u.pm * BM + h * HALF + R) * K + C) * 2u; }
    }
};
template <bool GATHER> struct GroupSched {
    const PG8_LAS int* utab; const PG8_LAS int* idx; int nmine, K; const char* W;
    __device__ __forceinline__ bool next(int i, Unit& u) const {
        if (i >= nmine) return false; const PG8_LAS int* t = utab + i * 8;
        u.e = __builtin_amdgcn_readfirstlane(t[0]); u.pm = __builtin_amdgcn_readfirstlane(t[1]); u.pn = __builtin_amdgcn_readfirstlane(t[2]);
        u.nvalid = __builtin_amdgcn_readfirstlane(t[3]); u.lbase = __builtin_amdgcn_readfirstlane(t[4]); u.pos0 = __builtin_amdgcn_readfirstlane(t[5]); u.slot = i; return true;
    }
    __device__ __forceinline__ const char* bptr(const Unit& u) const { return W + (size_t)u.e * EXPERT_BYTES + (size_t)u.pn * (BM * 2) * K; }
    __device__ __forceinline__ void avoff(const Unit& u, int tid, unsigned (&v)[2][2]) const {
#pragma unroll
        for (int i = 0; i < 2; ++i) { int R, C; stage_rc(tid * 16 + i * 8192, R, C);
#pragma unroll
            for (int h = 0; h < 2; ++h) {
                const int row = GATHER ? idx[u.slot * 256 + h * HALF + R] : (u.pm * BM + h * HALF + R);
                v[h][i] = (unsigned)(row * K + C) * 2u; } }
    }
};

typedef float f32x2v __attribute__((ext_vector_type(2))); typedef __bf16 bf16x2v __attribute__((ext_vector_type(2)));
__device__ __forceinline__ unsigned cvt_pk_bf16(float lo, float hi) { f32x2v v = {lo, hi}; bf16x2v b = __builtin_convertvector(v, bf16x2v); return __builtin_bit_cast(unsigned, b); }

struct EpiBf16 {
    static constexpr bool PERM = true; static constexpr int NST = 16;
    bf16_t* O; int ldc; int nsc; float scale;
    __device__ __forceinline__ void operator()(const f32x4 (&acc)[2][2][4][2], const Unit& u, int wr, int wc, int fr, int fq) const {
        const int row0 = u.pm * BM + wr * 64 + fr; const int col0 = u.pn * BM + wc * 32 + 8 * fq; const float sc = (u.pn < nsc) ? scale : 1.f;
#pragma unroll
        for (int ai = 0; ai < 2; ++ai)
#pragma unroll
            for (int m = 0; m < 4; ++m) { bf16_t* rowp = O + (size_t)(row0 + ai * HALF + m * 16) * ldc + col0;
#pragma unroll
                for (int bj = 0; bj < 2; ++bj) { const f32x4 v0 = acc[ai][bj][m][0] * sc, v1 = acc[ai][bj][m][1] * sc;
                    u32x4 w; w.x = cvt_pk_bf16(v0[0], v0[1]); w.y = cvt_pk_bf16(v0[2], v0[3]); w.z = cvt_pk_bf16(v1[0], v1[1]); w.w = cvt_pk_bf16(v1[2], v1[3]);
                    *(u32x4*)(rowp + bj * HALF) = w; } }
    }
};
__device__ __forceinline__ float silu_f(float x) { return x * __builtin_amdgcn_rcpf(1.0f + __builtin_amdgcn_exp2f(-1.4426950408889634f * x)); }
struct EpiM1 {
    static constexpr bool PERM = true; static constexpr int NST = 8;
    bf16_t* H; const PG8_LAS float* lgate;
    __device__ __forceinline__ void operator()(const f32x4 (&acc)[2][2][4][2], const Unit& u, int wr, int wc, int fr, int fq) const {
        const int col0 = u.pn * HALF + wc * 32 + 8 * fq; const PG8_LAS float* lg = lgate + u.slot * 256;
#pragma unroll
        for (int ai = 0; ai < 2; ++ai)
#pragma unroll
            for (int m = 0; m < 4; ++m) { const int r = ai * HALF + wr * 64 + m * 16 + fr;
                const float g = lg[r];
                const f32x4 ga = acc[ai][0][m][0], gb = acc[ai][0][m][1], ua = acc[ai][1][m][0], ub = acc[ai][1][m][1];
                f32x4 v0, v1;
#pragma unroll
                for (int j = 0; j < 4; ++j) { v0[j] = silu_f(ga[j]) * ua[j] * g; v1[j] = silu_f(gb[j]) * ub[j] * g; }
                u32x4 w; w.x = cvt_pk_bf16(v0[0], v0[1]); w.y = cvt_pk_bf16(v0[2], v0[3]); w.z = cvt_pk_bf16(v1[0], v1[1]); w.w = cvt_pk_bf16(v1[2], v1[3]);
                *(u32x4*)(H + (size_t)(u.pm * BM + r) * 256 + col0) = w; }
    }
};
constexpr float Y8_SCALE = 16.f;
typedef unsigned u32x2e __attribute__((ext_vector_type(2)));
struct EpiM2 {
    static constexpr bool PERM = true; static constexpr int NST = 16;
    unsigned char* Y; const PG8_LAS int* ldst;
    __device__ __forceinline__ void operator()(const f32x4 (&acc)[2][2][4][2], const Unit& u, int wr, int wc, int fr, int fq) const {
        const int col0 = u.pn * BM + wc * 32 + 8 * fq; const PG8_LAS int* ld = ldst + u.slot * 256;
#pragma unroll
        for (int ai = 0; ai < 2; ++ai)
#pragma unroll
            for (int m = 0; m < 4; ++m) { const int r = ai * HALF + wr * 64 + m * 16 + fr;
                const int dst = ld[r];
                {
                    unsigned char* rowp = Y + (size_t)dst * 1024 + col0;
#pragma unroll
                    for (int bj = 0; bj < 2; ++bj) { const f32x4 v0 = acc[ai][bj][m][0] * Y8_SCALE, v1 = acc[ai][bj][m][1] * Y8_SCALE;
                        int w0 = __builtin_amdgcn_cvt_pk_fp8_f32(v0[0], v0[1], 0, false); w0 = __builtin_amdgcn_cvt_pk_fp8_f32(v0[2], v0[3], w0, true);
                        int w1 = __builtin_amdgcn_cvt_pk_fp8_f32(v1[0], v1[1], 0, false); w1 = __builtin_amdgcn_cvt_pk_fp8_f32(v1[2], v1[3], w1, true);
                        *(u32x2e*)(rowp + bj * HALF) = (u32x2e){(unsigned)w0, (unsigned)w1}; } } }
    }
};

template <class Epi, class Sched>
__device__ __forceinline__ void gemm_phase(PG8_LAS unsigned char* lds, const bf16_t* Abase, const int K, const Sched& S, const Epi& E) {
    int tid = threadIdx.x; asm volatile("" : "+v"(tid));
    const int wid = __builtin_amdgcn_readfirstlane(tid >> 6), lane = tid & 63, wr = wid >> 2, wc = wid & 3, fr = lane & 15, fq = lane >> 4;
    const int nt = K / BK;
    unsigned voffB[2];
#pragma unroll
    for (int i = 0; i < 2; ++i) { int R, C; stage_rc(tid * 16 + i * 8192, R, C); const int Rb = Epi::PERM ? ((R & ~31) + perm32(R & 31)) : R; voffB[i] = (unsigned)(Rb * K + C) * 2u; }
    const size_t kstep = (size_t)(BK * 2);
    const size_t hstep = (size_t)HALF * K * 2;
    const unsigned ldsw = (unsigned)wid * 1024u;
    const int aoff = lds_byte(wr * 64 + fr, fq * 8), boff = lds_byte(wc * 32 + fr, fq * 8);
    const char* Ab = (const char*)Abase;
#define PG8_SA(b, h) (((b) * 2 + (h)) * HTB)
#define PG8_SB(b, h) ((4 + (b) * 2 + (h)) * HTB)
#define PG8_STAGE(bufoff, gbase, voff) do { _Pragma("unroll") for (int _i = 0; _i < 2; ++_i) \
        __builtin_amdgcn_global_load_lds((const unsigned*)((const char*)(gbase) + (voff)[_i]), (PG8_LAS unsigned*)(lds + (bufoff) + ldsw + _i * 8192), 16, 0, 0); } while (0)
#define PG8_STAGEA(bufoff, kb, V, h) do { _Pragma("unroll") for (int _i = 0; _i < 2; ++_i) \
        __builtin_amdgcn_global_load_lds((const unsigned*)(Ab + (kb) + (V)[h][_i]), (PG8_LAS unsigned*)(lds + (bufoff) + ldsw + _i * 8192), 16, 0, 0); } while (0)
#define PG8_LDA(dst, b, h) do { _Pragma("unroll") for (int m = 0; m < 4; ++m) _Pragma("unroll") for (int k = 0; k < 2; ++k) dst[m][k] = *(const PG8_LAS bf16x8*)(lds + PG8_SA(b, h) + aoff + m * 2048 + k * 1024); } while (0)
#define PG8_LDB(dst, b, h) do { _Pragma("unroll") for (int n = 0; n < 2; ++n) _Pragma("unroll") for (int k = 0; k < 2; ++k) dst[n][k] = *(const PG8_LAS bf16x8*)(lds + PG8_SB(b, h) + boff + n * 2048 + k * 1024); } while (0)
#define PG8_MMA(ai, bj, At, Bt) do { __builtin_amdgcn_s_setprio(1); _Pragma("unroll") for (int m = 0; m < 4; ++m) _Pragma("unroll") for (int n = 0; n < 2; ++n) _Pragma("unroll") for (int k = 0; k < 2; ++k) \
        acc[ai][bj][m][n] = __builtin_amdgcn_mfma_f32_16x16x32_bf16(Bt[n][k], At[m][k], acc[ai][bj][m][n], 0, 0, 0); __builtin_amdgcn_s_setprio(0); } while (0)
#define PG8_WAIT_V(n) asm volatile("s_waitcnt vmcnt(" #n ")" ::: "memory")
#define PG8_WAIT_VR(rl) do { if (rl) asm volatile("s_waitcnt vmcnt(%0)" :: "n"(8 + Epi::NST) : "memory"); else asm volatile("s_waitcnt vmcnt(8)" ::: "memory"); } while (0)
#define PG8_WAIT_L(n) asm volatile("s_waitcnt lgkmcnt(" #n ")" ::: "memory")
#define PG8_BAR __builtin_amdgcn_s_barrier()
#define PG8_SCHED __builtin_amdgcn_sched_barrier(0)
    Unit cur, nxt; int ui = 0;
    if (!S.next(0, cur)) return;
    nxt = cur;
    f32x4 acc[2][2][4][2];
#pragma unroll
    for (int a = 0; a < 2; ++a)
#pragma unroll
        for (int b = 0; b < 2; ++b)
#pragma unroll
            for (int m = 0; m < 4; ++m)
#pragma unroll
                for (int n = 0; n < 2; ++n) acc[a][b][m][n] = (f32x4){0.f, 0.f, 0.f, 0.f};
    bf16x8 At[4][2], B0[2][2], B1[2][2];
    unsigned vA[2][2];
    S.avoff(cur, tid, vA);
    const char* cB = S.bptr(cur);
    PG8_STAGE(PG8_SB(0, 0), cB, voffB); PG8_STAGE(PG8_SB(0, 1), cB + hstep, voffB); PG8_STAGEA(PG8_SA(0, 0), 0, vA, 0); PG8_STAGEA(PG8_SA(0, 1), 0, vA, 1);
    if (wr == 1) PG8_BAR;
    PG8_WAIT_V(2); PG8_BAR;
    PG8_STAGE(PG8_SB(1, 0), cB + kstep, voffB); PG8_STAGEA(PG8_SA(1, 0), kstep, vA, 0); PG8_STAGE(PG8_SB(1, 1), cB + hstep + kstep, voffB);
    PG8_WAIT_V(6); PG8_BAR;
    bool relax = false;
    for (;;) {
        const bool has_next = S.next(ui + 1, nxt);
        const char* nB = cB;
        if (has_next) nB = S.bptr(nxt);
#pragma unroll 1
        for (int t = 0; t < nt; t += 2) {
            const bool last = (t == nt - 2); const bool rl = relax && (t == 0);
            const size_t kb1 = (size_t)(t + 1) * kstep;
            const size_t kb2 = last ? (size_t)0 : (size_t)(t + 2) * kstep; const char* b2 = last ? nB : cB + (size_t)(t + 2) * kstep;
            const size_t kb3 = kb2 + kstep; const char* b3 = b2 + kstep;
            PG8_LDB(B0, 0, 0); PG8_LDB(B1, 0, 1); PG8_SCHED; PG8_LDA(At, 0, 0); if (!rl) PG8_STAGEA(PG8_SA(1, 1), kb1, vA, 1);
            if (last && has_next) S.avoff(nxt, tid, vA);
            PG8_WAIT_VR(rl); PG8_WAIT_L(0); PG8_BAR; PG8_MMA(0, 0, At, B0); PG8_MMA(0, 1, At, B1); PG8_BAR; PG8_SCHED;
            PG8_LDA(At, 0, 1); PG8_STAGE(PG8_SB(0, 0), b2, voffB); PG8_STAGE(PG8_SB(0, 1), b2 + hstep, voffB); PG8_STAGEA(PG8_SA(0, 0), kb2, vA, 0);
            PG8_WAIT_VR(rl); PG8_WAIT_L(0); PG8_BAR; PG8_MMA(1, 0, At, B0); PG8_MMA(1, 1, At, B1); PG8_BAR; PG8_SCHED;
            PG8_LDB(B0, 1, 0); PG8_LDB(B1, 1, 1); PG8_SCHED; PG8_LDA(At, 1, 0); PG8_STAGEA(PG8_SA(0, 1), kb2, vA, 1);
            PG8_WAIT_VR(rl); PG8_WAIT_L(0); PG8_BAR; PG8_MMA(0, 0, At, B0); PG8_MMA(0, 1, At, B1); PG8_BAR; PG8_SCHED;
            PG8_LDA(At, 1, 1); PG8_STAGE(PG8_SB(1, 0), b3, voffB); PG8_STAGE(PG8_SB(1, 1), b3 + hstep, voffB); PG8_STAGEA(PG8_SA(1, 0), kb3, vA, 0);
            PG8_WAIT_V(8); PG8_WAIT_L(0); PG8_BAR; PG8_MMA(1, 0, At, B0); PG8_MMA(1, 1, At, B1); PG8_BAR; PG8_SCHED;
        }
        if (wr == 0) PG8_BAR;
        if (has_next) PG8_STAGEA(PG8_SA(1, 1), kstep, vA, 1);
        E(acc, cur, wr, wc, fr, fq);
        if (!has_next) break;
#pragma unroll
        for (int a = 0; a < 2; ++a)
#pragma unroll
            for (int b = 0; b < 2; ++b)
#pragma unroll
                for (int m = 0; m < 4; ++m)
#pragma unroll
                    for (int n = 0; n < 2; ++n) acc[a][b][m][n] = (f32x4){0.f, 0.f, 0.f, 0.f};
        cur = nxt; cB = nB; ++ui; relax = true;
        if (wr == 1) PG8_BAR;
    }
    PG8_WAIT_V(0);
    PG8_BAR;
#undef PG8_SA
#undef PG8_SB
#undef PG8_STAGE
#undef PG8_STAGEA
#undef PG8_LDA
#undef PG8_LDB
#undef PG8_MMA
#undef PG8_WAIT_V
#undef PG8_WAIT_VR
#undef PG8_WAIT_L
#undef PG8_BAR
#undef PG8_SCHED
}
}
namespace attn_body {
using bf16=__hip_bfloat16;
using bf16x8=__attribute__((ext_vector_type(8)))short;
using s16x4=__attribute__((ext_vector_type(4)))short;
using f32x16=__attribute__((ext_vector_type(16)))float;
using u32x4=__attribute__((ext_vector_type(4)))unsigned;
constexpr int D=64,NW=8,QBLK=32,QB=QBLK*NW,KVBLK=64;
__device__ __forceinline__ int crow(int r,int hi){return (r&3)+8*(r>>2)+4*hi;}
#define SBAR() __builtin_amdgcn_sched_barrier(0)
constexpr int NSLOT=3, SLOTB=8192;
constexpr int LDS_K=0, LDS_V=NSLOT*SLOTB, LDS_WS=2*NSLOT*SLOTB, LDS_OST=LDS_WS+NW*64*4, LDS_BYTES=LDS_OST+NW*4096;
constexpr float LOG2E=1.4426950408889634f;
constexpr float C2=0.125f*LOG2E;
__device__ __forceinline__ void glds16(const void*gsrc,unsigned lds_dst){unsigned keep;
  asm volatile("s_mov_b32 %0, m0\n\ts_mov_b32 m0, %2\n\ts_nop 0\n\tglobal_load_lds_dwordx4 %1, off\n\ts_mov_b32 m0, %0":"=&s"(keep):"v"(gsrc),"s"(lds_dst):"memory");}
__device__ __forceinline__ float max3f(float a,float b,float c){float r;asm("v_max3_f32 %0, %1, %2, %3":"=v"(r):"v"(a),"v"(b),"v"(c));return r;}
__device__ __forceinline__ float max2f(float a,float b){float r;asm("v_max_f32_e32 %0, %1, %2":"=v"(r):"v"(a),"v"(b));return r;}
__device__ __forceinline__ float fadd_s(float a,float b){float r;asm("v_add_f32_e32 %0, %1, %2":"=v"(r):"v"(a),"v"(b));return r;}
__device__ __forceinline__ float fsub_s(float a,float b){float r;asm("v_sub_f32_e32 %0, %1, %2":"=v"(r):"v"(a),"v"(b));return r;}
typedef float f32x2_t __attribute__((ext_vector_type(2))); typedef __bf16 bf16x2_t __attribute__((ext_vector_type(2)));
__device__ __forceinline__ unsigned cvtpk_s(float lo,float hi){f32x2_t v={lo,hi};bf16x2_t b=__builtin_convertvector(v,bf16x2_t);return __builtin_bit_cast(unsigned,b);}
#define WAIT_BAR(N) asm volatile("s_waitcnt vmcnt(" #N ") lgkmcnt(0)\n\ts_barrier":::"memory")

template<int MODE> __device__ __forceinline__ void maskbias(f32x16&p0,f32x16&p1,int kb,int qrel,float slope2,float mhat,bool band,bool tile_ok){
  if(MODE==0)return;
  const float NEG=-INFINITY; const float lb=slope2*(float)(kb-qrel)-mhat;
  #pragma unroll
  for(int r=0;r<16;++r){const int c=(r&3)+8*(r>>2); p0[r]=__builtin_fmaf(slope2,(float)c,p0[r]+lb); p1[r]=__builtin_fmaf(slope2,(float)(c+32),p1[r]+lb);}
  if(MODE==1){ if(band){
    #pragma unroll
    for(int r=0;r<16;++r){const int kv=kb+(r&3)+8*(r>>2); if(kv>qrel)p0[r]=NEG; if(kv+32>qrel)p1[r]=NEG;} } }
  if(MODE==2){
    #pragma unroll
    for(int r=0;r<16;++r){const int d=qrel-kb-((r&3)+8*(r>>2)); if((unsigned)d>=128u||!tile_ok)p0[r]=NEG; if((unsigned)(d-32)>=128u||!tile_ok)p1[r]=NEG;} }
}

__device__ __forceinline__ void qkt(f32x16&p0,f32x16&p1,const char*Kslot,const bf16x8*qr,const f32x16&negm,int r32,int hi){
  const char*kb=Kslot+hi*1024+r32*16;
  #pragma unroll
  for(int d0=0;d0<4;++d0){
    const bf16x8 b0=*reinterpret_cast<const bf16x8*>(kb+d0*2048);
    const bf16x8 b1=*reinterpret_cast<const bf16x8*>(kb+d0*2048+512);
    if(d0==0){p0=__builtin_amdgcn_mfma_f32_32x32x16_bf16(b0,qr[0],negm,0,0,0);p1=__builtin_amdgcn_mfma_f32_32x32x16_bf16(b1,qr[0],negm,0,0,0);}
    else{p0=__builtin_amdgcn_mfma_f32_32x32x16_bf16(b0,qr[d0],p0,0,0,0);p1=__builtin_amdgcn_mfma_f32_32x32x16_bf16(b1,qr[d0],p1,0,0,0);}}
}
typedef __attribute__((address_space(3))) const char* lds_cptr;
typedef short v4i16_t __attribute__((ext_vector_type(4)));
__device__ __forceinline__ void kload8(bf16x8*kf,lds_cptr kp){
  kf[0]=*(const __attribute__((address_space(3))) bf16x8*)(kp);      kf[1]=*(const __attribute__((address_space(3))) bf16x8*)(kp+512);
  kf[2]=*(const __attribute__((address_space(3))) bf16x8*)(kp+2048); kf[3]=*(const __attribute__((address_space(3))) bf16x8*)(kp+2560);
  kf[4]=*(const __attribute__((address_space(3))) bf16x8*)(kp+4096); kf[5]=*(const __attribute__((address_space(3))) bf16x8*)(kp+4608);
  kf[6]=*(const __attribute__((address_space(3))) bf16x8*)(kp+6144); kf[7]=*(const __attribute__((address_space(3))) bf16x8*)(kp+6656);
}
__device__ __forceinline__ void kload2(bf16x8*kf,lds_cptr kp,int j){ kf[2*j]=*(const __attribute__((address_space(3))) bf16x8*)(kp+j*2048); kf[2*j+1]=*(const __attribute__((address_space(3))) bf16x8*)(kp+j*2048+512); }
__device__ __forceinline__ s16x4 vtr(lds_cptr p){ return __builtin_bit_cast(s16x4,__builtin_amdgcn_ds_read_tr16_b64_v4i16((__attribute__((address_space(3))) v4i16_t*)p)); }
__device__ __forceinline__ float rowmax(const f32x16&p0,const f32x16&p1){
  float a=max3f(p0[0],p0[1],p1[0]),b=max3f(p0[2],p0[3],p1[1]);a=max3f(a,p1[2],p1[3]);
  #pragma unroll
  for(int r=4;r<16;r+=4){a=max3f(a,p0[r],p0[r+1]);b=max3f(b,p0[r+2],p0[r+3]);a=max3f(a,p1[r],p1[r+1]);b=max3f(b,p1[r+2],p1[r+3]);}
  const float m=max2f(a,b);
  auto rr=__builtin_amdgcn_permlane32_swap(__float_as_uint(m),__float_as_uint(m),false,false);
  return max2f(__uint_as_float(rr[0]),__uint_as_float(rr[1]));
}
__device__ __forceinline__ void pv(f32x16*o,int vb,bf16x8 pa0,bf16x8 pa1,bf16x8 pa2,bf16x8 pa3){
  #pragma unroll
  for(int d0=0;d0<2;++d0){s16x4 lo[4],hi[4];
    #pragma unroll
    for(int ks=0;ks<4;++ks){
      asm volatile("ds_read_b64_tr_b16 %0,%1 offset:%c2":"=&v"(lo[ks]):"v"(vb),"i"(d0*4096+ks*1024):"memory");
      asm volatile("ds_read_b64_tr_b16 %0,%1 offset:%c2":"=&v"(hi[ks]):"v"(vb),"i"(d0*4096+ks*1024+512):"memory");}
    asm volatile("s_waitcnt lgkmcnt(0)":::"memory");SBAR();
    #define PK(k) (bf16x8){lo[k][0],lo[k][1],lo[k][2],lo[k][3],hi[k][0],hi[k][1],hi[k][2],hi[k][3]}
    o[d0]=__builtin_amdgcn_mfma_f32_32x32x16_bf16(pa0,PK(0),o[d0],0,0,0);
    o[d0]=__builtin_amdgcn_mfma_f32_32x32x16_bf16(pa1,PK(1),o[d0],0,0,0);
    o[d0]=__builtin_amdgcn_mfma_f32_32x32x16_bf16(pa2,PK(2),o[d0],0,0,0);
    o[d0]=__builtin_amdgcn_mfma_f32_32x32x16_bf16(pa3,PK(3),o[d0],0,0,0);
    #undef PK
  }
}
struct AttnArgs {
  const bf16* Qw;
  const bf16* K0; const bf16* V0;
  int NT;
  int tmax;
  bf16* Ow;
  int qrel;
  float slope2, sink2;
};
#define ATTN_STORE16(p,v) (*(u32x4*)(p)=(v))
template<int MODE,int THRL,int QP,int KVP,int OP> __device__ __forceinline__ void attn_unit(const AttnArgs&a,char*shm){
  int tid=threadIdx.x; asm volatile("":"+v"(tid)); const int lane=tid&63,r32=lane&31,hi=lane>>5; const int wid=__builtin_amdgcn_readfirstlane(tid>>6);
  const bf16*Qw=a.Qw; constexpr int qp=QP; constexpr long kvp=KVP;
  const unsigned lds0=(unsigned)(uintptr_t)shm;
  float*wsf=(float*)(shm+LDS_WS)+wid*64;
  const bf16*ksrc=a.K0+(long)lane*kvp+wid*8;
  const bf16*vsrc=a.V0+(long)(16*(wid&3)+(lane>>2))*kvp+(wid>>2)*32+(lane&3)*8;
  const unsigned kdst=lds0+LDS_K+wid*1024, vdst=lds0+LDS_V+wid*1024;
  const int tmax=a.tmax;
  #define TROW(t) ((MODE==2)?(-64*(((t)<tmax)?(t):tmax)):(64*(t)))
  #define DMA_K(t,slot) glds16(ksrc+(long)TROW(t)*kvp,(unsigned)__builtin_amdgcn_readfirstlane(kdst+(slot)))
  #define DMA_V(t,slot) glds16(vsrc+(long)TROW(t)*kvp,(unsigned)__builtin_amdgcn_readfirstlane(vdst+(slot)))
  const int vb0=(int)(lds0+LDS_V)+((lane>>4)&1)*32+(lane&3)*8+(4*hi+((lane&15)>>2))*64;
  const char*Kbase=shm+LDS_K; bf16x8 kf[8];
  const lds_cptr shm3=(lds_cptr)shm; const lds_cptr kp0=shm3+LDS_K+hi*1024+r32*16; const lds_cptr vp0=shm3+LDS_V+((lane>>4)&1)*32+(lane&3)*8+(4*hi+((lane&15)>>2))*64;
  const int NT=a.NT;
  DMA_K(0,0);DMA_V(0,0);DMA_K(1,SLOTB);
  bf16x8 qr[4];
  #pragma unroll
  for(int d0=0;d0<4;++d0)qr[d0]=*reinterpret_cast<const bf16x8*>(&Qw[(long)r32*qp+d0*16+hi*8]);
  float z0_; asm volatile("v_mov_b32 %0, 0":"=v"(z0_));
  f32x16 zv_; _Pragma("unroll") for(int r=0;r<16;++r)zv_[r]=z0_;
  float mhat=0.f,l_reg=0.f;f32x16 o[2];o[0]=zv_;o[1]=zv_;f32x16 negm=zv_;if(MODE==0)asm volatile("":"+v"(negm));
  const int qrel=a.qrel; const float slope2=a.slope2;
  #define KBREL(t) ((MODE==2)?(-64*(t)):(64*((t)-(NT-4))))
  #define MBIAS(P0,P1,t,BAND) maskbias<MODE>(P0,P1,KBREL(t)+4*hi,qrel,slope2,mhat,(BAND)&&((t)>=NT-4),(t)<=tmax)
  #define CINIT ((MODE==0)?negm:(f32x16{}))
  #define CMASK(P0,P1,t) MBIAS(P0,P1,t,true)
  bool resc=false;
  #define START(P0,P1) do{ const float rm=rowmax(P0,P1); resc=false; \
    { const float dl=rm; mhat=fadd_s(mhat,dl); \
      _Pragma("unroll") for(int r=0;r<16;++r){P0[r]=fsub_s(P0[r],dl);P1[r]=fsub_s(P1[r],dl);} \
      if(MODE==0){ _Pragma("unroll") for(int r=0;r<16;++r)negm[r]=-mhat; asm volatile("":"+v"(negm)); } } \
    _Pragma("unroll") for(int r=0;r<16;++r)P0[r]=__builtin_amdgcn_exp2f(P0[r]); }while(0)
  #define RESC() do{ if(resc){ asm volatile("s_waitcnt lgkmcnt(0)":::"memory"); \
      _Pragma("unroll") for(int d_=0;d_<2;++d_) _Pragma("unroll") for(int r=0;r<16;++r)o[d_][r]*=wsf[crow(r,hi)]; } }while(0)
  f32x16 pA0,pA1,pB0,pB1;
  int sl_prev=0,sl_cur=0,sl_next=SLOTB;
  #define ROT() do{sl_prev=sl_cur;sl_cur=sl_next;sl_next=(sl_next==(NSLOT-1)*SLOTB)?0:sl_next+SLOTB;}while(0)
  DMA_K(2,2*SLOTB);
  WAIT_BAR(3);
  qkt(pA0,pA1,Kbase,qr,negm,r32,hi);asm volatile("s_nop 15\n\ts_nop 7":"+v"(pA0),"+v"(pA1));CMASK(pA0,pA1,0);
  START(pA0,pA1);
  _Pragma("unroll") for(int r=0;r<16;++r)pA1[r]=__builtin_amdgcn_exp2f(pA1[r]);
  WAIT_BAR(0);
  DMA_K(3,0);DMA_V(1,SLOTB);
  ROT();
  kload8(kf,kp0+sl_cur);
  WAIT_BAR(2);
  s16x4 vlo[8],vhi[8]; u32x4 pw0,pw1,pw2,pw3;
  #define PKW(P,B) cvtpk_s(P[B],P[B+1])
  #define PAF(k) __builtin_bit_cast(bf16x8,pw##k)
  #define VFR(i) (bf16x8){vlo[i][0],vlo[i][1],vlo[i][2],vlo[i][3],vhi[i][0],vhi[i][1],vhi[i][2],vhi[i][3]}
  #define PIN(x) asm volatile("":"+v"(x))
  #define MX3(a,b,c) __builtin_fmaxf(__builtin_fmaxf((a),(b)),(c))
  #define GAPA(MF,A0,A1,A2,A3,W0,W1,PW) do{ MF; sacc+=A0; sacc+=A1; sacc+=A2; sacc+=A3; PIN(sacc); W0; W1; PIN(PW); SBAR(); }while(0)
  #define EX(v) __builtin_amdgcn_exp2f(v)
  #define GAPB(MF,X,B) do{ MF; X[B]=EX(X[B]); X[B+1]=EX(X[B+1]); X[B+2]=EX(X[B+2]); X[B+3]=EX(X[B+3]); PIN(X); SBAR(); }while(0)
  #define VRD(i) do{ vlo[i]=vtr(vp_+(((i)>>2)*4096+((i)&3)*1024)); vhi[i]=vtr(vp_+(((i)>>2)*4096+((i)&3)*1024+512)); }while(0)
  #define KRD(G,j) do{ if(G){ kload2(kf,kp0+sl_next,j); SBAR(); } }while(0)
  #define STEP(C0,C1,P0,P1,t,GK,GV,GL) do{ SBAR(); \
    const lds_cptr vp_=vp0+sl_prev; \
    VRD(0); SBAR(); float sacc=(P0[0]+P0[1]); \
    GAPA(C0=__builtin_amdgcn_mfma_f32_32x32x16_bf16(kf[0],qr[0],CINIT,0,0,0), P0[2],P0[3],P0[4],P0[5],     pw0[0]=PKW(P0,0), pw0[1]=PKW(P0,2), pw0); \
    VRD(4); SBAR(); GAPA(C1=__builtin_amdgcn_mfma_f32_32x32x16_bf16(kf[1],qr[0],CINIT,0,0,0), P0[6],P0[7],P0[8],P0[9],     pw0[2]=PKW(P0,4), pw0[3]=PKW(P0,6), pw0); \
    VRD(1); SBAR(); GAPA(C0=__builtin_amdgcn_mfma_f32_32x32x16_bf16(kf[2],qr[1],C0,0,0,0),   P0[10],P0[11],P0[12],P0[13], pw1[0]=PKW(P0,8), pw1[1]=PKW(P0,10), pw1); \
    VRD(5); SBAR(); GAPA(C1=__builtin_amdgcn_mfma_f32_32x32x16_bf16(kf[3],qr[1],C1,0,0,0),   P0[14],P0[15],P1[0],P1[1],   pw1[2]=PKW(P0,12),pw1[3]=PKW(P0,14), pw1); \
    VRD(2); SBAR(); GAPA(C0=__builtin_amdgcn_mfma_f32_32x32x16_bf16(kf[4],qr[2],C0,0,0,0),   P1[2],P1[3],P1[4],P1[5],     pw2[0]=PKW(P1,0), pw2[1]=PKW(P1,2), pw2); \
    VRD(6); SBAR(); GAPA(C1=__builtin_amdgcn_mfma_f32_32x32x16_bf16(kf[5],qr[2],C1,0,0,0),   P1[6],P1[7],P1[8],P1[9],     pw2[2]=PKW(P1,4), pw2[3]=PKW(P1,6), pw2); \
    VRD(3); SBAR(); GAPA(C0=__builtin_amdgcn_mfma_f32_32x32x16_bf16(kf[6],qr[3],C0,0,0,0),   P1[10],P1[11],P1[12],P1[13], pw3[0]=PKW(P1,8), pw3[1]=PKW(P1,10), pw3); \
    VRD(7); SBAR(); GAPA(C1=__builtin_amdgcn_mfma_f32_32x32x16_bf16(kf[7],qr[3],C1,0,0,0),   P1[14],P1[15],0.f,0.f,       pw3[2]=PKW(P1,12),pw3[3]=PKW(P1,14), pw3); \
    l_reg+=sacc; \
    if(GK){DMA_K((t)+3,sl_cur);} if(GV){DMA_V((t)+1,sl_next);} \
    CMASK(C0,C1,t); \
    { float a_=MX3(C0[0],C0[1],C1[0]),b_=MX3(C0[2],C0[3],C1[1]); a_=MX3(a_,C1[2],C1[3]); \
      _Pragma("unroll") for(int r=4;r<16;r+=4){a_=MX3(a_,C0[r],C0[r+1]);b_=MX3(b_,C0[r+2],C0[r+3]);a_=MX3(a_,C1[r],C1[r+1]);b_=MX3(b_,C1[r+2],C1[r+3]);} \
      float rm=__builtin_fmaxf(a_,b_); { auto rr=__builtin_amdgcn_permlane32_swap(__float_as_uint(rm),__float_as_uint(rm),false,false); rm=__builtin_fmaxf(__uint_as_float(rr[0]),__uint_as_float(rr[1])); } \
      resc=false; \
      if(__builtin_expect(__any(rm>(float)THRL),0)){ const float dl=__builtin_fmaxf(rm,0.f); mhat+=dl; \
        _Pragma("unroll") for(int r=0;r<16;++r){C0[r]-=dl;C1[r]-=dl;} \
        if(MODE==0){ _Pragma("unroll") for(int r=0;r<16;++r)negm[r]=-mhat; asm volatile("":"+v"(negm)); } \
        const float f=__builtin_amdgcn_exp2f(-dl); l_reg*=f; if(hi==0)wsf[r32]=f; resc=true; } } \
    SBAR(); \
    GAPB(o[0]=__builtin_amdgcn_mfma_f32_32x32x16_bf16(PAF(0),VFR(0),o[0],0,0,0), C0,0); \
    GAPB(o[1]=__builtin_amdgcn_mfma_f32_32x32x16_bf16(PAF(0),VFR(4),o[1],0,0,0), C0,4); \
    KRD(GL,0); GAPB(o[0]=__builtin_amdgcn_mfma_f32_32x32x16_bf16(PAF(1),VFR(1),o[0],0,0,0), C0,8); \
    KRD(GL,1); GAPB(o[1]=__builtin_amdgcn_mfma_f32_32x32x16_bf16(PAF(1),VFR(5),o[1],0,0,0), C0,12); \
    KRD(GL,2); GAPB(o[0]=__builtin_amdgcn_mfma_f32_32x32x16_bf16(PAF(2),VFR(2),o[0],0,0,0), C1,0); \
    KRD(GL,3); GAPB(o[1]=__builtin_amdgcn_mfma_f32_32x32x16_bf16(PAF(2),VFR(6),o[1],0,0,0), C1,4); \
    GAPB(o[0]=__builtin_amdgcn_mfma_f32_32x32x16_bf16(PAF(3),VFR(3),o[0],0,0,0), C1,8); \
    GAPB(o[1]=__builtin_amdgcn_mfma_f32_32x32x16_bf16(PAF(3),VFR(7),o[1],0,0,0), C1,12); \
    }while(0)
  int t=1;
  #undef CMASK
  #define CMASK(P0,P1,t) MBIAS(P0,P1,t,false)
  for(;t+5<NT;t+=2){
    STEP(pB0,pB1,pA0,pA1,t,true,true,true);     WAIT_BAR(2); RESC(); ROT();
    STEP(pA0,pA1,pB0,pB1,t+1,true,true,true);   WAIT_BAR(2); RESC(); ROT();
  }
  #undef CMASK
  #define CMASK(P0,P1,t) MBIAS(P0,P1,t,true)
  #define ENDW(tt) do{ if((tt)+3<NT){WAIT_BAR(2);} else if((tt)+2<NT){WAIT_BAR(1);} else {WAIT_BAR(0);} }while(0)
  for(;t+1<NT;t+=2){
    STEP(pB0,pB1,pA0,pA1,t,(t+3<NT),(t+1<NT),(t+1<NT));       ENDW(t);   RESC(); ROT();
    STEP(pA0,pA1,pB0,pB1,t+1,(t+4<NT),(t+2<NT),(t+2<NT));     ENDW(t+1); RESC(); ROT();
  }
  STEP(pB0,pB1,pA0,pA1,NT-1,false,false,false); RESC();
  { float sacc=pB0[0]+pB0[1]; _Pragma("unroll") for(int r=2;r<16;++r)sacc+=pB0[r]; _Pragma("unroll") for(int r=0;r<16;++r)sacc+=pB1[r]; l_reg+=sacc;
    pw0=(u32x4){PKW(pB0,0),PKW(pB0,2),PKW(pB0,4),PKW(pB0,6)};pw1=(u32x4){PKW(pB0,8),PKW(pB0,10),PKW(pB0,12),PKW(pB0,14)};pw2=(u32x4){PKW(pB1,0),PKW(pB1,2),PKW(pB1,4),PKW(pB1,6)};pw3=(u32x4){PKW(pB1,8),PKW(pB1,10),PKW(pB1,12),PKW(pB1,14)};
    SBAR(); pv(o,vb0+sl_cur,PAF(0),PAF(1),PAF(2),PAF(3)); }
  #undef PKW
  #undef PAF
  #undef VFR
  #undef PIN
  #undef MX3
  #undef GAPA
  #undef GAPB
  #undef EX
  #undef VRD
  #undef KRD
  #undef STEP
  #undef ENDW
  {auto rr=__builtin_amdgcn_permlane32_swap(__float_as_uint(l_reg),__float_as_uint(l_reg),false,false);l_reg=__uint_as_float(rr[0])+__uint_as_float(rr[1]);}
  if(MODE==2)l_reg+=__builtin_amdgcn_exp2f(a.sink2-mhat);
  if(hi==0)wsf[32+r32]=l_reg;asm volatile("s_waitcnt lgkmcnt(0)":::"memory");
  float rli[16];
  #pragma unroll
  for(int r=0;r<16;++r)rli[r]=__builtin_amdgcn_rcpf(wsf[32+crow(r,hi)]);
  bf16*Ow=a.Ow; constexpr long op=OP;
  { bf16*stg=(bf16*)(shm+LDS_OST)+wid*2048;
    #pragma unroll
    for(int r=0;r<16;++r){const int orow=crow(r,hi);
      #pragma unroll
      for(int d0=0;d0<2;++d0)stg[orow*64+d0*32+r32]=__float2bfloat16(o[d0][r]*rli[r]);}
    asm volatile("s_waitcnt lgkmcnt(0)":::"memory");
    #pragma unroll
    for(int i=0;i<4;++i){const int row=i*8+(lane>>3),ch=lane&7; const u32x4 v=*(const u32x4*)(stg+row*64+ch*8); ATTN_STORE16(Ow+(long)row*op+ch*8,v);} }
  asm volatile("s_waitcnt lgkmcnt(0)\n\ts_barrier":::"memory");
  #undef DMA_K
  #undef DMA_V
  #undef TROW
  #undef KBREL
  #undef MBIAS
  #undef CINIT
  #undef CMASK
  #undef START
  #undef RESC
  #undef ROT
}

constexpr int DP_K=0, DP_V=3*8192, DP_WS=DP_V+3*16384, DP_BYTES=DP_WS+NW*256;
template<int THRL,int QP,int KVP,int OP> __device__ __forceinline__ void diff_unit(const AttnArgs&a,char*shm){
  int tid=threadIdx.x; asm volatile("":"+v"(tid)); const int lane=tid&63,r32=lane&31,hi=lane>>5; const int wid=__builtin_amdgcn_readfirstlane(tid>>6);
  const bf16*Qw=a.Qw; constexpr int qp=QP; constexpr long kvp=KVP;
  const unsigned lds0=(unsigned)(uintptr_t)shm;
  float*wsf=(float*)(shm+DP_WS)+wid*64;
  const bf16*ksrc=a.K0+(long)lane*kvp+wid*8;
  const bf16*vsrc=a.V0+(long)(16*(wid&3)+(lane>>2))*kvp+(wid>>2)*32+(lane&3)*8;
  const unsigned kdst=lds0+DP_K+wid*1024, vdst=lds0+DP_V+wid*1024;
  #define DMA_K(t,slot) glds16(ksrc+(long)(64*(t))*kvp,(unsigned)__builtin_amdgcn_readfirstlane(kdst+(slot)))
  #define DMA_V(t,slot) do{ glds16(vsrc+(long)(64*(t))*kvp,(unsigned)__builtin_amdgcn_readfirstlane(vdst+2*(slot))); glds16(vsrc+(long)(64*(t))*kvp+64,(unsigned)__builtin_amdgcn_readfirstlane(vdst+2*(slot)+8192)); }while(0)
  const int vb0=(int)(lds0+DP_V)+((lane>>4)&1)*32+(lane&3)*8+(4*hi+((lane&15)>>2))*64;
  const char*Kbase=shm+DP_K; bf16x8 kf[8];
  const lds_cptr shm3=(lds_cptr)shm; const lds_cptr kp0=shm3+DP_K+hi*1024+r32*16; const lds_cptr vp0=shm3+DP_V+((lane>>4)&1)*32+(lane&3)*8+(4*hi+((lane&15)>>2))*64;
  const int NT=a.NT;
  DMA_K(0,0);DMA_V(0,0);DMA_K(1,SLOTB);
  bf16x8 qr[4];
  #pragma unroll
  for(int d0=0;d0<4;++d0)qr[d0]=*reinterpret_cast<const bf16x8*>(&Qw[(long)r32*qp+d0*16+hi*8]);
  float z0_; asm volatile("v_mov_b32 %0, 0":"=v"(z0_));
  f32x16 zv_; _Pragma("unroll") for(int r=0;r<16;++r)zv_[r]=z0_;
  float mhat=0.f,l_reg=0.f;f32x16 o[4];o[0]=zv_;o[1]=zv_;o[2]=zv_;o[3]=zv_;
  const int qrel=a.qrel; const float slope2=a.slope2;
  #define KBREL(t) (64*((t)-(NT-4)))
  #define MBIAS(P0,P1,t,BAND) maskbias<1>(P0,P1,KBREL(t)+4*hi,qrel,slope2,mhat,(BAND)&&((t)>=NT-4),true)
  #define CMASK(P0,P1,t) MBIAS(P0,P1,t,true)
  bool resc=false;
  #define START(P0,P1) do{ const float rm=rowmax(P0,P1); resc=false; \
    { const float dl=rm; mhat=fadd_s(mhat,dl); \
      _Pragma("unroll") for(int r=0;r<16;++r){P0[r]=fsub_s(P0[r],dl);P1[r]=fsub_s(P1[r],dl);} } \
    _Pragma("unroll") for(int r=0;r<16;++r)P0[r]=__builtin_amdgcn_exp2f(P0[r]); }while(0)
  #define RESC() do{ if(resc){ asm volatile("s_waitcnt lgkmcnt(0)":::"memory"); \
      _Pragma("unroll") for(int d_=0;d_<4;++d_) _Pragma("unroll") for(int r=0;r<16;++r)o[d_][r]*=wsf[crow(r,hi)]; } }while(0)
  f32x16 pA0,pA1,pB0,pB1;
  int sl_prev=0,sl_cur=0,sl_next=SLOTB;
  #define ROT() do{sl_prev=sl_cur;sl_cur=sl_next;sl_next=(sl_next==(NSLOT-1)*SLOTB)?0:sl_next+SLOTB;}while(0)
  DMA_K(2,2*SLOTB);
  WAIT_BAR(4);
  qkt(pA0,pA1,Kbase,qr,zv_,r32,hi);asm volatile("s_nop 15\n\ts_nop 7":"+v"(pA0),"+v"(pA1));CMASK(pA0,pA1,0);
  START(pA0,pA1);
  _Pragma("unroll") for(int r=0;r<16;++r)pA1[r]=__builtin_amdgcn_exp2f(pA1[r]);
  WAIT_BAR(0);
  DMA_K(3,0);DMA_V(1,SLOTB);
  ROT();
  kload8(kf,kp0+sl_cur);
  WAIT_BAR(0);
  s16x4 vlo[8],vhi[8]; u32x4 pw0,pw1,pw2,pw3;
  #define PKW(P,B) cvtpk_s(P[B],P[B+1])
  #define PAF(k) __builtin_bit_cast(bf16x8,pw##k)
  #define VFR(i) (bf16x8){vlo[i][0],vlo[i][1],vlo[i][2],vlo[i][3],vhi[i][0],vhi[i][1],vhi[i][2],vhi[i][3]}
  #define PIN(x) asm volatile("":"+v"(x))
  #define MX3(a,b,c) __builtin_fmaxf(__builtin_fmaxf((a),(b)),(c))
  #define GAPA(MF,A0,A1,A2,A3,W0,W1,PW) do{ MF; sacc+=A0; sacc+=A1; sacc+=A2; sacc+=A3; PIN(sacc); W0; W1; PIN(PW); SBAR(); }while(0)
  #define EX(v) __builtin_amdgcn_exp2f(v)
  #define GAPB(MF,X,B) do{ MF; X[B]=EX(X[B]); X[B+1]=EX(X[B+1]); X[B+2]=EX(X[B+2]); X[B+3]=EX(X[B+3]); PIN(X); SBAR(); }while(0)
  #define GAPC(MF) do{ MF; SBAR(); }while(0)
  #define VRD(i) do{ vlo[i]=vtr(vp_+(((i)>>2)*4096+((i)&3)*1024)); vhi[i]=vtr(vp_+(((i)>>2)*4096+((i)&3)*1024+512)); SBAR(); }while(0)
  #define VRD2(i) do{ vlo[i]=vtr(vp_+(8192+((i)>>2)*4096+((i)&3)*1024)); vhi[i]=vtr(vp_+(8192+((i)>>2)*4096+((i)&3)*1024+512)); SBAR(); }while(0)
  #define KRD(G,j) do{ if(G){ kload2(kf,kp0+sl_next,j); SBAR(); } }while(0)
  #define STEP(C0,C1,P0,P1,t,GK,GV,GL) do{ SBAR(); \
    const lds_cptr vp_=vp0+2*sl_prev; \
    float sacc=(P0[0]+P0[1]); \
    GAPA(C0=__builtin_amdgcn_mfma_f32_32x32x16_bf16(kf[0],qr[0],f32x16{},0,0,0), P0[2],P0[3],P0[4],P0[5],     pw0[0]=PKW(P0,0), pw0[1]=PKW(P0,2), pw0); \
    GAPA(C1=__builtin_amdgcn_mfma_f32_32x32x16_bf16(kf[1],qr[0],f32x16{},0,0,0), P0[6],P0[7],P0[8],P0[9],     pw0[2]=PKW(P0,4), pw0[3]=PKW(P0,6), pw0); \
    GAPA(C0=__builtin_amdgcn_mfma_f32_32x32x16_bf16(kf[2],qr[1],C0,0,0,0),   P0[10],P0[11],P0[12],P0[13], pw1[0]=PKW(P0,8), pw1[1]=PKW(P0,10), pw1); \
    GAPA(C1=__builtin_amdgcn_mfma_f32_32x32x16_bf16(kf[3],qr[1],C1,0,0,0),   P0[14],P0[15],P1[0],P1[1],   pw1[2]=PKW(P0,12),pw1[3]=PKW(P0,14), pw1); \
    GAPA(C0=__builtin_amdgcn_mfma_f32_32x32x16_bf16(kf[4],qr[2],C0,0,0,0),   P1[2],P1[3],P1[4],P1[5],     pw2[0]=PKW(P1,0), pw2[1]=PKW(P1,2), pw2); \
    GAPA(C1=__builtin_amdgcn_mfma_f32_32x32x16_bf16(kf[5],qr[2],C1,0,0,0),   P1[6],P1[7],P1[8],P1[9],     pw2[2]=PKW(P1,4), pw2[3]=PKW(P1,6), pw2); \
    GAPA(C0=__builtin_amdgcn_mfma_f32_32x32x16_bf16(kf[6],qr[3],C0,0,0,0),   P1[10],P1[11],P1[12],P1[13], pw3[0]=PKW(P1,8), pw3[1]=PKW(P1,10), pw3); \
    VRD(0); GAPA(C1=__builtin_amdgcn_mfma_f32_32x32x16_bf16(kf[7],qr[3],C1,0,0,0),   P1[14],P1[15],0.f,0.f,       pw3[2]=PKW(P1,12),pw3[3]=PKW(P1,14), pw3); \
    l_reg+=sacc; \
    if(GK){DMA_K((t)+3,sl_cur);} if(GV){DMA_V((t)+1,sl_next);} \
    VRD(4); VRD(1); VRD(5); \
    CMASK(C0,C1,t); \
    { float a_=MX3(C0[0],C0[1],C1[0]),b_=MX3(C0[2],C0[3],C1[1]); a_=MX3(a_,C1[2],C1[3]); \
      _Pragma("unroll") for(int r=4;r<16;r+=4){a_=MX3(a_,C0[r],C0[r+1]);b_=MX3(b_,C0[r+2],C0[r+3]);a_=MX3(a_,C1[r],C1[r+1]);b_=MX3(b_,C1[r+2],C1[r+3]);} \
      float rm=__builtin_fmaxf(a_,b_); { auto rr=__builtin_amdgcn_permlane32_swap(__float_as_uint(rm),__float_as_uint(rm),false,false); rm=__builtin_fmaxf(__uint_as_float(rr[0]),__uint_as_float(rr[1])); } \
      resc=false; \
      if(__builtin_expect(__any(rm>(float)THRL),0)){ const float dl=__builtin_fmaxf(rm,0.f); mhat+=dl; \
        _Pragma("unroll") for(int r=0;r<16;++r){C0[r]-=dl;C1[r]-=dl;} \
        const float f=__builtin_amdgcn_exp2f(-dl); l_reg*=f; if(hi==0)wsf[r32]=f; resc=true; } } \
    SBAR(); \
    VRD(2); GAPB(o[0]=__builtin_amdgcn_mfma_f32_32x32x16_bf16(PAF(0),VFR(0),o[0],0,0,0), C0,0);  VRD2(0); \
    VRD(6); GAPB(o[1]=__builtin_amdgcn_mfma_f32_32x32x16_bf16(PAF(0),VFR(4),o[1],0,0,0), C0,4);  VRD2(4); \
    VRD(3); GAPB(o[0]=__builtin_amdgcn_mfma_f32_32x32x16_bf16(PAF(1),VFR(1),o[0],0,0,0), C0,8);  VRD2(1); \
    VRD(7); GAPB(o[1]=__builtin_amdgcn_mfma_f32_32x32x16_bf16(PAF(1),VFR(5),o[1],0,0,0), C0,12); VRD2(5); \
    GAPB(o[0]=__builtin_amdgcn_mfma_f32_32x32x16_bf16(PAF(2),VFR(2),o[0],0,0,0), C1,0);  VRD2(2); \
    GAPB(o[1]=__builtin_amdgcn_mfma_f32_32x32x16_bf16(PAF(2),VFR(6),o[1],0,0,0), C1,4);  VRD2(6); \
    GAPB(o[0]=__builtin_amdgcn_mfma_f32_32x32x16_bf16(PAF(3),VFR(3),o[0],0,0,0), C1,8);  VRD2(3); \
    GAPB(o[1]=__builtin_amdgcn_mfma_f32_32x32x16_bf16(PAF(3),VFR(7),o[1],0,0,0), C1,12); VRD2(7); \
    KRD(GL,0); GAPC(o[2]=__builtin_amdgcn_mfma_f32_32x32x16_bf16(PAF(0),VFR(0),o[2],0,0,0)); \
    KRD(GL,1); GAPC(o[3]=__builtin_amdgcn_mfma_f32_32x32x16_bf16(PAF(0),VFR(4),o[3],0,0,0)); \
    KRD(GL,2); GAPC(o[2]=__builtin_amdgcn_mfma_f32_32x32x16_bf16(PAF(1),VFR(1),o[2],0,0,0)); \
    KRD(GL,3); GAPC(o[3]=__builtin_amdgcn_mfma_f32_32x32x16_bf16(PAF(1),VFR(5),o[3],0,0,0)); \
    GAPC(o[2]=__builtin_amdgcn_mfma_f32_32x32x16_bf16(PAF(2),VFR(2),o[2],0,0,0)); \
    GAPC(o[3]=__builtin_amdgcn_mfma_f32_32x32x16_bf16(PAF(2),VFR(6),o[3],0,0,0)); \
    GAPC(o[2]=__builtin_amdgcn_mfma_f32_32x32x16_bf16(PAF(3),VFR(3),o[2],0,0,0)); \
    GAPC(o[3]=__builtin_amdgcn_mfma_f32_32x32x16_bf16(PAF(3),VFR(7),o[3],0,0,0)); \
    }while(0)
  int t=1;
  #undef CMASK
  #define CMASK(P0,P1,t) MBIAS(P0,P1,t,false)
  for(;t+5<NT;t+=2){
    STEP(pB0,pB1,pA0,pA1,t,true,true,true);     WAIT_BAR(0); RESC(); ROT();
    STEP(pA0,pA1,pB0,pB1,t+1,true,true,true);   WAIT_BAR(0); RESC(); ROT();
  }
  #undef CMASK
  #define CMASK(P0,P1,t) MBIAS(P0,P1,t,true)
  #define ENDW(tt) do{ WAIT_BAR(0); }while(0)
  for(;t+1<NT;t+=2){
    STEP(pB0,pB1,pA0,pA1,t,(t+3<NT),(t+1<NT),(t+1<NT));       ENDW(t);   RESC(); ROT();
    STEP(pA0,pA1,pB0,pB1,t+1,(t+4<NT),(t+2<NT),(t+2<NT));     ENDW(t+1); RESC(); ROT();
  }
  STEP(pB0,pB1,pA0,pA1,NT-1,false,false,false); RESC();
  { float sacc=pB0[0]+pB0[1]; _Pragma("unroll") for(int r=2;r<16;++r)sacc+=pB0[r]; _Pragma("unroll") for(int r=0;r<16;++r)sacc+=pB1[r]; l_reg+=sacc;
    pw0=(u32x4){PKW(pB0,0),PKW(pB0,2),PKW(pB0,4),PKW(pB0,6)};pw1=(u32x4){PKW(pB0,8),PKW(pB0,10),PKW(pB0,12),PKW(pB0,14)};pw2=(u32x4){PKW(pB1,0),PKW(pB1,2),PKW(pB1,4),PKW(pB1,6)};pw3=(u32x4){PKW(pB1,8),PKW(pB1,10),PKW(pB1,12),PKW(pB1,14)};
    SBAR(); pv(o,vb0+2*sl_cur,PAF(0),PAF(1),PAF(2),PAF(3)); pv(o+2,vb0+2*sl_cur+8192,PAF(0),PAF(1),PAF(2),PAF(3)); }
  #undef PKW
  #undef PAF
  #undef VFR
  #undef PIN
  #undef MX3
  #undef GAPA
  #undef GAPB
  #undef GAPC
  #undef EX
  #undef VRD
  #undef VRD2
  #undef KRD
  #undef STEP
  #undef ENDW
  {auto rr=__builtin_amdgcn_permlane32_swap(__float_as_uint(l_reg),__float_as_uint(l_reg),false,false);l_reg=__uint_as_float(rr[0])+__uint_as_float(rr[1]);}
  if(hi==0)wsf[32+r32]=l_reg;asm volatile("s_waitcnt lgkmcnt(0)":::"memory");
  float rli[16];
  #pragma unroll
  for(int r=0;r<16;++r)rli[r]=__builtin_amdgcn_rcpf(wsf[32+crow(r,hi)]);
  asm volatile("s_waitcnt lgkmcnt(0)\n\ts_barrier":::"memory");
  { bf16*stg=(bf16*)(shm)+wid*4096;
    #pragma unroll
    for(int r=0;r<16;++r){const int orow=crow(r,hi);
      #pragma unroll
      for(int dq=0;dq<4;++dq)stg[orow*128+dq*32+r32]=__float2bfloat16(o[dq][r]*rli[r]);}
    asm volatile("s_waitcnt lgkmcnt(0)":::"memory");
    #pragma unroll
    for(int i=0;i<8;++i){const int row=i*4+(lane>>4),ch=lane&15; const u32x4 v=*(const u32x4*)(stg+row*128+ch*8); *(u32x4*)(a.Ow+(long)row*OP+ch*8)=v;} }
  asm volatile("s_waitcnt lgkmcnt(0)\n\ts_barrier":::"memory");
  #undef DMA_K
  #undef DMA_V
  #undef KBREL
  #undef MBIAS
  #undef CMASK
  #undef START
  #undef RESC
  #undef ROT
}
constexpr int ATTN_LDS_BYTES=LDS_BYTES;
#undef SBAR
#undef WAIT_BAR
}
constexpr int NWAVES = 8;
constexpr int BATCH = 2, SEQ = 16384, D = 1024, M = BATCH * SEQ, DEPTH = 4, MEMLEN = 256;
constexpr int NPA = 1536, NPB = 2560;
constexpr int NEXP = 64, CAP = 32768, HID = 256;
constexpr int HROWS = (M * 8 / 256 + NEXP + M / 256) * 256;
constexpr float LN_EPS = 1e-5f;
constexpr float DN_ALPHA = 1.681792830507429f;
__device__ const float SLOPES_A[12] = {0.5f, 0.25f, 0.125f, 0.0625f, 0.03125f, 0.015625f, 0.0078125f, 0.00390625f, 0.7071067811865476f, 0.35355339059327384f, 0.17677669529663695f, 0.08838834764831849f};
__device__ const float SLOPES_B[6] = {0.25f, 0.0625f, 0.015625f, 0.00390625f, 0.5f, 0.125f};

constexpr size_t MiB = 1u << 20;
constexpr size_t WS_CTL = 0, CTL_ZERO_BYTES = 1 * MiB;
constexpr size_t WS_MEMKV = 2 * MiB;
constexpr size_t WS_WROUT = 4 * MiB;
constexpr size_t WS_WINA = 6 * MiB, WS_WINB = 12 * MiB;
constexpr size_t WS_WOUT = 22 * MiB;
constexpr size_t WS_WMKV = 30 * MiB;
constexpr size_t WS_MEMB = 34 * MiB;
constexpr size_t WS_LOGIT = 36 * MiB;
constexpr size_t WS_ROWTOK = 44 * MiB, WS_ROWGATE = 52 * MiB;
constexpr size_t WS_WEXP = 60 * MiB;
constexpr size_t WS_XB = 158 * MiB;
constexpr size_t WS_HB = 222 * MiB;
constexpr size_t WS_BIG = 374 * MiB;
constexpr size_t WS_QKV = WS_BIG, WS_OTMP = WS_BIG + 160 * MiB, WS_CAT = WS_BIG + 256 * MiB, WS_Y = WS_BIG + 320 * MiB;
constexpr size_t WS_END = WS_BIG + 576 * MiB;
static_assert(WS_WEXP + 65 * (size_t)pg8::EXPERT_BYTES <= WS_XB && WS_HB + (size_t)HROWS * 512 <= WS_BIG, "d_ws map");
constexpr int CW_TMO = 0;
constexpr int CW_BAR = 4096;
constexpr int CW_CNT = 16384;
constexpr int CW_Q = CW_CNT + DEPTH * 64 * 64;
constexpr int CW_NORM = CW_Q + 64 * DEPTH;
static_assert((CW_NORM + 64 * DEPTH) * 4 <= (int)CTL_ZERO_BYTES, "CTL words inside the memset region");

constexpr int RING_OFF = 0, RING_BYTES = 131072;
constexpr int LDSCTL_OFF = RING_BYTES;
constexpr int TAB_OFF = RING_BYTES + 512;
constexpr int IDX_OFF = RING_BYTES + 2560;
constexpr int GATE_OFF = IDX_OFF + 10 * 1024;
constexpr int LDS_BYTES = 163840;
static_assert(IDX_OFF + 20 * 1024 <= LDS_BYTES, "LDS map");

#define GAS __attribute__((address_space(1)))
#define LAS __attribute__((address_space(3)))
typedef unsigned short bf16;
typedef unsigned v4u __attribute__((ext_vector_type(4)));
typedef unsigned v2u __attribute__((ext_vector_type(2)));
typedef float f32x4 __attribute__((ext_vector_type(4)));
typedef GAS unsigned gu32;
#define RLX_AGENT __ATOMIC_RELAXED, __HIP_MEMORY_SCOPE_AGENT
#define LDS_WAIT() asm volatile("s_waitcnt lgkmcnt(0)" ::: "memory")
__device__ __forceinline__ unsigned f2bf(float f) { unsigned u = __builtin_bit_cast(unsigned, f); return (u + 0x7fffu + ((u >> 16) & 1u)) >> 16; }
__device__ __forceinline__ unsigned pk2(float lo, float hi) { return f2bf(lo) | (f2bf(hi) << 16); }
__device__ __forceinline__ float bflo(unsigned u) { return __builtin_bit_cast(float, u << 16); }
__device__ __forceinline__ float bfhi(unsigned u) { return __builtin_bit_cast(float, u & 0xffff0000u); }

#define XB_TMO      128
#define XB_XCNT(j)  (256  + 64 * (j))
#define XB_XSUB(j)  (1280 + 64 * (j))
#define XB_XGEN(j)  (2304 + 64 * (j))
#define XB_TOP      3328
#define XB_TOPGEN   3392
#define XCD_BAR_WORDS 3456
#define XB_SPIN_CAP (1u << 18)
__device__ __forceinline__ unsigned xb_ld(unsigned* p)              { return __hip_atomic_load(p, __ATOMIC_RELAXED, __HIP_MEMORY_SCOPE_AGENT); }
__device__ __forceinline__ unsigned xb_add(unsigned* p, unsigned v) { return __hip_atomic_fetch_add(p, v, __ATOMIC_RELAXED, __HIP_MEMORY_SCOPE_AGENT); }
__device__ __forceinline__ unsigned xb_xcc_id() { return (unsigned)__builtin_amdgcn_s_getreg((3 << 11) | 20) & 0xFu; }
#define XB_SPIN(cond, bar) do { unsigned _sp = 0; while (cond) { __builtin_amdgcn_s_sleep(1); \
    if ((++_sp & 255u) == 0u) { if (xb_ld(&(bar)[XB_TMO])) break; if (_sp > XB_SPIN_CAP) { atomicAdd(&(bar)[XB_TMO], 1u); break; } } } } while (0)
struct XcdBarrier { unsigned* bar; unsigned x; volatile LAS unsigned* st; };
__device__ __forceinline__ XcdBarrier xcd_barrier_post(unsigned* bar, volatile LAS unsigned* st) {
    XcdBarrier b; b.bar = bar; b.x = xb_xcc_id(); b.st = st;
    if (threadIdx.x == 0) (void)xb_add(&bar[XB_XCNT(b.x)], 1u);
    return b;
}
__device__ __forceinline__ void xcd_barrier_complete(unsigned* bar, unsigned x, unsigned& nloc, unsigned& nx) {
    const unsigned G = gridDim.x * gridDim.y * gridDim.z;
    unsigned sum, cnt, mine, sp = 0u;
    for (;;) {
        sum = 0u; cnt = 0u; mine = 0u;
#pragma unroll
        for (unsigned j = 0; j < 16; ++j) { const unsigned c = xb_ld(&bar[XB_XCNT(j)]); sum += c; cnt += (c > 0u) ? 1u : 0u; mine = (j == x) ? c : mine; }
        if (sum == G) break;
        __builtin_amdgcn_s_sleep(1);
        if ((++sp & 255u) == 0u) { if (xb_ld(&bar[XB_TMO])) break; if (sp > XB_SPIN_CAP) { atomicAdd(&bar[XB_TMO], 1u); break; } }
    }
    nloc = mine > 0u ? mine : 1u; nx = cnt > 0u ? cnt : 1u;
}
__device__ __forceinline__ void xcd_barrier(const XcdBarrier& b) {
    asm volatile("s_waitcnt vmcnt(0)" ::: "memory");
    __syncthreads();
    if (threadIdx.x == 0) {
        unsigned* bar = b.bar;
        __builtin_amdgcn_s_waitcnt(0);
        unsigned nloc = b.st[0], nx = b.st[1];
        if (nloc == 0u) { xcd_barrier_complete(bar, b.x, nloc, nx); b.st[0] = nloc; b.st[1] = nx; }
        const unsigned old = xb_add(&bar[XB_XSUB(b.x)], 1u);
        const unsigned gen = old / nloc;
        if (old + 1u == (gen + 1u) * nloc) {
            __builtin_amdgcn_fence(__ATOMIC_RELEASE, "agent");
            asm volatile("s_waitcnt vmcnt(0)" ::: "memory");
            const unsigned og = xb_add(&bar[XB_TOP], 1u);
            const unsigned tg = og / nx;
            if (og + 1u == (tg + 1u) * nx) xb_add(&bar[XB_TOPGEN], 1u);
            else XB_SPIN(xb_ld(&bar[XB_TOPGEN]) == tg, bar);
            __builtin_amdgcn_fence(__ATOMIC_ACQUIRE, "agent");
            xb_add(&bar[XB_XGEN(b.x)], 1u);
            asm volatile("s_waitcnt vmcnt(0)" ::: "memory");
        } else {
            XB_SPIN(xb_ld(&bar[XB_XGEN(b.x)]) == gen, bar);
            __builtin_amdgcn_fence(__ATOMIC_ACQUIRE, "agent");
            asm volatile("s_waitcnt vmcnt(0)" ::: "memory");
        }
    }
    __syncthreads();
}

struct Frame { LAS unsigned char* lds; int wave; };
__device__ __forceinline__ int f_G() { int g = (int)gridDim.x; asm volatile("" : "+s"(g)); return g; }
__device__ __forceinline__ int f_bx() { int b = (int)blockIdx.x; asm volatile("" : "+s"(b)); return b; }
__device__ __forceinline__ int f_gw(const Frame& F) { const int g = f_G(), b = f_bx(); return ((g % 8 == 0) ? (b % 8) * (g / 8) + b / 8 : b) * NWAVES + F.wave; }
__device__ __forceinline__ int f_ngw() { return f_G() * NWAVES; }
__device__ __forceinline__ volatile LAS unsigned* f_misc(const Frame& F) { return (volatile LAS unsigned*)(F.lds + LDSCTL_OFF); }
__device__ __forceinline__ int fresh_tid() { int t = threadIdx.x; asm volatile("" : "+v"(t)); return t; }
__device__ __forceinline__ float wave_sum(float v) {
#pragma unroll
    for (int o = 1; o < 64; o <<= 1) v += __shfl_xor(v, o);
    return v;
}
__device__ __forceinline__ void transpose_item64(const float* W, int N, bf16* WT, int ldt, int k0, int n0, int drow0, LAS float* scr, int lane) {
    const int rr = lane >> 4, cc = (lane & 15) * 4;
#pragma unroll 8
    for (int i = 0; i < 16; ++i) { const int kk = 4 * i + rr; const f32x4 v = *(const GAS f32x4*)(W + (size_t)(k0 + kk) * N + n0 + cc);
        LAS float* d = scr + kk * 65 + cc; d[0] = v.x; d[1] = v.y; d[2] = v.z; d[3] = v.w; }
    LDS_WAIT(); asm volatile("" ::: "memory");
    const int c = lane & 7;
#pragma unroll
    for (int j = 0; j < 8; ++j) { const int n = (lane >> 3) + 8 * j; const LAS float* s = scr + (8 * c) * 65 + n;
        v4u o; o.x = pk2(s[0 * 65], s[1 * 65]); o.y = pk2(s[2 * 65], s[3 * 65]); o.z = pk2(s[4 * 65], s[5 * 65]); o.w = pk2(s[6 * 65], s[7 * 65]);
        *(GAS v4u*)(WT + (size_t)(drow0 + n) * ldt + k0 + 8 * c) = o; }
    LDS_WAIT(); asm volatile("" ::: "memory");
}
__device__ __forceinline__ int map_in_a(int n) { return n < 768 ? n : (n < 960 ? n + 256 : (n < 1152 ? n + 256 : n - 384)); }
__device__ __forceinline__ int map_in_b(int n) { return n < 768 ? n : (n < 2304 ? n + 256 : n - 1536); }

struct Args { const float* in[19]; float* out; unsigned char* ws; };
typedef const __attribute__((address_space(4))) Args* ArgsP;
__device__ __forceinline__ ArgsP fresh_args() { ArgsP p = (ArgsP)__builtin_amdgcn_kernarg_segment_ptr(); asm volatile("" : "+s"(p)); return p; }
__device__ __forceinline__ gu32* f_ctl() { return (gu32*)(fresh_args()->ws + WS_CTL); }

__device__ __forceinline__ void p0_small_weights(Frame& F, ArgsP A) {
    const int tid_ = fresh_tid(), lane_ = tid_ & 63; (void)tid_; (void)lane_;
    LAS float* scr = (LAS float*)(F.lds + (F.wave < 7 ? RING_OFF + F.wave * 16640 : IDX_OFF));
    unsigned char* ws = A->ws;
    constexpr int I_A = 16 * 22, I_B = 16 * 40, I_M = 16 * 8, I_O = 16 * 16, I_R = 16;
    constexpr int NITEMS = 2 * I_A + 2 * I_B + 4 * I_M + 4 * I_O + 4 * I_R;
    for (int it = f_gw(F); it < NITEMS; it += f_ngw()) {
        int r = it;
        if (r < 2 * I_A) { const int j = r / I_A; r %= I_A; const int kb = r / 22, nb = r % 22;
            transpose_item64(A->in[2] + (size_t)j * D * 1408, 1408, (bf16*)(ws + WS_WINA) + (size_t)j * NPA * D, D, 64 * kb, 64 * nb, map_in_a(64 * nb), scr, lane_); continue; } r -= 2 * I_A;
        if (r < 2 * I_B) { const int j = r / I_B; r %= I_B; const int kb = r / 40, nb = r % 40;
            transpose_item64(A->in[4] + (size_t)j * D * 2560, 2560, (bf16*)(ws + WS_WINB) + (size_t)j * NPB * D, D, 64 * kb, 64 * nb, map_in_b(64 * nb), scr, lane_); continue; } r -= 2 * I_B;
        if (r < 4 * I_M) { const int l = r / I_M; r %= I_M; const int kb = r / 8, nb = r % 8;
            transpose_item64(A->in[7] + (size_t)l * D * 512, 512, (bf16*)(ws + WS_WMKV), D, 64 * kb, 64 * nb, l * 512 + 64 * nb, scr, lane_); continue; } r -= 4 * I_M;
        if (r < 4 * I_O) { const int l = r / I_O; r %= I_O; const int kb = r / 16, nb = r % 16;
            transpose_item64(A->in[8] + (size_t)l * D * D, D, (bf16*)(ws + WS_WOUT) + (size_t)l * D * D, D, 64 * kb, 64 * nb, 64 * nb, scr, lane_); continue; } r -= 4 * I_O;
        { const int l = r / I_R; const int kb = r % I_R;
            transpose_item64(A->in[11] + (size_t)l * D * 64, 64, (bf16*)(ws + WS_WROUT) + (size_t)l * 256 * D, D, 64 * kb, 0, 0, scr, lane_); }
    }
    for (int it = f_gw(F); it < 2 * 128 + 4 * 192; it += f_ngw()) {
        bf16* row = it < 256 ? (bf16*)(ws + WS_WINA) + ((size_t)(it >> 7) * NPA + 1408 + (it & 127)) * D
                             : (bf16*)(ws + WS_WROUT) + ((size_t)((it - 256) / 192) * 256 + 64 + (it - 256) % 192) * D;
        GAS v4u* o = (GAS v4u*)row + lane_;
        o[0] = (v4u){0u, 0u, 0u, 0u}; o[64] = (v4u){0u, 0u, 0u, 0u};
    }
    for (int m0 = 4 * f_gw(F); m0 < 512 + M; m0 += 4 * f_ngw()) {
        f32x4 v[4][4];
#pragma unroll
        for (int r = 0; r < 4; ++r) { const int m = m0 + r; const float* src = m < 512 ? A->in[1] + (size_t)m * D : A->in[0] + (size_t)(m - 512) * D;
            const GAS f32x4* xr = (const GAS f32x4*)src + lane_;
#pragma unroll
            for (int j = 0; j < 4; ++j) v[r][j] = xr[64 * j]; }
#pragma unroll
        for (int r = 0; r < 4; ++r) { const int m = m0 + r; bf16* dst = m < 512 ? (bf16*)(ws + WS_MEMB) + (size_t)m * D : (bf16*)(ws + WS_XB) + (size_t)(m - 512) * D;
            GAS v2u* o8 = (GAS v2u*)dst + lane_;
#pragma unroll
            for (int j = 0; j < 4; ++j) o8[64 * j] = (v2u){pk2(v[r][j].x, v[r][j].y), pk2(v[r][j].z, v[r][j].w)}; }
    }
}
constexpr int CONV_ITEMS = 65 * 192, CONV_UNITS = CONV_ITEMS / 8;
__device__ __forceinline__ void convert_item(ArgsP A, int layer, int it, LAS float* scr, int lane_) {
    bf16* wexp = (bf16*)(A->ws + WS_WEXP);
    const int e = it / 192, mat = (it % 192) >> 6, r = it & 63;
    bf16* dst = wexp + (size_t)e * (pg8::EXPERT_BYTES / 2);
    if (mat < 2) { const float* W = (e < 64) ? A->in[13 + mat] + ((size_t)layer * 64 + e) * (D * HID) : A->in[16 + mat] + (size_t)layer * (D * HID);
        const int kb = r >> 2, nb = r & 3, n0 = 64 * nb;
        transpose_item64(W, HID, dst, D, 64 * kb, n0, (n0 >> 7) * 256 + mat * 128 + (n0 & 127), scr, lane_); }
    else { const float* W = (e < 64) ? A->in[15] + ((size_t)layer * 64 + e) * (HID * D) : A->in[18] + (size_t)layer * (HID * D);
        const int kb = r >> 4, nb = r & 15;
        transpose_item64(W, D, dst + pg8::EXPERT_DOWN_OFF / 2, HID, 64 * kb, 64 * nb, 64 * nb, scr, lane_); }
}
__device__ __forceinline__ void convert_unit(Frame& F, ArgsP A, int layer, int cu) {
    const int tid_ = fresh_tid(), lane_ = tid_ & 63; (void)tid_;
    LAS float* scr = (LAS float*)(F.lds + (F.wave < 7 ? RING_OFF + F.wave * 16640 : IDX_OFF));
    const int it = 8 * cu + F.wave;
    if (it < CONV_ITEMS) convert_item(A, layer, it, scr, lane_);
    asm volatile("s_waitcnt vmcnt(0) lgkmcnt(0)\n\ts_barrier" ::: "memory");
}
template <bool LAST> __device__ __forceinline__ void ph_combine_ln2(Frame& F, float* xout, const unsigned char* yt, const float* g, const float* b, bf16* xb) {
    typedef float f32x2c __attribute__((ext_vector_type(2)));
    const int tid_ = fresh_tid(), lane_ = tid_ & 63; (void)tid_;
    for (int m = f_gw(F); m < M; m += f_ngw()) {
        GAS v4u* o8 = (GAS v4u*)(xb + (size_t)m * D) + 2 * lane_; const GAS v4u* yr = (const GAS v4u*)(yt + (size_t)m * 9 * D) + lane_;
        float v[16];
#pragma unroll
        for (int i = 0; i < 16; ++i) v[i] = 0.f;
#pragma unroll
        for (int k = 0; k < 9; ++k) { const v4u w = yr[k * 64];
#pragma unroll
            for (int q = 0; q < 4; ++q) { const f32x2c lo = __builtin_amdgcn_cvt_pk_f32_fp8((int)w[q], false), hi = __builtin_amdgcn_cvt_pk_f32_fp8((int)w[q], true);
                v[4 * q] += lo.x; v[4 * q + 1] += lo.y; v[4 * q + 2] += hi.x; v[4 * q + 3] += hi.y; } }
        float s = 0.f;
#pragma unroll
        for (int h = 0; h < 2; ++h) { const v4u xw = o8[h];
#pragma unroll
            for (int q = 0; q < 4; ++q) { v[8 * h + 2 * q] = v[8 * h + 2 * q] * (1.f / pg8::Y8_SCALE) + DN_ALPHA * bflo(xw[q]); v[8 * h + 2 * q + 1] = v[8 * h + 2 * q + 1] * (1.f / pg8::Y8_SCALE) + DN_ALPHA * bfhi(xw[q]); } }
#pragma unroll
        for (int i = 0; i < 16; ++i) s += v[i];
        const float mean = wave_sum(s) * (1.f / D); float s2 = 0.f;
#pragma unroll
        for (int i = 0; i < 16; ++i) { v[i] -= mean; s2 += v[i] * v[i]; }
        const float rstd = 1.f / sqrtf(wave_sum(s2) * (1.f / D) + LN_EPS);
        const GAS f32x4* gp = (const GAS f32x4*)g + 4 * lane_; const GAS f32x4* bp = (const GAS f32x4*)b + 4 * lane_;
        GAS f32x4* xo = (GAS f32x4*)(xout + (size_t)m * D) + 4 * lane_;
        float o[16];
#pragma unroll
        for (int q = 0; q < 4; ++q) { const f32x4 gv = gp[q], bv = bp[q];
            o[4 * q] = v[4 * q] * rstd * gv.x + bv.x; o[4 * q + 1] = v[4 * q + 1] * rstd * gv.y + bv.y; o[4 * q + 2] = v[4 * q + 2] * rstd * gv.z + bv.z; o[4 * q + 3] = v[4 * q + 3] * rstd * gv.w + bv.w;
            if (LAST) xo[q] = (f32x4){o[4 * q], o[4 * q + 1], o[4 * q + 2], o[4 * q + 3]}; }
        if (!LAST) { o8[0] = (v4u){pk2(o[0], o[1]), pk2(o[2], o[3]), pk2(o[4], o[5]), pk2(o[6], o[7])}; o8[1] = (v4u){pk2(o[8], o[9]), pk2(o[10], o[11]), pk2(o[12], o[13]), pk2(o[14], o[15])}; }
    }
}
__device__ __forceinline__ void ph_diff_combine(Frame& F, const bf16* otmp, const float* lq, const float* subg, float lam_init, bf16* cat) {
    const int tid_ = fresh_tid(), lane_ = tid_ & 63; (void)tid_; (void)lane_;
    float lam;
    { const float a = lq[lane_] * lq[64 + lane_], c = lq[128 + lane_] * lq[192 + lane_]; lam = expf(wave_sum(a)) - expf(wave_sum(c)) + lam_init; }
    const int l32 = lane_ & 31, hh = lane_ >> 5;
    const f32x4 gv = ((const GAS f32x4*)subg)[l32]; const float post = 1.f - lam_init;
    for (int m = f_gw(F); m < M; m += f_ngw()) {
#pragma unroll
        for (int hp = 0; hp < 3; ++hp) { const int h = 2 * hp + hh;
            const v2u a0 = *((const GAS v2u*)(otmp + (size_t)m * 1536 + h * 256) + l32), a1 = *((const GAS v2u*)(otmp + (size_t)m * 1536 + h * 256 + 128) + l32);
            f32x4 o; o.x = bflo(a0.x) - lam * bflo(a1.x); o.y = bfhi(a0.x) - lam * bfhi(a1.x); o.z = bflo(a0.y) - lam * bflo(a1.y); o.w = bfhi(a0.y) - lam * bfhi(a1.y);
            float s2 = (o.x * o.x + o.y * o.y) + (o.z * o.z + o.w * o.w);
#pragma unroll
            for (int sft = 1; sft < 32; sft <<= 1) s2 += __shfl_xor(s2, sft);
            const float r = post / sqrtf(s2 * (1.f / 128.f) + LN_EPS);
            o = o * r * gv;
            *((GAS v2u*)(cat + (size_t)m * D + h * 128) + l32) = (v2u){pk2(o.x, o.y), pk2(o.z, o.w)}; }
    }
}
__device__ __forceinline__ float ss8(v4u a) { float s = 0.f;
#pragma unroll
    for (int i = 0; i < 4; ++i) { const float lo = bflo(a[i]), hi = bfhi(a[i]); s += lo * lo + hi * hi; } return s; }
__device__ __forceinline__ void ph_qknorm(Frame& F, const bf16* qkv, gu32* gmax) {
    const int tid_ = fresh_tid(), lane_ = tid_ & 63;
    LAS unsigned* lmax = (LAS unsigned*)(F.lds + LDSCTL_OFF) + 32;
    if (tid_ < 24) lmax[tid_] = 0u;
    __syncthreads();
    float mq0 = 0.f, mq1 = 0.f, mk0 = 0.f, mk1 = 0.f;
    const v4u zero = (v4u){0u, 0u, 0u, 0u};
    for (int m = f_gw(F); m < M; m += f_ngw()) {
        const bf16* row = qkv + (size_t)m * NPB;
        const v4u a = *(const GAS v4u*)(row + 8 * lane_), c = *(const GAS v4u*)(row + 1024 + 8 * lane_);
        v4u b = zero, d = zero; if (lane_ < 32) { b = *(const GAS v4u*)(row + 512 + 8 * lane_); d = *(const GAS v4u*)(row + 1536 + 8 * lane_); }
        float sa = ss8(a), sb = ss8(b), sc = ss8(c), sd = ss8(d);
#pragma unroll
        for (int o = 1; o < 8; o <<= 1) { sa += __shfl_xor(sa, o); sb += __shfl_xor(sb, o); sc += __shfl_xor(sc, o); sd += __shfl_xor(sd, o); }
        mq0 = fmaxf(mq0, sa); mq1 = fmaxf(mq1, sb); mk0 = fmaxf(mk0, sc); mk1 = fmaxf(mk1, sd);
    }
    if ((lane_ & 7) == 0) { const int g = lane_ >> 3;
        __hip_atomic_fetch_max(lmax + g, __float_as_uint(mq0), __ATOMIC_RELAXED, __HIP_MEMORY_SCOPE_WORKGROUP); __hip_atomic_fetch_max(lmax + 12 + g, __float_as_uint(mk0), __ATOMIC_RELAXED, __HIP_MEMORY_SCOPE_WORKGROUP);
        if (lane_ < 32) { __hip_atomic_fetch_max(lmax + 8 + g, __float_as_uint(mq1), __ATOMIC_RELAXED, __HIP_MEMORY_SCOPE_WORKGROUP); __hip_atomic_fetch_max(lmax + 20 + g, __float_as_uint(mk1), __ATOMIC_RELAXED, __HIP_MEMORY_SCOPE_WORKGROUP); } }
    __syncthreads();
    if (tid_ < 24) __hip_atomic_fetch_max(gmax + tid_, lmax[tid_], RLX_AGENT);
}
typedef short bf16x8r __attribute__((ext_vector_type(8)));
constexpr int RT_SC_OFF = TAB_OFF, RT_GB_OFF = TAB_OFF + 16384;
static_assert(RT_GB_OFF + 8192 <= LDS_BYTES, "LDS map (route phase)");
template <bool XF32> __device__ __forceinline__ void ph_ln_route(Frame& F, const float* xin, const bf16* y, const float* g, const float* b, bf16* xb, const bf16* wrt, const float* rbias, gu32* cnt, int* rowtok, float* rowgate, float* gtmp) {
    const int tid_ = fresh_tid(), lane_ = tid_ & 63;
    for (int i = tid_; i < 64 * 128; i += NWAVES * 64) { const int e = i >> 7, c = i & 127;
        const v4u v = *(const GAS v4u*)(wrt + (size_t)e * D + c * 8); *(LAS v4u*)(F.lds + e * 2048 + ((c ^ (e & 15)) << 4)) = v; }
    LAS float* lgb = (LAS float*)(F.lds + RT_GB_OFF);
    if (tid_ < 256) { ((LAS f32x4*)lgb)[tid_] = ((const GAS f32x4*)g)[tid_]; ((LAS f32x4*)lgb)[256 + tid_] = ((const GAS f32x4*)b)[tid_]; }
    __syncthreads();
    LAS float* sc = (LAS float*)(F.lds + RT_SC_OFF) + F.wave * 512;
    const int r = lane_ & 15, kq = lane_ >> 4; const float bias = rbias[lane_]; const float NINF = -INFINITY;
    for (int base = f_gw(F) * 16; base < M; base += f_ngw() * 16) {
#pragma unroll 1
        for (int r4 = 0; r4 < 16; r4 += 4) {
            f32x4 v[4][4]; float s1[4];
#pragma unroll
            for (int q = 0; q < 4; ++q) { const size_t mo = (size_t)(base + r4 + q) * D; const GAS v2u* yr = (const GAS v2u*)(y + mo) + lane_; s1[q] = 0.f;
#pragma unroll
                for (int j = 0; j < 4; ++j) { f32x4 xv;
                    if (XF32) xv = ((const GAS f32x4*)(xin + mo) + lane_)[64 * j]; else { const v2u xw = ((const GAS v2u*)(xb + mo) + lane_)[64 * j]; xv = (f32x4){bflo(xw.x), bfhi(xw.x), bflo(xw.y), bfhi(xw.y)}; }
                    const v2u yv = yr[64 * j];
                    v[q][j].x = DN_ALPHA * xv.x + bflo(yv.x); v[q][j].y = DN_ALPHA * xv.y + bfhi(yv.x); v[q][j].z = DN_ALPHA * xv.z + bflo(yv.y); v[q][j].w = DN_ALPHA * xv.w + bfhi(yv.y);
                    s1[q] += (v[q][j].x + v[q][j].y) + (v[q][j].z + v[q][j].w); } }
#pragma unroll
            for (int o = 1; o < 64; o <<= 1) {
#pragma unroll
                for (int q = 0; q < 4; ++q) s1[q] += __shfl_xor(s1[q], o); }
            float s2[4];
#pragma unroll
            for (int q = 0; q < 4; ++q) { const float mean = s1[q] * (1.f / D); s2[q] = 0.f;
#pragma unroll
                for (int j = 0; j < 4; ++j) { v[q][j] = v[q][j] - mean; s2[q] += (v[q][j].x * v[q][j].x + v[q][j].y * v[q][j].y) + (v[q][j].z * v[q][j].z + v[q][j].w * v[q][j].w); } }
#pragma unroll
            for (int o = 1; o < 64; o <<= 1) {
#pragma unroll
                for (int q = 0; q < 4; ++q) s2[q] += __shfl_xor(s2[q], o); }
#pragma unroll
            for (int q = 0; q < 4; ++q) { const float rstd = 1.f / sqrtf(s2[q] * (1.f / D) + LN_EPS); GAS v2u* o8 = (GAS v2u*)(xb + (size_t)(base + r4 + q) * D) + lane_;
#pragma unroll
                for (int j = 0; j < 4; ++j) { const LAS f32x4* gp = (const LAS f32x4*)lgb + lane_ + 64 * j; const f32x4 gv = gp[0], bv = gp[256];
                    const f32x4 o = v[q][j] * rstd * gv + bv; o8[64 * j] = (v2u){pk2(o.x, o.y), pk2(o.z, o.w)}; } }
        }
        asm volatile("s_waitcnt vmcnt(0)" ::: "memory");
        f32x4 acc[4];
#pragma unroll
        for (int nt = 0; nt < 4; ++nt) acc[nt] = (f32x4){0.f, 0.f, 0.f, 0.f};
        const bf16* arow = xb + (size_t)(base + r) * D + 8 * kq;
#pragma unroll 8
        for (int s = 0; s < 32; ++s) { const v4u aw = __builtin_nontemporal_load((const GAS v4u*)(arow + 32 * s)); const bf16x8r af = __builtin_bit_cast(bf16x8r, aw);
#pragma unroll
            for (int nt = 0; nt < 4; ++nt) { const int e = 16 * nt + r, c = 4 * s + kq;
                const bf16x8r bfr = *(const LAS bf16x8r*)(F.lds + e * 2048 + ((c ^ (e & 15)) << 4));
                acc[nt] = __builtin_amdgcn_mfma_f32_16x16x32_bf16(bfr, af, acc[nt], 0, 0, 0); } }
        unsigned selmask = 0u; unsigned long long slots = 0ull; unsigned mycount = 0u;
#pragma unroll 1
        for (int half = 0; half < 2; ++half) {
            if ((r >> 3) == half) {
#pragma unroll
                for (int nt = 0; nt < 4; ++nt) *(LAS f32x4*)(sc + (r & 7) * 64 + 16 * nt + 4 * kq) = acc[nt]; }
            LDS_WAIT(); asm volatile("" ::: "memory");
#pragma unroll 1
            for (int j8 = 0; j8 < 8; ++j8) { const int j = half * 8 + j8;
                const float logit = sc[j8 * 64 + lane_];
                const float aff = 1.f / (1.f + expf(-logit)); const float sel = aff + bias;
                float m1 = sel; m1 = fmaxf(m1, __shfl_xor(m1, 1)); m1 = fmaxf(m1, __shfl_xor(m1, 2)); m1 = fmaxf(m1, __shfl_xor(m1, 4));
                const unsigned long long bm = __ballot(sel == m1); const unsigned gb = (unsigned)(bm >> (lane_ & 56)) & 0xffu; const int first = __builtin_ctz(gb | 0x100u);
                float m2 = ((lane_ & 7) == first) ? NINF : sel; m2 = fmaxf(m2, __shfl_xor(m2, 1)); m2 = fmaxf(m2, __shfl_xor(m2, 2)); m2 = fmaxf(m2, __shfl_xor(m2, 4));
                const float gs = m1 + m2; int grank = 0;
#pragma unroll
                for (int g2 = 0; g2 < 8; ++g2) { const float o = __builtin_bit_cast(float, __builtin_amdgcn_readlane(__builtin_bit_cast(int, gs), 8 * g2)); grank += (o > gs || (o == gs && g2 < (lane_ >> 3))) ? 1 : 0; }
                const bool gok = grank < 4; const float v = gok ? sel : NINF; int er = 0;
#pragma unroll 8
                for (int e2 = 0; e2 < 64; ++e2) { const float o = __builtin_bit_cast(float, __builtin_amdgcn_readlane(__builtin_bit_cast(int, v), e2)); er += (o > v) ? 1 : 0; }
                bool chosen = gok && er < 8;
                if (__builtin_popcountll(__ballot(chosen)) != 8) {
                    er = 0;
#pragma unroll 8
                    for (int e2 = 0; e2 < 64; ++e2) { const float o = __builtin_bit_cast(float, __builtin_amdgcn_readlane(__builtin_bit_cast(int, v), e2)); er += (o > v || (o == v && e2 < lane_)) ? 1 : 0; }
                    chosen = gok && er < 8; }
                const float ssum = wave_sum(chosen ? aff : 0.f);
                const unsigned long long bal = __ballot(chosen); const unsigned slot = __builtin_amdgcn_mbcnt_hi((unsigned)(bal >> 32), __builtin_amdgcn_mbcnt_lo((unsigned)bal, 0u));
                if (chosen) { selmask |= 1u << j; slots |= (unsigned long long)slot << (4 * j); ++mycount; gtmp[(size_t)(base + j) * 64 + lane_] = aff / ssum * 2.5f; }
            }
            LDS_WAIT(); asm volatile("" ::: "memory");
        }
        unsigned pos = 0u;
        { LAS unsigned* wgc = (LAS unsigned*)(F.lds + LDSCTL_OFF) + 64;
            if (tid_ < 64) wgc[tid_] = 0u;
            __syncthreads();
            if (mycount) pos = __hip_atomic_fetch_add(wgc + lane_, mycount, __ATOMIC_RELAXED, __HIP_MEMORY_SCOPE_WORKGROUP);
            __syncthreads();
            if (tid_ < 64) { const unsigned tot = wgc[tid_]; unsigned gb = 0u; if (tot) gb = __hip_atomic_fetch_add(cnt + 64 * tid_, tot, RLX_AGENT); wgc[tid_] = gb; }
            __syncthreads();
            pos += wgc[lane_];
            __syncthreads(); }
#pragma unroll 1
        for (int j = 0; j < 16; ++j) if ((selmask >> j) & 1u) { const size_t at = (size_t)lane_ * CAP + pos; ++pos;
            rowtok[at] = (base + j) | ((int)((slots >> (4 * j)) & 15ull) << 16); rowgate[at] = gtmp[(size_t)(base + j) * 64 + lane_]; }
    }
}
template <bool M1> __device__ __forceinline__ int build_units(Frame& F, gu32* cnt, const int* rowtok, const float* rowgate) {
    const int tid_ = fresh_tid();
    LAS int* tcnt = (LAS int*)(F.lds + TAB_OFF); LAS int* bst = tcnt + 80; LAS int* utab = tcnt + 160; LAS int* idx = (LAS int*)(F.lds + IDX_OFF); LAS float* lgate = (LAS float*)(F.lds + GATE_OFF);
    if (tid_ < 64) {
        const int c = (int)__hip_atomic_load(cnt + 64 * tid_, RLX_AGENT); const int nb = (c + 255) >> 8; int incl = nb;
#pragma unroll
        for (int o = 1; o < 64; o <<= 1) { const int u = __shfl_up(incl, o); if (tid_ >= o) incl += u; }
        tcnt[tid_] = c; bst[tid_] = incl - nb;
        if (tid_ == 63) { tcnt[64] = M; bst[64] = incl; bst[65] = incl + M / 256; }
    }
    __syncthreads();
    const int nblk = bst[65]; const int bx = blockIdx.x;
    const int per = M1 ? 128 : 64, blk0 = M1 ? (16 * (bx & 7) + (bx >> 4)) : (8 * (bx & 7) + (bx >> 5)), pn = M1 ? ((bx >> 3) & 1) : ((bx >> 3) & 3);
    int nmine = (nblk > blk0) ? (nblk - blk0 + per - 1) / per : 0; if (nmine > (M1 ? 10 : 20)) nmine = M1 ? 10 : 20;
    if (tid_ < nmine) { const int blk = tid_ * per + blk0;
        int e = 0;
#pragma unroll
        for (int st = 64; st > 0; st >>= 1) { const int q = e + st; if (q <= 64 && bst[q] <= blk) e = q; }
        const int j = blk - bst[e]; int nv = tcnt[e] - 256 * j; if (nv > 256) nv = 256;
        LAS int* t = utab + tid_ * 8; t[0] = e; t[1] = blk; t[2] = pn; t[3] = nv; t[4] = e * CAP + 256 * j; t[5] = 256 * j; }
    __syncthreads();
    for (int q = tid_; q < nmine * 256; q += NWAVES * 64) { const int g = q >> 8, i = q & 255;
        const LAS int* t = utab + g * 8; const int e = t[0], nv = t[3];
        if (M1) { int tok = 0; float gt = 0.f;
            if (e == 64) { tok = t[5] + i; gt = 1.f; } else if (i < nv) { tok = rowtok[t[4] + i] & 0xffff; gt = rowgate[t[4] + i]; }
            idx[q] = tok; lgate[q] = gt; }
        else { int dst = M * 9;
            if (e == 64) dst = (t[5] + i) * 9 + 8; else if (i < nv) { const int v = rowtok[t[4] + i]; dst = (v & 0xffff) * 9 + (v >> 16); }
            idx[q] = dst; } }
    __syncthreads();
    return nmine;
}
#define WSP(T, off) ((T*)(A->ws + (off)))
#ifndef REP_P1
#define REP_P1 1
#endif
#ifndef REP_P2
#define REP_P2 1
#endif
#ifndef REP_P3
#define REP_P3 1
#endif
#ifndef REP_P5
#define REP_P5 1
#endif
#ifndef REP_P7
#define REP_P7 1
#endif
#ifndef REP_P8
#define REP_P8 1
#endif
#define REPEAT(n) _Pragma("unroll 1") for (int rep_ = 0; rep_ < (n); ++rep_)
#define OPQ(x) asm volatile("" : "+s"(x))
#define FCTL() f_ctl()
#define FRESH_GB() const int G = f_G(), bx = f_bx(); (void)G; (void)bx
__global__ void __launch_bounds__(NWAVES * 64, 2) mega_fwd(Args args_unused) {
    extern __shared__ __attribute__((aligned(16))) unsigned char lds[];
    Frame F;
    F.lds = (LAS unsigned char*)lds;
    F.wave = __builtin_amdgcn_readfirstlane((int)threadIdx.x >> 6);
    for (int u = fresh_tid(); u < 512 / 4; u += NWAVES * 64) ((LAS unsigned*)(F.lds + LDSCTL_OFF))[u] = 0u;
    __syncthreads();
    (void)xcd_barrier_post((unsigned*)(f_ctl() + CW_BAR), f_misc(F) + 8);
#define GRID_BAR() do { XcdBarrier bar_; bar_.bar = (unsigned*)(f_ctl() + CW_BAR); bar_.x = xb_xcc_id(); bar_.st = f_misc(F) + 8; xcd_barrier(bar_); } while (0)

    { ArgsP A = fresh_args(); FRESH_GB(); p0_small_weights(F, A); }
    GRID_BAR();
    {   ArgsP A = fresh_args(); FRESH_GB();
        pg8::DenseSched S; S.init(512, 2048, D, G, bx, WSP(const bf16, WS_WMKV));
        pg8::EpiBf16 E{WSP(bf16, WS_MEMKV), 2048, 0, 1.f};
        pg8::gemm_phase<pg8::EpiBf16, pg8::DenseSched>(F.lds + RING_OFF, WSP(const bf16, WS_MEMB), D, S, E); }

    for (int layer = 0; layer < DEPTH; ++layer) {
        const int jm = layer >> 1; const bool isB = (layer & 1) != 0;
        REPEAT(REP_P1) {
        if (!isB) { ArgsP A = fresh_args(); FRESH_GB();
            pg8::DenseSched S; S.init(M, NPA, D, G, bx, WSP(const bf16, WS_WINA) + (size_t)jm * NPA * D);
            pg8::EpiBf16 E{WSP(bf16, WS_QKV), NPA, 4, attn_body::C2};
            pg8::gemm_phase<pg8::EpiBf16, pg8::DenseSched>(F.lds + RING_OFF, WSP(const bf16, WS_XB), D, S, E); }
        else { ArgsP A = fresh_args(); FRESH_GB();
            pg8::DenseSched S; S.init(M, NPB, D, G, bx, WSP(const bf16, WS_WINB) + (size_t)jm * NPB * D);
            pg8::EpiBf16 E{WSP(bf16, WS_QKV), NPB, 4, attn_body::C2};
            pg8::gemm_phase<pg8::EpiBf16, pg8::DenseSched>(F.lds + RING_OFF, WSP(const bf16, WS_XB), D, S, E); }
        GRID_BAR();
        }
        if (isB) {
            ArgsP A = fresh_args();
            ph_qknorm(F, WSP(const bf16, WS_QKV), FCTL() + CW_NORM + 64 * layer);
            GRID_BAR();
        }
        REPEAT(REP_P2) {
        if (!isB) {
            { FRESH_GB();
            for (int L = bx; L < 1536; L += G) {
                ArgsP A = fresh_args(); const bf16* qkv = WSP(const bf16, WS_QKV); const int wave = F.wave;
                const int b = L / 768, rem = L % 768, qblk = rem / 3, kvh = rem % 3;
                const int q0u = qblk * 64, head = kvh * 4 + (wave >> 1); const size_t rowq = (size_t)b * SEQ + q0u + 32 * (wave & 1);
                attn_body::AttnArgs a;
                a.Qw = (const attn_body::bf16*)(qkv + rowq * NPA + head * 64);
                a.K0 = (const attn_body::bf16*)(qkv + ((size_t)b * SEQ + q0u) * NPA + 1024 + kvh * 64); a.V0 = a.K0 + 192;
                a.NT = 4; a.tmax = qblk; a.Ow = (attn_body::bf16*)(WSP(bf16, WS_CAT) + rowq * D + head * 64);
                a.qrel = 32 * (wave & 1) + (fresh_tid() & 31); a.slope2 = SLOPES_A[head] * attn_body::LOG2E; a.sink2 = A->in[3][jm * 12 + head] * attn_body::LOG2E;
                attn_body::attn_unit<2, 8, NPA, NPA, D>(a, (char*)lds + RING_OFF);
                convert_unit(F, A, layer, L);
            }
            for (int cu = 1536 + bx; cu < CONV_UNITS; cu += G) { ArgsP A = fresh_args(); convert_unit(F, A, layer, cu); } }
            { FRESH_GB();
            for (int L = bx; L < 512; L += G) {
                ArgsP A = fresh_args(); const int wave = F.wave;
                const int b = L / 256, rem = L % 256, qb = rem >> 2, hm = rem & 3;
                const size_t rowq = (size_t)b * SEQ + qb * 256 + 32 * wave;
                attn_body::AttnArgs a;
                a.Qw = (const attn_body::bf16*)(WSP(const bf16, WS_QKV) + rowq * NPA + 768 + hm * 64);
                a.K0 = (const attn_body::bf16*)(WSP(const bf16, WS_MEMKV) + (size_t)b * MEMLEN * 2048 + layer * 512 + hm * 64); a.V0 = a.K0 + 256;
                a.NT = 4; a.tmax = 1 << 30; a.Ow = (attn_body::bf16*)(WSP(bf16, WS_CAT) + rowq * D + 768 + hm * 64);
                a.qrel = 32 * wave + (fresh_tid() & 31); a.slope2 = 0.f; a.sink2 = 0.f;
                attn_body::attn_unit<0, 8, NPA, 2048, D>(a, (char*)lds + RING_OFF);
            } }
        } else {
            {
                unsigned nextL = 0u;
                if (fresh_tid() == 0) nextL = __hip_atomic_fetch_add(FCTL() + CW_Q + 64 * layer + 16 * rep_, 1u, RLX_AGENT);
                for (;;) {
                    if (fresh_tid() == 0) f_misc(F)[16] = nextL;
                    __syncthreads();
                    const int Lq = __builtin_amdgcn_readfirstlane((int)f_misc(F)[16]);
                    __syncthreads();
                    if (Lq >= 1536 + CONV_UNITS) break;
                    if (fresh_tid() == 0) nextL = __hip_atomic_fetch_add(FCTL() + CW_Q + 64 * layer + 16 * rep_, 1u, RLX_AGENT);
                    ArgsP A = fresh_args(); const bf16* qkv = WSP(const bf16, WS_QKV); const int wave = F.wave;
                    const bool isconv = (Lq < 2 * 1536) ? (Lq & 1) : true; const int L = (Lq < 2 * 1536) ? (Lq >> 1) : (Lq - 1536);
                    if (isconv) { convert_unit(F, A, layer, L); continue; }
                    const int qb = 63 - L / 24, rem = L % 24, b = rem / 12, hc = rem % 12, h = hc >> 1, c = hc & 1;
                    const size_t rowq = (size_t)b * SEQ + qb * 256 + 32 * wave;
                    const float slope2 = SLOPES_B[h] * attn_body::LOG2E;
                    const float q2m = __uint_as_float(__hip_atomic_load(FCTL() + CW_NORM + 64 * layer + hc, RLX_AGENT)), k2m = __uint_as_float(__hip_atomic_load(FCTL() + CW_NORM + 64 * layer + 12 + hc, RLX_AGENT));
                    const float B2 = sqrtf(q2m * k2m) * 1.03f + 0.5f, dcut = (160.f + 2.f * B2) / slope2;
                    int t0 = (int)floorf(((float)(qb * 256 - 63) - dcut) * (1.f / 64.f)); t0 = __builtin_amdgcn_readfirstlane(t0 > 0 ? (t0 & ~1) : 0);
                    attn_body::AttnArgs a;
                    a.Qw = (const attn_body::bf16*)(qkv + rowq * NPB + hc * 64);
                    a.K0 = (const attn_body::bf16*)(qkv + ((size_t)b * SEQ + 64 * t0) * NPB + 1024 + hc * 64); a.V0 = (const attn_body::bf16*)(qkv + ((size_t)b * SEQ + 64 * t0) * NPB + 1792 + h * 128);
                    a.NT = 4 * (qb + 1) - t0; a.tmax = 1 << 30; a.Ow = (attn_body::bf16*)(WSP(bf16, WS_OTMP) + rowq * 1536 + hc * 128);
                    a.qrel = 32 * wave + (fresh_tid() & 31); a.slope2 = slope2; a.sink2 = 0.f;
                    attn_body::diff_unit<16, NPB, NPB, 1536>(a, (char*)lds + RING_OFF);
                }
            }
            { FRESH_GB();
            for (int L = bx; L < 512; L += G) {
                ArgsP A = fresh_args(); const int wave = F.wave;
                const int b = L / 256, rem = L % 256, qb = rem >> 2, hm = rem & 3;
                const size_t rowq = (size_t)b * SEQ + qb * 256 + 32 * wave;
                attn_body::AttnArgs a;
                a.Qw = (const attn_body::bf16*)(WSP(const bf16, WS_QKV) + rowq * NPB + 768 + hm * 64);
                a.K0 = (const attn_body::bf16*)(WSP(const bf16, WS_MEMKV) + (size_t)b * MEMLEN * 2048 + layer * 512 + hm * 64); a.V0 = a.K0 + 256;
                a.NT = 4; a.tmax = 1 << 30; a.Ow = (attn_body::bf16*)(WSP(bf16, WS_CAT) + rowq * D + 768 + hm * 64);
                a.qrel = 32 * wave + (fresh_tid() & 31); a.slope2 = 0.f; a.sink2 = 0.f;
                attn_body::attn_unit<0, 8, NPB, 2048, D>(a, (char*)lds + RING_OFF);
            } }
        }
        GRID_BAR();
        }
        if (isB) {
            ArgsP A = fresh_args(); FRESH_GB();
            ph_diff_combine(F, WSP(const bf16, WS_OTMP), A->in[5] + jm * 256, A->in[6] + jm * 128, 0.8f - 0.6f * expf(-0.3f * (float)layer), WSP(bf16, WS_CAT));
            GRID_BAR();
        }
        REPEAT(REP_P3) {
        {   ArgsP A = fresh_args(); FRESH_GB();
            pg8::DenseSched S; S.init(M, D, D, G, bx, WSP(const bf16, WS_WOUT) + (size_t)layer * D * D);
            pg8::EpiBf16 E{WSP(bf16, WS_Y), D, 0, 1.f};
            pg8::gemm_phase<pg8::EpiBf16, pg8::DenseSched>(F.lds + RING_OFF, WSP(const bf16, WS_CAT), D, S, E); }
        GRID_BAR();
        }
        {   ArgsP A = fresh_args();
            if (layer == 0) ph_ln_route<true>(F, A->in[0], WSP(const bf16, WS_Y), A->in[9] + (size_t)(layer * 2) * D, A->in[10] + (size_t)(layer * 2) * D, WSP(bf16, WS_XB), WSP(const bf16, WS_WROUT) + (size_t)layer * 256 * D, A->in[12] + layer * 64, FCTL() + CW_CNT + layer * 64 * 64, WSP(int, WS_ROWTOK), WSP(float, WS_ROWGATE), WSP(float, WS_LOGIT));
            else ph_ln_route<false>(F, nullptr, WSP(const bf16, WS_Y), A->in[9] + (size_t)(layer * 2) * D, A->in[10] + (size_t)(layer * 2) * D, WSP(bf16, WS_XB), WSP(const bf16, WS_WROUT) + (size_t)layer * 256 * D, A->in[12] + layer * 64, FCTL() + CW_CNT + layer * 64 * 64, WSP(int, WS_ROWTOK), WSP(float, WS_ROWGATE), WSP(float, WS_LOGIT)); }
        GRID_BAR();
        REPEAT(REP_P7) {
        {   ArgsP A = fresh_args(); FRESH_GB();
            const int nmine = build_units<true>(F, FCTL() + CW_CNT + layer * 64 * 64, WSP(const int, WS_ROWTOK), WSP(const float, WS_ROWGATE));
            pg8::GroupSched<true> S{(const LAS int*)(F.lds + TAB_OFF) + 160, (const LAS int*)(F.lds + IDX_OFF), nmine, D, (const char*)(A->ws + WS_WEXP)};
            pg8::EpiM1 E{WSP(bf16, WS_HB), (const LAS float*)(F.lds + GATE_OFF)};
            pg8::gemm_phase<pg8::EpiM1, pg8::GroupSched<true>>(F.lds + RING_OFF, WSP(const bf16, WS_XB), D, S, E); }
        GRID_BAR();
        }
        REPEAT(REP_P8) {
        {   ArgsP A = fresh_args(); FRESH_GB();
            const int nmine = build_units<false>(F, FCTL() + CW_CNT + layer * 64 * 64, WSP(const int, WS_ROWTOK), WSP(const float, WS_ROWGATE));
            pg8::GroupSched<false> S{(const LAS int*)(F.lds + TAB_OFF) + 160, (const LAS int*)(F.lds + IDX_OFF), nmine, HID, (const char*)(A->ws + WS_WEXP) + pg8::EXPERT_DOWN_OFF};
            pg8::EpiM2 E{WSP(unsigned char, WS_BIG), (const LAS int*)(F.lds + IDX_OFF)};
            pg8::gemm_phase<pg8::EpiM2, pg8::GroupSched<false>>(F.lds + RING_OFF, WSP(const bf16, WS_HB), HID, S, E); }
        GRID_BAR();
        }
        {   ArgsP A = fresh_args(); FRESH_GB();
            if (layer + 1 < DEPTH) ph_combine_ln2<false>(F, A->out, WSP(const unsigned char, WS_BIG), A->in[9] + (size_t)(layer * 2 + 1) * D, A->in[10] + (size_t)(layer * 2 + 1) * D, WSP(bf16, WS_XB));
            else ph_combine_ln2<true>(F, A->out, WSP(const unsigned char, WS_BIG), A->in[9] + (size_t)(layer * 2 + 1) * D, A->in[10] + (size_t)(layer * 2 + 1) * D, WSP(bf16, WS_XB));
            }
        if (layer + 1 < DEPTH) GRID_BAR();
    }
    if (__hip_atomic_load(FCTL() + CW_BAR + XB_TMO, RLX_AGENT) != 0u) {
        __syncthreads();
        ArgsP A = fresh_args(); FRESH_GB(); float* xf = A->out;
        const float q = __builtin_nanf("");
        for (int m = f_gw(F); m < M; m += f_ngw()) { GAS f32x4* o = (GAS f32x4*)(xf + (size_t)m * D) + (fresh_tid() & 63);
#pragma unroll
            for (int j = 0; j < 4; ++j) o[64 * j] = (f32x4){q, q, q, q}; }
    }
}

extern "C" void kernel_launch(void* const* d_in, const int* in_sizes, int n_in, void* d_out, int out_size, void* d_ws, size_t ws_size, hipStream_t stream) {
    static int grid = 0;
    if (grid == 0) {
        if (n_in != 19 || in_sizes[0] != M * D || out_size != M * D || ws_size < WS_END) { fprintf(stderr, "kernel_launch: shape / workspace mismatch (n_in %d, in0 %d, out %d, ws %zu, need %zu); nothing launched\n", n_in, n_in > 0 ? in_sizes[0] : -1, out_size, ws_size, (size_t)WS_END); grid = -1; return; }
        int dev = 0, cus = 0, per_cu = 0;
        if (hipGetDevice(&dev) != hipSuccess || hipDeviceGetAttribute(&cus, hipDeviceAttributeMultiprocessorCount, dev) != hipSuccess) { grid = -1; return; }
        if (hipFuncSetAttribute((const void*)mega_fwd, hipFuncAttributeMaxDynamicSharedMemorySize, LDS_BYTES) != hipSuccess) { fprintf(stderr, "kernel_launch: hipFuncSetAttribute failed\n"); grid = -1; return; }
        if (hipOccupancyMaxActiveBlocksPerMultiprocessor(&per_cu, (const void*)mega_fwd, NWAVES * 64, LDS_BYTES) != hipSuccess || per_cu < 1) { fprintf(stderr, "kernel_launch: occupancy query reports %d\n", per_cu); }
        (void)hipGetLastError();
        grid = cus;
        if (grid != 256) { fprintf(stderr, "kernel_launch: built for 256 CUs, device has %d; nothing launched\n", cus); grid = -1; return; }
    }
    if (grid < 0) return;
    if (hipMemsetAsync((char*)d_ws + WS_CTL, 0, CTL_ZERO_BYTES, stream) != hipSuccess) return;
    Args a{};
    for (int i = 0; i < 19; ++i) a.in[i] = (const float*)d_in[i];
    a.out = (float*)d_out; a.ws = (unsigned char*)d_ws;
    hipLaunchKernelGGL(mega_fwd, dim3(grid), dim3(NWAVES * 64), LDS_BYTES, stream, a);
}
```

```cpp
#include <hip/hip_runtime.h>
#include <hip/hip_bf16.h>
#include <cstdio>
#include <cstdint>
#include <cmath>

namespace pg8 {
#define PG8_LAS __attribute__((address_space(3)))
typedef unsigned short bf16_t;
typedef short bf16x8 __attribute__((ext_vector_type(8)));
typedef float f32x4 __attribute__((ext_vector_type(4)));
typedef unsigned u32x4 __attribute__((ext_vector_type(4)));
constexpr int BM = 256, BK = 64, HALF = 128, HTB = HALF * BK * 2  , STAGE_BYTES = 8 * HTB, NXCD = 8, WGM = 8;
constexpr int EXPERT_BYTES = 3 * 1024 * 256 * 2;
constexpr int EXPERT_DOWN_OFF = 2 * 1024 * 256 * 2;

__host__ __device__ __forceinline__ int lds_byte(int r, int c) { const int st = (r >> 4) * 2 + (c >> 5), rr = r & 15, cc = c & 31, ob = rr * 64 + cc * 2; return st * 1024 + (ob ^ (((ob >> 9) & 1) << 5)); }
__host__ __device__ __forceinline__ void stage_rc(int b, int& R, int& C) { const int st = b / 1024, sb = b % 1024, swz = sb ^ (((sb >> 9) & 1) << 5); R = (st >> 1) * 16 + swz / 64; C = (st & 1) * 32 + (swz % 64) / 2; }
__host__ __device__ __forceinline__ int perm32(int rho) { const int n = rho >> 4, i = rho & 15; return 8 * (i >> 2) + 4 * n + (i & 3); }

struct Unit { int pm, pn, e, nvalid, lbase, pos0, slot; };

struct StaticOrder {
    int nM, nN, nwg, G, c;
    __device__ __forceinline__ void init(int M, int N, int G_, int c_) { nM = M / BM; nN = N / BM; nwg = nM * nN; G = G_; c = c_; }
    __device__ __forceinline__ bool next(int i, Unit& u) const {
        const long L = (long)i * G + c; if (L >= nwg) return false;
        int wgid = (int)L; { const int q = nwg / NXCD, r = nwg % NXCD, xcd = wgid % NXCD, off = wgid / NXCD; wgid = (xcd < r ? xcd * (q + 1) : r * (q + 1) + (xcd - r) * q) + off; }
        const int nig = WGM * nN, gid = wgid / nig, fm = gid * WGM, gsz = (nM - fm) < WGM ? (nM - fm) : WGM;
        u.pm = fm + ((wgid % nig) % gsz); u.pn = (wgid % nig) / gsz; return true;
    }
};
struct DenseSched {
    StaticOrder o; const char* Bt; int K;
    __device__ __forceinline__ void init(int M, int N, int K_, int G, int c, const bf16_t* Bt_) { o.init(M, N, G, c); Bt = (const char*)Bt_; K = K_; }
    __device__ __forceinline__ bool next(int i, Unit& u) const { u.e = 0; u.nvalid = 256; u.lbase = 0; u.pos0 = 0; u.slot = 0; return o.next(i, u); }
    __device__ __forceinline__ const char* bptr(const Unit& u) const { return Bt + (size_t)u.pn * (BM * 2) * K; }
    __device__ __forceinline__ void avoff(const Unit& u, int tid, unsigned (&v)[2][2]) const {
#pragma unroll
        for (int i = 0; i < 2; ++i) { int R, C; stage_rc(tid * 16 + i * 8192, R, C);
#pragma unroll
            for (int h = 0; h < 2; ++h) v[h][i] = (unsigned)((u.pm * BM + h * HALF + R) * K + C) * 2u; }
    }
};
template <bool GATHER> struct GroupSched {
    const PG8_LAS int* utab; const PG8_LAS int* idx; int nmine, K; const char* W;
    __device__ __forceinline__ bool next(int i, Unit& u) const {
        if (i >= nmine) return false; const PG8_LAS int* t = utab + i * 8;
        u.e = __builtin_amdgcn_readfirstlane(t[0]); u.pm = __builtin_amdgcn_readfirstlane(t[1]); u.pn = __builtin_amdgcn_readfirstlane(t[2]);
        u.nvalid = __builtin_amdgcn_readfirstlane(t[3]); u.lbase = __builtin_amdgcn_readfirstlane(t[4]); u.pos0 = __builtin_amdgcn_readfirstlane(t[5]); u.slot = i; return true;
    }
    __device__ __forceinline__ const char* bptr(const Unit& u) const { return W + (size_t)u.e * EXPERT_BYTES + (size_t)u.pn * (BM * 2) * K; }
    __device__ __forceinline__ void avoff(const Unit& u, int tid, unsigned (&v)[2][2]) const {
#pragma unroll
        for (int i = 0; i < 2; ++i) { int R, C; stage_rc(tid * 16 + i * 8192, R, C);
#pragma unroll
            for (int h = 0; h < 2; ++h) {
                const int row = GATHER ? idx[u.slot * 256 + h * HALF + R] : (u.pm * BM + h * HALF + R);
                v[h][i] = (unsigned)(row * K + C) * 2u; } }
    }
};

typedef float f32x2v __attribute__((ext_vector_type(2))); typedef __bf16 bf16x2v __attribute__((ext_vector_type(2)));
__device__ __forceinline__ unsigned cvt_pk_bf16(float lo, float hi) { f32x2v v = {lo, hi}; bf16x2v b = __builtin_convertvector(v, bf16x2v); return __builtin_bit_cast(unsigned, b); }

struct EpiBf16 {
    static constexpr bool PERM = true; static constexpr int NST = 16;
    bf16_t* O; int ldc; int nsc; float scale;
    __device__ __forceinline__ void operator()(const f32x4 (&acc)[2][2][4][2], const Unit& u, int wr, int wc, int fr, int fq) const {
        const int row0 = u.pm * BM + wr * 64 + fr; const int col0 = u.pn * BM + wc * 32 + 8 * fq; const float sc = (u.pn < nsc) ? scale : 1.f;
#pragma unroll
        for (int ai = 0; ai < 2; ++ai)
#pragma unroll
            for (int m = 0; m < 4; ++m) { bf16_t* rowp = O + (size_t)(row0 + ai * HALF + m * 16) * ldc + col0;
#pragma unroll
                for (int bj = 0; bj < 2; ++bj) { const f32x4 v0 = acc[ai][bj][m][0] * sc, v1 = acc[ai][bj][m][1] * sc;
                    u32x4 w; w.x = cvt_pk_bf16(v0[0], v0[1]); w.y = cvt_pk_bf16(v0[2], v0[3]); w.z = cvt_pk_bf16(v1[0], v1[1]); w.w = cvt_pk_bf16(v1[2], v1[3]);
                    *(u32x4*)(rowp + bj * HALF) = w; } }
    }
};
__device__ __forceinline__ float silu_f(float x) { return x * __builtin_amdgcn_rcpf(1.0f + __builtin_amdgcn_exp2f(-1.4426950408889634f * x)); }
struct EpiM1 {
    static constexpr bool PERM = true; static constexpr int NST = 8;
    bf16_t* H; const PG8_LAS float* lgate;
    __device__ __forceinline__ void operator()(const f32x4 (&acc)[2][2][4][2], const Unit& u, int wr, int wc, int fr, int fq) const {
        const int col0 = u.pn * HALF + wc * 32 + 8 * fq; const PG8_LAS float* lg = lgate + u.slot * 256;
#pragma unroll
        for (int ai = 0; ai < 2; ++ai)
#pragma unroll
            for (int m = 0; m < 4; ++m) { const int r = ai * HALF + wr * 64 + m * 16 + fr;
                const float g = lg[r];
                const f32x4 ga = acc[ai][0][m][0], gb = acc[ai][0][m][1], ua = acc[ai][1][m][0], ub = acc[ai][1][m][1];
                f32x4 v0, v1;
#pragma unroll
                for (int j = 0; j < 4; ++j) { v0[j] = silu_f(ga[j]) * ua[j] * g; v1[j] = silu_f(gb[j]) * ub[j] * g; }
                u32x4 w; w.x = cvt_pk_bf16(v0[0], v0[1]); w.y = cvt_pk_bf16(v0[2], v0[3]); w.z = cvt_pk_bf16(v1[0], v1[1]); w.w = cvt_pk_bf16(v1[2], v1[3]);
                *(u32x4*)(H + (size_t)(u.pm * BM + r) * 256 + col0) = w; }
    }
};
constexpr float Y8_SCALE = 16.f;
typedef unsigned u32x2e __attribute__((ext_vector_type(2)));
struct EpiM2 {
    static constexpr bool PERM = true; static constexpr int NST = 16;
    unsigned char* Y; const PG8_LAS int* ldst;
    __device__ __forceinline__ void operator()(const f32x4 (&acc)[2][2][4][2], const Unit& u, int wr, int wc, int fr, int fq) const {
        const int col0 = u.pn * BM + wc * 32 + 8 * fq; const PG8_LAS int* ld = ldst + u.slot * 256;
#pragma unroll
        for (int ai = 0; ai < 2; ++ai)
#pragma unroll
            for (int m = 0; m < 4; ++m) { const int r = ai * HALF + wr * 64 + m * 16 + fr;
                const int dst = ld[r];
                {
                    unsigned char* rowp = Y + (size_t)dst * 1024 + col0;
#pragma unroll
                    for (int bj = 0; bj < 2; ++bj) { const f32x4 v0 = acc[ai][bj][m][0] * Y8_SCALE, v1 = acc[ai][bj][m][1] * Y8_SCALE;
                        int w0 = __builtin_amdgcn_cvt_pk_fp8_f32(v0[0], v0[1], 0, false); w0 = __builtin_amdgcn_cvt_pk_fp8_f32(v0[2], v0[3], w0, true);
                        int w1 = __builtin_amdgcn_cvt_pk_fp8_f32(v1[0], v1[1], 0, false); w1 = __builtin_amdgcn_cvt_pk_fp8_f32(v1[2], v1[3], w1, true);
                        *(u32x2e*)(rowp + bj * HALF) = (u32x2e){(unsigned)w0, (unsigned)w1}; } } }
    }
};

template <class Epi, class Sched>
__device__ __forceinline__ void gemm_phase(PG8_LAS unsigned char* lds, const bf16_t* Abase, const int K, const Sched& S, const Epi& E, int wave_) {
    asm volatile("" : "+s"(wave_)); unsigned am_; asm volatile("s_mov_b32 %0, -1" : "=s"(am_));
    const int tid = (wave_ << 6) | (int)__builtin_amdgcn_mbcnt_hi(am_, __builtin_amdgcn_mbcnt_lo(am_, 0u));
    const int wid = __builtin_amdgcn_readfirstlane(tid >> 6), lane = tid & 63, wr = wid >> 2, wc = wid & 3, fr = lane & 15, fq = lane >> 4;
    const int nt = K / BK;
    unsigned voffB[2];
#pragma unroll
    for (int i = 0; i < 2; ++i) { int R, C; stage_rc(tid * 16 + i * 8192, R, C); const int Rb = Epi::PERM ? ((R & ~31) + perm32(R & 31)) : R; voffB[i] = (unsigned)(Rb * K + C) * 2u; }
    const size_t kstep = (size_t)(BK * 2);
    const size_t hstep = (size_t)HALF * K * 2;
    const unsigned ldsw = (unsigned)wid * 1024u;
    const int aoff = lds_byte(wr * 64 + fr, fq * 8), boff = lds_byte(wc * 32 + fr, fq * 8);
    const char* Ab = (const char*)Abase;
#define PG8_SA(b, h) (((b) * 2 + (h)) * HTB)
#define PG8_SB(b, h) ((4 + (b) * 2 + (h)) * HTB)
#define PG8_STAGE(bufoff, gbase, voff) do { _Pragma("unroll") for (int _i = 0; _i < 2; ++_i) \
        __builtin_amdgcn_global_load_lds((const unsigned*)((const char*)(gbase) + (voff)[_i]), (PG8_LAS unsigned*)(lds + (bufoff) + ldsw + _i * 8192), 16, 0, 0); } while (0)
#define PG8_STAGEA(bufoff, kb, V, h) do { _Pragma("unroll") for (int _i = 0; _i < 2; ++_i) \
        __builtin_amdgcn_global_load_lds((const unsigned*)(Ab + (kb) + (V)[h][_i]), (PG8_LAS unsigned*)(lds + (bufoff) + ldsw + _i * 8192), 16, 0, 0); } while (0)
#define PG8_LDA(dst, b, h) do { _Pragma("unroll") for (int m = 0; m < 4; ++m) _Pragma("unroll") for (int k = 0; k < 2; ++k) dst[m][k] = *(const PG8_LAS bf16x8*)(lds + PG8_SA(b, h) + aoff + m * 2048 + k * 1024); } while (0)
#define PG8_LDB(dst, b, h) do { _Pragma("unroll") for (int n = 0; n < 2; ++n) _Pragma("unroll") for (int k = 0; k < 2; ++k) dst[n][k] = *(const PG8_LAS bf16x8*)(lds + PG8_SB(b, h) + boff + n * 2048 + k * 1024); } while (0)
#define PG8_MMA(ai, bj, At, Bt) do { __builtin_amdgcn_s_setprio(1); _Pragma("unroll") for (int m = 0; m < 4; ++m) _Pragma("unroll") for (int n = 0; n < 2; ++n) _Pragma("unroll") for (int k = 0; k < 2; ++k) \
        acc[ai][bj][m][n] = __builtin_amdgcn_mfma_f32_16x16x32_bf16(Bt[n][k], At[m][k], acc[ai][bj][m][n], 0, 0, 0); __builtin_amdgcn_s_setprio(0); } while (0)
#define PG8_WAIT_V(n) asm volatile("s_waitcnt vmcnt(" #n ")" ::: "memory")
#define PG8_WAIT_VR(rl) do { if (rl) asm volatile("s_waitcnt vmcnt(%0)" :: "n"(8 + Epi::NST) : "memory"); else asm volatile("s_waitcnt vmcnt(8)" ::: "memory"); } while (0)
#define PG8_WAIT_L(n) asm volatile("s_waitcnt lgkmcnt(" #n ")" ::: "memory")
#define PG8_BAR __builtin_amdgcn_s_barrier()
#define PG8_SCHED __builtin_amdgcn_sched_barrier(0)
    Unit cur, nxt; int ui = 0;
    if (!S.next(0, cur)) return;
    nxt = cur;
    f32x4 acc[2][2][4][2];
#pragma unroll
    for (int a = 0; a < 2; ++a)
#pragma unroll
        for (int b = 0; b < 2; ++b)
#pragma unroll
            for (int m = 0; m < 4; ++m)
#pragma unroll
                for (int n = 0; n < 2; ++n) acc[a][b][m][n] = (f32x4){0.f, 0.f, 0.f, 0.f};
    bf16x8 At[4][2], B0[2][2], B1[2][2];
    unsigned vA[2][2];
    S.avoff(cur, tid, vA);
    const char* cB = S.bptr(cur);
    PG8_STAGE(PG8_SB(0, 0), cB, voffB); PG8_STAGE(PG8_SB(0, 1), cB + hstep, voffB); PG8_STAGEA(PG8_SA(0, 0), 0, vA, 0); PG8_STAGEA(PG8_SA(0, 1), 0, vA, 1);
    if (wr == 1) PG8_BAR;
    PG8_WAIT_V(2); PG8_BAR;
    PG8_STAGE(PG8_SB(1, 0), cB + kstep, voffB); PG8_STAGEA(PG8_SA(1, 0), kstep, vA, 0); PG8_STAGE(PG8_SB(1, 1), cB + hstep + kstep, voffB);
    PG8_WAIT_V(6); PG8_BAR;
    bool relax = false;
    for (;;) {
        const bool has_next = S.next(ui + 1, nxt);
        const char* nB = cB;
        if (has_next) nB = S.bptr(nxt);
#pragma unroll 1
        for (int t = 0; t < nt; t += 2) {
            const bool last = (t == nt - 2); const bool rl = relax && (t == 0);
            const size_t kb1 = (size_t)(t + 1) * kstep;
            const size_t kb2 = last ? (size_t)0 : (size_t)(t + 2) * kstep; const char* b2 = last ? nB : cB + (size_t)(t + 2) * kstep;
            const size_t kb3 = kb2 + kstep; const char* b3 = b2 + kstep;
            PG8_LDB(B0, 0, 0); PG8_LDB(B1, 0, 1); PG8_SCHED; PG8_LDA(At, 0, 0); if (!rl) PG8_STAGEA(PG8_SA(1, 1), kb1, vA, 1);
            if (last && has_next) S.avoff(nxt, tid, vA);
            PG8_WAIT_VR(rl); PG8_WAIT_L(0); PG8_BAR; PG8_MMA(0, 0, At, B0); PG8_MMA(0, 1, At, B1); PG8_BAR; PG8_SCHED;
            PG8_LDA(At, 0, 1); PG8_STAGE(PG8_SB(0, 0), b2, voffB); PG8_STAGE(PG8_SB(0, 1), b2 + hstep, voffB); PG8_STAGEA(PG8_SA(0, 0), kb2, vA, 0);
            PG8_WAIT_VR(rl); PG8_WAIT_L(0); PG8_BAR; PG8_MMA(1, 0, At, B0); PG8_MMA(1, 1, At, B1); PG8_BAR; PG8_SCHED;
            PG8_LDB(B0, 1, 0); PG8_LDB(B1, 1, 1); PG8_SCHED; PG8_LDA(At, 1, 0); PG8_STAGEA(PG8_SA(0, 1), kb2, vA, 1);
            PG8_WAIT_VR(rl); PG8_WAIT_L(0); PG8_BAR; PG8_MMA(0, 0, At, B0); PG8_MMA(0, 1, At, B1); PG8_BAR; PG8_SCHED;
            PG8_LDA(At, 1, 1); PG8_STAGE(PG8_SB(1, 0), b3, voffB); PG8_STAGE(PG8_SB(1, 1), b3 + hstep, voffB); PG8_STAGEA(PG8_SA(1, 0), kb3, vA, 0);
            PG8_WAIT_V(8); PG8_WAIT_L(0); PG8_BAR; PG8_MMA(1, 0, At, B0); PG8_MMA(1, 1, At, B1); PG8_BAR; PG8_SCHED;
        }
        if (wr == 0) PG8_BAR;
        if (has_next) PG8_STAGEA(PG8_SA(1, 1), kstep, vA, 1);
        E(acc, cur, wr, wc, fr, fq);
        if (!has_next) break;
#pragma unroll
        for (int a = 0; a < 2; ++a)
#pragma unroll
            for (int b = 0; b < 2; ++b)
#pragma unroll
                for (int m = 0; m < 4; ++m)
#pragma unroll
                    for (int n = 0; n < 2; ++n) acc[a][b][m][n] = (f32x4){0.f, 0.f, 0.f, 0.f};
        cur = nxt; cB = nB; ++ui; relax = true;
        if (wr == 1) PG8_BAR;
    }
    PG8_WAIT_V(0);
    PG8_BAR;
#undef PG8_SA
#undef PG8_SB
#undef PG8_STAGE
#undef PG8_STAGEA
#undef PG8_LDA
#undef PG8_LDB
#undef PG8_MMA
#undef PG8_WAIT_V
#undef PG8_WAIT_VR
#undef PG8_WAIT_L
#undef PG8_BAR
#undef PG8_SCHED
}
}
namespace attn_body {
using bf16=__hip_bfloat16;
using bf16x8=__attribute__((ext_vector_type(8)))short;
using s16x4=__attribute__((ext_vector_type(4)))short;
using f32x16=__attribute__((ext_vector_type(16)))float;
using u32x4=__attribute__((ext_vector_type(4)))unsigned;
constexpr int D=64,NW=8,QBLK=32,QB=QBLK*NW,KVBLK=64;
__device__ __forceinline__ int crow(int r,int hi){return (r&3)+8*(r>>2)+4*hi;}
#define SBAR() __builtin_amdgcn_sched_barrier(0)
constexpr int NSLOT=3, SLOTB=8192;
constexpr int LDS_K=0, LDS_V=NSLOT*SLOTB, LDS_WS=2*NSLOT*SLOTB, LDS_OST=LDS_WS+NW*64*4, LDS_BYTES=LDS_OST+NW*4096;
constexpr float LOG2E=1.4426950408889634f;
constexpr float C2=0.125f*LOG2E;
__device__ __forceinline__ void glds16(const void*gsrc,unsigned lds_dst){unsigned keep;
  asm volatile("s_mov_b32 %0, m0\n\ts_mov_b32 m0, %2\n\ts_nop 0\n\tglobal_load_lds_dwordx4 %1, off\n\ts_mov_b32 m0, %0":"=&s"(keep):"v"(gsrc),"s"(lds_dst):"memory");}
__device__ __forceinline__ float max3f(float a,float b,float c){float r;asm("v_max3_f32 %0, %1, %2, %3":"=v"(r):"v"(a),"v"(b),"v"(c));return r;}
__device__ __forceinline__ float max2f(float a,float b){float r;asm("v_max_f32_e32 %0, %1, %2":"=v"(r):"v"(a),"v"(b));return r;}
__device__ __forceinline__ float fadd_s(float a,float b){float r;asm("v_add_f32_e32 %0, %1, %2":"=v"(r):"v"(a),"v"(b));return r;}
__device__ __forceinline__ float fsub_s(float a,float b){float r;asm("v_sub_f32_e32 %0, %1, %2":"=v"(r):"v"(a),"v"(b));return r;}
typedef float f32x2_t __attribute__((ext_vector_type(2))); typedef __bf16 bf16x2_t __attribute__((ext_vector_type(2)));
__device__ __forceinline__ unsigned cvtpk_s(float lo,float hi){f32x2_t v={lo,hi};bf16x2_t b=__builtin_convertvector(v,bf16x2_t);return __builtin_bit_cast(unsigned,b);}
#define WAIT_BAR(N) asm volatile("s_waitcnt vmcnt(" #N ") lgkmcnt(0)\n\ts_barrier":::"memory")

template<int MODE> __device__ __forceinline__ void maskbias(f32x16&p0,f32x16&p1,int kb,int qrel,float slope2,float mhat,bool band,bool tile_ok){
  if(MODE==0)return;
  const float NEG=-INFINITY; const float lb=slope2*(float)(kb-qrel)-mhat;
  #pragma unroll
  for(int r=0;r<16;++r){const int c=(r&3)+8*(r>>2); p0[r]=__builtin_fmaf(slope2,(float)c,p0[r]+lb); p1[r]=__builtin_fmaf(slope2,(float)(c+32),p1[r]+lb);}
  if(MODE==1){ if(band){
    #pragma unroll
    for(int r=0;r<16;++r){const int kv=kb+(r&3)+8*(r>>2); if(kv>qrel)p0[r]=NEG; if(kv+32>qrel)p1[r]=NEG;} } }
  if(MODE==2){
    #pragma unroll
    for(int r=0;r<16;++r){const int d=qrel-kb-((r&3)+8*(r>>2)); if((unsigned)d>=128u||!tile_ok)p0[r]=NEG; if((unsigned)(d-32)>=128u||!tile_ok)p1[r]=NEG;} }
}

__device__ __forceinline__ void qkt(f32x16&p0,f32x16&p1,const char*Kslot,const bf16x8*qr,const f32x16&negm,int r32,int hi){
  const char*kb=Kslot+hi*1024+r32*16;
  #pragma unroll
  for(int d0=0;d0<4;++d0){
    const bf16x8 b0=*reinterpret_cast<const bf16x8*>(kb+d0*2048);
    const bf16x8 b1=*reinterpret_cast<const bf16x8*>(kb+d0*2048+512);
    if(d0==0){p0=__builtin_amdgcn_mfma_f32_32x32x16_bf16(b0,qr[0],negm,0,0,0);p1=__builtin_amdgcn_mfma_f32_32x32x16_bf16(b1,qr[0],negm,0,0,0);}
    else{p0=__builtin_amdgcn_mfma_f32_32x32x16_bf16(b0,qr[d0],p0,0,0,0);p1=__builtin_amdgcn_mfma_f32_32x32x16_bf16(b1,qr[d0],p1,0,0,0);}}
}
template<int C> __device__ __forceinline__ float fmamk_c(float a,float b){float d;asm("v_fmamk_f32 %0, %1, %2, %3":"=v"(d):"v"(a),"n"(__builtin_bit_cast(int,(float)C)),"v"(b));return d;}
typedef __attribute__((address_space(3))) const char* lds_cptr;
typedef short v4i16_t __attribute__((ext_vector_type(4)));
__device__ __forceinline__ void kload8(bf16x8*kf,lds_cptr kp){
  kf[0]=*(const __attribute__((address_space(3))) bf16x8*)(kp);      kf[1]=*(const __attribute__((address_space(3))) bf16x8*)(kp+512);
  kf[2]=*(const __attribute__((address_space(3))) bf16x8*)(kp+2048); kf[3]=*(const __attribute__((address_space(3))) bf16x8*)(kp+2560);
  kf[4]=*(const __attribute__((address_space(3))) bf16x8*)(kp+4096); kf[5]=*(const __attribute__((address_space(3))) bf16x8*)(kp+4608);
  kf[6]=*(const __attribute__((address_space(3))) bf16x8*)(kp+6144); kf[7]=*(const __attribute__((address_space(3))) bf16x8*)(kp+6656);
}
__device__ __forceinline__ void kload2(bf16x8*kf,lds_cptr kp,int j){ kf[2*j]=*(const __attribute__((address_space(3))) bf16x8*)(kp+j*2048); kf[2*j+1]=*(const __attribute__((address_space(3))) bf16x8*)(kp+j*2048+512); }
__device__ __forceinline__ s16x4 vtr(lds_cptr p){ return __builtin_bit_cast(s16x4,__builtin_amdgcn_ds_read_tr16_b64_v4i16((__attribute__((address_space(3))) v4i16_t*)p)); }
__device__ __forceinline__ float rowmax(const f32x16&p0,const f32x16&p1){
  float a=max3f(p0[0],p0[1],p1[0]),b=max3f(p0[2],p0[3],p1[1]);a=max3f(a,p1[2],p1[3]);
  #pragma unroll
  for(int r=4;r<16;r+=4){a=max3f(a,p0[r],p0[r+1]);b=max3f(b,p0[r+2],p0[r+3]);a=max3f(a,p1[r],p1[r+1]);b=max3f(b,p1[r+2],p1[r+3]);}
  const float m=max2f(a,b);
  auto rr=__builtin_amdgcn_permlane32_swap(__float_as_uint(m),__float_as_uint(m),false,false);
  return max2f(__uint_as_float(rr[0]),__uint_as_float(rr[1]));
}
__device__ __forceinline__ void pv(f32x16*o,int vb,bf16x8 pa0,bf16x8 pa1,bf16x8 pa2,bf16x8 pa3){
  #pragma unroll
  for(int d0=0;d0<2;++d0){s16x4 lo[4],hi[4];
    #pragma unroll
    for(int ks=0;ks<4;++ks){
      asm volatile("ds_read_b64_tr_b16 %0,%1 offset:%c2":"=&v"(lo[ks]):"v"(vb),"i"(d0*4096+ks*1024):"memory");
      asm volatile("ds_read_b64_tr_b16 %0,%1 offset:%c2":"=&v"(hi[ks]):"v"(vb),"i"(d0*4096+ks*1024+512):"memory");}
    asm volatile("s_waitcnt lgkmcnt(0)":::"memory");SBAR();
    #define PK(k) (bf16x8){lo[k][0],lo[k][1],lo[k][2],lo[k][3],hi[k][0],hi[k][1],hi[k][2],hi[k][3]}
    o[d0]=__builtin_amdgcn_mfma_f32_32x32x16_bf16(pa0,PK(0),o[d0],0,0,0);
    o[d0]=__builtin_amdgcn_mfma_f32_32x32x16_bf16(pa1,PK(1),o[d0],0,0,0);
    o[d0]=__builtin_amdgcn_mfma_f32_32x32x16_bf16(pa2,PK(2),o[d0],0,0,0);
    o[d0]=__builtin_amdgcn_mfma_f32_32x32x16_bf16(pa3,PK(3),o[d0],0,0,0);
    #undef PK
  }
}
struct AttnArgs {
  const bf16* Qw;
  const bf16* K0; const bf16* V0;
  int NT;
  int tmax;
  bf16* Ow;
  int qrel;
  float slope2, sink2;
  int wave;
};
#define ATTN_STORE16(p,v) (*(u32x4*)(p)=(v))
template<int MODE,int THRL,int QP,int KVP,int OP> __device__ __forceinline__ void attn_unit(const AttnArgs&a,char*shm){
  unsigned am_; asm volatile("s_mov_b32 %0, -1":"=s"(am_)); const int lane=(int)__builtin_amdgcn_mbcnt_hi(am_,__builtin_amdgcn_mbcnt_lo(am_,0u)),r32=lane&31,hi=lane>>5; const int wid=a.wave;
  const bf16*Qw=a.Qw; constexpr int qp=QP; constexpr long kvp=KVP;
  const unsigned lds0=(unsigned)(uintptr_t)shm;
  float*wsf=(float*)(shm+LDS_WS)+wid*64;
  const bf16*ksrc=a.K0+(long)lane*kvp+wid*8;
  const bf16*vsrc=a.V0+(long)(16*(wid&3)+(lane>>2))*kvp+(wid>>2)*32+(lane&3)*8;
  const unsigned kdst=lds0+LDS_K+wid*1024, vdst=lds0+LDS_V+wid*1024;
  const int tmax=a.tmax;
  #define TROW(t) ((MODE==2)?(-64*(((t)<tmax)?(t):tmax)):(64*(t)))
  #define DMA_K(t,slot) glds16(ksrc+(long)TROW(t)*kvp,(unsigned)__builtin_amdgcn_readfirstlane(kdst+(slot)))
  #define DMA_V(t,slot) glds16(vsrc+(long)TROW(t)*kvp,(unsigned)__builtin_amdgcn_readfirstlane(vdst+(slot)))
  const int vb0=(int)(lds0+LDS_V)+((lane>>4)&1)*32+(lane&3)*8+(4*hi+((lane&15)>>2))*64;
  const char*Kbase=shm+LDS_K; bf16x8 kf[8];
  const lds_cptr shm3=(lds_cptr)shm; const lds_cptr kp0=shm3+LDS_K+hi*1024+r32*16; const lds_cptr vp0=shm3+LDS_V+((lane>>4)&1)*32+(lane&3)*8+(4*hi+((lane&15)>>2))*64;
  const int NT=a.NT;
  DMA_K(0,0);DMA_V(0,0);DMA_K(1,SLOTB);
  bf16x8 qr[4];
  #pragma unroll
  for(int d0=0;d0<4;++d0)qr[d0]=*reinterpret_cast<const bf16x8*>(&Qw[(long)r32*qp+d0*16+hi*8]);
  float z0_; asm volatile("v_mov_b32 %0, 0":"=v"(z0_));
  f32x16 zv_; _Pragma("unroll") for(int r=0;r<16;++r)zv_[r]=z0_;
  float mhat=0.f,l_reg=0.f;f32x16 o[2];o[0]=zv_;o[1]=zv_;f32x16 negm=zv_;if(MODE==0)asm volatile("":"+v"(negm));
  const int qrel=a.qrel; const float slope2=a.slope2;
  #define KBREL(t) ((MODE==2)?(-64*(t)):(64*((t)-(NT-4))))
  #define MBIAS(P0,P1,t,BAND) maskbias<MODE>(P0,P1,KBREL(t)+4*hi,qrel,slope2,mhat,(BAND)&&((t)>=NT-4),(t)<=tmax)
  #define CINIT ((MODE==0)?negm:(f32x16{}))
  #define CMASK(P0,P1,t) MBIAS(P0,P1,t,true)
  bool resc=false;
  #define START(P0,P1) do{ const float rm=rowmax(P0,P1); resc=false; \
    { const float dl=rm; mhat=fadd_s(mhat,dl); \
      _Pragma("unroll") for(int r=0;r<16;++r){P0[r]=fsub_s(P0[r],dl);P1[r]=fsub_s(P1[r],dl);} \
      if(MODE==0){ _Pragma("unroll") for(int r=0;r<16;++r)negm[r]=-mhat; asm volatile("":"+v"(negm)); } } \
    _Pragma("unroll") for(int r=0;r<16;++r)P0[r]=__builtin_amdgcn_exp2f(P0[r]); }while(0)
  #define RESC() do{ if(resc){ asm volatile("s_waitcnt lgkmcnt(0)":::"memory"); \
      _Pragma("unroll") for(int d_=0;d_<2;++d_) _Pragma("unroll") for(int r=0;r<16;++r)o[d_][r]*=wsf[crow(r,hi)]; } }while(0)
  f32x16 pA0,pA1,pB0,pB1;
  int sl_prev=0,sl_cur=0,sl_next=SLOTB;
  #define ROT() do{sl_prev=sl_cur;sl_cur=sl_next;sl_next=(sl_next==(NSLOT-1)*SLOTB)?0:sl_next+SLOTB;}while(0)
  DMA_K(2,2*SLOTB);
  WAIT_BAR(3);
  qkt(pA0,pA1,Kbase,qr,negm,r32,hi);asm volatile("s_nop 15\n\ts_nop 7":"+v"(pA0),"+v"(pA1));CMASK(pA0,pA1,0);
  START(pA0,pA1);
  _Pragma("unroll") for(int r=0;r<16;++r)pA1[r]=__builtin_amdgcn_exp2f(pA1[r]);
  WAIT_BAR(0);
  DMA_K(3,0);DMA_V(1,SLOTB);
  ROT();
  kload8(kf,kp0+sl_cur);
  WAIT_BAR(2);
  s16x4 vlo[8],vhi[8]; u32x4 pw0,pw1,pw2,pw3;
  #define PKW(P,B) cvtpk_s(P[B],P[B+1])
  #define PAF(k) __builtin_bit_cast(bf16x8,pw##k)
  #define VFR(i) (bf16x8){vlo[i][0],vlo[i][1],vlo[i][2],vlo[i][3],vhi[i][0],vhi[i][1],vhi[i][2],vhi[i][3]}
  #define PIN(x) asm volatile("":"+v"(x))
  #define MX3(a,b,c) __builtin_fmaxf(__builtin_fmaxf((a),(b)),(c))
  #define GAPA(MF,A0,A1,A2,A3,W0,W1,PW) do{ MF; sacc+=A0; sacc+=A1; sacc+=A2; sacc+=A3; PIN(sacc); W0; W1; PIN(PW); SBAR(); }while(0)
  #define EX(v) __builtin_amdgcn_exp2f(v)
  #define GAPB(MF,X,B) do{ MF; X[B]=EX(X[B]); X[B+1]=EX(X[B+1]); X[B+2]=EX(X[B+2]); X[B+3]=EX(X[B+3]); PIN(X); SBAR(); }while(0)
  #define VRD(i) do{ vlo[i]=vtr(vp_+(((i)>>2)*4096+((i)&3)*1024)); vhi[i]=vtr(vp_+(((i)>>2)*4096+((i)&3)*1024+512)); }while(0)
  #define KRD(G,j) do{ if(G){ kload2(kf,kp0+sl_next,j); SBAR(); } }while(0)
  #define STEP(C0,C1,P0,P1,t,GK,GV,GL) do{ SBAR(); \
    const lds_cptr vp_=vp0+sl_prev; \
    VRD(0); SBAR(); float sacc=(P0[0]+P0[1]); \
    GAPA(C0=__builtin_amdgcn_mfma_f32_32x32x16_bf16(kf[0],qr[0],CINIT,0,0,0), P0[2],P0[3],P0[4],P0[5],     pw0[0]=PKW(P0,0), pw0[1]=PKW(P0,2), pw0); \
    VRD(4); SBAR(); GAPA(C1=__builtin_amdgcn_mfma_f32_32x32x16_bf16(kf[1],qr[0],CINIT,0,0,0), P0[6],P0[7],P0[8],P0[9],     pw0[2]=PKW(P0,4), pw0[3]=PKW(P0,6), pw0); \
    VRD(1); SBAR(); GAPA(C0=__builtin_amdgcn_mfma_f32_32x32x16_bf16(kf[2],qr[1],C0,0,0,0),   P0[10],P0[11],P0[12],P0[13], pw1[0]=PKW(P0,8), pw1[1]=PKW(P0,10), pw1); \
    VRD(5); SBAR(); GAPA(C1=__builtin_amdgcn_mfma_f32_32x32x16_bf16(kf[3],qr[1],C1,0,0,0),   P0[14],P0[15],P1[0],P1[1],   pw1[2]=PKW(P0,12),pw1[3]=PKW(P0,14), pw1); \
    VRD(2); SBAR(); GAPA(C0=__builtin_amdgcn_mfma_f32_32x32x16_bf16(kf[4],qr[2],C0,0,0,0),   P1[2],P1[3],P1[4],P1[5],     pw2[0]=PKW(P1,0), pw2[1]=PKW(P1,2), pw2); \
    VRD(6); SBAR(); GAPA(C1=__builtin_amdgcn_mfma_f32_32x32x16_bf16(kf[5],qr[2],C1,0,0,0),   P1[6],P1[7],P1[8],P1[9],     pw2[2]=PKW(P1,4), pw2[3]=PKW(P1,6), pw2); \
    VRD(3); SBAR(); GAPA(C0=__builtin_amdgcn_mfma_f32_32x32x16_bf16(kf[6],qr[3],C0,0,0,0),   P1[10],P1[11],P1[12],P1[13], pw3[0]=PKW(P1,8), pw3[1]=PKW(P1,10), pw3); \
    VRD(7); SBAR(); GAPA(C1=__builtin_amdgcn_mfma_f32_32x32x16_bf16(kf[7],qr[3],C1,0,0,0),   P1[14],P1[15],0.f,0.f,       pw3[2]=PKW(P1,12),pw3[3]=PKW(P1,14), pw3); \
    l_reg+=sacc; \
    if(GK){DMA_K((t)+3,sl_cur);} if(GV){DMA_V((t)+1,sl_next);} \
    CMASK(C0,C1,t); \
    { float a_=MX3(C0[0],C0[1],C1[0]),b_=MX3(C0[2],C0[3],C1[1]); a_=MX3(a_,C1[2],C1[3]); \
      _Pragma("unroll") for(int r=4;r<16;r+=4){a_=MX3(a_,C0[r],C0[r+1]);b_=MX3(b_,C0[r+2],C0[r+3]);a_=MX3(a_,C1[r],C1[r+1]);b_=MX3(b_,C1[r+2],C1[r+3]);} \
      float rm=__builtin_fmaxf(a_,b_); { auto rr=__builtin_amdgcn_permlane32_swap(__float_as_uint(rm),__float_as_uint(rm),false,false); rm=__builtin_fmaxf(__uint_as_float(rr[0]),__uint_as_float(rr[1])); } \
      resc=false; \
      if(__builtin_expect(__any(rm>(float)THRL),0)){ const float dl=__builtin_fmaxf(rm,0.f); mhat+=dl; \
        _Pragma("unroll") for(int r=0;r<16;++r){C0[r]-=dl;C1[r]-=dl;} \
        if(MODE==0){ _Pragma("unroll") for(int r=0;r<16;++r)negm[r]=-mhat; asm volatile("":"+v"(negm)); } \
        const float f=__builtin_amdgcn_exp2f(-dl); l_reg*=f; if(hi==0)wsf[r32]=f; resc=true; } } \
    SBAR(); \
    GAPB(o[0]=__builtin_amdgcn_mfma_f32_32x32x16_bf16(PAF(0),VFR(0),o[0],0,0,0), C0,0); \
    GAPB(o[1]=__builtin_amdgcn_mfma_f32_32x32x16_bf16(PAF(0),VFR(4),o[1],0,0,0), C0,4); \
    KRD(GL,0); GAPB(o[0]=__builtin_amdgcn_mfma_f32_32x32x16_bf16(PAF(1),VFR(1),o[0],0,0,0), C0,8); \
    KRD(GL,1); GAPB(o[1]=__builtin_amdgcn_mfma_f32_32x32x16_bf16(PAF(1),VFR(5),o[1],0,0,0), C0,12); \
    KRD(GL,2); GAPB(o[0]=__builtin_amdgcn_mfma_f32_32x32x16_bf16(PAF(2),VFR(2),o[0],0,0,0), C1,0); \
    KRD(GL,3); GAPB(o[1]=__builtin_amdgcn_mfma_f32_32x32x16_bf16(PAF(2),VFR(6),o[1],0,0,0), C1,4); \
    GAPB(o[0]=__builtin_amdgcn_mfma_f32_32x32x16_bf16(PAF(3),VFR(3),o[0],0,0,0), C1,8); \
    GAPB(o[1]=__builtin_amdgcn_mfma_f32_32x32x16_bf16(PAF(3),VFR(7),o[1],0,0,0), C1,12); \
    }while(0)
  int t=1;
  #undef CMASK
  #define CMASK(P0,P1,t) MBIAS(P0,P1,t,false)
  for(;t+5<NT;t+=2){
    STEP(pB0,pB1,pA0,pA1,t,true,true,true);     WAIT_BAR(2); RESC(); ROT();
    STEP(pA0,pA1,pB0,pB1,t+1,true,true,true);   WAIT_BAR(2); RESC(); ROT();
  }
  #undef CMASK
  #define CMASK(P0,P1,t) MBIAS(P0,P1,t,true)
  #define ENDW(tt) do{ if((tt)+3<NT){WAIT_BAR(2);} else if((tt)+2<NT){WAIT_BAR(1);} else {WAIT_BAR(0);} }while(0)
  for(;t+1<NT;t+=2){
    STEP(pB0,pB1,pA0,pA1,t,(t+3<NT),(t+1<NT),(t+1<NT));       ENDW(t);   RESC(); ROT();
    STEP(pA0,pA1,pB0,pB1,t+1,(t+4<NT),(t+2<NT),(t+2<NT));     ENDW(t+1); RESC(); ROT();
  }
  STEP(pB0,pB1,pA0,pA1,NT-1,false,false,false); RESC();
  { float sacc=pB0[0]+pB0[1]; _Pragma("unroll") for(int r=2;r<16;++r)sacc+=pB0[r]; _Pragma("unroll") for(int r=0;r<16;++r)sacc+=pB1[r]; l_reg+=sacc;
    pw0=(u32x4){PKW(pB0,0),PKW(pB0,2),PKW(pB0,4),PKW(pB0,6)};pw1=(u32x4){PKW(pB0,8),PKW(pB0,10),PKW(pB0,12),PKW(pB0,14)};pw2=(u32x4){PKW(pB1,0),PKW(pB1,2),PKW(pB1,4),PKW(pB1,6)};pw3=(u32x4){PKW(pB1,8),PKW(pB1,10),PKW(pB1,12),PKW(pB1,14)};
    SBAR(); pv(o,vb0+sl_cur,PAF(0),PAF(1),PAF(2),PAF(3)); }
  #undef PKW
  #undef PAF
  #undef VFR
  #undef PIN
  #undef MX3
  #undef GAPA
  #undef GAPB
  #undef EX
  #undef VRD
  #undef KRD
  #undef STEP
  #undef ENDW
  {auto rr=__builtin_amdgcn_permlane32_swap(__float_as_uint(l_reg),__float_as_uint(l_reg),false,false);l_reg=__uint_as_float(rr[0])+__uint_as_float(rr[1]);}
  if(MODE==2)l_reg+=__builtin_amdgcn_exp2f(a.sink2-mhat);
  if(hi==0)wsf[32+r32]=l_reg;asm volatile("s_waitcnt lgkmcnt(0)":::"memory");
  float rli[16];
  #pragma unroll
  for(int r=0;r<16;++r)rli[r]=__builtin_amdgcn_rcpf(wsf[32+crow(r,hi)]);
  bf16*Ow=a.Ow; constexpr long op=OP;
  { bf16*stg=(bf16*)(shm+LDS_OST)+wid*2048;
    #pragma unroll
    for(int r=0;r<16;++r){const int orow=crow(r,hi);
      #pragma unroll
      for(int d0=0;d0<2;++d0)stg[orow*64+d0*32+r32]=__float2bfloat16(o[d0][r]*rli[r]);}
    asm volatile("s_waitcnt lgkmcnt(0)":::"memory");
    #pragma unroll
    for(int i=0;i<4;++i){const int row=i*8+(lane>>3),ch=lane&7; const u32x4 v=*(const u32x4*)(stg+row*64+ch*8); ATTN_STORE16(Ow+(long)row*op+ch*8,v);} }
  asm volatile("s_waitcnt lgkmcnt(0)\n\ts_barrier":::"memory");
  #undef DMA_K
  #undef DMA_V
  #undef TROW
  #undef KBREL
  #undef MBIAS
  #undef CINIT
  #undef CMASK
  #undef START
  #undef RESC
  #undef ROT
}

constexpr int DP_K=0, DP_V=3*8192, DP_WS=DP_V+3*16384, DP_BYTES=DP_WS+NW*256;
template<int THRL,int QP,int KVP,int OP> __device__ __forceinline__ void diff_unit(const AttnArgs&a,char*shm){
  unsigned am_; asm volatile("s_mov_b32 %0, -1":"=s"(am_)); const int lane=(int)__builtin_amdgcn_mbcnt_hi(am_,__builtin_amdgcn_mbcnt_lo(am_,0u)),r32=lane&31,hi=lane>>5; const int wid=a.wave;
  const bf16*Qw=a.Qw; constexpr int qp=QP; constexpr long kvp=KVP;
  const unsigned lds0=(unsigned)(uintptr_t)shm;
  float*wsf=(float*)(shm+DP_WS)+wid*64;
  const bf16*ksrc=a.K0+(long)lane*kvp+wid*8;
  const bf16*vsrc=a.V0+(long)(16*(wid&3)+(lane>>2))*kvp+(wid>>2)*32+(lane&3)*8;
  const unsigned kdst=lds0+DP_K+wid*1024, vdst=lds0+DP_V+wid*1024;
  #define DMA_K(t,slot) glds16(ksrc+(long)(64*(t))*kvp,(unsigned)__builtin_amdgcn_readfirstlane(kdst+(slot)))
  #define DMA_V(t,slot) do{ glds16(vsrc+(long)(64*(t))*kvp,(unsigned)__builtin_amdgcn_readfirstlane(vdst+2*(slot))); glds16(vsrc+(long)(64*(t))*kvp+64,(unsigned)__builtin_amdgcn_readfirstlane(vdst+2*(slot)+8192)); }while(0)
  const int vb0=(int)(lds0+DP_V)+((lane>>4)&1)*32+(lane&3)*8+(4*hi+((lane&15)>>2))*64;
  const char*Kbase=shm+DP_K; bf16x8 kf[8];
  const lds_cptr shm3=(lds_cptr)shm; const lds_cptr kp0=shm3+DP_K+hi*1024+r32*16; const lds_cptr vp0=shm3+DP_V+((lane>>4)&1)*32+(lane&3)*8+(4*hi+((lane&15)>>2))*64;
  const int NT=a.NT;
  DMA_K(0,0);DMA_V(0,0);DMA_K(1,SLOTB);
  bf16x8 qr[4];
  #pragma unroll
  for(int d0=0;d0<4;++d0)qr[d0]=*reinterpret_cast<const bf16x8*>(&Qw[(long)r32*qp+d0*16+hi*8]);
  float z0_; asm volatile("v_mov_b32 %0, 0":"=v"(z0_));
  f32x16 zv_; _Pragma("unroll") for(int r=0;r<16;++r)zv_[r]=z0_;
  float mhat=0.f,l_reg=0.f;f32x16 o[4];o[0]=zv_;o[1]=zv_;o[2]=zv_;o[3]=zv_;
  const int qrel=a.qrel; const float slope2=a.slope2;
  float slope2v=slope2; asm volatile("":"+v"(slope2v));
  #define KBREL(t) (64*((t)-(NT-4)))
  #define MBIAS(P0,P1,t,BAND) maskbias<1>(P0,P1,KBREL(t)+4*hi,qrel,slope2,mhat,(BAND)&&((t)>=NT-4),true)
  #define CMASK(P0,P1,t) MBIAS(P0,P1,t,true)
  bool resc=false;
  #define START(P0,P1) do{ const float rm=rowmax(P0,P1); resc=false; \
    { const float dl=rm; mhat=fadd_s(mhat,dl); \
      _Pragma("unroll") for(int r=0;r<16;++r){P0[r]=fsub_s(P0[r],dl);P1[r]=fsub_s(P1[r],dl);} } \
    _Pragma("unroll") for(int r=0;r<16;++r)P0[r]=__builtin_amdgcn_exp2f(P0[r]); }while(0)
  #define RESC() do{ if(resc){ asm volatile("s_waitcnt lgkmcnt(0)":::"memory"); \
      _Pragma("unroll") for(int d_=0;d_<4;++d_) _Pragma("unroll") for(int r=0;r<16;++r)o[d_][r]*=wsf[crow(r,hi)]; } }while(0)
  f32x16 pA0,pA1;
  int sl_prev=0,sl_cur=0,sl_next=SLOTB;
  #define ROT() do{sl_prev=sl_cur;sl_cur=sl_next;sl_next=(sl_next==(NSLOT-1)*SLOTB)?0:sl_next+SLOTB;}while(0)
  DMA_K(2,2*SLOTB);
  WAIT_BAR(4);
  qkt(pA0,pA1,Kbase,qr,zv_,r32,hi);asm volatile("s_nop 15\n\ts_nop 7":"+v"(pA0),"+v"(pA1));CMASK(pA0,pA1,0);
  START(pA0,pA1);
  _Pragma("unroll") for(int r=0;r<16;++r)pA1[r]=__builtin_amdgcn_exp2f(pA1[r]);
  f32x16 pB0,pB1;
  { const float lbn=__builtin_fmaf(slope2,(float)(KBREL(1)+4*hi-qrel),-mhat);
    _Pragma("unroll") for(int r=0;r<16;++r){ const int c=(r&3)+8*(r>>2); pB0[r]=__builtin_fmaf(slope2,(float)c,lbn); pB1[r]=__builtin_fmaf(slope2,(float)(c+32),lbn); } }
  WAIT_BAR(0);
  DMA_K(3,0);DMA_V(1,SLOTB);
  ROT();
  kload8(kf,kp0+sl_cur);
  WAIT_BAR(0);
  s16x4 vlo[8],vhi[8]; u32x4 pw0,pw1,pw2,pw3;
  #define PKW(P,B) cvtpk_s(P[B],P[B+1])
  #define PAF(k) __builtin_bit_cast(bf16x8,pw##k)
  #define VFR(i) (bf16x8){vlo[i][0],vlo[i][1],vlo[i][2],vlo[i][3],vhi[i][0],vhi[i][1],vhi[i][2],vhi[i][3]}
  #define PIN(x) asm volatile("":"+v"(x))
  #define MX3(a,b,c) __builtin_fmaxf(__builtin_fmaxf((a),(b)),(c))
  #define GAPA(MF,A0,A1,A2,A3,W0,W1,PW) do{ MF; sacc+=A0; sacc+=A1; sacc+=A2; sacc+=A3; PIN(sacc); W0; W1; PIN(PW); SBAR(); }while(0)
  #define EX(v) __builtin_amdgcn_exp2f(v)
  #define FILLV(r,OFF) fmamk_c<(((r)&3)+8*((r)>>2))+(OFF)>(slope2v,lbn)
  #define GAPB(MF,X0,X1,E0,E1,E2) do{ MF; E0=EX(E0); E1=EX(E1); E2=EX(E2); PIN(X0); PIN(X1); SBAR(); }while(0)
  #define GAPD(MF,X,E,Y,B,OFF) do{ MF; E=EX(E); Y[B]=FILLV(B,OFF); Y[B+1]=FILLV(B+1,OFF); Y[B+2]=FILLV(B+2,OFF); Y[B+3]=FILLV(B+3,OFF); PIN(X); PIN(Y); SBAR(); }while(0)
  #define GAPC(MF) do{ MF; SBAR(); }while(0)
  #define VRD(i) do{ vlo[i]=vtr(vp_+(((i)>>2)*4096+((i)&3)*1024)); vhi[i]=vtr(vp_+(((i)>>2)*4096+((i)&3)*1024+512)); SBAR(); }while(0)
  #define VRD2(i) do{ vlo[i]=vtr(vp_+(8192+((i)>>2)*4096+((i)&3)*1024)); vhi[i]=vtr(vp_+(8192+((i)>>2)*4096+((i)&3)*1024+512)); SBAR(); }while(0)
  #define KRD(G,j) do{ if(G){ kload2(kf,kp0+sl_next,j); SBAR(); } }while(0)
  #define STEP(C0,C1,P0,P1,t,GK,GV,GL) do{ SBAR(); \
    const lds_cptr vp_=vp0+2*sl_prev; \
    float sacc=(P0[0]+P0[1]); \
    GAPA(C0=__builtin_amdgcn_mfma_f32_32x32x16_bf16(kf[0],qr[0],C0,0,0,0), P0[2],P0[3],P0[4],P0[5],     pw0[0]=PKW(P0,0), pw0[1]=PKW(P0,2), pw0); \
    GAPA(C1=__builtin_amdgcn_mfma_f32_32x32x16_bf16(kf[1],qr[0],C1,0,0,0), P0[6],P0[7],P0[8],P0[9],     pw0[2]=PKW(P0,4), pw0[3]=PKW(P0,6), pw0); \
    GAPA(C0=__builtin_amdgcn_mfma_f32_32x32x16_bf16(kf[2],qr[1],C0,0,0,0),   P0[10],P0[11],P0[12],P0[13], pw1[0]=PKW(P0,8), pw1[1]=PKW(P0,10), pw1); \
    GAPA(C1=__builtin_amdgcn_mfma_f32_32x32x16_bf16(kf[3],qr[1],C1,0,0,0),   P0[14],P0[15],P1[0],P1[1],   pw1[2]=PKW(P0,12),pw1[3]=PKW(P0,14), pw1); \
    GAPA(C0=__builtin_amdgcn_mfma_f32_32x32x16_bf16(kf[4],qr[2],C0,0,0,0),   P1[2],P1[3],P1[4],P1[5],     pw2[0]=PKW(P1,0), pw2[1]=PKW(P1,2), pw2); \
    GAPA(C1=__builtin_amdgcn_mfma_f32_32x32x16_bf16(kf[5],qr[2],C1,0,0,0),   P1[6],P1[7],P1[8],P1[9],     pw2[2]=PKW(P1,4), pw2[3]=PKW(P1,6), pw2); \
    GAPA(C0=__builtin_amdgcn_mfma_f32_32x32x16_bf16(kf[6],qr[3],C0,0,0,0),   P1[10],P1[11],P1[12],P1[13], pw3[0]=PKW(P1,8), pw3[1]=PKW(P1,10), pw3); \
    VRD(0); GAPA(C1=__builtin_amdgcn_mfma_f32_32x32x16_bf16(kf[7],qr[3],C1,0,0,0),   P1[14],P1[15],0.f,0.f,       pw3[2]=PKW(P1,12),pw3[3]=PKW(P1,14), pw3); \
    l_reg+=sacc; \
    if(GK){DMA_K((t)+3,sl_cur);} if(GV){DMA_V((t)+1,sl_next);} \
    VRD(4); VRD(1); VRD(5); \
    SMASK(C0,C1,t); \
    { float a_=MX3(C0[0],C0[1],C1[0]),b_=MX3(C0[2],C0[3],C1[1]); a_=MX3(a_,C1[2],C1[3]); \
      _Pragma("unroll") for(int r=4;r<16;r+=4){a_=MX3(a_,C0[r],C0[r+1]);b_=MX3(b_,C0[r+2],C0[r+3]);a_=MX3(a_,C1[r],C1[r+1]);b_=MX3(b_,C1[r+2],C1[r+3]);} \
      float rm=__builtin_fmaxf(a_,b_); { auto rr=__builtin_amdgcn_permlane32_swap(__float_as_uint(rm),__float_as_uint(rm),false,false); rm=__builtin_fmaxf(__uint_as_float(rr[0]),__uint_as_float(rr[1])); } \
      resc=false; \
      if(__builtin_expect(__any(rm>(float)THRL),0)){ const float dl=__builtin_fmaxf(rm,0.f); mhat+=dl; \
        _Pragma("unroll") for(int r=0;r<16;++r){C0[r]-=dl;C1[r]-=dl;} \
        const float f=__builtin_amdgcn_exp2f(-dl); l_reg*=f; if(hi==0)wsf[r32]=f; resc=true; } } \
    const float lbn=__builtin_fmaf(slope2,(float)(KBREL((t)+1)+4*hi-qrel),-mhat); \
    SBAR(); \
    VRD(2); GAPB(o[0]=__builtin_amdgcn_mfma_f32_32x32x16_bf16(PAF(0),VFR(0),o[0],0,0,0), C0,C1, C0[0],C0[1],C0[2]);    VRD2(0); \
    VRD(6); GAPB(o[1]=__builtin_amdgcn_mfma_f32_32x32x16_bf16(PAF(0),VFR(4),o[1],0,0,0), C0,C1, C0[3],C0[4],C0[5]);    VRD2(4); \
    VRD(3); GAPB(o[0]=__builtin_amdgcn_mfma_f32_32x32x16_bf16(PAF(1),VFR(1),o[0],0,0,0), C0,C1, C0[6],C0[7],C0[8]);    VRD2(1); \
    VRD(7); GAPB(o[1]=__builtin_amdgcn_mfma_f32_32x32x16_bf16(PAF(1),VFR(5),o[1],0,0,0), C0,C1, C0[9],C0[10],C0[11]);  VRD2(5); \
    GAPB(o[0]=__builtin_amdgcn_mfma_f32_32x32x16_bf16(PAF(2),VFR(2),o[0],0,0,0), C0,C1, C0[12],C0[13],C0[14]); VRD2(2); \
    GAPB(o[1]=__builtin_amdgcn_mfma_f32_32x32x16_bf16(PAF(2),VFR(6),o[1],0,0,0), C0,C1, C0[15],C1[0],C1[1]);   VRD2(6); \
    GAPB(o[0]=__builtin_amdgcn_mfma_f32_32x32x16_bf16(PAF(3),VFR(3),o[0],0,0,0), C0,C1, C1[2],C1[3],C1[4]);    VRD2(3); \
    GAPB(o[1]=__builtin_amdgcn_mfma_f32_32x32x16_bf16(PAF(3),VFR(7),o[1],0,0,0), C0,C1, C1[5],C1[6],C1[7]);    VRD2(7); \
    KRD(GL,0); GAPD(o[2]=__builtin_amdgcn_mfma_f32_32x32x16_bf16(PAF(0),VFR(0),o[2],0,0,0), C1,C1[8], P0,0,0); \
    KRD(GL,1); GAPD(o[3]=__builtin_amdgcn_mfma_f32_32x32x16_bf16(PAF(0),VFR(4),o[3],0,0,0), C1,C1[9], P0,4,0); \
    KRD(GL,2); GAPD(o[2]=__builtin_amdgcn_mfma_f32_32x32x16_bf16(PAF(1),VFR(1),o[2],0,0,0), C1,C1[10],P0,8,0); \
    KRD(GL,3); GAPD(o[3]=__builtin_amdgcn_mfma_f32_32x32x16_bf16(PAF(1),VFR(5),o[3],0,0,0), C1,C1[11],P0,12,0); \
    GAPD(o[2]=__builtin_amdgcn_mfma_f32_32x32x16_bf16(PAF(2),VFR(2),o[2],0,0,0), C1,C1[12],P1,0,32); \
    GAPD(o[3]=__builtin_amdgcn_mfma_f32_32x32x16_bf16(PAF(2),VFR(6),o[3],0,0,0), C1,C1[13],P1,4,32); \
    GAPD(o[2]=__builtin_amdgcn_mfma_f32_32x32x16_bf16(PAF(3),VFR(3),o[2],0,0,0), C1,C1[14],P1,8,32); \
    GAPD(o[3]=__builtin_amdgcn_mfma_f32_32x32x16_bf16(PAF(3),VFR(7),o[3],0,0,0), C1,C1[15],P1,12,32); \
    }while(0)
  int t=1;
  #define SMASK(P0,P1,t) do{}while(0)
  for(;t+5<NT;t+=2){
    STEP(pB0,pB1,pA0,pA1,t,true,true,true);     WAIT_BAR(0); RESC(); ROT();
    STEP(pA0,pA1,pB0,pB1,t+1,true,true,true);   WAIT_BAR(0); RESC(); ROT();
  }
  #undef SMASK
  #define SMASK(P0,P1,t) do{ if((t)>=NT-4){ int dq_=qrel-(KBREL(t)+4*hi); asm volatile("":"+v"(dq_));        \
    _Pragma("unroll") for(int r=0;r<16;++r){ const int c_=(r&3)+8*(r>>2); if(c_>dq_)P0[r]=-INFINITY; if(c_+32>dq_)P1[r]=-INFINITY; } } }while(0)
  #define ENDW(tt) do{ WAIT_BAR(0); }while(0)
  for(;t+1<NT;t+=2){
    STEP(pB0,pB1,pA0,pA1,t,(t+3<NT),(t+1<NT),(t+1<NT));       ENDW(t);   RESC(); ROT();
    STEP(pA0,pA1,pB0,pB1,t+1,(t+4<NT),(t+2<NT),(t+2<NT));     ENDW(t+1); RESC(); ROT();
  }
  STEP(pB0,pB1,pA0,pA1,NT-1,false,false,false); RESC();
  { float sacc=pB0[0]+pB0[1]; _Pragma("unroll") for(int r=2;r<16;++r)sacc+=pB0[r]; _Pragma("unroll") for(int r=0;r<16;++r)sacc+=pB1[r]; l_reg+=sacc;
    pw0=(u32x4){PKW(pB0,0),PKW(pB0,2),PKW(pB0,4),PKW(pB0,6)};pw1=(u32x4){PKW(pB0,8),PKW(pB0,10),PKW(pB0,12),PKW(pB0,14)};pw2=(u32x4){PKW(pB1,0),PKW(pB1,2),PKW(pB1,4),PKW(pB1,6)};pw3=(u32x4){PKW(pB1,8),PKW(pB1,10),PKW(pB1,12),PKW(pB1,14)};
    SBAR(); pv(o,vb0+2*sl_cur,PAF(0),PAF(1),PAF(2),PAF(3)); pv(o+2,vb0+2*sl_cur+8192,PAF(0),PAF(1),PAF(2),PAF(3)); }
  #undef PKW
  #undef PAF
  #undef VFR
  #undef PIN
  #undef MX3
  #undef GAPA
  #undef GAPB
  #undef GAPD
  #undef GAPC
  #undef EX
  #undef VRD
  #undef VRD2
  #undef KRD
  #undef STEP
  #undef ENDW
  #undef SMASK
  #undef FILLV
  {auto rr=__builtin_amdgcn_permlane32_swap(__float_as_uint(l_reg),__float_as_uint(l_reg),false,false);l_reg=__uint_as_float(rr[0])+__uint_as_float(rr[1]);}
  if(hi==0)wsf[32+r32]=l_reg;asm volatile("s_waitcnt lgkmcnt(0)":::"memory");
  float rli[16];
  #pragma unroll
  for(int r=0;r<16;++r)rli[r]=__builtin_amdgcn_rcpf(wsf[32+crow(r,hi)]);
  asm volatile("s_waitcnt lgkmcnt(0)\n\ts_barrier":::"memory");
  { bf16*stg=(bf16*)(shm)+wid*4096;
    #pragma unroll
    for(int r=0;r<16;++r){const int orow=crow(r,hi);
      #pragma unroll
      for(int dq=0;dq<4;++dq)stg[orow*128+dq*32+r32]=__float2bfloat16(o[dq][r]*rli[r]);}
    asm volatile("s_waitcnt lgkmcnt(0)":::"memory");
    #pragma unroll
    for(int i=0;i<8;++i){const int row=i*4+(lane>>4),ch=lane&15; const u32x4 v=*(const u32x4*)(stg+row*128+ch*8); *(u32x4*)(a.Ow+(long)row*OP+ch*8)=v;} }
  asm volatile("s_waitcnt lgkmcnt(0)\n\ts_barrier":::"memory");
  #undef DMA_K
  #undef DMA_V
  #undef KBREL
  #undef MBIAS
  #undef CMASK
  #undef START
  #undef RESC
  #undef ROT
}
constexpr int ATTN_LDS_BYTES=LDS_BYTES;
#undef SBAR
#undef WAIT_BAR
}
constexpr int NWAVES = 8;
constexpr int BATCH = 2, SEQ = 16384, D = 1024, M = BATCH * SEQ, DEPTH = 4, MEMLEN = 256;
constexpr int NPA = 1536, NPB = 2560;
constexpr int NEXP = 64, CAP = 32768, HID = 256;
constexpr int HROWS = (M * 8 / 256 + NEXP + M / 256) * 256;
constexpr float LN_EPS = 1e-5f;
constexpr float DN_ALPHA = 1.681792830507429f;
__device__ const float SLOPES_A[12] = {0.5f, 0.25f, 0.125f, 0.0625f, 0.03125f, 0.015625f, 0.0078125f, 0.00390625f, 0.7071067811865476f, 0.35355339059327384f, 0.17677669529663695f, 0.08838834764831849f};
__device__ const float SLOPES_B[6] = {0.25f, 0.0625f, 0.015625f, 0.00390625f, 0.5f, 0.125f};

constexpr size_t MiB = 1u << 20;
constexpr size_t WS_CTL = 0, CTL_ZERO_BYTES = 1 * MiB;
constexpr size_t WS_MEMKV = 2 * MiB;
constexpr size_t WS_WROUT = 4 * MiB;
constexpr size_t WS_WINA = 6 * MiB, WS_WINB = 12 * MiB;
constexpr size_t WS_WOUT = 22 * MiB;
constexpr size_t WS_WMKV = 30 * MiB;
constexpr size_t WS_MEMB = 34 * MiB;
constexpr size_t WS_LOGIT = 36 * MiB;
constexpr size_t WS_ROWTOK = 44 * MiB, WS_ROWGATE = 52 * MiB;
constexpr size_t WS_WEXP = 60 * MiB;
constexpr size_t WS_XB = 158 * MiB;
constexpr size_t WS_HB = 222 * MiB;
constexpr size_t WS_BIG = 374 * MiB;
constexpr size_t WS_QKV = WS_BIG, WS_OTMP = WS_BIG + 160 * MiB, WS_CAT = WS_BIG + 256 * MiB, WS_Y = WS_BIG + 320 * MiB;
constexpr size_t WS_END = WS_BIG + 576 * MiB;
static_assert(WS_WEXP + 65 * (size_t)pg8::EXPERT_BYTES <= WS_XB && WS_HB + (size_t)HROWS * 512 <= WS_BIG, "d_ws map");
constexpr int CW_TMO = 0;
constexpr int CW_BAR = 4096;
constexpr int CW_CNT = 16384;
constexpr int CW_Q = CW_CNT + DEPTH * 64 * 64;
constexpr int CW_NORM = CW_Q + 64 * DEPTH;
static_assert((CW_NORM + 64 * DEPTH) * 4 <= (int)CTL_ZERO_BYTES, "CTL words inside the memset region");

constexpr int RING_OFF = 0, RING_BYTES = 131072;
constexpr int LDSCTL_OFF = RING_BYTES;
constexpr int TAB_OFF = RING_BYTES + 512;
constexpr int IDX_OFF = RING_BYTES + 2560;
constexpr int GATE_OFF = IDX_OFF + 10 * 1024;
constexpr int LDS_BYTES = 163840;
static_assert(IDX_OFF + 20 * 1024 <= LDS_BYTES, "LDS map");

#define GAS __attribute__((address_space(1)))
#define LAS __attribute__((address_space(3)))
typedef unsigned short bf16;
typedef unsigned v4u __attribute__((ext_vector_type(4)));
typedef unsigned v2u __attribute__((ext_vector_type(2)));
typedef float f32x4 __attribute__((ext_vector_type(4)));
typedef GAS unsigned gu32;
#define RLX_AGENT __ATOMIC_RELAXED, __HIP_MEMORY_SCOPE_AGENT
#define LDS_WAIT() asm volatile("s_waitcnt lgkmcnt(0)" ::: "memory")
__device__ __forceinline__ unsigned f2bf(float f) { unsigned u = __builtin_bit_cast(unsigned, f); return (u + 0x7fffu + ((u >> 16) & 1u)) >> 16; }
__device__ __forceinline__ unsigned pk2(float lo, float hi) { return f2bf(lo) | (f2bf(hi) << 16); }
__device__ __forceinline__ float bflo(unsigned u) { return __builtin_bit_cast(float, u << 16); }
__device__ __forceinline__ float bfhi(unsigned u) { return __builtin_bit_cast(float, u & 0xffff0000u); }

#define XB_TMO      128
#define XB_XCNT(j)  (256  + 64 * (j))
#define XB_XSUB(j)  (1280 + 64 * (j))
#define XB_XGEN(j)  (2304 + 64 * (j))
#define XB_TOP      3328
#define XB_TOPGEN   3392
#define XCD_BAR_WORDS 3456
#define XB_SPIN_CAP (1u << 18)
__device__ __forceinline__ unsigned xb_ld(unsigned* p)              { return __hip_atomic_load(p, __ATOMIC_RELAXED, __HIP_MEMORY_SCOPE_AGENT); }
__device__ __forceinline__ unsigned xb_add(unsigned* p, unsigned v) { return __hip_atomic_fetch_add(p, v, __ATOMIC_RELAXED, __HIP_MEMORY_SCOPE_AGENT); }
__device__ __forceinline__ unsigned xb_xcc_id() { return (unsigned)__builtin_amdgcn_s_getreg((3 << 11) | 20) & 0xFu; }
#define XB_SPIN(cond, bar) do { unsigned _sp = 0; while (cond) { __builtin_amdgcn_s_sleep(1); \
    if ((++_sp & 255u) == 0u) { if (xb_ld(&(bar)[XB_TMO])) break; if (_sp > XB_SPIN_CAP) { atomicAdd(&(bar)[XB_TMO], 1u); break; } } } } while (0)
struct XcdBarrier { unsigned* bar; unsigned x; volatile LAS unsigned* st; };
__device__ __forceinline__ XcdBarrier xcd_barrier_post(unsigned* bar, volatile LAS unsigned* st, const bool t0) {
    XcdBarrier b; b.bar = bar; b.x = xb_xcc_id(); b.st = st;
    if (t0) (void)xb_add(&bar[XB_XCNT(b.x)], 1u);
    return b;
}
__device__ __forceinline__ void xcd_barrier_complete(unsigned* bar, unsigned x, unsigned& nloc, unsigned& nx) {
    const unsigned G = gridDim.x * gridDim.y * gridDim.z;
    unsigned sum, cnt, mine, sp = 0u;
    for (;;) {
        sum = 0u; cnt = 0u; mine = 0u;
#pragma unroll
        for (unsigned j = 0; j < 16; ++j) { const unsigned c = xb_ld(&bar[XB_XCNT(j)]); sum += c; cnt += (c > 0u) ? 1u : 0u; mine = (j == x) ? c : mine; }
        if (sum == G) break;
        __builtin_amdgcn_s_sleep(1);
        if ((++sp & 255u) == 0u) { if (xb_ld(&bar[XB_TMO])) break; if (sp > XB_SPIN_CAP) { atomicAdd(&bar[XB_TMO], 1u); break; } }
    }
    nloc = mine > 0u ? mine : 1u; nx = cnt > 0u ? cnt : 1u;
}
__device__ __forceinline__ void xcd_barrier(const XcdBarrier& b, const bool t0) {
    asm volatile("s_waitcnt vmcnt(0)" ::: "memory");
    __syncthreads();
    if (t0) {
        unsigned* bar = b.bar;
        __builtin_amdgcn_s_waitcnt(0);
        unsigned nloc = b.st[0], nx = b.st[1];
        if (nloc == 0u) { xcd_barrier_complete(bar, b.x, nloc, nx); b.st[0] = nloc; b.st[1] = nx; }
        const unsigned old = xb_add(&bar[XB_XSUB(b.x)], 1u);
        const unsigned gen = old / nloc;
        if (old + 1u == (gen + 1u) * nloc) {
            __builtin_amdgcn_fence(__ATOMIC_RELEASE, "agent");
            asm volatile("s_waitcnt vmcnt(0)" ::: "memory");
            const unsigned og = xb_add(&bar[XB_TOP], 1u);
            const unsigned tg = og / nx;
            if (og + 1u == (tg + 1u) * nx) xb_add(&bar[XB_TOPGEN], 1u);
            else XB_SPIN(xb_ld(&bar[XB_TOPGEN]) == tg, bar);
            __builtin_amdgcn_fence(__ATOMIC_ACQUIRE, "agent");
            xb_add(&bar[XB_XGEN(b.x)], 1u);
            asm volatile("s_waitcnt vmcnt(0)" ::: "memory");
        } else {
            XB_SPIN(xb_ld(&bar[XB_XGEN(b.x)]) == gen, bar);
            __builtin_amdgcn_fence(__ATOMIC_ACQUIRE, "agent");
            asm volatile("s_waitcnt vmcnt(0)" ::: "memory");
        }
    }
    __syncthreads();
}

struct Frame { LAS unsigned char* lds; int wave; };
__device__ __forceinline__ int f_G() { int g = (int)gridDim.x; asm volatile("" : "+s"(g)); return g; }
__device__ __forceinline__ int f_bx() { int b = (int)blockIdx.x; asm volatile("" : "+s"(b)); return b; }
__device__ __forceinline__ int f_gw(const Frame& F) { const int g = f_G(), b = f_bx(); return ((g % 8 == 0) ? (b % 8) * (g / 8) + b / 8 : b) * NWAVES + F.wave; }
__device__ __forceinline__ int f_ngw() { return f_G() * NWAVES; }
__device__ __forceinline__ volatile LAS unsigned* f_misc(const Frame& F) { return (volatile LAS unsigned*)(F.lds + LDSCTL_OFF); }
__device__ __forceinline__ int lane_id() { unsigned m; asm volatile("s_mov_b32 %0, -1" : "=s"(m)); return (int)__builtin_amdgcn_mbcnt_hi(m, __builtin_amdgcn_mbcnt_lo(m, 0u)); }
__device__ __forceinline__ int tid_of(int wave) { asm volatile("" : "+s"(wave)); return (wave << 6) | lane_id(); }
#define fresh_tid() tid_of(F.wave)
__device__ __forceinline__ float sx(float v, int o, int ln) { return __builtin_bit_cast(float, __builtin_amdgcn_ds_bpermute((ln ^ o) << 2, __builtin_bit_cast(int, v))); }
__device__ __forceinline__ float wave_sum(float v) {
    const int ln_ = lane_id();
#pragma unroll
    for (int o = 1; o < 64; o <<= 1) v += sx(v, o, ln_);
    return v;
}
__device__ __forceinline__ void transpose_item64(const float* W, int N, bf16* WT, int ldt, int k0, int n0, int drow0, LAS float* scr, int lane) {
    const int rr = lane >> 4, cc = (lane & 15) * 4;
#pragma unroll 8
    for (int i = 0; i < 16; ++i) { const int kk = 4 * i + rr; const f32x4 v = *(const GAS f32x4*)(W + (size_t)(k0 + kk) * N + n0 + cc);
        LAS float* d = scr + kk * 65 + cc; d[0] = v.x; d[1] = v.y; d[2] = v.z; d[3] = v.w; }
    LDS_WAIT(); asm volatile("" ::: "memory");
    const int c = lane & 7;
#pragma unroll
    for (int j = 0; j < 8; ++j) { const int n = (lane >> 3) + 8 * j; const LAS float* s = scr + (8 * c) * 65 + n;
        v4u o; o.x = pk2(s[0 * 65], s[1 * 65]); o.y = pk2(s[2 * 65], s[3 * 65]); o.z = pk2(s[4 * 65], s[5 * 65]); o.w = pk2(s[6 * 65], s[7 * 65]);
        *(GAS v4u*)(WT + (size_t)(drow0 + n) * ldt + k0 + 8 * c) = o; }
    LDS_WAIT(); asm volatile("" ::: "memory");
}
__device__ __forceinline__ int map_in_a(int n) { return n < 768 ? n : (n < 960 ? n + 256 : (n < 1152 ? n + 256 : n - 384)); }
__device__ __forceinline__ int map_in_b(int n) { return n < 768 ? n : (n < 2304 ? n + 256 : n - 1536); }

struct Args { const float* in[19]; float* out; unsigned char* ws; };
typedef const __attribute__((address_space(4))) Args* ArgsP;
__device__ __forceinline__ ArgsP fresh_args() { ArgsP p = (ArgsP)__builtin_amdgcn_kernarg_segment_ptr(); asm volatile("" : "+s"(p)); return p; }
__device__ __forceinline__ gu32* f_ctl() { return (gu32*)(fresh_args()->ws + WS_CTL); }

__device__ __forceinline__ void p0_small_weights(Frame& F, ArgsP A) {
    const int tid_ = fresh_tid(), lane_ = tid_ & 63; (void)tid_; (void)lane_;
    LAS float* scr = (LAS float*)(F.lds + (F.wave < 7 ? RING_OFF + F.wave * 16640 : IDX_OFF));
    unsigned char* ws = A->ws;
    constexpr int I_A = 16 * 22, I_B = 16 * 40, I_M = 16 * 8, I_O = 16 * 16, I_R = 16;
    constexpr int NITEMS = 2 * I_A + 2 * I_B + 4 * I_M + 4 * I_O + 4 * I_R;
    for (int it = f_gw(F); it < NITEMS; it += f_ngw()) {
        int r = it;
        if (r < 2 * I_A) { const int j = r / I_A; r %= I_A; const int kb = r / 22, nb = r % 22;
            transpose_item64(A->in[2] + (size_t)j * D * 1408, 1408, (bf16*)(ws + WS_WINA) + (size_t)j * NPA * D, D, 64 * kb, 64 * nb, map_in_a(64 * nb), scr, lane_); continue; } r -= 2 * I_A;
        if (r < 2 * I_B) { const int j = r / I_B; r %= I_B; const int kb = r / 40, nb = r % 40;
            transpose_item64(A->in[4] + (size_t)j * D * 2560, 2560, (bf16*)(ws + WS_WINB) + (size_t)j * NPB * D, D, 64 * kb, 64 * nb, map_in_b(64 * nb), scr, lane_); continue; } r -= 2 * I_B;
        if (r < 4 * I_M) { const int l = r / I_M; r %= I_M; const int kb = r / 8, nb = r % 8;
            transpose_item64(A->in[7] + (size_t)l * D * 512, 512, (bf16*)(ws + WS_WMKV), D, 64 * kb, 64 * nb, l * 512 + 64 * nb, scr, lane_); continue; } r -= 4 * I_M;
        if (r < 4 * I_O) { const int l = r / I_O; r %= I_O; const int kb = r / 16, nb = r % 16;
            transpose_item64(A->in[8] + (size_t)l * D * D, D, (bf16*)(ws + WS_WOUT) + (size_t)l * D * D, D, 64 * kb, 64 * nb, 64 * nb, scr, lane_); continue; } r -= 4 * I_O;
        { const int l = r / I_R; const int kb = r % I_R;
            transpose_item64(A->in[11] + (size_t)l * D * 64, 64, (bf16*)(ws + WS_WROUT) + (size_t)l * 256 * D, D, 64 * kb, 0, 0, scr, lane_); }
    }
    for (int it = f_gw(F); it < 2 * 128 + 4 * 192; it += f_ngw()) {
        bf16* row = it < 256 ? (bf16*)(ws + WS_WINA) + ((size_t)(it >> 7) * NPA + 1408 + (it & 127)) * D
                             : (bf16*)(ws + WS_WROUT) + ((size_t)((it - 256) / 192) * 256 + 64 + (it - 256) % 192) * D;
        GAS v4u* o = (GAS v4u*)row + lane_;
        o[0] = (v4u){0u, 0u, 0u, 0u}; o[64] = (v4u){0u, 0u, 0u, 0u};
    }
    for (int m0 = 4 * f_gw(F); m0 < 512 + M; m0 += 4 * f_ngw()) {
        f32x4 v[4][4];
#pragma unroll
        for (int r = 0; r < 4; ++r) { const int m = m0 + r; const float* src = m < 512 ? A->in[1] + (size_t)m * D : A->in[0] + (size_t)(m - 512) * D;
            const GAS f32x4* xr = (const GAS f32x4*)src + lane_;
#pragma unroll
            for (int j = 0; j < 4; ++j) v[r][j] = xr[64 * j]; }
#pragma unroll
        for (int r = 0; r < 4; ++r) { const int m = m0 + r; bf16* dst = m < 512 ? (bf16*)(ws + WS_MEMB) + (size_t)m * D : (bf16*)(ws + WS_XB) + (size_t)(m - 512) * D;
            GAS v2u* o8 = (GAS v2u*)dst + lane_;
#pragma unroll
            for (int j = 0; j < 4; ++j) o8[64 * j] = (v2u){pk2(v[r][j].x, v[r][j].y), pk2(v[r][j].z, v[r][j].w)}; }
    }
}
constexpr int CONV_ITEMS = 65 * 192, CONV_UNITS = CONV_ITEMS / 8;
__device__ __forceinline__ void convert_item(ArgsP A, int layer, int it, LAS float* scr, int lane_) {
    bf16* wexp = (bf16*)(A->ws + WS_WEXP);
    const int e = it / 192, mat = (it % 192) >> 6, r = it & 63;
    bf16* dst = wexp + (size_t)e * (pg8::EXPERT_BYTES / 2);
    if (mat < 2) { const float* W = (e < 64) ? A->in[13 + mat] + ((size_t)layer * 64 + e) * (D * HID) : A->in[16 + mat] + (size_t)layer * (D * HID);
        const int kb = r >> 2, nb = r & 3, n0 = 64 * nb;
        transpose_item64(W, HID, dst, D, 64 * kb, n0, (n0 >> 7) * 256 + mat * 128 + (n0 & 127), scr, lane_); }
    else { const float* W = (e < 64) ? A->in[15] + ((size_t)layer * 64 + e) * (HID * D) : A->in[18] + (size_t)layer * (HID * D);
        const int kb = r >> 4, nb = r & 15;
        transpose_item64(W, D, dst + pg8::EXPERT_DOWN_OFF / 2, HID, 64 * kb, 64 * nb, 64 * nb, scr, lane_); }
}
__device__ __forceinline__ void convert_unit(Frame& F, ArgsP A, int layer, int cu) {
    const int tid_ = fresh_tid(), lane_ = tid_ & 63; (void)tid_;
    LAS float* scr = (LAS float*)(F.lds + (F.wave < 7 ? RING_OFF + F.wave * 16640 : IDX_OFF));
    const int it = 8 * cu + F.wave;
    if (it < CONV_ITEMS) convert_item(A, layer, it, scr, lane_);
    asm volatile("s_waitcnt vmcnt(0) lgkmcnt(0)\n\ts_barrier" ::: "memory");
}
template <bool LAST> __device__ __forceinline__ void ph_combine_ln2(Frame& F, float* xout, const unsigned char* yt, const float* g, const float* b, bf16* xb) {
    typedef float f32x2c __attribute__((ext_vector_type(2)));
    const int tid_ = fresh_tid(), lane_ = tid_ & 63; (void)tid_;
    for (int m = f_gw(F); m < M; m += f_ngw()) {
        GAS v4u* o8 = (GAS v4u*)(xb + (size_t)m * D) + 2 * lane_; const GAS v4u* yr = (const GAS v4u*)(yt + (size_t)m * 9 * D) + lane_;
        float v[16];
#pragma unroll
        for (int i = 0; i < 16; ++i) v[i] = 0.f;
#pragma unroll
        for (int k = 0; k < 9; ++k) { const v4u w = yr[k * 64];
#pragma unroll
            for (int q = 0; q < 4; ++q) { const f32x2c lo = __builtin_amdgcn_cvt_pk_f32_fp8((int)w[q], false), hi = __builtin_amdgcn_cvt_pk_f32_fp8((int)w[q], true);
                v[4 * q] += lo.x; v[4 * q + 1] += lo.y; v[4 * q + 2] += hi.x; v[4 * q + 3] += hi.y; } }
        float s = 0.f;
#pragma unroll
        for (int h = 0; h < 2; ++h) { const v4u xw = o8[h];
#pragma unroll
            for (int q = 0; q < 4; ++q) { v[8 * h + 2 * q] = v[8 * h + 2 * q] * (1.f / pg8::Y8_SCALE) + DN_ALPHA * bflo(xw[q]); v[8 * h + 2 * q + 1] = v[8 * h + 2 * q + 1] * (1.f / pg8::Y8_SCALE) + DN_ALPHA * bfhi(xw[q]); } }
#pragma unroll
        for (int i = 0; i < 16; ++i) s += v[i];
        const float mean = wave_sum(s) * (1.f / D); float s2 = 0.f;
#pragma unroll
        for (int i = 0; i < 16; ++i) { v[i] -= mean; s2 += v[i] * v[i]; }
        const float rstd = 1.f / sqrtf(wave_sum(s2) * (1.f / D) + LN_EPS);
        const GAS f32x4* gp = (const GAS f32x4*)g + 4 * lane_; const GAS f32x4* bp = (const GAS f32x4*)b + 4 * lane_;
        GAS f32x4* xo = (GAS f32x4*)(xout + (size_t)m * D) + 4 * lane_;
        float o[16];
#pragma unroll
        for (int q = 0; q < 4; ++q) { const f32x4 gv = gp[q], bv = bp[q];
            o[4 * q] = v[4 * q] * rstd * gv.x + bv.x; o[4 * q + 1] = v[4 * q + 1] * rstd * gv.y + bv.y; o[4 * q + 2] = v[4 * q + 2] * rstd * gv.z + bv.z; o[4 * q + 3] = v[4 * q + 3] * rstd * gv.w + bv.w;
            if (LAST) xo[q] = (f32x4){o[4 * q], o[4 * q + 1], o[4 * q + 2], o[4 * q + 3]}; }
        if (!LAST) { o8[0] = (v4u){pk2(o[0], o[1]), pk2(o[2], o[3]), pk2(o[4], o[5]), pk2(o[6], o[7])}; o8[1] = (v4u){pk2(o[8], o[9]), pk2(o[10], o[11]), pk2(o[12], o[13]), pk2(o[14], o[15])}; }
    }
}
__device__ __forceinline__ void ph_diff_combine(Frame& F, const bf16* otmp, const float* lq, const float* subg, float lam_init, bf16* cat) {
    const int tid_ = fresh_tid(), lane_ = tid_ & 63; (void)tid_; (void)lane_;
    float lam;
    { const float a = lq[lane_] * lq[64 + lane_], c = lq[128 + lane_] * lq[192 + lane_]; lam = expf(wave_sum(a)) - expf(wave_sum(c)) + lam_init; }
    const int l32 = lane_ & 31, hh = lane_ >> 5;
    const f32x4 gv = ((const GAS f32x4*)subg)[l32]; const float post = 1.f - lam_init;
    for (int m = f_gw(F); m < M; m += f_ngw()) {
#pragma unroll
        for (int hp = 0; hp < 3; ++hp) { const int h = 2 * hp + hh;
            const v2u a0 = *((const GAS v2u*)(otmp + (size_t)m * 1536 + h * 256) + l32), a1 = *((const GAS v2u*)(otmp + (size_t)m * 1536 + h * 256 + 128) + l32);
            f32x4 o; o.x = bflo(a0.x) - lam * bflo(a1.x); o.y = bfhi(a0.x) - lam * bfhi(a1.x); o.z = bflo(a0.y) - lam * bflo(a1.y); o.w = bfhi(a0.y) - lam * bfhi(a1.y);
            float s2 = (o.x * o.x + o.y * o.y) + (o.z * o.z + o.w * o.w);
#pragma unroll
            for (int sft = 1; sft < 32; sft <<= 1) s2 += sx(s2, sft, lane_);
            const float r = post / sqrtf(s2 * (1.f / 128.f) + LN_EPS);
            o = o * r * gv;
            *((GAS v2u*)(cat + (size_t)m * D + h * 128) + l32) = (v2u){pk2(o.x, o.y), pk2(o.z, o.w)}; }
    }
}
__device__ __forceinline__ float ss8(v4u a) { float s = 0.f;
#pragma unroll
    for (int i = 0; i < 4; ++i) { const float lo = bflo(a[i]), hi = bfhi(a[i]); s += lo * lo + hi * hi; } return s; }
__device__ __forceinline__ void ph_qknorm(Frame& F, const bf16* qkv, gu32* gmax) {
    const int tid_ = fresh_tid(), lane_ = tid_ & 63;
    LAS unsigned* lmax = (LAS unsigned*)(F.lds + LDSCTL_OFF) + 32;
    if (tid_ < 24) lmax[tid_] = 0u;
    __syncthreads();
    float mq0 = 0.f, mq1 = 0.f, mk0 = 0.f, mk1 = 0.f;
    const v4u zero = (v4u){0u, 0u, 0u, 0u};
    for (int m = f_gw(F); m < M; m += f_ngw()) {
        const bf16* row = qkv + (size_t)m * NPB;
        const v4u a = *(const GAS v4u*)(row + 8 * lane_), c = *(const GAS v4u*)(row + 1024 + 8 * lane_);
        v4u b = zero, d = zero; if (lane_ < 32) { b = *(const GAS v4u*)(row + 512 + 8 * lane_); d = *(const GAS v4u*)(row + 1536 + 8 * lane_); }
        float sa = ss8(a), sb = ss8(b), sc = ss8(c), sd = ss8(d);
#pragma unroll
        for (int o = 1; o < 8; o <<= 1) { sa += sx(sa, o, lane_); sb += sx(sb, o, lane_); sc += sx(sc, o, lane_); sd += sx(sd, o, lane_); }
        mq0 = fmaxf(mq0, sa); mq1 = fmaxf(mq1, sb); mk0 = fmaxf(mk0, sc); mk1 = fmaxf(mk1, sd);
    }
    if ((lane_ & 7) == 0) { const int g = lane_ >> 3;
        __hip_atomic_fetch_max(lmax + g, __float_as_uint(mq0), __ATOMIC_RELAXED, __HIP_MEMORY_SCOPE_WORKGROUP); __hip_atomic_fetch_max(lmax + 12 + g, __float_as_uint(mk0), __ATOMIC_RELAXED, __HIP_MEMORY_SCOPE_WORKGROUP);
        if (lane_ < 32) { __hip_atomic_fetch_max(lmax + 8 + g, __float_as_uint(mq1), __ATOMIC_RELAXED, __HIP_MEMORY_SCOPE_WORKGROUP); __hip_atomic_fetch_max(lmax + 20 + g, __float_as_uint(mk1), __ATOMIC_RELAXED, __HIP_MEMORY_SCOPE_WORKGROUP); } }
    __syncthreads();
    if (tid_ < 24) __hip_atomic_fetch_max(gmax + tid_, lmax[tid_], RLX_AGENT);
}
typedef short bf16x8r __attribute__((ext_vector_type(8)));
constexpr int RT_SC_OFF = TAB_OFF, RT_GB_OFF = TAB_OFF + 16384;
static_assert(RT_GB_OFF + 8192 <= LDS_BYTES, "LDS map (route phase)");
template <bool XF32> __device__ __forceinline__ void ph_ln_route(Frame& F, const float* xin, const bf16* y, const float* g, const float* b, bf16* xb, const bf16* wrt, const float* rbias, gu32* cnt, int* rowtok, float* rowgate, float* gtmp) {
    const int tid_ = fresh_tid(), lane_ = tid_ & 63;
    for (int i = tid_; i < 64 * 128; i += NWAVES * 64) { const int e = i >> 7, c = i & 127;
        const v4u v = *(const GAS v4u*)(wrt + (size_t)e * D + c * 8); *(LAS v4u*)(F.lds + e * 2048 + ((c ^ (e & 15)) << 4)) = v; }
    LAS float* lgb = (LAS float*)(F.lds + RT_GB_OFF);
    if (tid_ < 256) { ((LAS f32x4*)lgb)[tid_] = ((const GAS f32x4*)g)[tid_]; ((LAS f32x4*)lgb)[256 + tid_] = ((const GAS f32x4*)b)[tid_]; }
    __syncthreads();
    LAS float* sc = (LAS float*)(F.lds + RT_SC_OFF) + F.wave * 512;
    const int r = lane_ & 15, kq = lane_ >> 4; const float bias = rbias[lane_]; const float NINF = -INFINITY;
    for (int base = f_gw(F) * 16; base < M; base += f_ngw() * 16) {
#pragma unroll 1
        for (int r4 = 0; r4 < 16; r4 += 4) {
            f32x4 v[4][4]; float s1[4];
#pragma unroll
            for (int q = 0; q < 4; ++q) { const size_t mo = (size_t)(base + r4 + q) * D; const GAS v2u* yr = (const GAS v2u*)(y + mo) + lane_; s1[q] = 0.f;
#pragma unroll
                for (int j = 0; j < 4; ++j) { f32x4 xv;
                    if (XF32) xv = ((const GAS f32x4*)(xin + mo) + lane_)[64 * j]; else { const v2u xw = ((const GAS v2u*)(xb + mo) + lane_)[64 * j]; xv = (f32x4){bflo(xw.x), bfhi(xw.x), bflo(xw.y), bfhi(xw.y)}; }
                    const v2u yv = yr[64 * j];
                    v[q][j].x = DN_ALPHA * xv.x + bflo(yv.x); v[q][j].y = DN_ALPHA * xv.y + bfhi(yv.x); v[q][j].z = DN_ALPHA * xv.z + bflo(yv.y); v[q][j].w = DN_ALPHA * xv.w + bfhi(yv.y);
                    s1[q] += (v[q][j].x + v[q][j].y) + (v[q][j].z + v[q][j].w); } }
#pragma unroll
            for (int o = 1; o < 64; o <<= 1) {
#pragma unroll
                for (int q = 0; q < 4; ++q) s1[q] += sx(s1[q], o, lane_); }
            float s2[4];
#pragma unroll
            for (int q = 0; q < 4; ++q) { const float mean = s1[q] * (1.f / D); s2[q] = 0.f;
#pragma unroll
                for (int j = 0; j < 4; ++j) { v[q][j] = v[q][j] - mean; s2[q] += (v[q][j].x * v[q][j].x + v[q][j].y * v[q][j].y) + (v[q][j].z * v[q][j].z + v[q][j].w * v[q][j].w); } }
#pragma unroll
            for (int o = 1; o < 64; o <<= 1) {
#pragma unroll
                for (int q = 0; q < 4; ++q) s2[q] += sx(s2[q], o, lane_); }
#pragma unroll
            for (int q = 0; q < 4; ++q) { const float rstd = 1.f / sqrtf(s2[q] * (1.f / D) + LN_EPS); GAS v2u* o8 = (GAS v2u*)(xb + (size_t)(base + r4 + q) * D) + lane_;
#pragma unroll
                for (int j = 0; j < 4; ++j) { const LAS f32x4* gp = (const LAS f32x4*)lgb + lane_ + 64 * j; const f32x4 gv = gp[0], bv = gp[256];
                    const f32x4 o = v[q][j] * rstd * gv + bv; o8[64 * j] = (v2u){pk2(o.x, o.y), pk2(o.z, o.w)}; } }
        }
        asm volatile("s_waitcnt vmcnt(0)" ::: "memory");
        f32x4 acc[4];
#pragma unroll
        for (int nt = 0; nt < 4; ++nt) acc[nt] = (f32x4){0.f, 0.f, 0.f, 0.f};
        const bf16* arow = xb + (size_t)(base + r) * D + 8 * kq;
#pragma unroll 8
        for (int s = 0; s < 32; ++s) { const v4u aw = __builtin_nontemporal_load((const GAS v4u*)(arow + 32 * s)); const bf16x8r af = __builtin_bit_cast(bf16x8r, aw);
#pragma unroll
            for (int nt = 0; nt < 4; ++nt) { const int e = 16 * nt + r, c = 4 * s + kq;
                const bf16x8r bfr = *(const LAS bf16x8r*)(F.lds + e * 2048 + ((c ^ (e & 15)) << 4));
                acc[nt] = __builtin_amdgcn_mfma_f32_16x16x32_bf16(bfr, af, acc[nt], 0, 0, 0); } }
        unsigned selmask = 0u; unsigned long long slots = 0ull; unsigned mycount = 0u;
#pragma unroll 1
        for (int half = 0; half < 2; ++half) {
            if ((r >> 3) == half) {
#pragma unroll
                for (int nt = 0; nt < 4; ++nt) *(LAS f32x4*)(sc + (r & 7) * 64 + 16 * nt + 4 * kq) = acc[nt]; }
            LDS_WAIT(); asm volatile("" ::: "memory");
#pragma unroll 1
            for (int j8 = 0; j8 < 8; ++j8) { const int j = half * 8 + j8;
                const float logit = sc[j8 * 64 + lane_];
                const float aff = 1.f / (1.f + expf(-logit)); const float sel = aff + bias;
                float m1 = sel; m1 = fmaxf(m1, sx(m1, 1, lane_)); m1 = fmaxf(m1, sx(m1, 2, lane_)); m1 = fmaxf(m1, sx(m1, 4, lane_));
                const unsigned long long bm = __ballot(sel == m1); const unsigned gb = (unsigned)(bm >> (lane_ & 56)) & 0xffu; const int first = __builtin_ctz(gb | 0x100u);
                float m2 = ((lane_ & 7) == first) ? NINF : sel; m2 = fmaxf(m2, sx(m2, 1, lane_)); m2 = fmaxf(m2, sx(m2, 2, lane_)); m2 = fmaxf(m2, sx(m2, 4, lane_));
                const float gs = m1 + m2; int grank = 0;
#pragma unroll
                for (int g2 = 0; g2 < 8; ++g2) { const float o = __builtin_bit_cast(float, __builtin_amdgcn_readlane(__builtin_bit_cast(int, gs), 8 * g2)); grank += (o > gs || (o == gs && g2 < (lane_ >> 3))) ? 1 : 0; }
                const bool gok = grank < 4; const float v = gok ? sel : NINF; int er = 0;
#pragma unroll 8
                for (int e2 = 0; e2 < 64; ++e2) { const float o = __builtin_bit_cast(float, __builtin_amdgcn_readlane(__builtin_bit_cast(int, v), e2)); er += (o > v) ? 1 : 0; }
                bool chosen = gok && er < 8;
                if (__builtin_popcountll(__ballot(chosen)) != 8) {
                    er = 0;
#pragma unroll 8
                    for (int e2 = 0; e2 < 64; ++e2) { const float o = __builtin_bit_cast(float, __builtin_amdgcn_readlane(__builtin_bit_cast(int, v), e2)); er += (o > v || (o == v && e2 < lane_)) ? 1 : 0; }
                    chosen = gok && er < 8; }
                const float ssum = wave_sum(chosen ? aff : 0.f);
                const unsigned long long bal = __ballot(chosen); const unsigned slot = __builtin_amdgcn_mbcnt_hi((unsigned)(bal >> 32), __builtin_amdgcn_mbcnt_lo((unsigned)bal, 0u));
                if (chosen) { selmask |= 1u << j; slots |= (unsigned long long)slot << (4 * j); ++mycount; gtmp[(size_t)(base + j) * 64 + lane_] = aff / ssum * 2.5f; }
            }
            LDS_WAIT(); asm volatile("" ::: "memory");
        }
        unsigned pos = 0u;
        { LAS unsigned* wgc = (LAS unsigned*)(F.lds + LDSCTL_OFF) + 64;
            if (tid_ < 64) wgc[tid_] = 0u;
            __syncthreads();
            if (mycount) pos = __hip_atomic_fetch_add(wgc + lane_, mycount, __ATOMIC_RELAXED, __HIP_MEMORY_SCOPE_WORKGROUP);
            __syncthreads();
            if (tid_ < 64) { const unsigned tot = wgc[tid_]; unsigned gb = 0u; if (tot) gb = __hip_atomic_fetch_add(cnt + 64 * tid_, tot, RLX_AGENT); wgc[tid_] = gb; }
            __syncthreads();
            pos += wgc[lane_];
            __syncthreads(); }
#pragma unroll 1
        for (int j = 0; j < 16; ++j) if ((selmask >> j) & 1u) { const size_t at = (size_t)lane_ * CAP + pos; ++pos;
            rowtok[at] = (base + j) | ((int)((slots >> (4 * j)) & 15ull) << 16); rowgate[at] = gtmp[(size_t)(base + j) * 64 + lane_]; }
    }
}
template <bool M1> __device__ __forceinline__ int build_units(Frame& F, gu32* cnt, const int* rowtok, const float* rowgate) {
    const int tid_ = fresh_tid();
    LAS int* tcnt = (LAS int*)(F.lds + TAB_OFF); LAS int* bst = tcnt + 80; LAS int* utab = tcnt + 160; LAS int* idx = (LAS int*)(F.lds + IDX_OFF); LAS float* lgate = (LAS float*)(F.lds + GATE_OFF);
    if (tid_ < 64) {
        const int c = (int)__hip_atomic_load(cnt + 64 * tid_, RLX_AGENT); const int nb = (c + 255) >> 8; int incl = nb;
#pragma unroll
        for (int o = 1; o < 64; o <<= 1) { const int u = __builtin_amdgcn_ds_bpermute((tid_ - o) << 2, incl); if (tid_ >= o) incl += u; }
        tcnt[tid_] = c; bst[tid_] = incl - nb;
        if (tid_ == 63) { tcnt[64] = M; bst[64] = incl; bst[65] = incl + M / 256; }
    }
    __syncthreads();
    const int nblk = bst[65]; const int bx = blockIdx.x;
    const int per = M1 ? 128 : 64, blk0 = M1 ? (16 * (bx & 7) + (bx >> 4)) : (8 * (bx & 7) + (bx >> 5)), pn = M1 ? ((bx >> 3) & 1) : ((bx >> 3) & 3);
    int nmine = (nblk > blk0) ? (nblk - blk0 + per - 1) / per : 0; if (nmine > (M1 ? 10 : 20)) nmine = M1 ? 10 : 20;
    if (tid_ < nmine) { const int blk = tid_ * per + blk0;
        int e = 0;
#pragma unroll
        for (int st = 64; st > 0; st >>= 1) { const int q = e + st; if (q <= 64 && bst[q] <= blk) e = q; }
        const int j = blk - bst[e]; int nv = tcnt[e] - 256 * j; if (nv > 256) nv = 256;
        LAS int* t = utab + tid_ * 8; t[0] = e; t[1] = blk; t[2] = pn; t[3] = nv; t[4] = e * CAP + 256 * j; t[5] = 256 * j; }
    __syncthreads();
    for (int q = tid_; q < nmine * 256; q += NWAVES * 64) { const int g = q >> 8, i = q & 255;
        const LAS int* t = utab + g * 8; const int e = t[0], nv = t[3];
        if (M1) { int tok = 0; float gt = 0.f;
            if (e == 64) { tok = t[5] + i; gt = 1.f; } else if (i < nv) { tok = rowtok[t[4] + i] & 0xffff; gt = rowgate[t[4] + i]; }
            idx[q] = tok; lgate[q] = gt; }
        else { int dst = M * 9;
            if (e == 64) dst = (t[5] + i) * 9 + 8; else if (i < nv) { const int v = rowtok[t[4] + i]; dst = (v & 0xffff) * 9 + (v >> 16); }
            idx[q] = dst; } }
    __syncthreads();
    return nmine;
}
#define WSP(T, off) ((T*)(A->ws + (off)))
#ifndef REP_P1
#define REP_P1 1
#endif
#ifndef REP_P2
#define REP_P2 1
#endif
#ifndef REP_P3
#define REP_P3 1
#endif
#ifndef REP_P5
#define REP_P5 1
#endif
#ifndef REP_P7
#define REP_P7 1
#endif
#ifndef REP_P8
#define REP_P8 1
#endif
#define REPEAT(n) _Pragma("unroll 1") for (int rep_ = 0; rep_ < (n); ++rep_)
#define OPQ(x) asm volatile("" : "+s"(x))
#define FCTL() f_ctl()
#define FRESH_GB() const int G = f_G(), bx = f_bx(); (void)G; (void)bx
__global__ void __launch_bounds__(NWAVES * 64, 2) mega_fwd(Args args_unused) {
    extern __shared__ __attribute__((aligned(16))) unsigned char lds[];
    Frame F;
    F.lds = (LAS unsigned char*)lds;
    F.wave = __builtin_amdgcn_readfirstlane((int)threadIdx.x >> 6);
    for (int u = fresh_tid(); u < 512 / 4; u += NWAVES * 64) ((LAS unsigned*)(F.lds + LDSCTL_OFF))[u] = 0u;
    __syncthreads();
    (void)xcd_barrier_post((unsigned*)(f_ctl() + CW_BAR), f_misc(F) + 8, fresh_tid() == 0);
#define GRID_BAR() do { XcdBarrier bar_; bar_.bar = (unsigned*)(f_ctl() + CW_BAR); bar_.x = xb_xcc_id(); bar_.st = f_misc(F) + 8; xcd_barrier(bar_, fresh_tid() == 0); } while (0)

    { ArgsP A = fresh_args(); FRESH_GB(); p0_small_weights(F, A); }
    GRID_BAR();
    {   ArgsP A = fresh_args(); FRESH_GB();
        pg8::DenseSched S; S.init(512, 2048, D, G, bx, WSP(const bf16, WS_WMKV));
        pg8::EpiBf16 E{WSP(bf16, WS_MEMKV), 2048, 0, 1.f};
        pg8::gemm_phase<pg8::EpiBf16, pg8::DenseSched>(F.lds + RING_OFF, WSP(const bf16, WS_MEMB), D, S, E, F.wave); }

    for (int layer = 0; layer < DEPTH; ++layer) {
        const int jm = layer >> 1; const bool isB = (layer & 1) != 0;
        REPEAT(REP_P1) {
        if (!isB) { ArgsP A = fresh_args(); FRESH_GB();
            pg8::DenseSched S; S.init(M, NPA, D, G, bx, WSP(const bf16, WS_WINA) + (size_t)jm * NPA * D);
            pg8::EpiBf16 E{WSP(bf16, WS_QKV), NPA, 4, attn_body::C2};
            pg8::gemm_phase<pg8::EpiBf16, pg8::DenseSched>(F.lds + RING_OFF, WSP(const bf16, WS_XB), D, S, E, F.wave); }
        else { ArgsP A = fresh_args(); FRESH_GB();
            pg8::DenseSched S; S.init(M, NPB, D, G, bx, WSP(const bf16, WS_WINB) + (size_t)jm * NPB * D);
            pg8::EpiBf16 E{WSP(bf16, WS_QKV), NPB, 4, attn_body::C2};
            pg8::gemm_phase<pg8::EpiBf16, pg8::DenseSched>(F.lds + RING_OFF, WSP(const bf16, WS_XB), D, S, E, F.wave); }
        GRID_BAR();
        }
        if (isB) {
            ArgsP A = fresh_args();
            ph_qknorm(F, WSP(const bf16, WS_QKV), FCTL() + CW_NORM + 64 * layer);
            GRID_BAR();
        }
        REPEAT(REP_P2) {
        if (!isB) {
            { FRESH_GB();
            for (int L = bx; L < 1536; L += G) {
                ArgsP A = fresh_args(); const bf16* qkv = WSP(const bf16, WS_QKV); const int wave = F.wave;
                const int b = L / 768, rem = L % 768, qblk = rem / 3, kvh = rem % 3;
                const int q0u = qblk * 64, head = kvh * 4 + (wave >> 1); const size_t rowq = (size_t)b * SEQ + q0u + 32 * (wave & 1);
                attn_body::AttnArgs a;
                a.Qw = (const attn_body::bf16*)(qkv + rowq * NPA + head * 64);
                a.K0 = (const attn_body::bf16*)(qkv + ((size_t)b * SEQ + q0u) * NPA + 1024 + kvh * 64); a.V0 = a.K0 + 192;
                a.NT = 4; a.tmax = qblk; a.Ow = (attn_body::bf16*)(WSP(bf16, WS_CAT) + rowq * D + head * 64);
                a.qrel = 32 * (wave & 1) + (fresh_tid() & 31); a.slope2 = SLOPES_A[head] * attn_body::LOG2E; a.sink2 = A->in[3][jm * 12 + head] * attn_body::LOG2E; a.wave = F.wave;
                attn_body::attn_unit<2, 8, NPA, NPA, D>(a, (char*)lds + RING_OFF);
                convert_unit(F, A, layer, L);
            }
            for (int cu = 1536 + bx; cu < CONV_UNITS; cu += G) { ArgsP A = fresh_args(); convert_unit(F, A, layer, cu); } }
            { FRESH_GB();
            for (int L = bx; L < 512; L += G) {
                ArgsP A = fresh_args(); const int wave = F.wave;
                const int b = L / 256, rem = L % 256, qb = rem >> 2, hm = rem & 3;
                const size_t rowq = (size_t)b * SEQ + qb * 256 + 32 * wave;
                attn_body::AttnArgs a;
                a.Qw = (const attn_body::bf16*)(WSP(const bf16, WS_QKV) + rowq * NPA + 768 + hm * 64);
                a.K0 = (const attn_body::bf16*)(WSP(const bf16, WS_MEMKV) + (size_t)b * MEMLEN * 2048 + layer * 512 + hm * 64); a.V0 = a.K0 + 256;
                a.NT = 4; a.tmax = 1 << 30; a.Ow = (attn_body::bf16*)(WSP(bf16, WS_CAT) + rowq * D + 768 + hm * 64);
                a.qrel = 32 * wave + (fresh_tid() & 31); a.slope2 = 0.f; a.sink2 = 0.f; a.wave = F.wave;
                attn_body::attn_unit<0, 8, NPA, 2048, D>(a, (char*)lds + RING_OFF);
            } }
        } else {
            {
                unsigned nextL = 0u;
                if (fresh_tid() == 0) nextL = __hip_atomic_fetch_add(FCTL() + CW_Q + 64 * layer + 16 * rep_, 1u, RLX_AGENT);
                for (;;) {
                    if (fresh_tid() == 0) f_misc(F)[16] = nextL;
                    __syncthreads();
                    const int Lq = __builtin_amdgcn_readfirstlane((int)f_misc(F)[16]);
                    __syncthreads();
                    if (Lq >= 1536 + CONV_UNITS) break;
                    if (fresh_tid() == 0) nextL = __hip_atomic_fetch_add(FCTL() + CW_Q + 64 * layer + 16 * rep_, 1u, RLX_AGENT);
                    ArgsP A = fresh_args(); const bf16* qkv = WSP(const bf16, WS_QKV); const int wave = F.wave;
                    const bool isconv = (Lq < 2 * 1536) ? (Lq & 1) : true; const int L = (Lq < 2 * 1536) ? (Lq >> 1) : (Lq - 1536);
                    if (isconv) { convert_unit(F, A, layer, L); continue; }
                    const int qb = 63 - L / 24, rem = L % 24, b = rem / 12, hc = rem % 12, h = hc >> 1, c = hc & 1;
                    const size_t rowq = (size_t)b * SEQ + qb * 256 + 32 * wave;
                    const float slope2 = SLOPES_B[h] * attn_body::LOG2E;
                    const float q2m = __uint_as_float(__hip_atomic_load(FCTL() + CW_NORM + 64 * layer + hc, RLX_AGENT)), k2m = __uint_as_float(__hip_atomic_load(FCTL() + CW_NORM + 64 * layer + 12 + hc, RLX_AGENT));
                    const float B2 = sqrtf(q2m * k2m) * 1.03f + 0.5f, dcut = (160.f + 2.f * B2) / slope2;
                    int t0 = (int)floorf(((float)(qb * 256 - 63) - dcut) * (1.f / 64.f)); t0 = __builtin_amdgcn_readfirstlane(t0 > 0 ? (t0 & ~1) : 0);
                    attn_body::AttnArgs a;
                    a.Qw = (const attn_body::bf16*)(qkv + rowq * NPB + hc * 64);
                    a.K0 = (const attn_body::bf16*)(qkv + ((size_t)b * SEQ + 64 * t0) * NPB + 1024 + hc * 64); a.V0 = (const attn_body::bf16*)(qkv + ((size_t)b * SEQ + 64 * t0) * NPB + 1792 + h * 128);
                    a.NT = 4 * (qb + 1) - t0; a.tmax = 1 << 30; a.Ow = (attn_body::bf16*)(WSP(bf16, WS_OTMP) + rowq * 1536 + hc * 128);
                    a.qrel = 32 * wave + (fresh_tid() & 31); a.slope2 = slope2; a.sink2 = 0.f; a.wave = F.wave;
                    attn_body::diff_unit<16, NPB, NPB, 1536>(a, (char*)lds + RING_OFF);
                }
            }
            { FRESH_GB();
            for (int L = bx; L < 512; L += G) {
                ArgsP A = fresh_args(); const int wave = F.wave;
                const int b = L / 256, rem = L % 256, qb = rem >> 2, hm = rem & 3;
                const size_t rowq = (size_t)b * SEQ + qb * 256 + 32 * wave;
                attn_body::AttnArgs a;
                a.Qw = (const attn_body::bf16*)(WSP(const bf16, WS_QKV) + rowq * NPB + 768 + hm * 64);
                a.K0 = (const attn_body::bf16*)(WSP(const bf16, WS_MEMKV) + (size_t)b * MEMLEN * 2048 + layer * 512 + hm * 64); a.V0 = a.K0 + 256;
                a.NT = 4; a.tmax = 1 << 30; a.Ow = (attn_body::bf16*)(WSP(bf16, WS_CAT) + rowq * D + 768 + hm * 64);
                a.qrel = 32 * wave + (fresh_tid() & 31); a.slope2 = 0.f; a.sink2 = 0.f; a.wave = F.wave;
                attn_body::attn_unit<0, 8, NPB, 2048, D>(a, (char*)lds + RING_OFF);
            } }
        }
        GRID_BAR();
        }
        if (isB) {
            ArgsP A = fresh_args(); FRESH_GB();
            ph_diff_combine(F, WSP(const bf16, WS_OTMP), A->in[5] + jm * 256, A->in[6] + jm * 128, 0.8f - 0.6f * expf(-0.3f * (float)layer), WSP(bf16, WS_CAT));
            GRID_BAR();
        }
        REPEAT(REP_P3) {
        {   ArgsP A = fresh_args(); FRESH_GB();
            pg8::DenseSched S; S.init(M, D, D, G, bx, WSP(const bf16, WS_WOUT) + (size_t)layer * D * D);
            pg8::EpiBf16 E{WSP(bf16, WS_Y), D, 0, 1.f};
            pg8::gemm_phase<pg8::EpiBf16, pg8::DenseSched>(F.lds + RING_OFF, WSP(const bf16, WS_CAT), D, S, E, F.wave); }
        GRID_BAR();
        }
        {   ArgsP A = fresh_args();
            if (layer == 0) ph_ln_route<true>(F, A->in[0], WSP(const bf16, WS_Y), A->in[9] + (size_t)(layer * 2) * D, A->in[10] + (size_t)(layer * 2) * D, WSP(bf16, WS_XB), WSP(const bf16, WS_WROUT) + (size_t)layer * 256 * D, A->in[12] + layer * 64, FCTL() + CW_CNT + layer * 64 * 64, WSP(int, WS_ROWTOK), WSP(float, WS_ROWGATE), WSP(float, WS_LOGIT));
            else ph_ln_route<false>(F, nullptr, WSP(const bf16, WS_Y), A->in[9] + (size_t)(layer * 2) * D, A->in[10] + (size_t)(layer * 2) * D, WSP(bf16, WS_XB), WSP(const bf16, WS_WROUT) + (size_t)layer * 256 * D, A->in[12] + layer * 64, FCTL() + CW_CNT + layer * 64 * 64, WSP(int, WS_ROWTOK), WSP(float, WS_ROWGATE), WSP(float, WS_LOGIT)); }
        GRID_BAR();
        REPEAT(REP_P7) {
        {   ArgsP A = fresh_args(); FRESH_GB();
            const int nmine = build_units<true>(F, FCTL() + CW_CNT + layer * 64 * 64, WSP(const int, WS_ROWTOK), WSP(const float, WS_ROWGATE));
            pg8::GroupSched<true> S{(const LAS int*)(F.lds + TAB_OFF) + 160, (const LAS int*)(F.lds + IDX_OFF), nmine, D, (const char*)(A->ws + WS_WEXP)};
            pg8::EpiM1 E{WSP(bf16, WS_HB), (const LAS float*)(F.lds + GATE_OFF)};
            pg8::gemm_phase<pg8::EpiM1, pg8::GroupSched<true>>(F.lds + RING_OFF, WSP(const bf16, WS_XB), D, S, E, F.wave); }
        GRID_BAR();
        }
        REPEAT(REP_P8) {
        {   ArgsP A = fresh_args(); FRESH_GB();
            const int nmine = build_units<false>(F, FCTL() + CW_CNT + layer * 64 * 64, WSP(const int, WS_ROWTOK), WSP(const float, WS_ROWGATE));
            pg8::GroupSched<false> S{(const LAS int*)(F.lds + TAB_OFF) + 160, (const LAS int*)(F.lds + IDX_OFF), nmine, HID, (const char*)(A->ws + WS_WEXP) + pg8::EXPERT_DOWN_OFF};
            pg8::EpiM2 E{WSP(unsigned char, WS_BIG), (const LAS int*)(F.lds + IDX_OFF)};
            pg8::gemm_phase<pg8::EpiM2, pg8::GroupSched<false>>(F.lds + RING_OFF, WSP(const bf16, WS_HB), HID, S, E, F.wave); }
        GRID_BAR();
        }
        {   ArgsP A = fresh_args(); FRESH_GB();
            if (layer + 1 < DEPTH) ph_combine_ln2<false>(F, A->out, WSP(const unsigned char, WS_BIG), A->in[9] + (size_t)(layer * 2 + 1) * D, A->in[10] + (size_t)(layer * 2 + 1) * D, WSP(bf16, WS_XB));
            else ph_combine_ln2<true>(F, A->out, WSP(const unsigned char, WS_BIG), A->in[9] + (size_t)(layer * 2 + 1) * D, A->in[10] + (size_t)(layer * 2 + 1) * D, WSP(bf16, WS_XB));
            }
        if (layer + 1 < DEPTH) GRID_BAR();
    }
    if (__hip_atomic_load(FCTL() + CW_BAR + XB_TMO, RLX_AGENT) != 0u) {
        __syncthreads();
        ArgsP A = fresh_args(); FRESH_GB(); float* xf = A->out;
        const float q = __builtin_nanf("");
        for (int m = f_gw(F); m < M; m += f_ngw()) { GAS f32x4* o = (GAS f32x4*)(xf + (size_t)m * D) + (fresh_tid() & 63);
#pragma unroll
            for (int j = 0; j < 4; ++j) o[64 * j] = (f32x4){q, q, q, q}; }
    }
}

extern "C" void kernel_launch(void* const* d_in, const int* in_sizes, int n_in, void* d_out, int out_size, void* d_ws, size_t ws_size, hipStream_t stream) {
    static int grid = 0;
    if (grid == 0) {
        if (n_in != 19 || in_sizes[0] != M * D || out_size != M * D || ws_size < WS_END) { fprintf(stderr, "kernel_launch: shape / workspace mismatch (n_in %d, in0 %d, out %d, ws %zu, need %zu); nothing launched\n", n_in, n_in > 0 ? in_sizes[0] : -1, out_size, ws_size, (size_t)WS_END); grid = -1; return; }
        int dev = 0, cus = 0, per_cu = 0;
        if (hipGetDevice(&dev) != hipSuccess || hipDeviceGetAttribute(&cus, hipDeviceAttributeMultiprocessorCount, dev) != hipSuccess) { grid = -1; return; }
        if (hipFuncSetAttribute((const void*)mega_fwd, hipFuncAttributeMaxDynamicSharedMemorySize, LDS_BYTES) != hipSuccess) { fprintf(stderr, "kernel_launch: hipFuncSetAttribute failed\n"); grid = -1; return; }
        if (hipOccupancyMaxActiveBlocksPerMultiprocessor(&per_cu, (const void*)mega_fwd, NWAVES * 64, LDS_BYTES) != hipSuccess || per_cu < 1) { fprintf(stderr, "kernel_launch: occupancy query reports %d\n", per_cu); }
        (void)hipGetLastError();
        grid = cus;
        if (grid != 256) { fprintf(stderr, "kernel_launch: built for 256 CUs, device has %d; nothing launched\n", cus); grid = -1; return; }
    }
    if (grid < 0) return;
    if (hipMemsetAsync((char*)d_ws + WS_CTL, 0, CTL_ZERO_BYTES, stream) != hipSuccess) return;
    Args a{};
    for (int i = 0; i < 19; ++i) a.in[i] = (const float*)d_in[i];
    a.out = (float*)d_out; a.ws = (unsigned char*)d_ws;
    hipLaunchKernelGGL(mega_fwd, dim3(grid), dim3(NWAVES * 64), LDS_BYTES, stream, a);
}
```

```cpp
#include <hip/hip_runtime.h>
#include <hip/hip_bf16.h>
#include <cstdio>
#include <cstdint>
#include <cmath>

namespace pg8 {
#define PG8_LAS __attribute__((address_space(3)))
typedef unsigned short bf16_t;
typedef short bf16x8 __attribute__((ext_vector_type(8)));
typedef float f32x4 __attribute__((ext_vector_type(4)));
typedef unsigned u32x4 __attribute__((ext_vector_type(4)));
constexpr int BM = 256, BK = 64, HALF = 128, HTB = HALF * BK * 2  , STAGE_BYTES = 8 * HTB, NXCD = 8, WGM = 8;
constexpr int EXPERT_BYTES = 3 * 1024 * 256 * 2;
constexpr int EXPERT_DOWN_OFF = 2 * 1024 * 256 * 2;

__host__ __device__ __forceinline__ int lds_byte(int r, int c) { const int st = (r >> 4) * 2 + (c >> 5), rr = r & 15, cc = c & 31, ob = rr * 64 + cc * 2; return st * 1024 + (ob ^ (((ob >> 9) & 1) << 5)); }
__host__ __device__ __forceinline__ void stage_rc(int b, int& R, int& C) { const int st = b / 1024, sb = b % 1024, swz = sb ^ (((sb >> 9) & 1) << 5); R = (st >> 1) * 16 + swz / 64; C = (st & 1) * 32 + (swz % 64) / 2; }
__host__ __device__ __forceinline__ int perm32(int rho) { const int n = rho >> 4, i = rho & 15; return 8 * (i >> 2) + 4 * n + (i & 3); }

struct Unit { int pm, pn, e, nvalid, lbase, pos0, slot; };

struct StaticOrder {
    int nM, nN, nwg, G, c;
    __device__ __forceinline__ void init(int M, int N, int G_, int c_) { nM = M / BM; nN = N / BM; nwg = nM * nN; G = G_; c = c_; }
    __device__ __forceinline__ bool next(int i, Unit& u) const {
        const long L = (long)i * G + c; if (L >= nwg) return false;
        int wgid = (int)L; { const int q = nwg / NXCD, r = nwg % NXCD, xcd = wgid % NXCD, off = wgid / NXCD; wgid = (xcd < r ? xcd * (q + 1) : r * (q + 1) + (xcd - r) * q) + off; }
        const int nig = WGM * nN, gid = wgid / nig, fm = gid * WGM, gsz = (nM - fm) < WGM ? (nM - fm) : WGM;
        u.pm = fm + ((wgid % nig) % gsz); u.pn = (wgid % nig) / gsz; return true;
    }
};
struct DenseSched {
    StaticOrder o; const char* Bt; int K;
    __device__ __forceinline__ void init(int M, int N, int K_, int G, int c, const bf16_t* Bt_) { o.init(M, N, G, c); Bt = (const char*)Bt_; K = K_; }
    __device__ __forceinline__ bool next(int i, Unit& u) const { u.e = 0; u.nvalid = 256; u.lbase = 0; u.pos0 = 0; u.slot = 0; return o.next(i, u); }
    __device__ __forceinline__ const char* bptr(const Unit& u) const { return Bt + (size_t)u.pn * (BM * 2) * K; }
    __device__ __forceinline__ void avoff(const Unit& u, int tid, unsigned (&v)[2][2]) const {
#pragma unroll
        for (int i = 0; i < 2; ++i) { int R, C; stage_rc(tid * 16 + i * 8192, R, C);
#pragma unroll
            for (int h = 0; h < 2; ++h) v[h][i] = (unsigned)((u.pm * BM + h * HALF + R) * K + C) * 2u; }
    }
};
template <bool GATHER> struct GroupSched {
    const PG8_LAS int* utab; const PG8_LAS int* idx; int nmine, K; const char* W;
    __device__ __forceinline__ bool next(int i, Unit& u) const {
        if (i >= nmine) return false; const PG8_LAS int* t = utab + i * 8;
        u.e = __builtin_amdgcn_readfirstlane(t[0]); u.pm = __builtin_amdgcn_readfirstlane(t[1]); u.pn = __builtin_amdgcn_readfirstlane(t[2]);
        u.nvalid = __builtin_amdgcn_readfirstlane(t[3]); u.lbase = __builtin_amdgcn_readfirstlane(t[4]); u.pos0 = __builtin_amdgcn_readfirstlane(t[5]); u.slot = i; return true;
    }
    __device__ __forceinline__ const char* bptr(const Unit& u) const { return W + (size_t)u.e * EXPERT_BYTES + (size_t)u.pn * (BM * 2) * K; }
    __device__ __forceinline__ void avoff(const Unit& u, int tid, unsigned (&v)[2][2]) const {
#pragma unroll
        for (int i = 0; i < 2; ++i) { int R, C; stage_rc(tid * 16 + i * 8192, R, C);
#pragma unroll
            for (int h = 0; h < 2; ++h) {
                const int row = GATHER ? idx[u.slot * 256 + h * HALF + R] : (u.pm * BM + h * HALF + R);
                v[h][i] = (unsigned)(row * K + C) * 2u; } }
    }
};

typedef float f32x2v __attribute__((ext_vector_type(2))); typedef __bf16 bf16x2v __attribute__((ext_vector_type(2)));
__device__ __forceinline__ unsigned cvt_pk_bf16(float lo, float hi) { f32x2v v = {lo, hi}; bf16x2v b = __builtin_convertvector(v, bf16x2v); return __builtin_bit_cast(unsigned, b); }

struct EpiBf16 {
    static constexpr bool PERM = true; static constexpr int NST = 16;
    bf16_t* O; int ldc; int nsc; float scale;
    __device__ __forceinline__ void operator()(const f32x4 (&acc)[2][2][4][2], const Unit& u, int wr, int wc, int fr, int fq) const {
        const int row0 = u.pm * BM + wr * 64 + fr; const int col0 = u.pn * BM + wc * 32 + 8 * fq; const float sc = (u.pn < nsc) ? scale : 1.f;
#pragma unroll
        for (int ai = 0; ai < 2; ++ai)
#pragma unroll
            for (int m = 0; m < 4; ++m) { bf16_t* rowp = O + (size_t)(row0 + ai * HALF + m * 16) * ldc + col0;
#pragma unroll
                for (int bj = 0; bj < 2; ++bj) { const f32x4 v0 = acc[ai][bj][m][0] * sc, v1 = acc[ai][bj][m][1] * sc;
                    u32x4 w; w.x = cvt_pk_bf16(v0[0], v0[1]); w.y = cvt_pk_bf16(v0[2], v0[3]); w.z = cvt_pk_bf16(v1[0], v1[1]); w.w = cvt_pk_bf16(v1[2], v1[3]);
                    *(u32x4*)(rowp + bj * HALF) = w; } }
    }
};
__device__ __forceinline__ float silu_f(float x) { return x * __builtin_amdgcn_rcpf(1.0f + __builtin_amdgcn_exp2f(-1.4426950408889634f * x)); }
struct EpiM1 {
    static constexpr bool PERM = true; static constexpr int NST = 8;
    bf16_t* H; const PG8_LAS float* lgate;
    __device__ __forceinline__ void operator()(const f32x4 (&acc)[2][2][4][2], const Unit& u, int wr, int wc, int fr, int fq) const {
        const int col0 = u.pn * HALF + wc * 32 + 8 * fq; const PG8_LAS float* lg = lgate + u.slot * 256;
#pragma unroll
        for (int ai = 0; ai < 2; ++ai)
#pragma unroll
            for (int m = 0; m < 4; ++m) { const int r = ai * HALF + wr * 64 + m * 16 + fr;
                const float g = lg[r];
                const f32x4 ga = acc[ai][0][m][0], gb = acc[ai][0][m][1], ua = acc[ai][1][m][0], ub = acc[ai][1][m][1];
                f32x4 v0, v1;
#pragma unroll
                for (int j = 0; j < 4; ++j) { v0[j] = silu_f(ga[j]) * ua[j] * g; v1[j] = silu_f(gb[j]) * ub[j] * g; }
                u32x4 w; w.x = cvt_pk_bf16(v0[0], v0[1]); w.y = cvt_pk_bf16(v0[2], v0[3]); w.z = cvt_pk_bf16(v1[0], v1[1]); w.w = cvt_pk_bf16(v1[2], v1[3]);
                *(u32x4*)(H + (size_t)(u.pm * BM + r) * 256 + col0) = w; }
    }
};
constexpr float Y8_SCALE = 16.f;
typedef unsigned u32x2e __attribute__((ext_vector_type(2)));
struct EpiM2 {
    static constexpr bool PERM = true; static constexpr int NST = 16;
    unsigned char* Y; const PG8_LAS int* ldst;
    __device__ __forceinline__ void operator()(const f32x4 (&acc)[2][2][4][2], const Unit& u, int wr, int wc, int fr, int fq) const {
        const int col0 = u.pn * BM + wc * 32 + 8 * fq; const PG8_LAS int* ld = ldst + u.slot * 256;
#pragma unroll
        for (int ai = 0; ai < 2; ++ai)
#pragma unroll
            for (int m = 0; m < 4; ++m) { const int r = ai * HALF + wr * 64 + m * 16 + fr;
                const int dst = ld[r];
                {
                    unsigned char* rowp = Y + (size_t)dst * 1024 + col0;
#pragma unroll
                    for (int bj = 0; bj < 2; ++bj) { const f32x4 v0 = acc[ai][bj][m][0] * Y8_SCALE, v1 = acc[ai][bj][m][1] * Y8_SCALE;
                        int w0 = __builtin_amdgcn_cvt_pk_fp8_f32(v0[0], v0[1], 0, false); w0 = __builtin_amdgcn_cvt_pk_fp8_f32(v0[2], v0[3], w0, true);
                        int w1 = __builtin_amdgcn_cvt_pk_fp8_f32(v1[0], v1[1], 0, false); w1 = __builtin_amdgcn_cvt_pk_fp8_f32(v1[2], v1[3], w1, true);
                        *(u32x2e*)(rowp + bj * HALF) = (u32x2e){(unsigned)w0, (unsigned)w1}; } } }
    }
};

template <class Epi, class Sched>
__device__ __forceinline__ void gemm_phase(PG8_LAS unsigned char* lds, const bf16_t* Abase, const int K, const Sched& S, const Epi& E, int wave_) {
    asm volatile("" : "+s"(wave_)); unsigned am_; asm volatile("s_mov_b32 %0, -1" : "=s"(am_));
    const int tid = (wave_ << 6) | (int)__builtin_amdgcn_mbcnt_hi(am_, __builtin_amdgcn_mbcnt_lo(am_, 0u));
    const int wid = __builtin_amdgcn_readfirstlane(tid >> 6), lane = tid & 63, wr = wid >> 2, wc = wid & 3, fr = lane & 15, fq = lane >> 4;
    const int nt = K / BK;
    unsigned voffB[2];
#pragma unroll
    for (int i = 0; i < 2; ++i) { int R, C; stage_rc(tid * 16 + i * 8192, R, C); const int Rb = Epi::PERM ? ((R & ~31) + perm32(R & 31)) : R; voffB[i] = (unsigned)(Rb * K + C) * 2u; }
    const size_t kstep = (size_t)(BK * 2);
    const size_t hstep = (size_t)HALF * K * 2;
    const unsigned ldsw = (unsigned)wid * 1024u;
    const int aoff = lds_byte(wr * 64 + fr, fq * 8), boff = lds_byte(wc * 32 + fr, fq * 8);
    const char* Ab = (const char*)Abase;
#define PG8_SA(b, h) (((b) * 2 + (h)) * HTB)
#define PG8_SB(b, h) ((4 + (b) * 2 + (h)) * HTB)
#define PG8_STAGE(bufoff, gbase, voff) do { _Pragma("unroll") for (int _i = 0; _i < 2; ++_i) \
        __builtin_amdgcn_global_load_lds((const unsigned*)((const char*)(gbase) + (voff)[_i]), (PG8_LAS unsigned*)(lds + (bufoff) + ldsw + _i * 8192), 16, 0, 0); } while (0)
#define PG8_STAGEA(bufoff, kb, V, h) do { _Pragma("unroll") for (int _i = 0; _i < 2; ++_i) \
        __builtin_amdgcn_global_load_lds((const unsigned*)(Ab + (kb) + (V)[h][_i]), (PG8_LAS unsigned*)(lds + (bufoff) + ldsw + _i * 8192), 16, 0, 0); } while (0)
#define PG8_LDA(dst, b, h) do { _Pragma("unroll") for (int m = 0; m < 4; ++m) _Pragma("unroll") for (int k = 0; k < 2; ++k) dst[m][k] = *(const PG8_LAS bf16x8*)(lds + PG8_SA(b, h) + aoff + m * 2048 + k * 1024); } while (0)
#define PG8_LDB(dst, b, h) do { _Pragma("unroll") for (int n = 0; n < 2; ++n) _Pragma("unroll") for (int k = 0; k < 2; ++k) dst[n][k] = *(const PG8_LAS bf16x8*)(lds + PG8_SB(b, h) + boff + n * 2048 + k * 1024); } while (0)
#define PG8_MMA(ai, bj, At, Bt) do { __builtin_amdgcn_s_setprio(1); _Pragma("unroll") for (int m = 0; m < 4; ++m) _Pragma("unroll") for (int n = 0; n < 2; ++n) _Pragma("unroll") for (int k = 0; k < 2; ++k) \
        acc[ai][bj][m][n] = __builtin_amdgcn_mfma_f32_16x16x32_bf16(Bt[n][k], At[m][k], acc[ai][bj][m][n], 0, 0, 0); __builtin_amdgcn_s_setprio(0); } while (0)
#define PG8_WAIT_V(n) asm volatile("s_waitcnt vmcnt(" #n ")" ::: "memory")
#define PG8_WAIT_VR(rl) do { if (rl) asm volatile("s_waitcnt vmcnt(%0)" :: "n"(8 + Epi::NST) : "memory"); else asm volatile("s_waitcnt vmcnt(8)" ::: "memory"); } while (0)
#define PG8_WAIT_L(n) asm volatile("s_waitcnt lgkmcnt(" #n ")" ::: "memory")
#define PG8_BAR __builtin_amdgcn_s_barrier()
#define PG8_SCHED __builtin_amdgcn_sched_barrier(0)
    Unit cur, nxt; int ui = 0;
    if (!S.next(0, cur)) return;
    nxt = cur;
    f32x4 acc[2][2][4][2];
#pragma unroll
    for (int a = 0; a < 2; ++a)
#pragma unroll
        for (int b = 0; b < 2; ++b)
#pragma unroll
            for (int m = 0; m < 4; ++m)
#pragma unroll
                for (int n = 0; n < 2; ++n) acc[a][b][m][n] = (f32x4){0.f, 0.f, 0.f, 0.f};
    bf16x8 At[4][2], B0[2][2], B1[2][2];
    unsigned vA[2][2];
    S.avoff(cur, tid, vA);
    const char* cB = S.bptr(cur);
    PG8_STAGE(PG8_SB(0, 0), cB, voffB); PG8_STAGE(PG8_SB(0, 1), cB + hstep, voffB); PG8_STAGEA(PG8_SA(0, 0), 0, vA, 0); PG8_STAGEA(PG8_SA(0, 1), 0, vA, 1);
    if (wr == 1) PG8_BAR;
    PG8_WAIT_V(2); PG8_BAR;
    PG8_STAGE(PG8_SB(1, 0), cB + kstep, voffB); PG8_STAGEA(PG8_SA(1, 0), kstep, vA, 0); PG8_STAGE(PG8_SB(1, 1), cB + hstep + kstep, voffB);
    PG8_WAIT_V(6); PG8_BAR;
    bool relax = false;
    for (;;) {
        const bool has_next = S.next(ui + 1, nxt);
        const char* nB = cB;
        if (has_next) nB = S.bptr(nxt);
#pragma unroll 1
        for (int t = 0; t < nt; t += 2) {
            const bool last = (t == nt - 2); const bool rl = relax && (t == 0);
            const size_t kb1 = (size_t)(t + 1) * kstep;
            const size_t kb2 = last ? (size_t)0 : (size_t)(t + 2) * kstep; const char* b2 = last ? nB : cB + (size_t)(t + 2) * kstep;
            const size_t kb3 = kb2 + kstep; const char* b3 = b2 + kstep;
            PG8_LDB(B0, 0, 0); PG8_LDB(B1, 0, 1); PG8_SCHED; PG8_LDA(At, 0, 0); if (!rl) PG8_STAGEA(PG8_SA(1, 1), kb1, vA, 1);
            if (last && has_next) S.avoff(nxt, tid, vA);
            PG8_WAIT_VR(rl); PG8_WAIT_L(0); PG8_BAR; PG8_MMA(0, 0, At, B0); PG8_MMA(0, 1, At, B1); PG8_BAR; PG8_SCHED;
            PG8_LDA(At, 0, 1); PG8_STAGE(PG8_SB(0, 0), b2, voffB); PG8_STAGE(PG8_SB(0, 1), b2 + hstep, voffB); PG8_STAGEA(PG8_SA(0, 0), kb2, vA, 0);
            PG8_WAIT_VR(rl); PG8_WAIT_L(0); PG8_BAR; PG8_MMA(1, 0, At, B0); PG8_MMA(1, 1, At, B1); PG8_BAR; PG8_SCHED;
            PG8_LDB(B0, 1, 0); PG8_LDB(B1, 1, 1); PG8_SCHED; PG8_LDA(At, 1, 0); PG8_STAGEA(PG8_SA(0, 1), kb2, vA, 1);
            PG8_WAIT_VR(rl); PG8_WAIT_L(0); PG8_BAR; PG8_MMA(0, 0, At, B0); PG8_MMA(0, 1, At, B1); PG8_BAR; PG8_SCHED;
            PG8_LDA(At, 1, 1); PG8_STAGE(PG8_SB(1, 0), b3, voffB); PG8_STAGE(PG8_SB(1, 1), b3 + hstep, voffB); PG8_STAGEA(PG8_SA(1, 0), kb3, vA, 0);
            PG8_WAIT_V(8); PG8_WAIT_L(0); PG8_BAR; PG8_MMA(1, 0, At, B0); PG8_MMA(1, 1, At, B1); PG8_BAR; PG8_SCHED;
        }
        if (wr == 0) PG8_BAR;
        if (has_next) PG8_STAGEA(PG8_SA(1, 1), kstep, vA, 1);
        E(acc, cur, wr, wc, fr, fq);
        if (!has_next) break;
#pragma unroll
        for (int a = 0; a < 2; ++a)
#pragma unroll
            for (int b = 0; b < 2; ++b)
#pragma unroll
                for (int m = 0; m < 4; ++m)
#pragma unroll
                    for (int n = 0; n < 2; ++n) acc[a][b][m][n] = (f32x4){0.f, 0.f, 0.f, 0.f};
        cur = nxt; cB = nB; ++ui; relax = true;
        if (wr == 1) PG8_BAR;
    }
    PG8_WAIT_V(0);
    PG8_BAR;
#undef PG8_SA
#undef PG8_SB
#undef PG8_STAGE
#undef PG8_STAGEA
#undef PG8_LDA
#undef PG8_LDB
#undef PG8_MMA
#undef PG8_WAIT_V
#undef PG8_WAIT_VR
#undef PG8_WAIT_L
#undef PG8_BAR
#undef PG8_SCHED
}
}
namespace attn_body {
using bf16=__hip_bfloat16;
using bf16x8=__attribute__((ext_vector_type(8)))short;
using s16x4=__attribute__((ext_vector_type(4)))short;
using f32x16=__attribute__((ext_vector_type(16)))float;
using u32x4=__attribute__((ext_vector_type(4)))unsigned;
constexpr int D=64,NW=8,QBLK=32,QB=QBLK*NW,KVBLK=64;
__device__ __forceinline__ int crow(int r,int hi){return (r&3)+8*(r>>2)+4*hi;}
#define SBAR() __builtin_amdgcn_sched_barrier(0)
constexpr int NSLOT=3, SLOTB=8192;
constexpr int LDS_K=0, LDS_V=NSLOT*SLOTB, LDS_WS=2*NSLOT*SLOTB, LDS_OST=LDS_WS+NW*64*4, LDS_BYTES=LDS_OST+NW*4096;
constexpr float LOG2E=1.4426950408889634f;
constexpr float C2=0.125f*LOG2E;
__device__ __forceinline__ void glds16(const void*gsrc,unsigned lds_dst){unsigned keep;
  asm volatile("s_mov_b32 %0, m0\n\ts_mov_b32 m0, %2\n\ts_nop 0\n\tglobal_load_lds_dwordx4 %1, off\n\ts_mov_b32 m0, %0":"=&s"(keep):"v"(gsrc),"s"(lds_dst):"memory");}
__device__ __forceinline__ float max3f(float a,float b,float c){float r;asm("v_max3_f32 %0, %1, %2, %3":"=v"(r):"v"(a),"v"(b),"v"(c));return r;}
__device__ __forceinline__ float max2f(float a,float b){float r;asm("v_max_f32_e32 %0, %1, %2":"=v"(r):"v"(a),"v"(b));return r;}
__device__ __forceinline__ float fadd_s(float a,float b){float r;asm("v_add_f32_e32 %0, %1, %2":"=v"(r):"v"(a),"v"(b));return r;}
__device__ __forceinline__ float fsub_s(float a,float b){float r;asm("v_sub_f32_e32 %0, %1, %2":"=v"(r):"v"(a),"v"(b));return r;}
typedef float f32x2_t __attribute__((ext_vector_type(2))); typedef __bf16 bf16x2_t __attribute__((ext_vector_type(2)));
__device__ __forceinline__ unsigned cvtpk_s(float lo,float hi){f32x2_t v={lo,hi};bf16x2_t b=__builtin_convertvector(v,bf16x2_t);return __builtin_bit_cast(unsigned,b);}
#define WAIT_BAR(N) asm volatile("s_waitcnt vmcnt(" #N ") lgkmcnt(0)\n\ts_barrier":::"memory")

template<int MODE> __device__ __forceinline__ void maskbias(f32x16&p0,f32x16&p1,int kb,int qrel,float slope2,float mhat,bool band,bool tile_ok){
  if(MODE==0)return;
  const float NEG=-INFINITY; const float lb=slope2*(float)(kb-qrel)-mhat;
  #pragma unroll
  for(int r=0;r<16;++r){const int c=(r&3)+8*(r>>2); p0[r]=__builtin_fmaf(slope2,(float)c,p0[r]+lb); p1[r]=__builtin_fmaf(slope2,(float)(c+32),p1[r]+lb);}
  if(MODE==1){ if(band){
    #pragma unroll
    for(int r=0;r<16;++r){const int kv=kb+(r&3)+8*(r>>2); if(kv>qrel)p0[r]=NEG; if(kv+32>qrel)p1[r]=NEG;} } }
  if(MODE==2){
    #pragma unroll
    for(int r=0;r<16;++r){const int d=qrel-kb-((r&3)+8*(r>>2)); if((unsigned)d>=128u||!tile_ok)p0[r]=NEG; if((unsigned)(d-32)>=128u||!tile_ok)p1[r]=NEG;} }
}

__device__ __forceinline__ void qkt(f32x16&p0,f32x16&p1,const char*Kslot,const bf16x8*qr,const f32x16&negm,int r32,int hi){
  const char*kb=Kslot+hi*1024+r32*16;
  #pragma unroll
  for(int d0=0;d0<4;++d0){
    const bf16x8 b0=*reinterpret_cast<const bf16x8*>(kb+d0*2048);
    const bf16x8 b1=*reinterpret_cast<const bf16x8*>(kb+d0*2048+512);
    if(d0==0){p0=__builtin_amdgcn_mfma_f32_32x32x16_bf16(b0,qr[0],negm,0,0,0);p1=__builtin_amdgcn_mfma_f32_32x32x16_bf16(b1,qr[0],negm,0,0,0);}
    else{p0=__builtin_amdgcn_mfma_f32_32x32x16_bf16(b0,qr[d0],p0,0,0,0);p1=__builtin_amdgcn_mfma_f32_32x32x16_bf16(b1,qr[d0],p1,0,0,0);}}
}
template<int C> __device__ __forceinline__ float fmamk_c(float a,float b){float d;asm("v_fmamk_f32 %0, %1, %2, %3":"=v"(d):"v"(a),"n"(__builtin_bit_cast(int,(float)C)),"v"(b));return d;}
typedef __attribute__((address_space(3))) const char* lds_cptr;
typedef short v4i16_t __attribute__((ext_vector_type(4)));
__device__ __forceinline__ void kload8(bf16x8*kf,lds_cptr kp){
  kf[0]=*(const __attribute__((address_space(3))) bf16x8*)(kp);      kf[1]=*(const __attribute__((address_space(3))) bf16x8*)(kp+512);
  kf[2]=*(const __attribute__((address_space(3))) bf16x8*)(kp+2048); kf[3]=*(const __attribute__((address_space(3))) bf16x8*)(kp+2560);
  kf[4]=*(const __attribute__((address_space(3))) bf16x8*)(kp+4096); kf[5]=*(const __attribute__((address_space(3))) bf16x8*)(kp+4608);
  kf[6]=*(const __attribute__((address_space(3))) bf16x8*)(kp+6144); kf[7]=*(const __attribute__((address_space(3))) bf16x8*)(kp+6656);
}
__device__ __forceinline__ void kload2(bf16x8*kf,lds_cptr kp,int j){ kf[2*j]=*(const __attribute__((address_space(3))) bf16x8*)(kp+j*2048); kf[2*j+1]=*(const __attribute__((address_space(3))) bf16x8*)(kp+j*2048+512); }
__device__ __forceinline__ s16x4 vtr(lds_cptr p){ return __builtin_bit_cast(s16x4,__builtin_amdgcn_ds_read_tr16_b64_v4i16((__attribute__((address_space(3))) v4i16_t*)p)); }
__device__ __forceinline__ float rowmax(const f32x16&p0,const f32x16&p1){
  float a=max3f(p0[0],p0[1],p1[0]),b=max3f(p0[2],p0[3],p1[1]);a=max3f(a,p1[2],p1[3]);
  #pragma unroll
  for(int r=4;r<16;r+=4){a=max3f(a,p0[r],p0[r+1]);b=max3f(b,p0[r+2],p0[r+3]);a=max3f(a,p1[r],p1[r+1]);b=max3f(b,p1[r+2],p1[r+3]);}
  const float m=max2f(a,b);
  auto rr=__builtin_amdgcn_permlane32_swap(__float_as_uint(m),__float_as_uint(m),false,false);
  return max2f(__uint_as_float(rr[0]),__uint_as_float(rr[1]));
}
__device__ __forceinline__ void pv(f32x16*o,int vb,bf16x8 pa0,bf16x8 pa1,bf16x8 pa2,bf16x8 pa3){
  #pragma unroll
  for(int d0=0;d0<2;++d0){s16x4 lo[4],hi[4];
    #pragma unroll
    for(int ks=0;ks<4;++ks){
      asm volatile("ds_read_b64_tr_b16 %0,%1 offset:%c2":"=&v"(lo[ks]):"v"(vb),"i"(d0*4096+ks*1024):"memory");
      asm volatile("ds_read_b64_tr_b16 %0,%1 offset:%c2":"=&v"(hi[ks]):"v"(vb),"i"(d0*4096+ks*1024+512):"memory");}
    asm volatile("s_waitcnt lgkmcnt(0)":::"memory");SBAR();
    #define PK(k) (bf16x8){lo[k][0],lo[k][1],lo[k][2],lo[k][3],hi[k][0],hi[k][1],hi[k][2],hi[k][3]}
    o[d0]=__builtin_amdgcn_mfma_f32_32x32x16_bf16(pa0,PK(0),o[d0],0,0,0);
    o[d0]=__builtin_amdgcn_mfma_f32_32x32x16_bf16(pa1,PK(1),o[d0],0,0,0);
    o[d0]=__builtin_amdgcn_mfma_f32_32x32x16_bf16(pa2,PK(2),o[d0],0,0,0);
    o[d0]=__builtin_amdgcn_mfma_f32_32x32x16_bf16(pa3,PK(3),o[d0],0,0,0);
    #undef PK
  }
}
struct AttnArgs {
  const bf16* Qw;
  const bf16* K0; const bf16* V0;
  int NT;
  int tmax;
  bf16* Ow;
  int qrel;
  float slope2, sink2;
  int wave;
};
#define ATTN_STORE16(p,v) (*(u32x4*)(p)=(v))
template<int MODE,int THRL,int QP,int KVP,int OP> __device__ __forceinline__ void attn_unit(const AttnArgs&a,char*shm){
  unsigned am_; asm volatile("s_mov_b32 %0, -1":"=s"(am_)); const int lane=(int)__builtin_amdgcn_mbcnt_hi(am_,__builtin_amdgcn_mbcnt_lo(am_,0u)),r32=lane&31,hi=lane>>5; const int wid=a.wave;
  const bf16*Qw=a.Qw; constexpr int qp=QP; constexpr long kvp=KVP;
  const unsigned lds0=(unsigned)(uintptr_t)shm;
  float*wsf=(float*)(shm+LDS_WS)+wid*64;
  const bf16*ksrc=a.K0+(long)lane*kvp+wid*8;
  const bf16*vsrc=a.V0+(long)(16*(wid&3)+(lane>>2))*kvp+(wid>>2)*32+(lane&3)*8;
  const unsigned kdst=lds0+LDS_K+wid*1024, vdst=lds0+LDS_V+wid*1024;
  const int tmax=a.tmax;
  #define TROW(t) ((MODE==2)?(-64*(((t)<tmax)?(t):tmax)):(64*(t)))
  #define DMA_K(t,slot) glds16(ksrc+(long)TROW(t)*kvp,(unsigned)__builtin_amdgcn_readfirstlane(kdst+(slot)))
  #define DMA_V(t,slot) glds16(vsrc+(long)TROW(t)*kvp,(unsigned)__builtin_amdgcn_readfirstlane(vdst+(slot)))
  const int vb0=(int)(lds0+LDS_V)+((lane>>4)&1)*32+(lane&3)*8+(4*hi+((lane&15)>>2))*64;
  const char*Kbase=shm+LDS_K; bf16x8 kf[8];
  const lds_cptr shm3=(lds_cptr)shm; const lds_cptr kp0=shm3+LDS_K+hi*1024+r32*16; const lds_cptr vp0=shm3+LDS_V+((lane>>4)&1)*32+(lane&3)*8+(4*hi+((lane&15)>>2))*64;
  const int NT=a.NT;
  DMA_K(0,0);DMA_V(0,0);DMA_K(1,SLOTB);
  bf16x8 qr[4];
  #pragma unroll
  for(int d0=0;d0<4;++d0)qr[d0]=*reinterpret_cast<const bf16x8*>(&Qw[(long)r32*qp+d0*16+hi*8]);
  float z0_; asm volatile("v_mov_b32 %0, 0":"=v"(z0_));
  f32x16 zv_; _Pragma("unroll") for(int r=0;r<16;++r)zv_[r]=z0_;
  float mhat=0.f,l_reg=0.f;f32x16 o[2];o[0]=zv_;o[1]=zv_;f32x16 negm=zv_;if(MODE==0)asm volatile("":"+v"(negm));
  const int qrel=a.qrel; const float slope2=a.slope2;
  #define KBREL(t) ((MODE==2)?(-64*(t)):(64*((t)-(NT-4))))
  #define MBIAS(P0,P1,t,BAND) maskbias<MODE>(P0,P1,KBREL(t)+4*hi,qrel,slope2,mhat,(BAND)&&((t)>=NT-4),(t)<=tmax)
  #define CINIT ((MODE==0)?negm:(f32x16{}))
  #define CMASK(P0,P1,t) MBIAS(P0,P1,t,true)
  bool resc=false;
  #define START(P0,P1) do{ const float rm=rowmax(P0,P1); resc=false; \
    { const float dl=rm; mhat=fadd_s(mhat,dl); \
      _Pragma("unroll") for(int r=0;r<16;++r){P0[r]=fsub_s(P0[r],dl);P1[r]=fsub_s(P1[r],dl);} \
      if(MODE==0){ _Pragma("unroll") for(int r=0;r<16;++r)negm[r]=-mhat; asm volatile("":"+v"(negm)); } } \
    _Pragma("unroll") for(int r=0;r<16;++r)P0[r]=__builtin_amdgcn_exp2f(P0[r]); }while(0)
  #define RESC() do{ if(resc){ asm volatile("s_waitcnt lgkmcnt(0)":::"memory"); \
      _Pragma("unroll") for(int d_=0;d_<2;++d_) _Pragma("unroll") for(int r=0;r<16;++r)o[d_][r]*=wsf[crow(r,hi)]; } }while(0)
  f32x16 pA0,pA1,pB0,pB1;
  int sl_prev=0,sl_cur=0,sl_next=SLOTB;
  #define ROT() do{sl_prev=sl_cur;sl_cur=sl_next;sl_next=(sl_next==(NSLOT-1)*SLOTB)?0:sl_next+SLOTB;}while(0)
  DMA_K(2,2*SLOTB);
  WAIT_BAR(3);
  qkt(pA0,pA1,Kbase,qr,negm,r32,hi);asm volatile("s_nop 15\n\ts_nop 7":"+v"(pA0),"+v"(pA1));CMASK(pA0,pA1,0);
  START(pA0,pA1);
  _Pragma("unroll") for(int r=0;r<16;++r)pA1[r]=__builtin_amdgcn_exp2f(pA1[r]);
  WAIT_BAR(0);
  DMA_K(3,0);DMA_V(1,SLOTB);
  ROT();
  kload8(kf,kp0+sl_cur);
  WAIT_BAR(2);
  s16x4 vlo[8],vhi[8]; u32x4 pw0,pw1,pw2,pw3;
  #define PKW(P,B) cvtpk_s(P[B],P[B+1])
  #define PAF(k) __builtin_bit_cast(bf16x8,pw##k)
  #define VFR(i) (bf16x8){vlo[i][0],vlo[i][1],vlo[i][2],vlo[i][3],vhi[i][0],vhi[i][1],vhi[i][2],vhi[i][3]}
  #define PIN(x) asm volatile("":"+v"(x))
  #define MX3(a,b,c) __builtin_fmaxf(__builtin_fmaxf((a),(b)),(c))
  #define GAPA(MF,A0,A1,A2,A3,W0,W1,PW) do{ MF; sacc+=A0; sacc+=A1; sacc+=A2; sacc+=A3; PIN(sacc); W0; W1; PIN(PW); SBAR(); }while(0)
  #define EX(v) __builtin_amdgcn_exp2f(v)
  #define GAPB(MF,X,B) do{ MF; X[B]=EX(X[B]); X[B+1]=EX(X[B+1]); X[B+2]=EX(X[B+2]); X[B+3]=EX(X[B+3]); PIN(X); SBAR(); }while(0)
  #define VRD(i) do{ vlo[i]=vtr(vp_+(((i)>>2)*4096+((i)&3)*1024)); vhi[i]=vtr(vp_+(((i)>>2)*4096+((i)&3)*1024+512)); }while(0)
  #define KRD(G,j) do{ if(G){ kload2(kf,kp0+sl_next,j); SBAR(); } }while(0)
  #define STEP(C0,C1,P0,P1,t,GK,GV,GL) do{ SBAR(); \
    const lds_cptr vp_=vp0+sl_prev; \
    VRD(0); SBAR(); float sacc=(P0[0]+P0[1]); \
    GAPA(C0=__builtin_amdgcn_mfma_f32_32x32x16_bf16(kf[0],qr[0],CINIT,0,0,0), P0[2],P0[3],P0[4],P0[5],     pw0[0]=PKW(P0,0), pw0[1]=PKW(P0,2), pw0); \
    VRD(4); SBAR(); GAPA(C1=__builtin_amdgcn_mfma_f32_32x32x16_bf16(kf[1],qr[0],CINIT,0,0,0), P0[6],P0[7],P0[8],P0[9],     pw0[2]=PKW(P0,4), pw0[3]=PKW(P0,6), pw0); \
    VRD(1); SBAR(); GAPA(C0=__builtin_amdgcn_mfma_f32_32x32x16_bf16(kf[2],qr[1],C0,0,0,0),   P0[10],P0[11],P0[12],P0[13], pw1[0]=PKW(P0,8), pw1[1]=PKW(P0,10), pw1); \
    VRD(5); SBAR(); GAPA(C1=__builtin_amdgcn_mfma_f32_32x32x16_bf16(kf[3],qr[1],C1,0,0,0),   P0[14],P0[15],P1[0],P1[1],   pw1[2]=PKW(P0,12),pw1[3]=PKW(P0,14), pw1); \
    VRD(2); SBAR(); GAPA(C0=__builtin_amdgcn_mfma_f32_32x32x16_bf16(kf[4],qr[2],C0,0,0,0),   P1[2],P1[3],P1[4],P1[5],     pw2[0]=PKW(P1,0), pw2[1]=PKW(P1,2), pw2); \
    VRD(6); SBAR(); GAPA(C1=__builtin_amdgcn_mfma_f32_32x32x16_bf16(kf[5],qr[2],C1,0,0,0),   P1[6],P1[7],P1[8],P1[9],     pw2[2]=PKW(P1,4), pw2[3]=PKW(P1,6), pw2); \
    VRD(3); SBAR(); GAPA(C0=__builtin_amdgcn_mfma_f32_32x32x16_bf16(kf[6],qr[3],C0,0,0,0),   P1[10],P1[11],P1[12],P1[13], pw3[0]=PKW(P1,8), pw3[1]=PKW(P1,10), pw3); \
    VRD(7); SBAR(); GAPA(C1=__builtin_amdgcn_mfma_f32_32x32x16_bf16(kf[7],qr[3],C1,0,0,0),   P1[14],P1[15],0.f,0.f,       pw3[2]=PKW(P1,12),pw3[3]=PKW(P1,14), pw3); \
    l_reg+=sacc; \
    if(GK){DMA_K((t)+3,sl_cur);} if(GV){DMA_V((t)+1,sl_next);} \
    CMASK(C0,C1,t); \
    { float a_=MX3(C0[0],C0[1],C1[0]),b_=MX3(C0[2],C0[3],C1[1]); a_=MX3(a_,C1[2],C1[3]); \
      _Pragma("unroll") for(int r=4;r<16;r+=4){a_=MX3(a_,C0[r],C0[r+1]);b_=MX3(b_,C0[r+2],C0[r+3]);a_=MX3(a_,C1[r],C1[r+1]);b_=MX3(b_,C1[r+2],C1[r+3]);} \
      float rm=__builtin_fmaxf(a_,b_); { auto rr=__builtin_amdgcn_permlane32_swap(__float_as_uint(rm),__float_as_uint(rm),false,false); rm=__builtin_fmaxf(__uint_as_float(rr[0]),__uint_as_float(rr[1])); } \
      resc=false; \
      if(__builtin_expect(__any(rm>(float)THRL),0)){ const float dl=__builtin_fmaxf(rm,0.f); mhat+=dl; \
        _Pragma("unroll") for(int r=0;r<16;++r){C0[r]-=dl;C1[r]-=dl;} \
        if(MODE==0){ _Pragma("unroll") for(int r=0;r<16;++r)negm[r]=-mhat; asm volatile("":"+v"(negm)); } \
        const float f=__builtin_amdgcn_exp2f(-dl); l_reg*=f; if(hi==0)wsf[r32]=f; resc=true; } } \
    SBAR(); \
    GAPB(o[0]=__builtin_amdgcn_mfma_f32_32x32x16_bf16(PAF(0),VFR(0),o[0],0,0,0), C0,0); \
    GAPB(o[1]=__builtin_amdgcn_mfma_f32_32x32x16_bf16(PAF(0),VFR(4),o[1],0,0,0), C0,4); \
    KRD(GL,0); GAPB(o[0]=__builtin_amdgcn_mfma_f32_32x32x16_bf16(PAF(1),VFR(1),o[0],0,0,0), C0,8); \
    KRD(GL,1); GAPB(o[1]=__builtin_amdgcn_mfma_f32_32x32x16_bf16(PAF(1),VFR(5),o[1],0,0,0), C0,12); \
    KRD(GL,2); GAPB(o[0]=__builtin_amdgcn_mfma_f32_32x32x16_bf16(PAF(2),VFR(2),o[0],0,0,0), C1,0); \
    KRD(GL,3); GAPB(o[1]=__builtin_amdgcn_mfma_f32_32x32x16_bf16(PAF(2),VFR(6),o[1],0,0,0), C1,4); \
    GAPB(o[0]=__builtin_amdgcn_mfma_f32_32x32x16_bf16(PAF(3),VFR(3),o[0],0,0,0), C1,8); \
    GAPB(o[1]=__builtin_amdgcn_mfma_f32_32x32x16_bf16(PAF(3),VFR(7),o[1],0,0,0), C1,12); \
    }while(0)
  int t=1;
  #undef CMASK
  #define CMASK(P0,P1,t) MBIAS(P0,P1,t,false)
  for(;t+5<NT;t+=2){
    STEP(pB0,pB1,pA0,pA1,t,true,true,true);     WAIT_BAR(2); RESC(); ROT();
    STEP(pA0,pA1,pB0,pB1,t+1,true,true,true);   WAIT_BAR(2); RESC(); ROT();
  }
  #undef CMASK
  #define CMASK(P0,P1,t) MBIAS(P0,P1,t,true)
  #define ENDW(tt) do{ if((tt)+3<NT){WAIT_BAR(2);} else if((tt)+2<NT){WAIT_BAR(1);} else {WAIT_BAR(0);} }while(0)
  for(;t+1<NT;t+=2){
    STEP(pB0,pB1,pA0,pA1,t,(t+3<NT),(t+1<NT),(t+1<NT));       ENDW(t);   RESC(); ROT();
    STEP(pA0,pA1,pB0,pB1,t+1,(t+4<NT),(t+2<NT),(t+2<NT));     ENDW(t+1); RESC(); ROT();
  }
  STEP(pB0,pB1,pA0,pA1,NT-1,false,false,false); RESC();
  { float sacc=pB0[0]+pB0[1]; _Pragma("unroll") for(int r=2;r<16;++r)sacc+=pB0[r]; _Pragma("unroll") for(int r=0;r<16;++r)sacc+=pB1[r]; l_reg+=sacc;
    pw0=(u32x4){PKW(pB0,0),PKW(pB0,2),PKW(pB0,4),PKW(pB0,6)};pw1=(u32x4){PKW(pB0,8),PKW(pB0,10),PKW(pB0,12),PKW(pB0,14)};pw2=(u32x4){PKW(pB1,0),PKW(pB1,2),PKW(pB1,4),PKW(pB1,6)};pw3=(u32x4){PKW(pB1,8),PKW(pB1,10),PKW(pB1,12),PKW(pB1,14)};
    SBAR(); pv(o,vb0+sl_cur,PAF(0),PAF(1),PAF(2),PAF(3)); }
  #undef PKW
  #undef PAF
  #undef VFR
  #undef PIN
  #undef MX3
  #undef GAPA
  #undef GAPB
  #undef EX
  #undef VRD
  #undef KRD
  #undef STEP
  #undef ENDW
  {auto rr=__builtin_amdgcn_permlane32_swap(__float_as_uint(l_reg),__float_as_uint(l_reg),false,false);l_reg=__uint_as_float(rr[0])+__uint_as_float(rr[1]);}
  if(MODE==2)l_reg+=__builtin_amdgcn_exp2f(a.sink2-mhat);
  if(hi==0)wsf[32+r32]=l_reg;asm volatile("s_waitcnt lgkmcnt(0)":::"memory");
  float rli[16];
  #pragma unroll
  for(int r=0;r<16;++r)rli[r]=__builtin_amdgcn_rcpf(wsf[32+crow(r,hi)]);
  bf16*Ow=a.Ow; constexpr long op=OP;
  { bf16*stg=(bf16*)(shm+LDS_OST)+wid*2048;
    #pragma unroll
    for(int r=0;r<16;++r){const int orow=crow(r,hi);
      #pragma unroll
      for(int d0=0;d0<2;++d0)stg[orow*64+d0*32+r32]=__float2bfloat16(o[d0][r]*rli[r]);}
    asm volatile("s_waitcnt lgkmcnt(0)":::"memory");
    #pragma unroll
    for(int i=0;i<4;++i){const int row=i*8+(lane>>3),ch=lane&7; const u32x4 v=*(const u32x4*)(stg+row*64+ch*8); ATTN_STORE16(Ow+(long)row*op+ch*8,v);} }
  asm volatile("s_waitcnt lgkmcnt(0)\n\ts_barrier":::"memory");
  #undef DMA_K
  #undef DMA_V
  #undef TROW
  #undef KBREL
  #undef MBIAS
  #undef CINIT
  #undef CMASK
  #undef START
  #undef RESC
  #undef ROT
}

constexpr int DP_K=0, DP_V=3*8192, DP_WS=DP_V+3*16384, DP_BYTES=DP_WS+NW*256;
template<int THRL,int QP,int KVP,int OP> __device__ __forceinline__ void diff_unit(const AttnArgs&a,char*shm){
  unsigned am_; asm volatile("s_mov_b32 %0, -1":"=s"(am_)); const int lane=(int)__builtin_amdgcn_mbcnt_hi(am_,__builtin_amdgcn_mbcnt_lo(am_,0u)),r32=lane&31,hi=lane>>5; const int wid=a.wave;
  const bf16*Qw=a.Qw; constexpr int qp=QP; constexpr long kvp=KVP;
  const unsigned lds0=(unsigned)(uintptr_t)shm;
  float*wsf=(float*)(shm+DP_WS)+wid*64;
  const bf16*ksrc=a.K0+(long)lane*kvp+wid*8;
  const bf16*vsrc=a.V0+(long)(16*(wid&3)+(lane>>2))*kvp+(wid>>2)*32+(lane&3)*8;
  const unsigned kdst=lds0+DP_K+wid*1024, vdst=lds0+DP_V+wid*1024;
  #define DMA_K(t,slot) glds16(ksrc+(long)(64*(t))*kvp,(unsigned)__builtin_amdgcn_readfirstlane(kdst+(slot)))
  #define DMA_V(t,slot) do{ glds16(vsrc+(long)(64*(t))*kvp,(unsigned)__builtin_amdgcn_readfirstlane(vdst+2*(slot))); glds16(vsrc+(long)(64*(t))*kvp+64,(unsigned)__builtin_amdgcn_readfirstlane(vdst+2*(slot)+8192)); }while(0)
  const int vb0=(int)(lds0+DP_V)+((lane>>4)&1)*32+(lane&3)*8+(4*hi+((lane&15)>>2))*64;
  const char*Kbase=shm+DP_K; bf16x8 kf[8];
  const lds_cptr shm3=(lds_cptr)shm; const lds_cptr kp0=shm3+DP_K+hi*1024+r32*16; const lds_cptr vp0=shm3+DP_V+((lane>>4)&1)*32+(lane&3)*8+(4*hi+((lane&15)>>2))*64;
  const int NT=a.NT;
  DMA_K(0,0);DMA_V(0,0);DMA_K(1,SLOTB);
  bf16x8 qr[4];
  #pragma unroll
  for(int d0=0;d0<4;++d0)qr[d0]=*reinterpret_cast<const bf16x8*>(&Qw[(long)r32*qp+d0*16+hi*8]);
  float z0_; asm volatile("v_mov_b32 %0, 0":"=v"(z0_));
  f32x16 zv_; _Pragma("unroll") for(int r=0;r<16;++r)zv_[r]=z0_;
  float mhat=0.f,l_reg=0.f;f32x16 o[4];o[0]=zv_;o[1]=zv_;o[2]=zv_;o[3]=zv_;
  const int qrel=a.qrel; const float slope2=a.slope2;
  float slope2v=slope2; asm volatile("":"+v"(slope2v));
  #define KBREL(t) (64*((t)-(NT-4)))
  #define MBIAS(P0,P1,t,BAND) maskbias<1>(P0,P1,KBREL(t)+4*hi,qrel,slope2,mhat,(BAND)&&((t)>=NT-4),true)
  #define CMASK(P0,P1,t) MBIAS(P0,P1,t,true)
  bool resc=false;
  #define START(P0,P1) do{ const float rm=rowmax(P0,P1); resc=false; \
    { const float dl=rm; mhat=fadd_s(mhat,dl); \
      _Pragma("unroll") for(int r=0;r<16;++r){P0[r]=fsub_s(P0[r],dl);P1[r]=fsub_s(P1[r],dl);} } \
    _Pragma("unroll") for(int r=0;r<16;++r)P0[r]=__builtin_amdgcn_exp2f(P0[r]); }while(0)
  #define RESC() do{ if(resc){ asm volatile("s_waitcnt lgkmcnt(0)":::"memory"); \
      _Pragma("unroll") for(int d_=0;d_<4;++d_) _Pragma("unroll") for(int r=0;r<16;++r)o[d_][r]*=wsf[crow(r,hi)]; } }while(0)
  f32x16 pA0,pA1;
  int sl_prev=0,sl_cur=0,sl_next=SLOTB;
  #define ROT() do{sl_prev=sl_cur;sl_cur=sl_next;sl_next=(sl_next==(NSLOT-1)*SLOTB)?0:sl_next+SLOTB;}while(0)
  DMA_K(2,2*SLOTB);
  WAIT_BAR(4);
  qkt(pA0,pA1,Kbase,qr,zv_,r32,hi);asm volatile("s_nop 15\n\ts_nop 7":"+v"(pA0),"+v"(pA1));CMASK(pA0,pA1,0);
  START(pA0,pA1);
  _Pragma("unroll") for(int r=0;r<16;++r)pA1[r]=__builtin_amdgcn_exp2f(pA1[r]);
  f32x16 pB0,pB1;
  { const float lbn=__builtin_fmaf(slope2,(float)(KBREL(1)+4*hi-qrel),-mhat);
    _Pragma("unroll") for(int r=0;r<16;++r){ const int c=(r&3)+8*(r>>2); pB0[r]=__builtin_fmaf(slope2,(float)c,lbn); pB1[r]=__builtin_fmaf(slope2,(float)(c+32),lbn); } }
  WAIT_BAR(0);
  DMA_K(3,0);DMA_V(1,SLOTB);
  ROT();
  kload8(kf,kp0+sl_cur);
  WAIT_BAR(0);
  s16x4 vlo[8],vhi[8]; u32x4 pw0,pw1,pw2,pw3;
  #define PKW(P,B) cvtpk_s(P[B],P[B+1])
  #define PAF(k) __builtin_bit_cast(bf16x8,pw##k)
  #define VFR(i) (bf16x8){vlo[i][0],vlo[i][1],vlo[i][2],vlo[i][3],vhi[i][0],vhi[i][1],vhi[i][2],vhi[i][3]}
  #define PIN(x) asm volatile("":"+v"(x))
  #define MX3(a,b,c) __builtin_fmaxf(__builtin_fmaxf((a),(b)),(c))
  #define GAPA(MF,A0,A1,A2,A3,W0,W1,PW) do{ MF; sacc+=A0; sacc+=A1; sacc+=A2; sacc+=A3; PIN(sacc); W0; W1; PIN(PW); SBAR(); }while(0)
  #define EX(v) __builtin_amdgcn_exp2f(v)
  #define FILLV(r,OFF) fmamk_c<(((r)&3)+8*((r)>>2))+(OFF)>(slope2v,lbn)
  #define GAPB(MF,X0,X1,E0,E1,E2) do{ MF; E0=EX(E0); E1=EX(E1); E2=EX(E2); PIN(X0); PIN(X1); SBAR(); }while(0)
  #define GAPD(MF,X,E,Y,B,OFF) do{ MF; E=EX(E); Y[B]=FILLV(B,OFF); Y[B+1]=FILLV(B+1,OFF); Y[B+2]=FILLV(B+2,OFF); Y[B+3]=FILLV(B+3,OFF); PIN(X); PIN(Y); SBAR(); }while(0)
  #define GAPC(MF) do{ MF; SBAR(); }while(0)
  #define VRD(i) do{ vlo[i]=vtr(vp_+(((i)>>2)*4096+((i)&3)*1024)); vhi[i]=vtr(vp_+(((i)>>2)*4096+((i)&3)*1024+512)); SBAR(); }while(0)
  #define VRD2(i) do{ vlo[i]=vtr(vp_+(8192+((i)>>2)*4096+((i)&3)*1024)); vhi[i]=vtr(vp_+(8192+((i)>>2)*4096+((i)&3)*1024+512)); SBAR(); }while(0)
  #define KRD(G,j) do{ if(G){ kload2(kf,kp0+sl_next,j); SBAR(); } }while(0)
  #define STEP(C0,C1,P0,P1,t,GK,GV,GL) do{ SBAR(); \
    const lds_cptr vp_=vp0+2*sl_prev; \
    float sacc=(P0[0]+P0[1]); \
    GAPA(C0=__builtin_amdgcn_mfma_f32_32x32x16_bf16(kf[0],qr[0],C0,0,0,0), P0[2],P0[3],P0[4],P0[5],     pw0[0]=PKW(P0,0), pw0[1]=PKW(P0,2), pw0); \
    GAPA(C1=__builtin_amdgcn_mfma_f32_32x32x16_bf16(kf[1],qr[0],C1,0,0,0), P0[6],P0[7],P0[8],P0[9],     pw0[2]=PKW(P0,4), pw0[3]=PKW(P0,6), pw0); \
    GAPA(C0=__builtin_amdgcn_mfma_f32_32x32x16_bf16(kf[2],qr[1],C0,0,0,0),   P0[10],P0[11],P0[12],P0[13], pw1[0]=PKW(P0,8), pw1[1]=PKW(P0,10), pw1); \
    GAPA(C1=__builtin_amdgcn_mfma_f32_32x32x16_bf16(kf[3],qr[1],C1,0,0,0),   P0[14],P0[15],P1[0],P1[1],   pw1[2]=PKW(P0,12),pw1[3]=PKW(P0,14), pw1); \
    GAPA(C0=__builtin_amdgcn_mfma_f32_32x32x16_bf16(kf[4],qr[2],C0,0,0,0),   P1[2],P1[3],P1[4],P1[5],     pw2[0]=PKW(P1,0), pw2[1]=PKW(P1,2), pw2); \
    GAPA(C1=__builtin_amdgcn_mfma_f32_32x32x16_bf16(kf[5],qr[2],C1,0,0,0),   P1[6],P1[7],P1[8],P1[9],     pw2[2]=PKW(P1,4), pw2[3]=PKW(P1,6), pw2); \
    GAPA(C0=__builtin_amdgcn_mfma_f32_32x32x16_bf16(kf[6],qr[3],C0,0,0,0),   P1[10],P1[11],P1[12],P1[13], pw3[0]=PKW(P1,8), pw3[1]=PKW(P1,10), pw3); \
    VRD(0); GAPA(C1=__builtin_amdgcn_mfma_f32_32x32x16_bf16(kf[7],qr[3],C1,0,0,0),   P1[14],P1[15],0.f,0.f,       pw3[2]=PKW(P1,12),pw3[3]=PKW(P1,14), pw3); \
    l_reg+=sacc; \
    if(GK){DMA_K((t)+3,sl_cur);} if(GV){DMA_V((t)+1,sl_next);} \
    VRD(4); VRD(1); VRD(5); \
    SMASK(C0,C1,t); \
    { float a_=MX3(C0[0],C0[1],C1[0]),b_=MX3(C0[2],C0[3],C1[1]); a_=MX3(a_,C1[2],C1[3]); \
      _Pragma("unroll") for(int r=4;r<16;r+=4){a_=MX3(a_,C0[r],C0[r+1]);b_=MX3(b_,C0[r+2],C0[r+3]);a_=MX3(a_,C1[r],C1[r+1]);b_=MX3(b_,C1[r+2],C1[r+3]);} \
      float rm=__builtin_fmaxf(a_,b_); { auto rr=__builtin_amdgcn_permlane32_swap(__float_as_uint(rm),__float_as_uint(rm),false,false); rm=__builtin_fmaxf(__uint_as_float(rr[0]),__uint_as_float(rr[1])); } \
      resc=false; \
      if(__builtin_expect(__any(rm>(float)THRL),0)){ const float dl=__builtin_fmaxf(rm,0.f); mhat+=dl; \
        _Pragma("unroll") for(int r=0;r<16;++r){C0[r]-=dl;C1[r]-=dl;} \
        const float f=__builtin_amdgcn_exp2f(-dl); l_reg*=f; if(hi==0)wsf[r32]=f; resc=true; } } \
    const float lbn=__builtin_fmaf(slope2,(float)(KBREL((t)+1)+4*hi-qrel),-mhat); \
    SBAR(); \
    VRD(2); GAPB(o[0]=__builtin_amdgcn_mfma_f32_32x32x16_bf16(PAF(0),VFR(0),o[0],0,0,0), C0,C1, C0[0],C0[1],C0[2]);    VRD2(0); \
    VRD(6); GAPB(o[1]=__builtin_amdgcn_mfma_f32_32x32x16_bf16(PAF(0),VFR(4),o[1],0,0,0), C0,C1, C0[3],C0[4],C0[5]);    VRD2(4); \
    VRD(3); GAPB(o[0]=__builtin_amdgcn_mfma_f32_32x32x16_bf16(PAF(1),VFR(1),o[0],0,0,0), C0,C1, C0[6],C0[7],C0[8]);    VRD2(1); \
    VRD(7); GAPB(o[1]=__builtin_amdgcn_mfma_f32_32x32x16_bf16(PAF(1),VFR(5),o[1],0,0,0), C0,C1, C0[9],C0[10],C0[11]);  VRD2(5); \
    GAPB(o[0]=__builtin_amdgcn_mfma_f32_32x32x16_bf16(PAF(2),VFR(2),o[0],0,0,0), C0,C1, C0[12],C0[13],C0[14]); VRD2(2); \
    GAPB(o[1]=__builtin_amdgcn_mfma_f32_32x32x16_bf16(PAF(2),VFR(6),o[1],0,0,0), C0,C1, C0[15],C1[0],C1[1]);   VRD2(6); \
    GAPB(o[0]=__builtin_amdgcn_mfma_f32_32x32x16_bf16(PAF(3),VFR(3),o[0],0,0,0), C0,C1, C1[2],C1[3],C1[4]);    VRD2(3); \
    GAPB(o[1]=__builtin_amdgcn_mfma_f32_32x32x16_bf16(PAF(3),VFR(7),o[1],0,0,0), C0,C1, C1[5],C1[6],C1[7]);    VRD2(7); \
    KRD(GL,0); GAPD(o[2]=__builtin_amdgcn_mfma_f32_32x32x16_bf16(PAF(0),VFR(0),o[2],0,0,0), C1,C1[8], P0,0,0); \
    KRD(GL,1); GAPD(o[3]=__builtin_amdgcn_mfma_f32_32x32x16_bf16(PAF(0),VFR(4),o[3],0,0,0), C1,C1[9], P0,4,0); \
    KRD(GL,2); GAPD(o[2]=__builtin_amdgcn_mfma_f32_32x32x16_bf16(PAF(1),VFR(1),o[2],0,0,0), C1,C1[10],P0,8,0); \
    KRD(GL,3); GAPD(o[3]=__builtin_amdgcn_mfma_f32_32x32x16_bf16(PAF(1),VFR(5),o[3],0,0,0), C1,C1[11],P0,12,0); \
    GAPD(o[2]=__builtin_amdgcn_mfma_f32_32x32x16_bf16(PAF(2),VFR(2),o[2],0,0,0), C1,C1[12],P1,0,32); \
    GAPD(o[3]=__builtin_amdgcn_mfma_f32_32x32x16_bf16(PAF(2),VFR(6),o[3],0,0,0), C1,C1[13],P1,4,32); \
    GAPD(o[2]=__builtin_amdgcn_mfma_f32_32x32x16_bf16(PAF(3),VFR(3),o[2],0,0,0), C1,C1[14],P1,8,32); \
    GAPD(o[3]=__builtin_amdgcn_mfma_f32_32x32x16_bf16(PAF(3),VFR(7),o[3],0,0,0), C1,C1[15],P1,12,32); \
    }while(0)
  int t=1;
  #define SMASK(P0,P1,t) do{}while(0)
  for(;t+5<NT;t+=2){
    STEP(pB0,pB1,pA0,pA1,t,true,true,true);     WAIT_BAR(0); RESC(); ROT();
    STEP(pA0,pA1,pB0,pB1,t+1,true,true,true);   WAIT_BAR(0); RESC(); ROT();
  }
  #undef SMASK
  #define SMASK(P0,P1,t) do{ if((t)>=NT-4){ int dq_=qrel-(KBREL(t)+4*hi); asm volatile("":"+v"(dq_));        \
    _Pragma("unroll") for(int r=0;r<16;++r){ const int c_=(r&3)+8*(r>>2); if(c_>dq_)P0[r]=-INFINITY; if(c_+32>dq_)P1[r]=-INFINITY; } } }while(0)
  #define ENDW(tt) do{ WAIT_BAR(0); }while(0)
  for(;t+1<NT;t+=2){
    STEP(pB0,pB1,pA0,pA1,t,(t+3<NT),(t+1<NT),(t+1<NT));       ENDW(t);   RESC(); ROT();
    STEP(pA0,pA1,pB0,pB1,t+1,(t+4<NT),(t+2<NT),(t+2<NT));     ENDW(t+1); RESC(); ROT();
  }
  STEP(pB0,pB1,pA0,pA1,NT-1,false,false,false); RESC();
  { float sacc=pB0[0]+pB0[1]; _Pragma("unroll") for(int r=2;r<16;++r)sacc+=pB0[r]; _Pragma("unroll") for(int r=0;r<16;++r)sacc+=pB1[r]; l_reg+=sacc;
    pw0=(u32x4){PKW(pB0,0),PKW(pB0,2),PKW(pB0,4),PKW(pB0,6)};pw1=(u32x4){PKW(pB0,8),PKW(pB0,10),PKW(pB0,12),PKW(pB0,14)};pw2=(u32x4){PKW(pB1,0),PKW(pB1,2),PKW(pB1,4),PKW(pB1,6)};pw3=(u32x4){PKW(pB1,8),PKW(pB1,10),PKW(pB1,12),PKW(pB1,14)};
    SBAR(); pv(o,vb0+2*sl_cur,PAF(0),PAF(1),PAF(2),PAF(3)); pv(o+2,vb0+2*sl_cur+8192,PAF(0),PAF(1),PAF(2),PAF(3)); }
  #undef PKW
  #undef PAF
  #undef VFR
  #undef PIN
  #undef MX3
  #undef GAPA
  #undef GAPB
  #undef GAPD
  #undef GAPC
  #undef EX
  #undef VRD
  #undef VRD2
  #undef KRD
  #undef STEP
  #undef ENDW
  #undef SMASK
  #undef FILLV
  {auto rr=__builtin_amdgcn_permlane32_swap(__float_as_uint(l_reg),__float_as_uint(l_reg),false,false);l_reg=__uint_as_float(rr[0])+__uint_as_float(rr[1]);}
  if(hi==0)wsf[32+r32]=l_reg;asm volatile("s_waitcnt lgkmcnt(0)":::"memory");
  float rli[16];
  #pragma unroll
  for(int r=0;r<16;++r)rli[r]=__builtin_amdgcn_rcpf(wsf[32+crow(r,hi)]);
  asm volatile("s_waitcnt lgkmcnt(0)\n\ts_barrier":::"memory");
  { bf16*stg=(bf16*)(shm)+wid*4096;
    #pragma unroll
    for(int r=0;r<16;++r){const int orow=crow(r,hi);
      #pragma unroll
      for(int dq=0;dq<4;++dq)stg[orow*128+dq*32+r32]=__float2bfloat16(o[dq][r]*rli[r]);}
    asm volatile("s_waitcnt lgkmcnt(0)":::"memory");
    #pragma unroll
    for(int i=0;i<8;++i){const int row=i*4+(lane>>4),ch=lane&15; const u32x4 v=*(const u32x4*)(stg+row*128+ch*8); *(u32x4*)(a.Ow+(long)row*OP+ch*8)=v;} }
  asm volatile("s_waitcnt lgkmcnt(0)\n\ts_barrier":::"memory");
  #undef DMA_K
  #undef DMA_V
  #undef KBREL
  #undef MBIAS
  #undef CMASK
  #undef START
  #undef RESC
  #undef ROT
}
constexpr int ATTN_LDS_BYTES=LDS_BYTES;
#undef SBAR
#undef WAIT_BAR
}
constexpr int NWAVES = 8;
constexpr int BATCH = 2, SEQ = 16384, D = 1024, M = BATCH * SEQ, DEPTH = 4, MEMLEN = 256;
constexpr int NPA = 1536, NPB = 2560;
constexpr int NEXP = 64, CAP = 32768, HID = 256;
constexpr int HROWS = (M * 8 / 256 + NEXP + M / 256) * 256;
constexpr float LN_EPS = 1e-5f;
constexpr float DN_ALPHA = 1.681792830507429f;
__device__ const float SLOPES_A[12] = {0.5f, 0.25f, 0.125f, 0.0625f, 0.03125f, 0.015625f, 0.0078125f, 0.00390625f, 0.7071067811865476f, 0.35355339059327384f, 0.17677669529663695f, 0.08838834764831849f};
__device__ const float SLOPES_B[6] = {0.25f, 0.0625f, 0.015625f, 0.00390625f, 0.5f, 0.125f};

constexpr size_t MiB = 1u << 20;
constexpr size_t WS_CTL = 0, CTL_ZERO_BYTES = 1 * MiB;
constexpr size_t WS_MEMKV = 2 * MiB;
constexpr size_t WS_WROUT = 4 * MiB;
constexpr size_t WS_WINA = 6 * MiB, WS_WINB = 12 * MiB;
constexpr size_t WS_WOUT = 22 * MiB;
constexpr size_t WS_WMKV = 30 * MiB;
constexpr size_t WS_MEMB = 34 * MiB;
constexpr size_t WS_LOGIT = 36 * MiB;
constexpr size_t WS_ROWTOK = 44 * MiB, WS_ROWGATE = 52 * MiB;
constexpr size_t WS_WEXP = 60 * MiB;
constexpr size_t WS_XB = 158 * MiB;
constexpr size_t WS_HB = 222 * MiB;
constexpr size_t WS_BIG = 374 * MiB;
constexpr size_t WS_QKV = WS_BIG, WS_OTMP = WS_BIG + 160 * MiB, WS_CAT = WS_BIG + 256 * MiB, WS_Y = WS_BIG + 320 * MiB;
constexpr size_t WS_END = WS_BIG + 576 * MiB;
static_assert(WS_WEXP + 65 * (size_t)pg8::EXPERT_BYTES <= WS_XB && WS_HB + (size_t)HROWS * 512 <= WS_BIG, "d_ws map");
constexpr int CW_TMO = 0;
constexpr int CW_BAR = 4096;
constexpr int CW_CNT = 16384;
constexpr int CW_Q = CW_CNT + DEPTH * 64 * 64;
constexpr int CW_NORM = CW_Q + 64 * DEPTH;
static_assert((CW_NORM + 64 * DEPTH) * 4 <= (int)CTL_ZERO_BYTES, "CTL words inside the memset region");

constexpr int RING_OFF = 0, RING_BYTES = 131072;
constexpr int LDSCTL_OFF = RING_BYTES;
constexpr int TAB_OFF = RING_BYTES + 512;
constexpr int IDX_OFF = RING_BYTES + 2560;
constexpr int GATE_OFF = IDX_OFF + 10 * 1024;
constexpr int LDS_BYTES = 163840;
static_assert(IDX_OFF + 20 * 1024 <= LDS_BYTES, "LDS map");

#define GAS __attribute__((address_space(1)))
#define LAS __attribute__((address_space(3)))
typedef unsigned short bf16;
typedef unsigned v4u __attribute__((ext_vector_type(4)));
typedef unsigned v2u __attribute__((ext_vector_type(2)));
typedef float f32x4 __attribute__((ext_vector_type(4)));
typedef GAS unsigned gu32;
#define RLX_AGENT __ATOMIC_RELAXED, __HIP_MEMORY_SCOPE_AGENT
#define LDS_WAIT() asm volatile("s_waitcnt lgkmcnt(0)" ::: "memory")
__device__ __forceinline__ unsigned f2bf(float f) { unsigned u = __builtin_bit_cast(unsigned, f); return (u + 0x7fffu + ((u >> 16) & 1u)) >> 16; }
__device__ __forceinline__ unsigned pk2(float lo, float hi) { return f2bf(lo) | (f2bf(hi) << 16); }
__device__ __forceinline__ float bflo(unsigned u) { return __builtin_bit_cast(float, u << 16); }
__device__ __forceinline__ float bfhi(unsigned u) { return __builtin_bit_cast(float, u & 0xffff0000u); }

#define XB_TMO      128
#define XB_XCNT(j)  (256  + 64 * (j))
#define XB_XSUB(j)  (1280 + 64 * (j))
#define XB_XGEN(j)  (2304 + 64 * (j))
#define XB_TOP      3328
#define XB_TOPGEN   3392
#define XCD_BAR_WORDS 3456
#define XB_SPIN_CAP (1u << 18)
__device__ __forceinline__ unsigned xb_ld(unsigned* p)              { return __hip_atomic_load(p, __ATOMIC_RELAXED, __HIP_MEMORY_SCOPE_AGENT); }
__device__ __forceinline__ unsigned xb_add(unsigned* p, unsigned v) { return __hip_atomic_fetch_add(p, v, __ATOMIC_RELAXED, __HIP_MEMORY_SCOPE_AGENT); }
__device__ __forceinline__ unsigned xb_xcc_id() { return (unsigned)__builtin_amdgcn_s_getreg((3 << 11) | 20) & 0xFu; }
#define XB_SPIN(cond, bar) do { unsigned _sp = 0; while (cond) { __builtin_amdgcn_s_sleep(1); \
    if ((++_sp & 255u) == 0u) { if (xb_ld(&(bar)[XB_TMO])) break; if (_sp > XB_SPIN_CAP) { atomicAdd(&(bar)[XB_TMO], 1u); break; } } } } while (0)
struct XcdBarrier { unsigned* bar; unsigned x; volatile LAS unsigned* st; };
__device__ __forceinline__ XcdBarrier xcd_barrier_post(unsigned* bar, volatile LAS unsigned* st, const bool t0) {
    XcdBarrier b; b.bar = bar; b.x = xb_xcc_id(); b.st = st;
    if (t0) (void)xb_add(&bar[XB_XCNT(b.x)], 1u);
    return b;
}
__device__ __forceinline__ void xcd_barrier_complete(unsigned* bar, unsigned x, unsigned& nloc, unsigned& nx) {
    const unsigned G = gridDim.x * gridDim.y * gridDim.z;
    unsigned sum, cnt, mine, sp = 0u;
    for (;;) {
        sum = 0u; cnt = 0u; mine = 0u;
#pragma unroll
        for (unsigned j = 0; j < 16; ++j) { const unsigned c = xb_ld(&bar[XB_XCNT(j)]); sum += c; cnt += (c > 0u) ? 1u : 0u; mine = (j == x) ? c : mine; }
        if (sum == G) break;
        __builtin_amdgcn_s_sleep(1);
        if ((++sp & 255u) == 0u) { if (xb_ld(&bar[XB_TMO])) break; if (sp > XB_SPIN_CAP) { atomicAdd(&bar[XB_TMO], 1u); break; } }
    }
    nloc = mine > 0u ? mine : 1u; nx = cnt > 0u ? cnt : 1u;
}
__device__ __forceinline__ void xcd_barrier(const XcdBarrier& b, const bool t0) {
    asm volatile("s_waitcnt vmcnt(0)" ::: "memory");
    __syncthreads();
    if (t0) {
        unsigned* bar = b.bar;
        __builtin_amdgcn_s_waitcnt(0);
        unsigned nloc = b.st[0], nx = b.st[1];
        if (nloc == 0u) { xcd_barrier_complete(bar, b.x, nloc, nx); b.st[0] = nloc; b.st[1] = nx; }
        const unsigned old = xb_add(&bar[XB_XSUB(b.x)], 1u);
        const unsigned gen = old / nloc;
        if (old + 1u == (gen + 1u) * nloc) {
            __builtin_amdgcn_fence(__ATOMIC_RELEASE, "agent");
            asm volatile("s_waitcnt vmcnt(0)" ::: "memory");
            const unsigned og = xb_add(&bar[XB_TOP], 1u);
            const unsigned tg = og / nx;
            if (og + 1u == (tg + 1u) * nx) xb_add(&bar[XB_TOPGEN], 1u);
            else XB_SPIN(xb_ld(&bar[XB_TOPGEN]) == tg, bar);
            __builtin_amdgcn_fence(__ATOMIC_ACQUIRE, "agent");
            xb_add(&bar[XB_XGEN(b.x)], 1u);
            asm volatile("s_waitcnt vmcnt(0)" ::: "memory");
        } else {
            XB_SPIN(xb_ld(&bar[XB_XGEN(b.x)]) == gen, bar);
            __builtin_amdgcn_fence(__ATOMIC_ACQUIRE, "agent");
            asm volatile("s_waitcnt vmcnt(0)" ::: "memory");
        }
    }
    __syncthreads();
}

struct Frame { LAS unsigned char* lds; int wave; };
__device__ __forceinline__ int f_G() { int g = (int)gridDim.x; asm volatile("" : "+s"(g)); return g; }
__device__ __forceinline__ int f_bx() { int b = (int)blockIdx.x; asm volatile("" : "+s"(b)); return b; }
__device__ __forceinline__ int f_gw(const Frame& F) { const int g = f_G(), b = f_bx(); return ((g % 8 == 0) ? (b % 8) * (g / 8) + b / 8 : b) * NWAVES + F.wave; }
__device__ __forceinline__ int f_ngw() { return f_G() * NWAVES; }
__device__ __forceinline__ volatile LAS unsigned* f_misc(const Frame& F) { return (volatile LAS unsigned*)(F.lds + LDSCTL_OFF); }
__device__ __forceinline__ int lane_id() { unsigned m; asm volatile("s_mov_b32 %0, -1" : "=s"(m)); return (int)__builtin_amdgcn_mbcnt_hi(m, __builtin_amdgcn_mbcnt_lo(m, 0u)); }
__device__ __forceinline__ int tid_of(int wave) { asm volatile("" : "+s"(wave)); return (wave << 6) | lane_id(); }
#define fresh_tid() tid_of(F.wave)
__device__ __forceinline__ float sx(float v, int o, int ln) { return __builtin_bit_cast(float, __builtin_amdgcn_ds_bpermute((ln ^ o) << 2, __builtin_bit_cast(int, v))); }
__device__ __forceinline__ float wave_sum(float v) {
    const int ln_ = lane_id();
#pragma unroll
    for (int o = 1; o < 64; o <<= 1) v += sx(v, o, ln_);
    return v;
}
__device__ __forceinline__ void transpose_item64(const float* W, int N, bf16* WT, int ldt, int k0, int n0, int drow0, LAS float* scr, int lane) {
    const int rr = lane >> 4, cc = (lane & 15) * 4;
    f32x4 v[16];
#pragma unroll
    for (int i = 0; i < 16; ++i) { const int kk = 4 * i + rr; v[i] = *(const GAS f32x4*)(W + (size_t)(k0 + kk) * N + n0 + cc); }
#pragma unroll
    for (int i = 0; i < 16; ++i) { const int kk = 4 * i + rr; LAS float* d = scr + kk * 65 + cc; d[0] = v[i].x; d[1] = v[i].y; d[2] = v[i].z; d[3] = v[i].w; }
    LDS_WAIT(); asm volatile("" ::: "memory");
    const int c = lane & 7;
#pragma unroll
    for (int j = 0; j < 8; ++j) { const int n = (lane >> 3) + 8 * j; const LAS float* s = scr + (8 * c) * 65 + n;
        v4u o; o.x = pk2(s[0 * 65], s[1 * 65]); o.y = pk2(s[2 * 65], s[3 * 65]); o.z = pk2(s[4 * 65], s[5 * 65]); o.w = pk2(s[6 * 65], s[7 * 65]);
        *(GAS v4u*)(WT + (size_t)(drow0 + n) * ldt + k0 + 8 * c) = o; }
    LDS_WAIT(); asm volatile("" ::: "memory");
}
__device__ __forceinline__ int map_in_a(int n) { return n < 768 ? n : (n < 960 ? n + 256 : (n < 1152 ? n + 256 : n - 384)); }
__device__ __forceinline__ int map_in_b(int n) { return n < 768 ? n : (n < 2304 ? n + 256 : n - 1536); }

struct Args { const float* in[19]; float* out; unsigned char* ws; };
typedef const __attribute__((address_space(4))) Args* ArgsP;
__device__ __forceinline__ ArgsP fresh_args() { ArgsP p = (ArgsP)__builtin_amdgcn_kernarg_segment_ptr(); asm volatile("" : "+s"(p)); return p; }
__device__ __forceinline__ gu32* f_ctl() { return (gu32*)(fresh_args()->ws + WS_CTL); }

__device__ __forceinline__ void p0_small_weights(Frame& F, ArgsP A) {
    const int tid_ = fresh_tid(), lane_ = tid_ & 63; (void)tid_; (void)lane_;
    LAS float* scr = (LAS float*)(F.lds + (F.wave < 7 ? RING_OFF + F.wave * 16640 : IDX_OFF));
    unsigned char* ws = A->ws;
    constexpr int I_A = 16 * 22, I_B = 16 * 40, I_M = 16 * 8, I_O = 16 * 16, I_R = 16;
    constexpr int NITEMS = 2 * I_A + 2 * I_B + 4 * I_M + 4 * I_O + 4 * I_R;
    for (int it = f_gw(F); it < NITEMS; it += f_ngw()) {
        int r = it;
        if (r < 2 * I_A) { const int j = r / I_A; r %= I_A; const int kb = r / 22, nb = r % 22;
            transpose_item64(A->in[2] + (size_t)j * D * 1408, 1408, (bf16*)(ws + WS_WINA) + (size_t)j * NPA * D, D, 64 * kb, 64 * nb, map_in_a(64 * nb), scr, lane_); continue; } r -= 2 * I_A;
        if (r < 2 * I_B) { const int j = r / I_B; r %= I_B; const int kb = r / 40, nb = r % 40;
            transpose_item64(A->in[4] + (size_t)j * D * 2560, 2560, (bf16*)(ws + WS_WINB) + (size_t)j * NPB * D, D, 64 * kb, 64 * nb, map_in_b(64 * nb), scr, lane_); continue; } r -= 2 * I_B;
        if (r < 4 * I_M) { const int l = r / I_M; r %= I_M; const int kb = r / 8, nb = r % 8;
            transpose_item64(A->in[7] + (size_t)l * D * 512, 512, (bf16*)(ws + WS_WMKV), D, 64 * kb, 64 * nb, l * 512 + 64 * nb, scr, lane_); continue; } r -= 4 * I_M;
        if (r < 4 * I_O) { const int l = r / I_O; r %= I_O; const int kb = r / 16, nb = r % 16;
            transpose_item64(A->in[8] + (size_t)l * D * D, D, (bf16*)(ws + WS_WOUT) + (size_t)l * D * D, D, 64 * kb, 64 * nb, 64 * nb, scr, lane_); continue; } r -= 4 * I_O;
        { const int l = r / I_R; const int kb = r % I_R;
            transpose_item64(A->in[11] + (size_t)l * D * 64, 64, (bf16*)(ws + WS_WROUT) + (size_t)l * 256 * D, D, 64 * kb, 0, 0, scr, lane_); }
    }
    for (int it = f_gw(F); it < 2 * 128 + 4 * 192; it += f_ngw()) {
        bf16* row = it < 256 ? (bf16*)(ws + WS_WINA) + ((size_t)(it >> 7) * NPA + 1408 + (it & 127)) * D
                             : (bf16*)(ws + WS_WROUT) + ((size_t)((it - 256) / 192) * 256 + 64 + (it - 256) % 192) * D;
        GAS v4u* o = (GAS v4u*)row + lane_;
        o[0] = (v4u){0u, 0u, 0u, 0u}; o[64] = (v4u){0u, 0u, 0u, 0u};
    }
    for (int m0 = 4 * f_gw(F); m0 < 512 + M; m0 += 4 * f_ngw()) {
        f32x4 v[4][4];
#pragma unroll
        for (int r = 0; r < 4; ++r) { const int m = m0 + r; const float* src = m < 512 ? A->in[1] + (size_t)m * D : A->in[0] + (size_t)(m - 512) * D;
            const GAS f32x4* xr = (const GAS f32x4*)src + lane_;
#pragma unroll
            for (int j = 0; j < 4; ++j) v[r][j] = xr[64 * j]; }
#pragma unroll
        for (int r = 0; r < 4; ++r) { const int m = m0 + r; bf16* dst = m < 512 ? (bf16*)(ws + WS_MEMB) + (size_t)m * D : (bf16*)(ws + WS_XB) + (size_t)(m - 512) * D;
            GAS v2u* o8 = (GAS v2u*)dst + lane_;
#pragma unroll
            for (int j = 0; j < 4; ++j) o8[64 * j] = (v2u){pk2(v[r][j].x, v[r][j].y), pk2(v[r][j].z, v[r][j].w)}; }
    }
}
constexpr int CONV_ITEMS = 65 * 192, CONV_UNITS = CONV_ITEMS / 8;
__device__ __forceinline__ void convert_item(ArgsP A, int layer, int it, LAS float* scr, int lane_) {
    bf16* wexp = (bf16*)(A->ws + WS_WEXP);
    const int e = it / 192, mat = (it % 192) >> 6, r = it & 63;
    bf16* dst = wexp + (size_t)e * (pg8::EXPERT_BYTES / 2);
    if (mat < 2) { const float* W = (e < 64) ? A->in[13 + mat] + ((size_t)layer * 64 + e) * (D * HID) : A->in[16 + mat] + (size_t)layer * (D * HID);
        const int kb = r >> 2, nb = r & 3, n0 = 64 * nb;
        transpose_item64(W, HID, dst, D, 64 * kb, n0, (n0 >> 7) * 256 + mat * 128 + (n0 & 127), scr, lane_); }
    else { const float* W = (e < 64) ? A->in[15] + ((size_t)layer * 64 + e) * (HID * D) : A->in[18] + (size_t)layer * (HID * D);
        const int kb = r >> 4, nb = r & 15;
        transpose_item64(W, D, dst + pg8::EXPERT_DOWN_OFF / 2, HID, 64 * kb, 64 * nb, 64 * nb, scr, lane_); }
}
__device__ __forceinline__ void convert_unit(Frame& F, ArgsP A, int layer, int cu) {
    const int tid_ = fresh_tid(), lane_ = tid_ & 63; (void)tid_;
    LAS float* scr = (LAS float*)(F.lds + (F.wave < 7 ? RING_OFF + F.wave * 16640 : IDX_OFF));
    const int it = 8 * cu + F.wave;
    if (it < CONV_ITEMS) convert_item(A, layer, it, scr, lane_);
    asm volatile("s_waitcnt lgkmcnt(0)\n\ts_barrier" ::: "memory");
}
template <bool LAST> __device__ __forceinline__ void ph_combine_ln2(Frame& F, float* xout, const unsigned char* yt, const float* g, const float* b, bf16* xb) {
    typedef float f32x2c __attribute__((ext_vector_type(2)));
    const int tid_ = fresh_tid(), lane_ = tid_ & 63; (void)tid_;
    for (int m = f_gw(F); m < M; m += f_ngw()) {
        GAS v4u* o8 = (GAS v4u*)(xb + (size_t)m * D) + 2 * lane_; const GAS v4u* yr = (const GAS v4u*)(yt + (size_t)m * 9 * D) + lane_;
        float v[16];
#pragma unroll
        for (int i = 0; i < 16; ++i) v[i] = 0.f;
#pragma unroll
        for (int k = 0; k < 9; ++k) { const v4u w = yr[k * 64];
#pragma unroll
            for (int q = 0; q < 4; ++q) { const f32x2c lo = __builtin_amdgcn_cvt_pk_f32_fp8((int)w[q], false), hi = __builtin_amdgcn_cvt_pk_f32_fp8((int)w[q], true);
                v[4 * q] += lo.x; v[4 * q + 1] += lo.y; v[4 * q + 2] += hi.x; v[4 * q + 3] += hi.y; } }
        float s = 0.f;
#pragma unroll
        for (int h = 0; h < 2; ++h) { const v4u xw = o8[h];
#pragma unroll
            for (int q = 0; q < 4; ++q) { v[8 * h + 2 * q] = v[8 * h + 2 * q] * (1.f / pg8::Y8_SCALE) + DN_ALPHA * bflo(xw[q]); v[8 * h + 2 * q + 1] = v[8 * h + 2 * q + 1] * (1.f / pg8::Y8_SCALE) + DN_ALPHA * bfhi(xw[q]); } }
#pragma unroll
        for (int i = 0; i < 16; ++i) s += v[i];
        const float mean = wave_sum(s) * (1.f / D); float s2 = 0.f;
#pragma unroll
        for (int i = 0; i < 16; ++i) { v[i] -= mean; s2 += v[i] * v[i]; }
        const float rstd = 1.f / sqrtf(wave_sum(s2) * (1.f / D) + LN_EPS);
        const GAS f32x4* gp = (const GAS f32x4*)g + 4 * lane_; const GAS f32x4* bp = (const GAS f32x4*)b + 4 * lane_;
        GAS f32x4* xo = (GAS f32x4*)(xout + (size_t)m * D) + 4 * lane_;
        float o[16];
#pragma unroll
        for (int q = 0; q < 4; ++q) { const f32x4 gv = gp[q], bv = bp[q];
            o[4 * q] = v[4 * q] * rstd * gv.x + bv.x; o[4 * q + 1] = v[4 * q + 1] * rstd * gv.y + bv.y; o[4 * q + 2] = v[4 * q + 2] * rstd * gv.z + bv.z; o[4 * q + 3] = v[4 * q + 3] * rstd * gv.w + bv.w;
            if (LAST) xo[q] = (f32x4){o[4 * q], o[4 * q + 1], o[4 * q + 2], o[4 * q + 3]}; }
        if (!LAST) { o8[0] = (v4u){pk2(o[0], o[1]), pk2(o[2], o[3]), pk2(o[4], o[5]), pk2(o[6], o[7])}; o8[1] = (v4u){pk2(o[8], o[9]), pk2(o[10], o[11]), pk2(o[12], o[13]), pk2(o[14], o[15])}; }
    }
}
__device__ __forceinline__ void ph_diff_combine(Frame& F, const bf16* otmp, const float* lq, const float* subg, float lam_init, bf16* cat) {
    const int tid_ = fresh_tid(), lane_ = tid_ & 63; (void)tid_; (void)lane_;
    float lam;
    { const float a = lq[lane_] * lq[64 + lane_], c = lq[128 + lane_] * lq[192 + lane_]; lam = expf(wave_sum(a)) - expf(wave_sum(c)) + lam_init; }
    const int l32 = lane_ & 31, hh = lane_ >> 5;
    const f32x4 gv = ((const GAS f32x4*)subg)[l32]; const float post = 1.f - lam_init;
    for (int m = f_gw(F); m < M; m += f_ngw()) {
#pragma unroll
        for (int hp = 0; hp < 3; ++hp) { const int h = 2 * hp + hh;
            const v2u a0 = *((const GAS v2u*)(otmp + (size_t)m * 1536 + h * 256) + l32), a1 = *((const GAS v2u*)(otmp + (size_t)m * 1536 + h * 256 + 128) + l32);
            f32x4 o; o.x = bflo(a0.x) - lam * bflo(a1.x); o.y = bfhi(a0.x) - lam * bfhi(a1.x); o.z = bflo(a0.y) - lam * bflo(a1.y); o.w = bfhi(a0.y) - lam * bfhi(a1.y);
            float s2 = (o.x * o.x + o.y * o.y) + (o.z * o.z + o.w * o.w);
#pragma unroll
            for (int sft = 1; sft < 32; sft <<= 1) s2 += sx(s2, sft, lane_);
            const float r = post / sqrtf(s2 * (1.f / 128.f) + LN_EPS);
            o = o * r * gv;
            *((GAS v2u*)(cat + (size_t)m * D + h * 128) + l32) = (v2u){pk2(o.x, o.y), pk2(o.z, o.w)}; }
    }
}
__device__ __forceinline__ float ss8(v4u a) { float s = 0.f;
#pragma unroll
    for (int i = 0; i < 4; ++i) { const float lo = bflo(a[i]), hi = bfhi(a[i]); s += lo * lo + hi * hi; } return s; }
__device__ __forceinline__ void ph_qknorm(Frame& F, const bf16* qkv, gu32* gmax) {
    const int tid_ = fresh_tid(), lane_ = tid_ & 63;
    LAS unsigned* lmax = (LAS unsigned*)(F.lds + LDSCTL_OFF) + 32;
    if (tid_ < 24) lmax[tid_] = 0u;
    __syncthreads();
    float mq0 = 0.f, mq1 = 0.f, mk0 = 0.f, mk1 = 0.f;
    const v4u zero = (v4u){0u, 0u, 0u, 0u};
    for (int m = f_gw(F); m < M; m += f_ngw()) {
        const bf16* row = qkv + (size_t)m * NPB;
        const v4u a = *(const GAS v4u*)(row + 8 * lane_), c = *(const GAS v4u*)(row + 1024 + 8 * lane_);
        v4u b = zero, d = zero; if (lane_ < 32) { b = *(const GAS v4u*)(row + 512 + 8 * lane_); d = *(const GAS v4u*)(row + 1536 + 8 * lane_); }
        float sa = ss8(a), sb = ss8(b), sc = ss8(c), sd = ss8(d);
#pragma unroll
        for (int o = 1; o < 8; o <<= 1) { sa += sx(sa, o, lane_); sb += sx(sb, o, lane_); sc += sx(sc, o, lane_); sd += sx(sd, o, lane_); }
        mq0 = fmaxf(mq0, sa); mq1 = fmaxf(mq1, sb); mk0 = fmaxf(mk0, sc); mk1 = fmaxf(mk1, sd);
    }
    if ((lane_ & 7) == 0) { const int g = lane_ >> 3;
        __hip_atomic_fetch_max(lmax + g, __float_as_uint(mq0), __ATOMIC_RELAXED, __HIP_MEMORY_SCOPE_WORKGROUP); __hip_atomic_fetch_max(lmax + 12 + g, __float_as_uint(mk0), __ATOMIC_RELAXED, __HIP_MEMORY_SCOPE_WORKGROUP);
        if (lane_ < 32) { __hip_atomic_fetch_max(lmax + 8 + g, __float_as_uint(mq1), __ATOMIC_RELAXED, __HIP_MEMORY_SCOPE_WORKGROUP); __hip_atomic_fetch_max(lmax + 20 + g, __float_as_uint(mk1), __ATOMIC_RELAXED, __HIP_MEMORY_SCOPE_WORKGROUP); } }
    __syncthreads();
    if (tid_ < 24) __hip_atomic_fetch_max(gmax + tid_, lmax[tid_], RLX_AGENT);
}
typedef short bf16x8r __attribute__((ext_vector_type(8)));
constexpr int RT_SC_OFF = TAB_OFF, RT_GB_OFF = TAB_OFF + 16384;
static_assert(RT_GB_OFF + 8192 <= LDS_BYTES, "LDS map (route phase)");
template <bool XF32> __device__ __forceinline__ void ph_ln_route(Frame& F, const float* xin, const bf16* y, const float* g, const float* b, bf16* xb, const bf16* wrt, const float* rbias, gu32* cnt, int* rowtok, float* rowgate, float* gtmp) {
    const int tid_ = fresh_tid(), lane_ = tid_ & 63;
    for (int i = tid_; i < 64 * 128; i += NWAVES * 64) { const int e = i >> 7, c = i & 127;
        const v4u v = *(const GAS v4u*)(wrt + (size_t)e * D + c * 8); *(LAS v4u*)(F.lds + e * 2048 + ((c ^ (e & 15)) << 4)) = v; }
    LAS float* lgb = (LAS float*)(F.lds + RT_GB_OFF);
    if (tid_ < 256) { ((LAS f32x4*)lgb)[tid_] = ((const GAS f32x4*)g)[tid_]; ((LAS f32x4*)lgb)[256 + tid_] = ((const GAS f32x4*)b)[tid_]; }
    __syncthreads();
    LAS float* sc = (LAS float*)(F.lds + RT_SC_OFF) + F.wave * 512;
    const int r = lane_ & 15, kq = lane_ >> 4; const float bias = rbias[lane_]; const float NINF = -INFINITY;
    for (int base = f_gw(F) * 16; base < M; base += f_ngw() * 16) {
#pragma unroll 1
        for (int r4 = 0; r4 < 16; r4 += 4) {
            f32x4 v[4][4]; float s1[4];
#pragma unroll
            for (int q = 0; q < 4; ++q) { const size_t mo = (size_t)(base + r4 + q) * D; const GAS v2u* yr = (const GAS v2u*)(y + mo) + lane_; s1[q] = 0.f;
#pragma unroll
                for (int j = 0; j < 4; ++j) { f32x4 xv;
                    if (XF32) xv = ((const GAS f32x4*)(xin + mo) + lane_)[64 * j]; else { const v2u xw = ((const GAS v2u*)(xb + mo) + lane_)[64 * j]; xv = (f32x4){bflo(xw.x), bfhi(xw.x), bflo(xw.y), bfhi(xw.y)}; }
                    const v2u yv = yr[64 * j];
                    v[q][j].x = DN_ALPHA * xv.x + bflo(yv.x); v[q][j].y = DN_ALPHA * xv.y + bfhi(yv.x); v[q][j].z = DN_ALPHA * xv.z + bflo(yv.y); v[q][j].w = DN_ALPHA * xv.w + bfhi(yv.y);
                    s1[q] += (v[q][j].x + v[q][j].y) + (v[q][j].z + v[q][j].w); } }
#pragma unroll
            for (int o = 1; o < 64; o <<= 1) {
#pragma unroll
                for (int q = 0; q < 4; ++q) s1[q] += sx(s1[q], o, lane_); }
            float s2[4];
#pragma unroll
            for (int q = 0; q < 4; ++q) { const float mean = s1[q] * (1.f / D); s2[q] = 0.f;
#pragma unroll
                for (int j = 0; j < 4; ++j) { v[q][j] = v[q][j] - mean; s2[q] += (v[q][j].x * v[q][j].x + v[q][j].y * v[q][j].y) + (v[q][j].z * v[q][j].z + v[q][j].w * v[q][j].w); } }
#pragma unroll
            for (int o = 1; o < 64; o <<= 1) {
#pragma unroll
                for (int q = 0; q < 4; ++q) s2[q] += sx(s2[q], o, lane_); }
#pragma unroll
            for (int q = 0; q < 4; ++q) { const float rstd = 1.f / sqrtf(s2[q] * (1.f / D) + LN_EPS); GAS v2u* o8 = (GAS v2u*)(xb + (size_t)(base + r4 + q) * D) + lane_;
#pragma unroll
                for (int j = 0; j < 4; ++j) { const LAS f32x4* gp = (const LAS f32x4*)lgb + lane_ + 64 * j; const f32x4 gv = gp[0], bv = gp[256];
                    const f32x4 o = v[q][j] * rstd * gv + bv; o8[64 * j] = (v2u){pk2(o.x, o.y), pk2(o.z, o.w)}; } }
        }
        asm volatile("s_waitcnt vmcnt(0)" ::: "memory");
        f32x4 acc[4];
#pragma unroll
        for (int nt = 0; nt < 4; ++nt) acc[nt] = (f32x4){0.f, 0.f, 0.f, 0.f};
        const bf16* arow = xb + (size_t)(base + r) * D + 8 * kq;
#pragma unroll 8
        for (int s = 0; s < 32; ++s) { const v4u aw = __builtin_nontemporal_load((const GAS v4u*)(arow + 32 * s)); const bf16x8r af = __builtin_bit_cast(bf16x8r, aw);
#pragma unroll
            for (int nt = 0; nt < 4; ++nt) { const int e = 16 * nt + r, c = 4 * s + kq;
                const bf16x8r bfr = *(const LAS bf16x8r*)(F.lds + e * 2048 + ((c ^ (e & 15)) << 4));
                acc[nt] = __builtin_amdgcn_mfma_f32_16x16x32_bf16(bfr, af, acc[nt], 0, 0, 0); } }
        unsigned selmask = 0u; unsigned long long slots = 0ull; unsigned mycount = 0u;
#pragma unroll 1
        for (int half = 0; half < 2; ++half) {
            if ((r >> 3) == half) {
#pragma unroll
                for (int nt = 0; nt < 4; ++nt) *(LAS f32x4*)(sc + (r & 7) * 64 + 16 * nt + 4 * kq) = acc[nt]; }
            LDS_WAIT(); asm volatile("" ::: "memory");
#pragma unroll 1
            for (int j8 = 0; j8 < 8; ++j8) { const int j = half * 8 + j8;
                const float logit = sc[j8 * 64 + lane_];
                const float aff = 1.f / (1.f + expf(-logit)); const float sel = aff + bias;
                float m1 = sel; m1 = fmaxf(m1, sx(m1, 1, lane_)); m1 = fmaxf(m1, sx(m1, 2, lane_)); m1 = fmaxf(m1, sx(m1, 4, lane_));
                const unsigned long long bm = __ballot(sel == m1); const unsigned gb = (unsigned)(bm >> (lane_ & 56)) & 0xffu; const int first = __builtin_ctz(gb | 0x100u);
                float m2 = ((lane_ & 7) == first) ? NINF : sel; m2 = fmaxf(m2, sx(m2, 1, lane_)); m2 = fmaxf(m2, sx(m2, 2, lane_)); m2 = fmaxf(m2, sx(m2, 4, lane_));
                const float gs = m1 + m2; int grank = 0;
#pragma unroll
                for (int g2 = 0; g2 < 8; ++g2) { const float o = __builtin_bit_cast(float, __builtin_amdgcn_readlane(__builtin_bit_cast(int, gs), 8 * g2)); grank += (o > gs || (o == gs && g2 < (lane_ >> 3))) ? 1 : 0; }
                const bool gok = grank < 4; const float v = gok ? sel : NINF; int er = 0;
#pragma unroll 8
                for (int e2 = 0; e2 < 64; ++e2) { const float o = __builtin_bit_cast(float, __builtin_amdgcn_readlane(__builtin_bit_cast(int, v), e2)); er += (o > v) ? 1 : 0; }
                bool chosen = gok && er < 8;
                if (__builtin_popcountll(__ballot(chosen)) != 8) {
                    er = 0;
#pragma unroll 8
                    for (int e2 = 0; e2 < 64; ++e2) { const float o = __builtin_bit_cast(float, __builtin_amdgcn_readlane(__builtin_bit_cast(int, v), e2)); er += (o > v || (o == v && e2 < lane_)) ? 1 : 0; }
                    chosen = gok && er < 8; }
                const float ssum = wave_sum(chosen ? aff : 0.f);
                const unsigned long long bal = __ballot(chosen); const unsigned slot = __builtin_amdgcn_mbcnt_hi((unsigned)(bal >> 32), __builtin_amdgcn_mbcnt_lo((unsigned)bal, 0u));
                if (chosen) { selmask |= 1u << j; slots |= (unsigned long long)slot << (4 * j); ++mycount; gtmp[(size_t)(base + j) * 64 + lane_] = aff / ssum * 2.5f; }
            }
            LDS_WAIT(); asm volatile("" ::: "memory");
        }
        unsigned pos = 0u;
        { LAS unsigned* wgc = (LAS unsigned*)(F.lds + LDSCTL_OFF) + 64;
            if (tid_ < 64) wgc[tid_] = 0u;
            __syncthreads();
            if (mycount) pos = __hip_atomic_fetch_add(wgc + lane_, mycount, __ATOMIC_RELAXED, __HIP_MEMORY_SCOPE_WORKGROUP);
            __syncthreads();
            if (tid_ < 64) { const unsigned tot = wgc[tid_]; unsigned gb = 0u; if (tot) gb = __hip_atomic_fetch_add(cnt + 64 * tid_, tot, RLX_AGENT); wgc[tid_] = gb; }
            __syncthreads();
            pos += wgc[lane_];
            __syncthreads(); }
#pragma unroll 1
        for (int j = 0; j < 16; ++j) if ((selmask >> j) & 1u) { const size_t at = (size_t)lane_ * CAP + pos; ++pos;
            rowtok[at] = (base + j) | ((int)((slots >> (4 * j)) & 15ull) << 16); rowgate[at] = gtmp[(size_t)(base + j) * 64 + lane_]; }
    }
}
template <bool M1> __device__ __forceinline__ int build_units(Frame& F, gu32* cnt, const int* rowtok, const float* rowgate) {
    const int tid_ = fresh_tid();
    LAS int* tcnt = (LAS int*)(F.lds + TAB_OFF); LAS int* bst = tcnt + 80; LAS int* utab = tcnt + 160; LAS int* idx = (LAS int*)(F.lds + IDX_OFF); LAS float* lgate = (LAS float*)(F.lds + GATE_OFF);
    if (tid_ < 64) {
        const int c = (int)__hip_atomic_load(cnt + 64 * tid_, RLX_AGENT); const int nb = (c + 255) >> 8; int incl = nb;
#pragma unroll
        for (int o = 1; o < 64; o <<= 1) { const int u = __builtin_amdgcn_ds_bpermute((tid_ - o) << 2, incl); if (tid_ >= o) incl += u; }
        tcnt[tid_] = c; bst[tid_] = incl - nb;
        if (tid_ == 63) { tcnt[64] = M; bst[64] = incl; bst[65] = incl + M / 256; }
    }
    __syncthreads();
    const int nblk = bst[65]; const int bx = blockIdx.x;
    const int per = M1 ? 128 : 64, blk0 = M1 ? (16 * (bx & 7) + (bx >> 4)) : (8 * (bx & 7) + (bx >> 5)), pn = M1 ? ((bx >> 3) & 1) : ((bx >> 3) & 3);
    int nmine = (nblk > blk0) ? (nblk - blk0 + per - 1) / per : 0; if (nmine > (M1 ? 10 : 20)) nmine = M1 ? 10 : 20;
    if (tid_ < nmine) { const int blk = tid_ * per + blk0;
        int e = 0;
#pragma unroll
        for (int st = 64; st > 0; st >>= 1) { const int q = e + st; if (q <= 64 && bst[q] <= blk) e = q; }
        const int j = blk - bst[e]; int nv = tcnt[e] - 256 * j; if (nv > 256) nv = 256;
        LAS int* t = utab + tid_ * 8; t[0] = e; t[1] = blk; t[2] = pn; t[3] = nv; t[4] = e * CAP + 256 * j; t[5] = 256 * j; }
    __syncthreads();
    for (int q = tid_; q < nmine * 256; q += NWAVES * 64) { const int g = q >> 8, i = q & 255;
        const LAS int* t = utab + g * 8; const int e = t[0], nv = t[3];
        if (M1) { int tok = 0; float gt = 0.f;
            if (e == 64) { tok = t[5] + i; gt = 1.f; } else if (i < nv) { tok = rowtok[t[4] + i] & 0xffff; gt = rowgate[t[4] + i]; }
            idx[q] = tok; lgate[q] = gt; }
        else { int dst = M * 9;
            if (e == 64) dst = (t[5] + i) * 9 + 8; else if (i < nv) { const int v = rowtok[t[4] + i]; dst = (v & 0xffff) * 9 + (v >> 16); }
            idx[q] = dst; } }
    __syncthreads();
    return nmine;
}
#define WSP(T, off) ((T*)(A->ws + (off)))
#ifndef REP_P1
#define REP_P1 1
#endif
#ifndef REP_P2
#define REP_P2 1
#endif
#ifndef REP_P3
#define REP_P3 1
#endif
#ifndef REP_P5
#define REP_P5 1
#endif
#ifndef REP_P7
#define REP_P7 1
#endif
#ifndef REP_P8
#define REP_P8 1
#endif
#define REPEAT(n) _Pragma("unroll 1") for (int rep_ = 0; rep_ < (n); ++rep_)
#define OPQ(x) asm volatile("" : "+s"(x))
#define FCTL() f_ctl()
#define FRESH_GB() const int G = f_G(), bx = f_bx(); (void)G; (void)bx
__global__ void __launch_bounds__(NWAVES * 64, 2) mega_fwd(Args args_unused) {
    extern __shared__ __attribute__((aligned(16))) unsigned char lds[];
    Frame F;
    F.lds = (LAS unsigned char*)lds;
    F.wave = __builtin_amdgcn_readfirstlane((int)threadIdx.x >> 6);
    for (int u = fresh_tid(); u < 512 / 4; u += NWAVES * 64) ((LAS unsigned*)(F.lds + LDSCTL_OFF))[u] = 0u;
    __syncthreads();
    (void)xcd_barrier_post((unsigned*)(f_ctl() + CW_BAR), f_misc(F) + 8, fresh_tid() == 0);
#define GRID_BAR() do { XcdBarrier bar_; bar_.bar = (unsigned*)(f_ctl() + CW_BAR); bar_.x = xb_xcc_id(); bar_.st = f_misc(F) + 8; xcd_barrier(bar_, fresh_tid() == 0); } while (0)

    { ArgsP A = fresh_args(); FRESH_GB(); p0_small_weights(F, A); }
    GRID_BAR();
    {   ArgsP A = fresh_args(); FRESH_GB();
        pg8::DenseSched S; S.init(512, 2048, D, G, bx, WSP(const bf16, WS_WMKV));
        pg8::EpiBf16 E{WSP(bf16, WS_MEMKV), 2048, 0, 1.f};
        pg8::gemm_phase<pg8::EpiBf16, pg8::DenseSched>(F.lds + RING_OFF, WSP(const bf16, WS_MEMB), D, S, E, F.wave); }

    for (int layer = 0; layer < DEPTH; ++layer) {
        const int jm = layer >> 1; const bool isB = (layer & 1) != 0;
        REPEAT(REP_P1) {
        if (!isB) { ArgsP A = fresh_args(); FRESH_GB();
            pg8::DenseSched S; S.init(M, NPA, D, G, bx, WSP(const bf16, WS_WINA) + (size_t)jm * NPA * D);
            pg8::EpiBf16 E{WSP(bf16, WS_QKV), NPA, 4, attn_body::C2};
            pg8::gemm_phase<pg8::EpiBf16, pg8::DenseSched>(F.lds + RING_OFF, WSP(const bf16, WS_XB), D, S, E, F.wave); }
        else { ArgsP A = fresh_args(); FRESH_GB();
            pg8::DenseSched S; S.init(M, NPB, D, G, bx, WSP(const bf16, WS_WINB) + (size_t)jm * NPB * D);
            pg8::EpiBf16 E{WSP(bf16, WS_QKV), NPB, 4, attn_body::C2};
            pg8::gemm_phase<pg8::EpiBf16, pg8::DenseSched>(F.lds + RING_OFF, WSP(const bf16, WS_XB), D, S, E, F.wave); }
        GRID_BAR();
        }
        if (isB) {
            ArgsP A = fresh_args();
            ph_qknorm(F, WSP(const bf16, WS_QKV), FCTL() + CW_NORM + 64 * layer);
            GRID_BAR();
        }
        REPEAT(REP_P2) {
        if (!isB) {
            { FRESH_GB();
            for (int L = bx; L < 1536; L += G) {
                ArgsP A = fresh_args(); const bf16* qkv = WSP(const bf16, WS_QKV); const int wave = F.wave;
                const int b = L / 768, rem = L % 768, qblk = rem / 3, kvh = rem % 3;
                const int q0u = qblk * 64, head = kvh * 4 + (wave >> 1); const size_t rowq = (size_t)b * SEQ + q0u + 32 * (wave & 1);
                attn_body::AttnArgs a;
                a.Qw = (const attn_body::bf16*)(qkv + rowq * NPA + head * 64);
                a.K0 = (const attn_body::bf16*)(qkv + ((size_t)b * SEQ + q0u) * NPA + 1024 + kvh * 64); a.V0 = a.K0 + 192;
                a.NT = 4; a.tmax = qblk; a.Ow = (attn_body::bf16*)(WSP(bf16, WS_CAT) + rowq * D + head * 64);
                a.qrel = 32 * (wave & 1) + (fresh_tid() & 31); a.slope2 = SLOPES_A[head] * attn_body::LOG2E; a.sink2 = A->in[3][jm * 12 + head] * attn_body::LOG2E; a.wave = F.wave;
                attn_body::attn_unit<2, 8, NPA, NPA, D>(a, (char*)lds + RING_OFF);
                convert_unit(F, A, layer, L);
            }
            for (int cu = 1536 + bx; cu < CONV_UNITS; cu += G) { ArgsP A = fresh_args(); convert_unit(F, A, layer, cu); } }
            { FRESH_GB();
            for (int L = bx; L < 512; L += G) {
                ArgsP A = fresh_args(); const int wave = F.wave;
                const int b = L / 256, rem = L % 256, qb = rem >> 2, hm = rem & 3;
                const size_t rowq = (size_t)b * SEQ + qb * 256 + 32 * wave;
                attn_body::AttnArgs a;
                a.Qw = (const attn_body::bf16*)(WSP(const bf16, WS_QKV) + rowq * NPA + 768 + hm * 64);
                a.K0 = (const attn_body::bf16*)(WSP(const bf16, WS_MEMKV) + (size_t)b * MEMLEN * 2048 + layer * 512 + hm * 64); a.V0 = a.K0 + 256;
                a.NT = 4; a.tmax = 1 << 30; a.Ow = (attn_body::bf16*)(WSP(bf16, WS_CAT) + rowq * D + 768 + hm * 64);
                a.qrel = 32 * wave + (fresh_tid() & 31); a.slope2 = 0.f; a.sink2 = 0.f; a.wave = F.wave;
                attn_body::attn_unit<0, 8, NPA, 2048, D>(a, (char*)lds + RING_OFF);
            } }
        } else {
            {
                unsigned nextL = 0u;
                if (fresh_tid() == 0) nextL = __hip_atomic_fetch_add(FCTL() + CW_Q + 64 * layer + 16 * rep_, 1u, RLX_AGENT);
                for (;;) {
                    if (fresh_tid() == 0) f_misc(F)[16] = nextL;
                    __syncthreads();
                    const int Lq = __builtin_amdgcn_readfirstlane((int)f_misc(F)[16]);
                    __syncthreads();
                    if (Lq >= 1536 + CONV_UNITS) break;
                    if (fresh_tid() == 0) nextL = __hip_atomic_fetch_add(FCTL() + CW_Q + 64 * layer + 16 * rep_, 1u, RLX_AGENT);
                    ArgsP A = fresh_args(); const bf16* qkv = WSP(const bf16, WS_QKV); const int wave = F.wave;
                    const bool isconv = (Lq < 2 * 1536) ? (Lq & 1) : true; const int L = (Lq < 2 * 1536) ? (Lq >> 1) : (Lq - 1536);
                    if (isconv) { convert_unit(F, A, layer, L); continue; }
                    const int qb = 63 - L / 24, rem = L % 24, b = rem / 12, hc = rem % 12, h = hc >> 1, c = hc & 1;
                    const size_t rowq = (size_t)b * SEQ + qb * 256 + 32 * wave;
                    const float slope2 = SLOPES_B[h] * attn_body::LOG2E;
                    const float q2m = __uint_as_float(__hip_atomic_load(FCTL() + CW_NORM + 64 * layer + hc, RLX_AGENT)), k2m = __uint_as_float(__hip_atomic_load(FCTL() + CW_NORM + 64 * layer + 12 + hc, RLX_AGENT));
                    const float B2 = sqrtf(q2m * k2m) * 1.03f + 0.5f, dcut = (160.f + 2.f * B2) / slope2;
                    int t0 = (int)floorf(((float)(qb * 256 - 63) - dcut) * (1.f / 64.f)); t0 = __builtin_amdgcn_readfirstlane(t0 > 0 ? (t0 & ~1) : 0);
                    attn_body::AttnArgs a;
                    a.Qw = (const attn_body::bf16*)(qkv + rowq * NPB + hc * 64);
                    a.K0 = (const attn_body::bf16*)(qkv + ((size_t)b * SEQ + 64 * t0) * NPB + 1024 + hc * 64); a.V0 = (const attn_body::bf16*)(qkv + ((size_t)b * SEQ + 64 * t0) * NPB + 1792 + h * 128);
                    a.NT = 4 * (qb + 1) - t0; a.tmax = 1 << 30; a.Ow = (attn_body::bf16*)(WSP(bf16, WS_OTMP) + rowq * 1536 + hc * 128);
                    a.qrel = 32 * wave + (fresh_tid() & 31); a.slope2 = slope2; a.sink2 = 0.f; a.wave = F.wave;
                    attn_body::diff_unit<16, NPB, NPB, 1536>(a, (char*)lds + RING_OFF);
                }
            }
            { FRESH_GB();
            for (int L = bx; L < 512; L += G) {
                ArgsP A = fresh_args(); const int wave = F.wave;
                const int b = L / 256, rem = L % 256, qb = rem >> 2, hm = rem & 3;
                const size_t rowq = (size_t)b * SEQ + qb * 256 + 32 * wave;
                attn_body::AttnArgs a;
                a.Qw = (const attn_body::bf16*)(WSP(const bf16, WS_QKV) + rowq * NPB + 768 + hm * 64);
                a.K0 = (const attn_body::bf16*)(WSP(const bf16, WS_MEMKV) + (size_t)b * MEMLEN * 2048 + layer * 512 + hm * 64); a.V0 = a.K0 + 256;
                a.NT = 4; a.tmax = 1 << 30; a.Ow = (attn_body::bf16*)(WSP(bf16, WS_CAT) + rowq * D + 768 + hm * 64);
                a.qrel = 32 * wave + (fresh_tid() & 31); a.slope2 = 0.f; a.sink2 = 0.f; a.wave = F.wave;
                attn_body::attn_unit<0, 8, NPB, 2048, D>(a, (char*)lds + RING_OFF);
            } }
        }
        GRID_BAR();
        }
        if (isB) {
            ArgsP A = fresh_args(); FRESH_GB();
            ph_diff_combine(F, WSP(const bf16, WS_OTMP), A->in[5] + jm * 256, A->in[6] + jm * 128, 0.8f - 0.6f * expf(-0.3f * (float)layer), WSP(bf16, WS_CAT));
            GRID_BAR();
        }
        REPEAT(REP_P3) {
        {   ArgsP A = fresh_args(); FRESH_GB();
            pg8::DenseSched S; S.init(M, D, D, G, bx, WSP(const bf16, WS_WOUT) + (size_t)layer * D * D);
            pg8::EpiBf16 E{WSP(bf16, WS_Y), D, 0, 1.f};
            pg8::gemm_phase<pg8::EpiBf16, pg8::DenseSched>(F.lds + RING_OFF, WSP(const bf16, WS_CAT), D, S, E, F.wave); }
        GRID_BAR();
        }
        {   ArgsP A = fresh_args();
            if (layer == 0) ph_ln_route<true>(F, A->in[0], WSP(const bf16, WS_Y), A->in[9] + (size_t)(layer * 2) * D, A->in[10] + (size_t)(layer * 2) * D, WSP(bf16, WS_XB), WSP(const bf16, WS_WROUT) + (size_t)layer * 256 * D, A->in[12] + layer * 64, FCTL() + CW_CNT + layer * 64 * 64, WSP(int, WS_ROWTOK), WSP(float, WS_ROWGATE), WSP(float, WS_LOGIT));
            else ph_ln_route<false>(F, nullptr, WSP(const bf16, WS_Y), A->in[9] + (size_t)(layer * 2) * D, A->in[10] + (size_t)(layer * 2) * D, WSP(bf16, WS_XB), WSP(const bf16, WS_WROUT) + (size_t)layer * 256 * D, A->in[12] + layer * 64, FCTL() + CW_CNT + layer * 64 * 64, WSP(int, WS_ROWTOK), WSP(float, WS_ROWGATE), WSP(float, WS_LOGIT)); }
        GRID_BAR();
        REPEAT(REP_P7) {
        {   ArgsP A = fresh_args(); FRESH_GB();
            const int nmine = build_units<true>(F, FCTL() + CW_CNT + layer * 64 * 64, WSP(const int, WS_ROWTOK), WSP(const float, WS_ROWGATE));
            pg8::GroupSched<true> S{(const LAS int*)(F.lds + TAB_OFF) + 160, (const LAS int*)(F.lds + IDX_OFF), nmine, D, (const char*)(A->ws + WS_WEXP)};
            pg8::EpiM1 E{WSP(bf16, WS_HB), (const LAS float*)(F.lds + GATE_OFF)};
            pg8::gemm_phase<pg8::EpiM1, pg8::GroupSched<true>>(F.lds + RING_OFF, WSP(const bf16, WS_XB), D, S, E, F.wave); }
        GRID_BAR();
        }
        REPEAT(REP_P8) {
        {   ArgsP A = fresh_args(); FRESH_GB();
            const int nmine = build_units<false>(F, FCTL() + CW_CNT + layer * 64 * 64, WSP(const int, WS_ROWTOK), WSP(const float, WS_ROWGATE));
            pg8::GroupSched<false> S{(const LAS int*)(F.lds + TAB_OFF) + 160, (const LAS int*)(F.lds + IDX_OFF), nmine, HID, (const char*)(A->ws + WS_WEXP) + pg8::EXPERT_DOWN_OFF};
            pg8::EpiM2 E{WSP(unsigned char, WS_BIG), (const LAS int*)(F.lds + IDX_OFF)};
            pg8::gemm_phase<pg8::EpiM2, pg8::GroupSched<false>>(F.lds + RING_OFF, WSP(const bf16, WS_HB), HID, S, E, F.wave); }
        GRID_BAR();
        }
        {   ArgsP A = fresh_args(); FRESH_GB();
            if (layer + 1 < DEPTH) ph_combine_ln2<false>(F, A->out, WSP(const unsigned char, WS_BIG), A->in[9] + (size_t)(layer * 2 + 1) * D, A->in[10] + (size_t)(layer * 2 + 1) * D, WSP(bf16, WS_XB));
            else ph_combine_ln2<true>(F, A->out, WSP(const unsigned char, WS_BIG), A->in[9] + (size_t)(layer * 2 + 1) * D, A->in[10] + (size_t)(layer * 2 + 1) * D, WSP(bf16, WS_XB));
            }
        if (layer + 1 < DEPTH) GRID_BAR();
    }
    if (__hip_atomic_load(FCTL() + CW_BAR + XB_TMO, RLX_AGENT) != 0u) {
        __syncthreads();
        ArgsP A = fresh_args(); FRESH_GB(); float* xf = A->out;
        const float q = __builtin_nanf("");
        for (int m = f_gw(F); m < M; m += f_ngw()) { GAS f32x4* o = (GAS f32x4*)(xf + (size_t)m * D) + (fresh_tid() & 63);
#pragma unroll
            for (int j = 0; j < 4; ++j) o[64 * j] = (f32x4){q, q, q, q}; }
    }
}

extern "C" void kernel_launch(void* const* d_in, const int* in_sizes, int n_in, void* d_out, int out_size, void* d_ws, size_t ws_size, hipStream_t stream) {
    static int grid = 0;
    if (grid == 0) {
        if (n_in != 19 || in_sizes[0] != M * D || out_size != M * D || ws_size < WS_END) { fprintf(stderr, "kernel_launch: shape / workspace mismatch (n_in %d, in0 %d, out %d, ws %zu, need %zu); nothing launched\n", n_in, n_in > 0 ? in_sizes[0] : -1, out_size, ws_size, (size_t)WS_END); grid = -1; return; }
        int dev = 0, cus = 0, per_cu = 0;
        if (hipGetDevice(&dev) != hipSuccess || hipDeviceGetAttribute(&cus, hipDeviceAttributeMultiprocessorCount, dev) != hipSuccess) { grid = -1; return; }
        if (hipFuncSetAttribute((const void*)mega_fwd, hipFuncAttributeMaxDynamicSharedMemorySize, LDS_BYTES) != hipSuccess) { fprintf(stderr, "kernel_launch: hipFuncSetAttribute failed\n"); grid = -1; return; }
        if (hipOccupancyMaxActiveBlocksPerMultiprocessor(&per_cu, (const void*)mega_fwd, NWAVES * 64, LDS_BYTES) != hipSuccess || per_cu < 1) { fprintf(stderr, "kernel_launch: occupancy query reports %d\n", per_cu); }
        (void)hipGetLastError();
        grid = cus;
        if (grid != 256) { fprintf(stderr, "kernel_launch: built for 256 CUs, device has %d; nothing launched\n", cus); grid = -1; return; }
    }
    if (grid < 0) return;
    if (hipMemsetAsync((char*)d_ws + WS_CTL, 0, CTL_ZERO_BYTES, stream) != hipSuccess) return;
    Args a{};
    for (int i = 0; i < 19; ++i) a.in[i] = (const float*)d_in[i];
    a.out = (float*)d_out; a.ws = (unsigned char*)d_ws;
    hipLaunchKernelGGL(mega_fwd, dim3(grid), dim3(NWAVES * 64), LDS_BYTES, stream, a);
}
```

```cpp
#include <hip/hip_runtime.h>
#include <hip/hip_bf16.h>
#include <cstdio>
#include <cstdint>
#include <cmath>

namespace pg8 {
#define PG8_LAS __attribute__((address_space(3)))
typedef unsigned short bf16_t;
typedef short bf16x8 __attribute__((ext_vector_type(8)));
typedef float f32x4 __attribute__((ext_vector_type(4)));
typedef unsigned u32x4 __attribute__((ext_vector_type(4)));
constexpr int BM = 256, BK = 64, HALF = 128, HTB = HALF * BK * 2  , STAGE_BYTES = 8 * HTB, NXCD = 8, WGM = 8;
constexpr int EXPERT_BYTES = 3 * 1024 * 256 * 2;
constexpr int EXPERT_DOWN_OFF = 2 * 1024 * 256 * 2;

__host__ __device__ __forceinline__ int lds_byte(int r, int c) { const int st = (r >> 4) * 2 + (c >> 5), rr = r & 15, cc = c & 31, ob = rr * 64 + cc * 2; return st * 1024 + (ob ^ (((ob >> 9) & 1) << 5)); }
__host__ __device__ __forceinline__ void stage_rc(int b, int& R, int& C) { const int st = b / 1024, sb = b % 1024, swz = sb ^ (((sb >> 9) & 1) << 5); R = (st >> 1) * 16 + swz / 64; C = (st & 1) * 32 + (swz % 64) / 2; }
__host__ __device__ __forceinline__ int perm32(int rho) { const int n = rho >> 4, i = rho & 15; return 8 * (i >> 2) + 4 * n + (i & 3); }

struct Unit { int pm, pn, e, nvalid, lbase, pos0, slot; };

struct StaticOrder {
    int nM, nN, nwg, G, c;
    __device__ __forceinline__ void init(int M, int N, int G_, int c_) { nM = M / BM; nN = N / BM; nwg = nM * nN; G = G_; c = c_; }
    __device__ __forceinline__ bool next(int i, Unit& u) const {
        const long L = (long)i * G + c; if (L >= nwg) return false;
        int wgid = (int)L; { const int q = nwg / NXCD, r = nwg % NXCD, xcd = wgid % NXCD, off = wgid / NXCD; wgid = (xcd < r ? xcd * (q + 1) : r * (q + 1) + (xcd - r) * q) + off; }
        const int nig = WGM * nN, gid = wgid / nig, fm = gid * WGM, gsz = (nM - fm) < WGM ? (nM - fm) : WGM;
        u.pm = fm + ((wgid % nig) % gsz); u.pn = (wgid % nig) / gsz; return true;
    }
};
struct DenseSched {
    StaticOrder o; const char* Bt; int K;
    __device__ __forceinline__ void init(int M, int N, int K_, int G, int c, const bf16_t* Bt_) { o.init(M, N, G, c); Bt = (const char*)Bt_; K = K_; }
    __device__ __forceinline__ bool next(int i, Unit& u) const { u.e = 0; u.nvalid = 256; u.lbase = 0; u.pos0 = 0; u.slot = 0; return o.next(i, u); }
    __device__ __forceinline__ const char* bptr(const Unit& u) const { return Bt + (size_t)u.pn * (BM * 2) * K; }
    __device__ __forceinline__ void avoff(const Unit& u, int tid, unsigned (&v)[2][2]) const {
#pragma unroll
        for (int i = 0; i < 2; ++i) { int R, C; stage_rc(tid * 16 + i * 8192, R, C);
#pragma unroll
            for (int h = 0; h < 2; ++h) v[h][i] = (unsigned)((u.pm * BM + h * HALF + R) * K + C) * 2u; }
    }
};
template <bool GATHER> struct GroupSched {
    const PG8_LAS int* utab; const PG8_LAS int* idx; int nmine, K; const char* W;
    __device__ __forceinline__ bool next(int i, Unit& u) const {
        if (i >= nmine) return false; const PG8_LAS int* t = utab + i * 8;
        u.e = __builtin_amdgcn_readfirstlane(t[0]); u.pm = __builtin_amdgcn_readfirstlane(t[1]); u.pn = __builtin_amdgcn_readfirstlane(t[2]);
        u.nvalid = __builtin_amdgcn_readfirstlane(t[3]); u.lbase = __builtin_amdgcn_readfirstlane(t[4]); u.pos0 = __builtin_amdgcn_readfirstlane(t[5]); u.slot = i; return true;
    }
    __device__ __forceinline__ const char* bptr(const Unit& u) const { return W + (size_t)u.e * EXPERT_BYTES + (size_t)u.pn * (BM * 2) * K; }
    __device__ __forceinline__ void avoff(const Unit& u, int tid, unsigned (&v)[2][2]) const {
#pragma unroll
        for (int i = 0; i < 2; ++i) { int R, C; stage_rc(tid * 16 + i * 8192, R, C);
#pragma unroll
            for (int h = 0; h < 2; ++h) {
                const int row = GATHER ? idx[u.slot * 256 + h * HALF + R] : (u.pm * BM + h * HALF + R);
                v[h][i] = (unsigned)(row * K + C) * 2u; } }
    }
};

typedef float f32x2v __attribute__((ext_vector_type(2))); typedef __bf16 bf16x2v __attribute__((ext_vector_type(2)));
__device__ __forceinline__ unsigned cvt_pk_bf16(float lo, float hi) { f32x2v v = {lo, hi}; bf16x2v b = __builtin_convertvector(v, bf16x2v); return __builtin_bit_cast(unsigned, b); }

struct EpiBf16 {
    static constexpr bool PERM = true; static constexpr int NST = 16;
    bf16_t* O; int ldc; int nsc; float scale;
    __device__ __forceinline__ void operator()(const f32x4 (&acc)[2][2][4][2], const Unit& u, int wr, int wc, int fr, int fq) const {
        const int row0 = u.pm * BM + wr * 64 + fr; const int col0 = u.pn * BM + wc * 32 + 8 * fq; const float sc = (u.pn < nsc) ? scale : 1.f;
#pragma unroll
        for (int ai = 0; ai < 2; ++ai)
#pragma unroll
            for (int m = 0; m < 4; ++m) { bf16_t* rowp = O + (size_t)(row0 + ai * HALF + m * 16) * ldc + col0;
#pragma unroll
                for (int bj = 0; bj < 2; ++bj) { const f32x4 v0 = acc[ai][bj][m][0] * sc, v1 = acc[ai][bj][m][1] * sc;
                    u32x4 w; w.x = cvt_pk_bf16(v0[0], v0[1]); w.y = cvt_pk_bf16(v0[2], v0[3]); w.z = cvt_pk_bf16(v1[0], v1[1]); w.w = cvt_pk_bf16(v1[2], v1[3]);
                    *(u32x4*)(rowp + bj * HALF) = w; } }
    }
};
__device__ __forceinline__ float silu_f(float x) { return x * __builtin_amdgcn_rcpf(1.0f + __builtin_amdgcn_exp2f(-1.4426950408889634f * x)); }
struct EpiM1 {
    static constexpr bool PERM = true; static constexpr int NST = 8;
    bf16_t* H; const PG8_LAS float* lgate;
    __device__ __forceinline__ void operator()(const f32x4 (&acc)[2][2][4][2], const Unit& u, int wr, int wc, int fr, int fq) const {
        const int col0 = u.pn * HALF + wc * 32 + 8 * fq; const PG8_LAS float* lg = lgate + u.slot * 256;
#pragma unroll
        for (int ai = 0; ai < 2; ++ai)
#pragma unroll
            for (int m = 0; m < 4; ++m) { const int r = ai * HALF + wr * 64 + m * 16 + fr;
                const float g = lg[r];
                const f32x4 ga = acc[ai][0][m][0], gb = acc[ai][0][m][1], ua = acc[ai][1][m][0], ub = acc[ai][1][m][1];
                f32x4 v0, v1;
#pragma unroll
                for (int j = 0; j < 4; ++j) { v0[j] = silu_f(ga[j]) * ua[j] * g; v1[j] = silu_f(gb[j]) * ub[j] * g; }
                u32x4 w; w.x = cvt_pk_bf16(v0[0], v0[1]); w.y = cvt_pk_bf16(v0[2], v0[3]); w.z = cvt_pk_bf16(v1[0], v1[1]); w.w = cvt_pk_bf16(v1[2], v1[3]);
                *(u32x4*)(H + (size_t)(u.pm * BM + r) * 256 + col0) = w; }
    }
};
constexpr float Y8_SCALE = 16.f;
typedef unsigned u32x2e __attribute__((ext_vector_type(2)));
struct EpiM2 {
    static constexpr bool PERM = true; static constexpr int NST = 16;
    unsigned char* Y; const PG8_LAS int* ldst;
    __device__ __forceinline__ void operator()(const f32x4 (&acc)[2][2][4][2], const Unit& u, int wr, int wc, int fr, int fq) const {
        const int col0 = u.pn * BM + wc * 32 + 8 * fq; const PG8_LAS int* ld = ldst + u.slot * 256;
#pragma unroll
        for (int ai = 0; ai < 2; ++ai)
#pragma unroll
            for (int m = 0; m < 4; ++m) { const int r = ai * HALF + wr * 64 + m * 16 + fr;
                const int dst = ld[r];
                {
                    unsigned char* rowp = Y + (size_t)dst * 1024 + col0;
#pragma unroll
                    for (int bj = 0; bj < 2; ++bj) { const f32x4 v0 = acc[ai][bj][m][0] * Y8_SCALE, v1 = acc[ai][bj][m][1] * Y8_SCALE;
                        int w0 = __builtin_amdgcn_cvt_pk_fp8_f32(v0[0], v0[1], 0, false); w0 = __builtin_amdgcn_cvt_pk_fp8_f32(v0[2], v0[3], w0, true);
                        int w1 = __builtin_amdgcn_cvt_pk_fp8_f32(v1[0], v1[1], 0, false); w1 = __builtin_amdgcn_cvt_pk_fp8_f32(v1[2], v1[3], w1, true);
                        *(u32x2e*)(rowp + bj * HALF) = (u32x2e){(unsigned)w0, (unsigned)w1}; } } }
    }
};

template <class Epi, class Sched>
__device__ __forceinline__ void gemm_phase(PG8_LAS unsigned char* lds, const bf16_t* Abase, const int K, const Sched& S, const Epi& E, int wave_) {
    asm volatile("" : "+s"(wave_)); unsigned am_; asm volatile("s_mov_b32 %0, -1" : "=s"(am_));
    const int tid = (wave_ << 6) | (int)__builtin_amdgcn_mbcnt_hi(am_, __builtin_amdgcn_mbcnt_lo(am_, 0u));
    const int wid = __builtin_amdgcn_readfirstlane(tid >> 6), lane = tid & 63, wr = wid >> 2, wc = wid & 3, fr = lane & 15, fq = lane >> 4;
    const int nt = K / BK;
    unsigned voffB[2];
#pragma unroll
    for (int i = 0; i < 2; ++i) { int R, C; stage_rc(tid * 16 + i * 8192, R, C); const int Rb = Epi::PERM ? ((R & ~31) + perm32(R & 31)) : R; voffB[i] = (unsigned)(Rb * K + C) * 2u; }
    const size_t kstep = (size_t)(BK * 2);
    const size_t hstep = (size_t)HALF * K * 2;
    const unsigned ldsw = (unsigned)wid * 1024u;
    const int aoff = lds_byte(wr * 64 + fr, fq * 8), boff = lds_byte(wc * 32 + fr, fq * 8);
    const char* Ab = (const char*)Abase;
#define PG8_SA(b, h) (((b) * 2 + (h)) * HTB)
#define PG8_SB(b, h) ((4 + (b) * 2 + (h)) * HTB)
#define PG8_STAGE(bufoff, gbase, voff) do { _Pragma("unroll") for (int _i = 0; _i < 2; ++_i) \
        __builtin_amdgcn_global_load_lds((const unsigned*)((const char*)(gbase) + (voff)[_i]), (PG8_LAS unsigned*)(lds + (bufoff) + ldsw + _i * 8192), 16, 0, 0); } while (0)
#define PG8_STAGEA(bufoff, kb, V, h) do { _Pragma("unroll") for (int _i = 0; _i < 2; ++_i) \
        __builtin_amdgcn_global_load_lds((const unsigned*)(Ab + (kb) + (V)[h][_i]), (PG8_LAS unsigned*)(lds + (bufoff) + ldsw + _i * 8192), 16, 0, 0); } while (0)
#define PG8_LDA(dst, b, h) do { _Pragma("unroll") for (int m = 0; m < 4; ++m) _Pragma("unroll") for (int k = 0; k < 2; ++k) dst[m][k] = *(const PG8_LAS bf16x8*)(lds + PG8_SA(b, h) + aoff + m * 2048 + k * 1024); } while (0)
#define PG8_LDB(dst, b, h) do { _Pragma("unroll") for (int n = 0; n < 2; ++n) _Pragma("unroll") for (int k = 0; k < 2; ++k) dst[n][k] = *(const PG8_LAS bf16x8*)(lds + PG8_SB(b, h) + boff + n * 2048 + k * 1024); } while (0)
#define PG8_MMA(ai, bj, At, Bt) do { __builtin_amdgcn_s_setprio(1); _Pragma("unroll") for (int m = 0; m < 4; ++m) _Pragma("unroll") for (int n = 0; n < 2; ++n) _Pragma("unroll") for (int k = 0; k < 2; ++k) \
        acc[ai][bj][m][n] = __builtin_amdgcn_mfma_f32_16x16x32_bf16(Bt[n][k], At[m][k], acc[ai][bj][m][n], 0, 0, 0); __builtin_amdgcn_s_setprio(0); } while (0)
#define PG8_WAIT_V(n) asm volatile("s_waitcnt vmcnt(" #n ")" ::: "memory")
#define PG8_WAIT_VR(rl) do { if (rl) asm volatile("s_waitcnt vmcnt(%0)" :: "n"(8 + Epi::NST) : "memory"); else asm volatile("s_waitcnt vmcnt(8)" ::: "memory"); } while (0)
#define PG8_WAIT_L(n) asm volatile("s_waitcnt lgkmcnt(" #n ")" ::: "memory")
#define PG8_BAR __builtin_amdgcn_s_barrier()
#define PG8_SCHED __builtin_amdgcn_sched_barrier(0)
    Unit cur, nxt; int ui = 0;
    if (!S.next(0, cur)) return;
    nxt = cur;
    f32x4 acc[2][2][4][2];
#pragma unroll
    for (int a = 0; a < 2; ++a)
#pragma unroll
        for (int b = 0; b < 2; ++b)
#pragma unroll
            for (int m = 0; m < 4; ++m)
#pragma unroll
                for (int n = 0; n < 2; ++n) acc[a][b][m][n] = (f32x4){0.f, 0.f, 0.f, 0.f};
    bf16x8 At[4][2], B0[2][2], B1[2][2];
    unsigned vA[2][2];
    S.avoff(cur, tid, vA);
    const char* cB = S.bptr(cur);
    PG8_STAGE(PG8_SB(0, 0), cB, voffB); PG8_STAGE(PG8_SB(0, 1), cB + hstep, voffB); PG8_STAGEA(PG8_SA(0, 0), 0, vA, 0); PG8_STAGEA(PG8_SA(0, 1), 0, vA, 1);
    if (wr == 1) PG8_BAR;
    PG8_WAIT_V(2); PG8_BAR;
    PG8_STAGE(PG8_SB(1, 0), cB + kstep, voffB); PG8_STAGEA(PG8_SA(1, 0), kstep, vA, 0); PG8_STAGE(PG8_SB(1, 1), cB + hstep + kstep, voffB);
    PG8_WAIT_V(6); PG8_BAR;
    bool relax = false;
    for (;;) {
        const bool has_next = S.next(ui + 1, nxt);
        const char* nB = cB;
        if (has_next) nB = S.bptr(nxt);
#pragma unroll 1
        for (int t = 0; t < nt; t += 2) {
            const bool last = (t == nt - 2); const bool rl = relax && (t == 0);
            const size_t kb1 = (size_t)(t + 1) * kstep;
            const size_t kb2 = last ? (size_t)0 : (size_t)(t + 2) * kstep; const char* b2 = last ? nB : cB + (size_t)(t + 2) * kstep;
            const size_t kb3 = kb2 + kstep; const char* b3 = b2 + kstep;
            PG8_LDB(B0, 0, 0); PG8_LDB(B1, 0, 1); PG8_SCHED; PG8_LDA(At, 0, 0); if (!rl) PG8_STAGEA(PG8_SA(1, 1), kb1, vA, 1);
            if (last && has_next) S.avoff(nxt, tid, vA);
            PG8_WAIT_VR(rl); PG8_WAIT_L(0); PG8_BAR; PG8_MMA(0, 0, At, B0); PG8_MMA(0, 1, At, B1); PG8_BAR; PG8_SCHED;
            PG8_LDA(At, 0, 1); PG8_STAGE(PG8_SB(0, 0), b2, voffB); PG8_STAGE(PG8_SB(0, 1), b2 + hstep, voffB); PG8_STAGEA(PG8_SA(0, 0), kb2, vA, 0);
            PG8_WAIT_VR(rl); PG8_WAIT_L(0); PG8_BAR; PG8_MMA(1, 0, At, B0); PG8_MMA(1, 1, At, B1); PG8_BAR; PG8_SCHED;
            PG8_LDB(B0, 1, 0); PG8_LDB(B1, 1, 1); PG8_SCHED; PG8_LDA(At, 1, 0); PG8_STAGEA(PG8_SA(0, 1), kb2, vA, 1);
            PG8_WAIT_VR(rl); PG8_WAIT_L(0); PG8_BAR; PG8_MMA(0, 0, At, B0); PG8_MMA(0, 1, At, B1); PG8_BAR; PG8_SCHED;
            PG8_LDA(At, 1, 1); PG8_STAGE(PG8_SB(1, 0), b3, voffB); PG8_STAGE(PG8_SB(1, 1), b3 + hstep, voffB); PG8_STAGEA(PG8_SA(1, 0), kb3, vA, 0);
            PG8_WAIT_V(8); PG8_WAIT_L(0); PG8_BAR; PG8_MMA(1, 0, At, B0); PG8_MMA(1, 1, At, B1); PG8_BAR; PG8_SCHED;
        }
        if (wr == 0) PG8_BAR;
        if (has_next) PG8_STAGEA(PG8_SA(1, 1), kstep, vA, 1);
        E(acc, cur, wr, wc, fr, fq);
        if (!has_next) break;
#pragma unroll
        for (int a = 0; a < 2; ++a)
#pragma unroll
            for (int b = 0; b < 2; ++b)
#pragma unroll
                for (int m = 0; m < 4; ++m)
#pragma unroll
                    for (int n = 0; n < 2; ++n) acc[a][b][m][n] = (f32x4){0.f, 0.f, 0.f, 0.f};
        cur = nxt; cB = nB; ++ui; relax = true;
        if (wr == 1) PG8_BAR;
    }
    PG8_WAIT_V(0);
    PG8_BAR;
#undef PG8_SA
#undef PG8_SB
#undef PG8_STAGE
#undef PG8_STAGEA
#undef PG8_LDA
#undef PG8_LDB
#undef PG8_MMA
#undef PG8_WAIT_V
#undef PG8_WAIT_VR
#undef PG8_WAIT_L
#undef PG8_BAR
#undef PG8_SCHED
}
}
namespace attn_body {
using bf16=__hip_bfloat16;
using bf16x8=__attribute__((ext_vector_type(8)))short;
using s16x4=__attribute__((ext_vector_type(4)))short;
using f32x16=__attribute__((ext_vector_type(16)))float;
using u32x4=__attribute__((ext_vector_type(4)))unsigned;
constexpr int D=64,NW=8,QBLK=32,QB=QBLK*NW,KVBLK=64;
__device__ __forceinline__ int crow(int r,int hi){return (r&3)+8*(r>>2)+4*hi;}
#define SBAR() __builtin_amdgcn_sched_barrier(0)
constexpr int NSLOT=3, SLOTB=8192;
constexpr int LDS_K=0, LDS_V=NSLOT*SLOTB, LDS_WS=2*NSLOT*SLOTB, LDS_OST=LDS_WS+NW*64*4, LDS_BYTES=LDS_OST+NW*4096;
constexpr float LOG2E=1.4426950408889634f;
constexpr float C2=0.125f*LOG2E;
__device__ __forceinline__ void glds16(const void*gsrc,unsigned lds_dst){unsigned keep;
  asm volatile("s_mov_b32 %0, m0\n\ts_mov_b32 m0, %2\n\ts_nop 0\n\tglobal_load_lds_dwordx4 %1, off\n\ts_mov_b32 m0, %0":"=&s"(keep):"v"(gsrc),"s"(lds_dst):"memory");}
__device__ __forceinline__ void glds16s(const void*sbase,unsigned voff,unsigned lds_dst){unsigned keep;
  asm volatile("s_mov_b32 %0, m0\n\ts_mov_b32 m0, %3\n\ts_nop 0\n\tglobal_load_lds_dwordx4 %1, %2\n\ts_mov_b32 m0, %0":"=&s"(keep):"v"(voff),"s"(sbase),"s"(lds_dst):"memory");}
__device__ __forceinline__ float max3f(float a,float b,float c){float r;asm("v_max3_f32 %0, %1, %2, %3":"=v"(r):"v"(a),"v"(b),"v"(c));return r;}
__device__ __forceinline__ float max2f(float a,float b){float r;asm("v_max_f32_e32 %0, %1, %2":"=v"(r):"v"(a),"v"(b));return r;}
__device__ __forceinline__ float fadd_s(float a,float b){float r;asm("v_add_f32_e32 %0, %1, %2":"=v"(r):"v"(a),"v"(b));return r;}
__device__ __forceinline__ float fsub_s(float a,float b){float r;asm("v_sub_f32_e32 %0, %1, %2":"=v"(r):"v"(a),"v"(b));return r;}
typedef float f32x2_t __attribute__((ext_vector_type(2))); typedef __bf16 bf16x2_t __attribute__((ext_vector_type(2)));
__device__ __forceinline__ unsigned cvtpk_s(float lo,float hi){f32x2_t v={lo,hi};bf16x2_t b=__builtin_convertvector(v,bf16x2_t);return __builtin_bit_cast(unsigned,b);}
#define WAIT_BAR(N) asm volatile("s_waitcnt vmcnt(" #N ") lgkmcnt(0)\n\ts_barrier":::"memory")

template<int MODE> __device__ __forceinline__ void maskbias(f32x16&p0,f32x16&p1,int kb,int qrel,float slope2,float mhat,bool band,bool tile_ok){
  if(MODE==0)return;
  const float NEG=-INFINITY; const float lb=slope2*(float)(kb-qrel)-mhat;
  #pragma unroll
  for(int r=0;r<16;++r){const int c=(r&3)+8*(r>>2); p0[r]=__builtin_fmaf(slope2,(float)c,p0[r]+lb); p1[r]=__builtin_fmaf(slope2,(float)(c+32),p1[r]+lb);}
  if(MODE==1){ if(band){
    #pragma unroll
    for(int r=0;r<16;++r){const int kv=kb+(r&3)+8*(r>>2); if(kv>qrel)p0[r]=NEG; if(kv+32>qrel)p1[r]=NEG;} } }
  if(MODE==2){
    #pragma unroll
    for(int r=0;r<16;++r){const int d=qrel-kb-((r&3)+8*(r>>2)); if((unsigned)d>=128u||!tile_ok)p0[r]=NEG; if((unsigned)(d-32)>=128u||!tile_ok)p1[r]=NEG;} }
}

__device__ __forceinline__ void qkt(f32x16&p0,f32x16&p1,const char*Kslot,const bf16x8*qr,const f32x16&negm,int r32,int hi){
  const char*kb=Kslot+hi*1024+r32*16;
  #pragma unroll
  for(int d0=0;d0<4;++d0){
    const bf16x8 b0=*reinterpret_cast<const bf16x8*>(kb+d0*2048);
    const bf16x8 b1=*reinterpret_cast<const bf16x8*>(kb+d0*2048+512);
    if(d0==0){p0=__builtin_amdgcn_mfma_f32_32x32x16_bf16(b0,qr[0],negm,0,0,0);p1=__builtin_amdgcn_mfma_f32_32x32x16_bf16(b1,qr[0],negm,0,0,0);}
    else{p0=__builtin_amdgcn_mfma_f32_32x32x16_bf16(b0,qr[d0],p0,0,0,0);p1=__builtin_amdgcn_mfma_f32_32x32x16_bf16(b1,qr[d0],p1,0,0,0);}}
}
template<int C> __device__ __forceinline__ float fmamk_c(float a,float b){float d;asm("v_fmamk_f32 %0, %1, %2, %3":"=v"(d):"v"(a),"n"(__builtin_bit_cast(int,(float)C)),"v"(b));return d;}
typedef __attribute__((address_space(3))) const char* lds_cptr;
typedef short v4i16_t __attribute__((ext_vector_type(4)));
__device__ __forceinline__ void kload8(bf16x8*kf,lds_cptr kp){
  kf[0]=*(const __attribute__((address_space(3))) bf16x8*)(kp);      kf[1]=*(const __attribute__((address_space(3))) bf16x8*)(kp+512);
  kf[2]=*(const __attribute__((address_space(3))) bf16x8*)(kp+2048); kf[3]=*(const __attribute__((address_space(3))) bf16x8*)(kp+2560);
  kf[4]=*(const __attribute__((address_space(3))) bf16x8*)(kp+4096); kf[5]=*(const __attribute__((address_space(3))) bf16x8*)(kp+4608);
  kf[6]=*(const __attribute__((address_space(3))) bf16x8*)(kp+6144); kf[7]=*(const __attribute__((address_space(3))) bf16x8*)(kp+6656);
}
__device__ __forceinline__ void kload2(bf16x8*kf,lds_cptr kp,int j){ kf[2*j]=*(const __attribute__((address_space(3))) bf16x8*)(kp+j*2048); kf[2*j+1]=*(const __attribute__((address_space(3))) bf16x8*)(kp+j*2048+512); }
__device__ __forceinline__ s16x4 vtr(lds_cptr p){ return __builtin_bit_cast(s16x4,__builtin_amdgcn_ds_read_tr16_b64_v4i16((__attribute__((address_space(3))) v4i16_t*)p)); }
__device__ __forceinline__ float rowmax(const f32x16&p0,const f32x16&p1){
  float a=max3f(p0[0],p0[1],p1[0]),b=max3f(p0[2],p0[3],p1[1]);a=max3f(a,p1[2],p1[3]);
  #pragma unroll
  for(int r=4;r<16;r+=4){a=max3f(a,p0[r],p0[r+1]);b=max3f(b,p0[r+2],p0[r+3]);a=max3f(a,p1[r],p1[r+1]);b=max3f(b,p1[r+2],p1[r+3]);}
  const float m=max2f(a,b);
  auto rr=__builtin_amdgcn_permlane32_swap(__float_as_uint(m),__float_as_uint(m),false,false);
  return max2f(__uint_as_float(rr[0]),__uint_as_float(rr[1]));
}
__device__ __forceinline__ void pv(f32x16*o,int vb,bf16x8 pa0,bf16x8 pa1,bf16x8 pa2,bf16x8 pa3){
  #pragma unroll
  for(int d0=0;d0<2;++d0){s16x4 lo[4],hi[4];
    #pragma unroll
    for(int ks=0;ks<4;++ks){
      asm volatile("ds_read_b64_tr_b16 %0,%1 offset:%c2":"=&v"(lo[ks]):"v"(vb),"i"(d0*4096+ks*1024):"memory");
      asm volatile("ds_read_b64_tr_b16 %0,%1 offset:%c2":"=&v"(hi[ks]):"v"(vb),"i"(d0*4096+ks*1024+512):"memory");}
    asm volatile("s_waitcnt lgkmcnt(0)":::"memory");SBAR();
    #define PK(k) (bf16x8){lo[k][0],lo[k][1],lo[k][2],lo[k][3],hi[k][0],hi[k][1],hi[k][2],hi[k][3]}
    o[d0]=__builtin_amdgcn_mfma_f32_32x32x16_bf16(pa0,PK(0),o[d0],0,0,0);
    o[d0]=__builtin_amdgcn_mfma_f32_32x32x16_bf16(pa1,PK(1),o[d0],0,0,0);
    o[d0]=__builtin_amdgcn_mfma_f32_32x32x16_bf16(pa2,PK(2),o[d0],0,0,0);
    o[d0]=__builtin_amdgcn_mfma_f32_32x32x16_bf16(pa3,PK(3),o[d0],0,0,0);
    #undef PK
  }
}
struct AttnArgs {
  const bf16* Qw;
  const bf16* K0; const bf16* V0;
  int NT;
  int tmax;
  bf16* Ow;
  int qrel;
  float slope2, sink2;
  int wave;
};
#define ATTN_STORE16(p,v) (*(u32x4*)(p)=(v))
template<int MODE,int THRL,int QP,int KVP,int OP> __device__ __forceinline__ void attn_unit(const AttnArgs&a,char*shm){
  unsigned am_; asm volatile("s_mov_b32 %0, -1":"=s"(am_)); const int lane=(int)__builtin_amdgcn_mbcnt_hi(am_,__builtin_amdgcn_mbcnt_lo(am_,0u)),r32=lane&31,hi=lane>>5; const int wid=a.wave;
  const bf16*Qw=a.Qw; constexpr int qp=QP; constexpr long kvp=KVP;
  const unsigned lds0=(unsigned)(uintptr_t)shm;
  float*wsf=(float*)(shm+LDS_WS)+wid*64;
  const bf16*ksrc=a.K0+(long)lane*kvp+wid*8;
  const bf16*vsrc=a.V0+(long)(16*(wid&3)+(lane>>2))*kvp+(wid>>2)*32+(lane&3)*8;
  const unsigned kdst=lds0+LDS_K+wid*1024, vdst=lds0+LDS_V+wid*1024;
  const int tmax=a.tmax;
  #define TROW(t) ((MODE==2)?(-64*(((t)<tmax)?(t):tmax)):(64*(t)))
  #define DMA_K(t,slot) glds16(ksrc+(long)TROW(t)*kvp,(unsigned)__builtin_amdgcn_readfirstlane(kdst+(slot)))
  #define DMA_V(t,slot) glds16(vsrc+(long)TROW(t)*kvp,(unsigned)__builtin_amdgcn_readfirstlane(vdst+(slot)))
  const int vb0=(int)(lds0+LDS_V)+((lane>>4)&1)*32+(lane&3)*8+(4*hi+((lane&15)>>2))*64;
  const char*Kbase=shm+LDS_K; bf16x8 kf[8];
  const lds_cptr shm3=(lds_cptr)shm; const lds_cptr kp0=shm3+LDS_K+hi*1024+r32*16; const lds_cptr vp0=shm3+LDS_V+((lane>>4)&1)*32+(lane&3)*8+(4*hi+((lane&15)>>2))*64;
  const int NT=a.NT;
  DMA_K(0,0);DMA_V(0,0);DMA_K(1,SLOTB);
  bf16x8 qr[4];
  #pragma unroll
  for(int d0=0;d0<4;++d0)qr[d0]=*reinterpret_cast<const bf16x8*>(&Qw[(long)r32*qp+d0*16+hi*8]);
  float z0_; asm volatile("v_mov_b32 %0, 0":"=v"(z0_));
  f32x16 zv_; _Pragma("unroll") for(int r=0;r<16;++r)zv_[r]=z0_;
  float mhat=0.f,l_reg=0.f;f32x16 o[2];o[0]=zv_;o[1]=zv_;f32x16 negm=zv_;if(MODE==0)asm volatile("":"+v"(negm));
  const int qrel=a.qrel; const float slope2=a.slope2;
  #define KBREL(t) ((MODE==2)?(-64*(t)):(64*((t)-(NT-4))))
  #define MBIAS(P0,P1,t,BAND) maskbias<MODE>(P0,P1,KBREL(t)+4*hi,qrel,slope2,mhat,(BAND)&&((t)>=NT-4),(t)<=tmax)
  #define CINIT ((MODE==0)?negm:(f32x16{}))
  #define CMASK(P0,P1,t) MBIAS(P0,P1,t,true)
  bool resc=false;
  #define START(P0,P1) do{ const float rm=rowmax(P0,P1); resc=false; \
    { const float dl=rm; mhat=fadd_s(mhat,dl); \
      _Pragma("unroll") for(int r=0;r<16;++r){P0[r]=fsub_s(P0[r],dl);P1[r]=fsub_s(P1[r],dl);} \
      if(MODE==0){ _Pragma("unroll") for(int r=0;r<16;++r)negm[r]=-mhat; asm volatile("":"+v"(negm)); } } \
    _Pragma("unroll") for(int r=0;r<16;++r)P0[r]=__builtin_amdgcn_exp2f(P0[r]); }while(0)
  #define RESC() do{ if(resc){ asm volatile("s_waitcnt lgkmcnt(0)":::"memory"); \
      _Pragma("unroll") for(int d_=0;d_<2;++d_) _Pragma("unroll") for(int r=0;r<16;++r)o[d_][r]*=wsf[crow(r,hi)]; } }while(0)
  f32x16 pA0,pA1,pB0,pB1;
  int sl_prev=0,sl_cur=0,sl_next=SLOTB;
  #define ROT() do{sl_prev=sl_cur;sl_cur=sl_next;sl_next=(sl_next==(NSLOT-1)*SLOTB)?0:sl_next+SLOTB;}while(0)
  DMA_K(2,2*SLOTB);
  WAIT_BAR(3);
  qkt(pA0,pA1,Kbase,qr,negm,r32,hi);asm volatile("s_nop 15\n\ts_nop 7":"+v"(pA0),"+v"(pA1));CMASK(pA0,pA1,0);
  START(pA0,pA1);
  _Pragma("unroll") for(int r=0;r<16;++r)pA1[r]=__builtin_amdgcn_exp2f(pA1[r]);
  WAIT_BAR(0);
  DMA_K(3,0);DMA_V(1,SLOTB);
  ROT();
  kload8(kf,kp0+sl_cur);
  WAIT_BAR(2);
  s16x4 vlo[8],vhi[8]; u32x4 pw0,pw1,pw2,pw3;
  #define PKW(P,B) cvtpk_s(P[B],P[B+1])
  #define PAF(k) __builtin_bit_cast(bf16x8,pw##k)
  #define VFR(i) (bf16x8){vlo[i][0],vlo[i][1],vlo[i][2],vlo[i][3],vhi[i][0],vhi[i][1],vhi[i][2],vhi[i][3]}
  #define PIN(x) asm volatile("":"+v"(x))
  #define MX3(a,b,c) __builtin_fmaxf(__builtin_fmaxf((a),(b)),(c))
  #define GAPA(MF,A0,A1,A2,A3,W0,W1,PW) do{ MF; sacc+=A0; sacc+=A1; sacc+=A2; sacc+=A3; PIN(sacc); W0; W1; PIN(PW); SBAR(); }while(0)
  #define EX(v) __builtin_amdgcn_exp2f(v)
  #define GAPB(MF,X,B) do{ MF; X[B]=EX(X[B]); X[B+1]=EX(X[B+1]); X[B+2]=EX(X[B+2]); X[B+3]=EX(X[B+3]); PIN(X); SBAR(); }while(0)
  #define VRD(i) do{ vlo[i]=vtr(vp_+(((i)>>2)*4096+((i)&3)*1024)); vhi[i]=vtr(vp_+(((i)>>2)*4096+((i)&3)*1024+512)); }while(0)
  #define KRD(G,j) do{ if(G){ kload2(kf,kp0+sl_next,j); SBAR(); } }while(0)
  #define STEP(C0,C1,P0,P1,t,GK,GV,GL) do{ SBAR(); \
    const lds_cptr vp_=vp0+sl_prev; \
    VRD(0); SBAR(); float sacc=(P0[0]+P0[1]); \
    GAPA(C0=__builtin_amdgcn_mfma_f32_32x32x16_bf16(kf[0],qr[0],CINIT,0,0,0), P0[2],P0[3],P0[4],P0[5],     pw0[0]=PKW(P0,0), pw0[1]=PKW(P0,2), pw0); \
    VRD(4); SBAR(); GAPA(C1=__builtin_amdgcn_mfma_f32_32x32x16_bf16(kf[1],qr[0],CINIT,0,0,0), P0[6],P0[7],P0[8],P0[9],     pw0[2]=PKW(P0,4), pw0[3]=PKW(P0,6), pw0); \
    VRD(1); SBAR(); GAPA(C0=__builtin_amdgcn_mfma_f32_32x32x16_bf16(kf[2],qr[1],C0,0,0,0),   P0[10],P0[11],P0[12],P0[13], pw1[0]=PKW(P0,8), pw1[1]=PKW(P0,10), pw1); \
    VRD(5); SBAR(); GAPA(C1=__builtin_amdgcn_mfma_f32_32x32x16_bf16(kf[3],qr[1],C1,0,0,0),   P0[14],P0[15],P1[0],P1[1],   pw1[2]=PKW(P0,12),pw1[3]=PKW(P0,14), pw1); \
    VRD(2); SBAR(); GAPA(C0=__builtin_amdgcn_mfma_f32_32x32x16_bf16(kf[4],qr[2],C0,0,0,0),   P1[2],P1[3],P1[4],P1[5],     pw2[0]=PKW(P1,0), pw2[1]=PKW(P1,2), pw2); \
    VRD(6); SBAR(); GAPA(C1=__builtin_amdgcn_mfma_f32_32x32x16_bf16(kf[5],qr[2],C1,0,0,0),   P1[6],P1[7],P1[8],P1[9],     pw2[2]=PKW(P1,4), pw2[3]=PKW(P1,6), pw2); \
    VRD(3); SBAR(); GAPA(C0=__builtin_amdgcn_mfma_f32_32x32x16_bf16(kf[6],qr[3],C0,0,0,0),   P1[10],P1[11],P1[12],P1[13], pw3[0]=PKW(P1,8), pw3[1]=PKW(P1,10), pw3); \
    VRD(7); SBAR(); GAPA(C1=__builtin_amdgcn_mfma_f32_32x32x16_bf16(kf[7],qr[3],C1,0,0,0),   P1[14],P1[15],0.f,0.f,       pw3[2]=PKW(P1,12),pw3[3]=PKW(P1,14), pw3); \
    l_reg+=sacc; \
    if(GK){DMA_K((t)+3,sl_cur);} if(GV){DMA_V((t)+1,sl_next);} \
    CMASK(C0,C1,t); \
    { float a_=MX3(C0[0],C0[1],C1[0]),b_=MX3(C0[2],C0[3],C1[1]); a_=MX3(a_,C1[2],C1[3]); \
      _Pragma("unroll") for(int r=4;r<16;r+=4){a_=MX3(a_,C0[r],C0[r+1]);b_=MX3(b_,C0[r+2],C0[r+3]);a_=MX3(a_,C1[r],C1[r+1]);b_=MX3(b_,C1[r+2],C1[r+3]);} \
      float rm=__builtin_fmaxf(a_,b_); { auto rr=__builtin_amdgcn_permlane32_swap(__float_as_uint(rm),__float_as_uint(rm),false,false); rm=__builtin_fmaxf(__uint_as_float(rr[0]),__uint_as_float(rr[1])); } \
      resc=false; \
      if(__builtin_expect(__any(rm>(float)THRL),0)){ const float dl=__builtin_fmaxf(rm,0.f); mhat+=dl; \
        _Pragma("unroll") for(int r=0;r<16;++r){C0[r]-=dl;C1[r]-=dl;} \
        if(MODE==0){ _Pragma("unroll") for(int r=0;r<16;++r)negm[r]=-mhat; asm volatile("":"+v"(negm)); } \
        const float f=__builtin_amdgcn_exp2f(-dl); l_reg*=f; if(hi==0)wsf[r32]=f; resc=true; } } \
    SBAR(); \
    GAPB(o[0]=__builtin_amdgcn_mfma_f32_32x32x16_bf16(PAF(0),VFR(0),o[0],0,0,0), C0,0); \
    GAPB(o[1]=__builtin_amdgcn_mfma_f32_32x32x16_bf16(PAF(0),VFR(4),o[1],0,0,0), C0,4); \
    KRD(GL,0); GAPB(o[0]=__builtin_amdgcn_mfma_f32_32x32x16_bf16(PAF(1),VFR(1),o[0],0,0,0), C0,8); \
    KRD(GL,1); GAPB(o[1]=__builtin_amdgcn_mfma_f32_32x32x16_bf16(PAF(1),VFR(5),o[1],0,0,0), C0,12); \
    KRD(GL,2); GAPB(o[0]=__builtin_amdgcn_mfma_f32_32x32x16_bf16(PAF(2),VFR(2),o[0],0,0,0), C1,0); \
    KRD(GL,3); GAPB(o[1]=__builtin_amdgcn_mfma_f32_32x32x16_bf16(PAF(2),VFR(6),o[1],0,0,0), C1,4); \
    GAPB(o[0]=__builtin_amdgcn_mfma_f32_32x32x16_bf16(PAF(3),VFR(3),o[0],0,0,0), C1,8); \
    GAPB(o[1]=__builtin_amdgcn_mfma_f32_32x32x16_bf16(PAF(3),VFR(7),o[1],0,0,0), C1,12); \
    }while(0)
  int t=1;
  #undef CMASK
  #define CMASK(P0,P1,t) MBIAS(P0,P1,t,false)
  for(;t+5<NT;t+=2){
    STEP(pB0,pB1,pA0,pA1,t,true,true,true);     WAIT_BAR(2); RESC(); ROT();
    STEP(pA0,pA1,pB0,pB1,t+1,true,true,true);   WAIT_BAR(2); RESC(); ROT();
  }
  #undef CMASK
  #define CMASK(P0,P1,t) MBIAS(P0,P1,t,true)
  #define ENDW(tt) do{ if((tt)+3<NT){WAIT_BAR(2);} else if((tt)+2<NT){WAIT_BAR(1);} else {WAIT_BAR(0);} }while(0)
  for(;t+1<NT;t+=2){
    STEP(pB0,pB1,pA0,pA1,t,(t+3<NT),(t+1<NT),(t+1<NT));       ENDW(t);   RESC(); ROT();
    STEP(pA0,pA1,pB0,pB1,t+1,(t+4<NT),(t+2<NT),(t+2<NT));     ENDW(t+1); RESC(); ROT();
  }
  STEP(pB0,pB1,pA0,pA1,NT-1,false,false,false); RESC();
  { float sacc=pB0[0]+pB0[1]; _Pragma("unroll") for(int r=2;r<16;++r)sacc+=pB0[r]; _Pragma("unroll") for(int r=0;r<16;++r)sacc+=pB1[r]; l_reg+=sacc;
    pw0=(u32x4){PKW(pB0,0),PKW(pB0,2),PKW(pB0,4),PKW(pB0,6)};pw1=(u32x4){PKW(pB0,8),PKW(pB0,10),PKW(pB0,12),PKW(pB0,14)};pw2=(u32x4){PKW(pB1,0),PKW(pB1,2),PKW(pB1,4),PKW(pB1,6)};pw3=(u32x4){PKW(pB1,8),PKW(pB1,10),PKW(pB1,12),PKW(pB1,14)};
    SBAR(); pv(o,vb0+sl_cur,PAF(0),PAF(1),PAF(2),PAF(3)); }
  #undef PKW
  #undef PAF
  #undef VFR
  #undef PIN
  #undef MX3
  #undef GAPA
  #undef GAPB
  #undef EX
  #undef VRD
  #undef KRD
  #undef STEP
  #undef ENDW
  {auto rr=__builtin_amdgcn_permlane32_swap(__float_as_uint(l_reg),__float_as_uint(l_reg),false,false);l_reg=__uint_as_float(rr[0])+__uint_as_float(rr[1]);}
  if(MODE==2)l_reg+=__builtin_amdgcn_exp2f(a.sink2-mhat);
  if(hi==0)wsf[32+r32]=l_reg;asm volatile("s_waitcnt lgkmcnt(0)":::"memory");
  float rli[16];
  #pragma unroll
  for(int r=0;r<16;++r)rli[r]=__builtin_amdgcn_rcpf(wsf[32+crow(r,hi)]);
  bf16*Ow=a.Ow; constexpr long op=OP;
  { bf16*stg=(bf16*)(shm+LDS_OST)+wid*2048;
    #pragma unroll
    for(int r=0;r<16;++r){const int orow=crow(r,hi);
      #pragma unroll
      for(int d0=0;d0<2;++d0)stg[orow*64+d0*32+r32]=__float2bfloat16(o[d0][r]*rli[r]);}
    asm volatile("s_waitcnt lgkmcnt(0)":::"memory");
    #pragma unroll
    for(int i=0;i<4;++i){const int row=i*8+(lane>>3),ch=lane&7; const u32x4 v=*(const u32x4*)(stg+row*64+ch*8); ATTN_STORE16(Ow+(long)row*op+ch*8,v);} }
  asm volatile("s_waitcnt lgkmcnt(0)\n\ts_barrier":::"memory");
  #undef DMA_K
  #undef DMA_V
  #undef TROW
  #undef KBREL
  #undef MBIAS
  #undef CINIT
  #undef CMASK
  #undef START
  #undef RESC
  #undef ROT
}

constexpr int DP_K=0, DP_V=3*8192, DP_WS=DP_V+3*16384, DP_BYTES=DP_WS+NW*256;
template<int THRL,int QP,int KVP,int OP> __device__ __forceinline__ void diff_unit(const AttnArgs&a,char*shm){
  unsigned am_; asm volatile("s_mov_b32 %0, -1":"=s"(am_)); const int lane=(int)__builtin_amdgcn_mbcnt_hi(am_,__builtin_amdgcn_mbcnt_lo(am_,0u)),r32=lane&31,hi=lane>>5; const int wid=a.wave;
  const bf16*Qw=a.Qw; constexpr int qp=QP; constexpr long kvp=KVP;
  const unsigned lds0=(unsigned)(uintptr_t)shm;
  float*wsf=(float*)(shm+DP_WS)+wid*64;
  const unsigned koff=(unsigned)((lane*KVP+wid*8)*2), voff=(unsigned)(((16*(wid&3)+(lane>>2))*KVP+(wid>>2)*32+(lane&3)*8)*2);
  const char*Kb=(const char*)a.K0; const char*Vb=(const char*)a.V0;
  const unsigned kdst=lds0+DP_K+wid*1024, vdst=lds0+DP_V+wid*1024;
  #define DMA_K(t,slot) glds16s(Kb+(long)(64*(t))*(kvp*2),koff,(unsigned)__builtin_amdgcn_readfirstlane(kdst+(slot)))
  #define DMA_V(t,slot) do{ DMA_VA(t,slot); DMA_VB(t,slot); }while(0)
  #define DMA_VA(t,slot) glds16s(Vb+(long)(64*(t))*(kvp*2),voff,(unsigned)__builtin_amdgcn_readfirstlane(vdst+2*(slot)))
  #define DMA_VB(t,slot) glds16s(Vb+(long)(64*(t))*(kvp*2)+128,voff,(unsigned)__builtin_amdgcn_readfirstlane(vdst+2*(slot)+8192))
  const int vb0=(int)(lds0+DP_V)+((lane>>4)&1)*32+(lane&3)*8+(4*hi+((lane&15)>>2))*64;
  const char*Kbase=shm+DP_K; bf16x8 kf[8];
  const lds_cptr shm3=(lds_cptr)shm; const lds_cptr kp0=shm3+DP_K+hi*1024+r32*16; const lds_cptr vp0=shm3+DP_V+((lane>>4)&1)*32+(lane&3)*8+(4*hi+((lane&15)>>2))*64;
  const int NT=a.NT;
  DMA_K(0,0);DMA_V(0,0);DMA_K(1,SLOTB);
  bf16x8 qr[4];
  #pragma unroll
  for(int d0=0;d0<4;++d0)qr[d0]=*reinterpret_cast<const bf16x8*>(&Qw[(long)r32*qp+d0*16+hi*8]);
  float z0_; asm volatile("v_mov_b32 %0, 0":"=v"(z0_));
  f32x16 zv_; _Pragma("unroll") for(int r=0;r<16;++r)zv_[r]=z0_;
  float mhat=0.f,l_reg=0.f;f32x16 o[4];o[0]=zv_;o[1]=zv_;o[2]=zv_;o[3]=zv_;
  const int qrel=a.qrel; const float slope2=a.slope2;
  float slope2v=slope2; asm volatile("":"+v"(slope2v));
  #define KBREL(t) (64*((t)-(NT-4)))
  #define MBIAS(P0,P1,t,BAND) maskbias<1>(P0,P1,KBREL(t)+4*hi,qrel,slope2,mhat,(BAND)&&((t)>=NT-4),true)
  #define CMASK(P0,P1,t) MBIAS(P0,P1,t,true)
  bool resc=false;
  #define START(P0,P1) do{ const float rm=rowmax(P0,P1); resc=false; \
    { const float dl=rm; mhat=fadd_s(mhat,dl); \
      _Pragma("unroll") for(int r=0;r<16;++r){P0[r]=fsub_s(P0[r],dl);P1[r]=fsub_s(P1[r],dl);} } \
    _Pragma("unroll") for(int r=0;r<16;++r)P0[r]=__builtin_amdgcn_exp2f(P0[r]); }while(0)
  #define RESC() do{ if(resc){ asm volatile("s_waitcnt lgkmcnt(0)":::"memory"); \
      _Pragma("unroll") for(int d_=0;d_<4;++d_) _Pragma("unroll") for(int r=0;r<16;++r)o[d_][r]*=wsf[crow(r,hi)]; } }while(0)
  f32x16 pA0,pA1;
  int sl_prev=0,sl_cur=0,sl_next=SLOTB;
  #define ROT() do{sl_prev=sl_cur;sl_cur=sl_next;sl_next=(sl_next==(NSLOT-1)*SLOTB)?0:sl_next+SLOTB;}while(0)
  DMA_K(2,2*SLOTB);
  WAIT_BAR(4);
  qkt(pA0,pA1,Kbase,qr,zv_,r32,hi);asm volatile("s_nop 15\n\ts_nop 7":"+v"(pA0),"+v"(pA1));CMASK(pA0,pA1,0);
  START(pA0,pA1);
  _Pragma("unroll") for(int r=0;r<16;++r)pA1[r]=__builtin_amdgcn_exp2f(pA1[r]);
  f32x16 pB0,pB1;
  { const float lbn=__builtin_fmaf(slope2,(float)(KBREL(1)+4*hi-qrel),-mhat);
    _Pragma("unroll") for(int r=0;r<16;++r){ const int c=(r&3)+8*(r>>2); pB0[r]=__builtin_fmaf(slope2,(float)c,lbn); pB1[r]=__builtin_fmaf(slope2,(float)(c+32),lbn); } }
  WAIT_BAR(0);
  DMA_K(3,0);DMA_V(1,SLOTB);
  ROT();
  kload8(kf,kp0+sl_cur);
  WAIT_BAR(0);
  s16x4 vlo[8],vhi[8]; u32x4 pw0,pw1,pw2,pw3;
  #define PKW(P,B) cvtpk_s(P[B],P[B+1])
  #define PAF(k) __builtin_bit_cast(bf16x8,pw##k)
  #define VFR(i) (bf16x8){vlo[i][0],vlo[i][1],vlo[i][2],vlo[i][3],vhi[i][0],vhi[i][1],vhi[i][2],vhi[i][3]}
  #define PIN(x) asm volatile("":"+v"(x))
  #define MX3(a,b,c) __builtin_fmaxf(__builtin_fmaxf((a),(b)),(c))
  #define GAPA(MF,A0,A1,A2,A3,W0,W1,PW) do{ MF; sacc+=A0; sacc+=A1; sacc+=A2; sacc+=A3; PIN(sacc); W0; W1; PIN(PW); SBAR(); }while(0)
  #define EX(v) __builtin_amdgcn_exp2f(v)
  #define FILLV(r,OFF) fmamk_c<(((r)&3)+8*((r)>>2))+(OFF)>(slope2v,lbn)
  #define GAPB(MF,X0,X1,E0,E1,E2) do{ MF; E0=EX(E0); E1=EX(E1); E2=EX(E2); PIN(X0); PIN(X1); SBAR(); }while(0)
  #define GAPD(MF,X,E,Y,B,OFF) do{ MF; E=EX(E); Y[B]=FILLV(B,OFF); Y[B+1]=FILLV(B+1,OFF); Y[B+2]=FILLV(B+2,OFF); Y[B+3]=FILLV(B+3,OFF); PIN(X); PIN(Y); SBAR(); }while(0)
  #define GAPC(MF) do{ MF; SBAR(); }while(0)
  #define VRD(i) do{ vlo[i]=vtr(vp_+(((i)>>2)*4096+((i)&3)*1024)); vhi[i]=vtr(vp_+(((i)>>2)*4096+((i)&3)*1024+512)); SBAR(); }while(0)
  #define VRD2(i) do{ vlo[i]=vtr(vp_+(8192+((i)>>2)*4096+((i)&3)*1024)); vhi[i]=vtr(vp_+(8192+((i)>>2)*4096+((i)&3)*1024+512)); SBAR(); }while(0)
  #define KRD(G,j) do{ if(G){ kload2(kf,kp0+sl_next,j); SBAR(); } }while(0)
  #define STEP(C0,C1,P0,P1,t,GK,GV,GL) do{ SBAR(); \
    const lds_cptr vp_=vp0+2*sl_prev; \
    float sacc=(P0[0]+P0[1]); \
    GAPA(C0=__builtin_amdgcn_mfma_f32_32x32x16_bf16(kf[0],qr[0],C0,0,0,0), P0[2],P0[3],P0[4],P0[5],     pw0[0]=PKW(P0,0), pw0[1]=PKW(P0,2), pw0); \
    if(GK){DMA_K((t)+3,sl_cur); SBAR();} \
    GAPA(C1=__builtin_amdgcn_mfma_f32_32x32x16_bf16(kf[1],qr[0],C1,0,0,0), P0[6],P0[7],P0[8],P0[9],     pw0[2]=PKW(P0,4), pw0[3]=PKW(P0,6), pw0); \
    GAPA(C0=__builtin_amdgcn_mfma_f32_32x32x16_bf16(kf[2],qr[1],C0,0,0,0),   P0[10],P0[11],P0[12],P0[13], pw1[0]=PKW(P0,8), pw1[1]=PKW(P0,10), pw1); \
    if(GV){DMA_VA((t)+1,sl_next); SBAR();} \
    GAPA(C1=__builtin_amdgcn_mfma_f32_32x32x16_bf16(kf[3],qr[1],C1,0,0,0),   P0[14],P0[15],P1[0],P1[1],   pw1[2]=PKW(P0,12),pw1[3]=PKW(P0,14), pw1); \
    GAPA(C0=__builtin_amdgcn_mfma_f32_32x32x16_bf16(kf[4],qr[2],C0,0,0,0),   P1[2],P1[3],P1[4],P1[5],     pw2[0]=PKW(P1,0), pw2[1]=PKW(P1,2), pw2); \
    if(GV){DMA_VB((t)+1,sl_next); SBAR();} \
    GAPA(C1=__builtin_amdgcn_mfma_f32_32x32x16_bf16(kf[5],qr[2],C1,0,0,0),   P1[6],P1[7],P1[8],P1[9],     pw2[2]=PKW(P1,4), pw2[3]=PKW(P1,6), pw2); \
    GAPA(C0=__builtin_amdgcn_mfma_f32_32x32x16_bf16(kf[6],qr[3],C0,0,0,0),   P1[10],P1[11],P1[12],P1[13], pw3[0]=PKW(P1,8), pw3[1]=PKW(P1,10), pw3); \
    VRD(0); GAPA(C1=__builtin_amdgcn_mfma_f32_32x32x16_bf16(kf[7],qr[3],C1,0,0,0),   P1[14],P1[15],0.f,0.f,       pw3[2]=PKW(P1,12),pw3[3]=PKW(P1,14), pw3); \
    l_reg+=sacc; \
    VRD(4); VRD(1); VRD(5); \
    SMASK(C0,C1,t); \
    { float a_=MX3(C0[0],C0[1],C1[0]),b_=MX3(C0[2],C0[3],C1[1]); a_=MX3(a_,C1[2],C1[3]); \
      _Pragma("unroll") for(int r=4;r<16;r+=4){a_=MX3(a_,C0[r],C0[r+1]);b_=MX3(b_,C0[r+2],C0[r+3]);a_=MX3(a_,C1[r],C1[r+1]);b_=MX3(b_,C1[r+2],C1[r+3]);} \
      float rm=__builtin_fmaxf(a_,b_); { auto rr=__builtin_amdgcn_permlane32_swap(__float_as_uint(rm),__float_as_uint(rm),false,false); rm=__builtin_fmaxf(__uint_as_float(rr[0]),__uint_as_float(rr[1])); } \
      resc=false; \
      if(__builtin_expect(__any(rm>(float)THRL),0)){ const float dl=__builtin_fmaxf(rm,0.f); mhat+=dl; \
        _Pragma("unroll") for(int r=0;r<16;++r){C0[r]-=dl;C1[r]-=dl;} \
        const float f=__builtin_amdgcn_exp2f(-dl); l_reg*=f; if(hi==0)wsf[r32]=f; resc=true; } } \
    const float lbn=__builtin_fmaf(slope2,(float)(KBREL((t)+1)+4*hi-qrel),-mhat); \
    SBAR(); \
    VRD(2); GAPB(o[0]=__builtin_amdgcn_mfma_f32_32x32x16_bf16(PAF(0),VFR(0),o[0],0,0,0), C0,C1, C0[0],C0[1],C0[2]);    VRD2(0); \
    VRD(6); GAPB(o[1]=__builtin_amdgcn_mfma_f32_32x32x16_bf16(PAF(0),VFR(4),o[1],0,0,0), C0,C1, C0[3],C0[4],C0[5]);    VRD2(4); \
    VRD(3); GAPB(o[0]=__builtin_amdgcn_mfma_f32_32x32x16_bf16(PAF(1),VFR(1),o[0],0,0,0), C0,C1, C0[6],C0[7],C0[8]);    VRD2(1); \
    VRD(7); GAPB(o[1]=__builtin_amdgcn_mfma_f32_32x32x16_bf16(PAF(1),VFR(5),o[1],0,0,0), C0,C1, C0[9],C0[10],C0[11]);  VRD2(5); \
    GAPB(o[0]=__builtin_amdgcn_mfma_f32_32x32x16_bf16(PAF(2),VFR(2),o[0],0,0,0), C0,C1, C0[12],C0[13],C0[14]); VRD2(2); \
    GAPB(o[1]=__builtin_amdgcn_mfma_f32_32x32x16_bf16(PAF(2),VFR(6),o[1],0,0,0), C0,C1, C0[15],C1[0],C1[1]);   VRD2(6); \
    GAPB(o[0]=__builtin_amdgcn_mfma_f32_32x32x16_bf16(PAF(3),VFR(3),o[0],0,0,0), C0,C1, C1[2],C1[3],C1[4]);    VRD2(3); \
    GAPB(o[1]=__builtin_amdgcn_mfma_f32_32x32x16_bf16(PAF(3),VFR(7),o[1],0,0,0), C0,C1, C1[5],C1[6],C1[7]);    VRD2(7); \
    KRD(GL,0); GAPD(o[2]=__builtin_amdgcn_mfma_f32_32x32x16_bf16(PAF(0),VFR(0),o[2],0,0,0), C1,C1[8], P0,0,0); \
    KRD(GL,1); GAPD(o[3]=__builtin_amdgcn_mfma_f32_32x32x16_bf16(PAF(0),VFR(4),o[3],0,0,0), C1,C1[9], P0,4,0); \
    KRD(GL,2); GAPD(o[2]=__builtin_amdgcn_mfma_f32_32x32x16_bf16(PAF(1),VFR(1),o[2],0,0,0), C1,C1[10],P0,8,0); \
    KRD(GL,3); GAPD(o[3]=__builtin_amdgcn_mfma_f32_32x32x16_bf16(PAF(1),VFR(5),o[3],0,0,0), C1,C1[11],P0,12,0); \
    GAPD(o[2]=__builtin_amdgcn_mfma_f32_32x32x16_bf16(PAF(2),VFR(2),o[2],0,0,0), C1,C1[12],P1,0,32); \
    GAPD(o[3]=__builtin_amdgcn_mfma_f32_32x32x16_bf16(PAF(2),VFR(6),o[3],0,0,0), C1,C1[13],P1,4,32); \
    GAPD(o[2]=__builtin_amdgcn_mfma_f32_32x32x16_bf16(PAF(3),VFR(3),o[2],0,0,0), C1,C1[14],P1,8,32); \
    GAPD(o[3]=__builtin_amdgcn_mfma_f32_32x32x16_bf16(PAF(3),VFR(7),o[3],0,0,0), C1,C1[15],P1,12,32); \
    }while(0)
  int t=1;
  #define SMASK(P0,P1,t) do{}while(0)
  for(;t+5<NT;t+=2){
    STEP(pB0,pB1,pA0,pA1,t,true,true,true);     WAIT_BAR(0); RESC(); ROT();
    STEP(pA0,pA1,pB0,pB1,t+1,true,true,true);   WAIT_BAR(0); RESC(); ROT();
  }
  #undef SMASK
  #define SMASK(P0,P1,t) do{ if((t)>=NT-4){ int dq_=qrel-(KBREL(t)+4*hi); asm volatile("":"+v"(dq_));        \
    _Pragma("unroll") for(int r=0;r<16;++r){ const int c_=(r&3)+8*(r>>2); if(c_>dq_)P0[r]=-INFINITY; if(c_+32>dq_)P1[r]=-INFINITY; } } }while(0)
  #define ENDW(tt) do{ WAIT_BAR(0); }while(0)
  for(;t+1<NT;t+=2){
    STEP(pB0,pB1,pA0,pA1,t,(t+3<NT),(t+1<NT),(t+1<NT));       ENDW(t);   RESC(); ROT();
    STEP(pA0,pA1,pB0,pB1,t+1,(t+4<NT),(t+2<NT),(t+2<NT));     ENDW(t+1); RESC(); ROT();
  }
  STEP(pB0,pB1,pA0,pA1,NT-1,false,false,false); RESC();
  { float sacc=pB0[0]+pB0[1]; _Pragma("unroll") for(int r=2;r<16;++r)sacc+=pB0[r]; _Pragma("unroll") for(int r=0;r<16;++r)sacc+=pB1[r]; l_reg+=sacc;
    pw0=(u32x4){PKW(pB0,0),PKW(pB0,2),PKW(pB0,4),PKW(pB0,6)};pw1=(u32x4){PKW(pB0,8),PKW(pB0,10),PKW(pB0,12),PKW(pB0,14)};pw2=(u32x4){PKW(pB1,0),PKW(pB1,2),PKW(pB1,4),PKW(pB1,6)};pw3=(u32x4){PKW(pB1,8),PKW(pB1,10),PKW(pB1,12),PKW(pB1,14)};
    SBAR(); pv(o,vb0+2*sl_cur,PAF(0),PAF(1),PAF(2),PAF(3)); pv(o+2,vb0+2*sl_cur+8192,PAF(0),PAF(1),PAF(2),PAF(3)); }
  #undef PKW
  #undef PAF
  #undef VFR
  #undef PIN
  #undef MX3
  #undef GAPA
  #undef GAPB
  #undef GAPD
  #undef GAPC
  #undef EX
  #undef VRD
  #undef VRD2
  #undef KRD
  #undef STEP
  #undef ENDW
  #undef SMASK
  #undef FILLV
  {auto rr=__builtin_amdgcn_permlane32_swap(__float_as_uint(l_reg),__float_as_uint(l_reg),false,false);l_reg=__uint_as_float(rr[0])+__uint_as_float(rr[1]);}
  if(hi==0)wsf[32+r32]=l_reg;asm volatile("s_waitcnt lgkmcnt(0)":::"memory");
  float rli[16];
  #pragma unroll
  for(int r=0;r<16;++r)rli[r]=__builtin_amdgcn_rcpf(wsf[32+crow(r,hi)]);
  asm volatile("s_waitcnt lgkmcnt(0)\n\ts_barrier":::"memory");
  { bf16*stg=(bf16*)(shm)+wid*4096;
    #pragma unroll
    for(int r=0;r<16;++r){const int orow=crow(r,hi);
      #pragma unroll
      for(int dq=0;dq<4;++dq)stg[orow*128+dq*32+r32]=__float2bfloat16(o[dq][r]*rli[r]);}
    asm volatile("s_waitcnt lgkmcnt(0)":::"memory");
    #pragma unroll
    for(int i=0;i<8;++i){const int row=i*4+(lane>>4),ch=lane&15; const u32x4 v=*(const u32x4*)(stg+row*128+ch*8); *(u32x4*)(a.Ow+(long)row*OP+ch*8)=v;} }
  asm volatile("s_waitcnt lgkmcnt(0)\n\ts_barrier":::"memory");
  #undef DMA_K
  #undef DMA_V
  #undef DMA_VA
  #undef DMA_VB
  #undef KBREL
  #undef MBIAS
  #undef CMASK
  #undef START
  #undef RESC
  #undef ROT
}
constexpr int ATTN_LDS_BYTES=LDS_BYTES;
#undef SBAR
#undef WAIT_BAR
}
constexpr int NWAVES = 8;
constexpr int BATCH = 2, SEQ = 16384, D = 1024, M = BATCH * SEQ, DEPTH = 4, MEMLEN = 256;
constexpr int NPA = 1536, NPB = 2560;
constexpr int NEXP = 64, CAP = 32768, HID = 256;
constexpr int HROWS = (M * 8 / 256 + NEXP + M / 256) * 256;
constexpr float LN_EPS = 1e-5f;
constexpr float DN_ALPHA = 1.681792830507429f;
__device__ const float SLOPES_A[12] = {0.5f, 0.25f, 0.125f, 0.0625f, 0.03125f, 0.015625f, 0.0078125f, 0.00390625f, 0.7071067811865476f, 0.35355339059327384f, 0.17677669529663695f, 0.08838834764831849f};
__device__ const float SLOPES_B[6] = {0.25f, 0.0625f, 0.015625f, 0.00390625f, 0.5f, 0.125f};

constexpr size_t MiB = 1u << 20;
constexpr size_t WS_CTL = 0, CTL_ZERO_BYTES = 1 * MiB;
constexpr size_t WS_MEMKV = 2 * MiB;
constexpr size_t WS_WROUT = 4 * MiB;
constexpr size_t WS_WINA = 6 * MiB, WS_WINB = 12 * MiB;
constexpr size_t WS_WOUT = 22 * MiB;
constexpr size_t WS_WMKV = 30 * MiB;
constexpr size_t WS_MEMB = 34 * MiB;
constexpr size_t WS_LOGIT = 36 * MiB;
constexpr size_t WS_ROWTOK = 44 * MiB, WS_ROWGATE = 52 * MiB;
constexpr size_t WS_WEXP = 60 * MiB;
constexpr size_t WS_XB = 158 * MiB;
constexpr size_t WS_HB = 222 * MiB;
constexpr size_t WS_BIG = 374 * MiB;
constexpr size_t WS_QKV = WS_BIG, WS_OTMP = WS_BIG + 160 * MiB, WS_CAT = WS_BIG + 256 * MiB, WS_Y = WS_BIG + 320 * MiB;
constexpr size_t WS_END = WS_BIG + 576 * MiB;
static_assert(WS_WEXP + 65 * (size_t)pg8::EXPERT_BYTES <= WS_XB && WS_HB + (size_t)HROWS * 512 <= WS_BIG, "d_ws map");
constexpr int CW_TMO = 0;
constexpr int CW_BAR = 4096;
constexpr int CW_CNT = 16384;
constexpr int CW_Q = CW_CNT + DEPTH * 64 * 64;
constexpr int CW_NORM = CW_Q + 64 * DEPTH;
static_assert((CW_NORM + 64 * DEPTH) * 4 <= (int)CTL_ZERO_BYTES, "CTL words inside the memset region");

constexpr int RING_OFF = 0, RING_BYTES = 131072;
constexpr int LDSCTL_OFF = RING_BYTES;
constexpr int TAB_OFF = RING_BYTES + 512;
constexpr int IDX_OFF = RING_BYTES + 2560;
constexpr int GATE_OFF = IDX_OFF + 10 * 1024;
constexpr int LDS_BYTES = 163840;
static_assert(IDX_OFF + 20 * 1024 <= LDS_BYTES, "LDS map");

#define GAS __attribute__((address_space(1)))
#define LAS __attribute__((address_space(3)))
typedef unsigned short bf16;
typedef unsigned v4u __attribute__((ext_vector_type(4)));
typedef unsigned v2u __attribute__((ext_vector_type(2)));
typedef float f32x4 __attribute__((ext_vector_type(4)));
typedef GAS unsigned gu32;
#define RLX_AGENT __ATOMIC_RELAXED, __HIP_MEMORY_SCOPE_AGENT
#define LDS_WAIT() asm volatile("s_waitcnt lgkmcnt(0)" ::: "memory")
__device__ __forceinline__ unsigned f2bf(float f) { unsigned u = __builtin_bit_cast(unsigned, f); return (u + 0x7fffu + ((u >> 16) & 1u)) >> 16; }
__device__ __forceinline__ unsigned pk2(float lo, float hi) { return f2bf(lo) | (f2bf(hi) << 16); }
__device__ __forceinline__ float bflo(unsigned u) { return __builtin_bit_cast(float, u << 16); }
__device__ __forceinline__ float bfhi(unsigned u) { return __builtin_bit_cast(float, u & 0xffff0000u); }

#define XB_TMO      128
#define XB_XCNT(j)  (256  + 64 * (j))
#define XB_XSUB(j)  (1280 + 64 * (j))
#define XB_XGEN(j)  (2304 + 64 * (j))
#define XB_TOP      3328
#define XB_TOPGEN   3392
#define XCD_BAR_WORDS 3456
#define XB_SPIN_CAP (1u << 18)
__device__ __forceinline__ unsigned xb_ld(unsigned* p)              { return __hip_atomic_load(p, __ATOMIC_RELAXED, __HIP_MEMORY_SCOPE_AGENT); }
__device__ __forceinline__ unsigned xb_add(unsigned* p, unsigned v) { return __hip_atomic_fetch_add(p, v, __ATOMIC_RELAXED, __HIP_MEMORY_SCOPE_AGENT); }
__device__ __forceinline__ unsigned xb_xcc_id() { return (unsigned)__builtin_amdgcn_s_getreg((3 << 11) | 20) & 0xFu; }
#define XB_SPIN(cond, bar) do { unsigned _sp = 0; while (cond) { __builtin_amdgcn_s_sleep(1); \
    if ((++_sp & 255u) == 0u) { if (xb_ld(&(bar)[XB_TMO])) break; if (_sp > XB_SPIN_CAP) { atomicAdd(&(bar)[XB_TMO], 1u); break; } } } } while (0)
struct XcdBarrier { unsigned* bar; unsigned x; volatile LAS unsigned* st; };
__device__ __forceinline__ XcdBarrier xcd_barrier_post(unsigned* bar, volatile LAS unsigned* st, const bool t0) {
    XcdBarrier b; b.bar = bar; b.x = xb_xcc_id(); b.st = st;
    if (t0) (void)xb_add(&bar[XB_XCNT(b.x)], 1u);
    return b;
}
__device__ __forceinline__ void xcd_barrier_complete(unsigned* bar, unsigned x, unsigned& nloc, unsigned& nx) {
    const unsigned G = gridDim.x * gridDim.y * gridDim.z;
    unsigned sum, cnt, mine, sp = 0u;
    for (;;) {
        sum = 0u; cnt = 0u; mine = 0u;
#pragma unroll
        for (unsigned j = 0; j < 16; ++j) { const unsigned c = xb_ld(&bar[XB_XCNT(j)]); sum += c; cnt += (c > 0u) ? 1u : 0u; mine = (j == x) ? c : mine; }
        if (sum == G) break;
        __builtin_amdgcn_s_sleep(1);
        if ((++sp & 255u) == 0u) { if (xb_ld(&bar[XB_TMO])) break; if (sp > XB_SPIN_CAP) { atomicAdd(&bar[XB_TMO], 1u); break; } }
    }
    nloc = mine > 0u ? mine : 1u; nx = cnt > 0u ? cnt : 1u;
}
__device__ __forceinline__ void xcd_barrier(const XcdBarrier& b, const bool t0) {
    asm volatile("s_waitcnt vmcnt(0)" ::: "memory");
    __syncthreads();
    if (t0) {
        unsigned* bar = b.bar;
        __builtin_amdgcn_s_waitcnt(0);
        unsigned nloc = b.st[0], nx = b.st[1];
        if (nloc == 0u) { xcd_barrier_complete(bar, b.x, nloc, nx); b.st[0] = nloc; b.st[1] = nx; }
        const unsigned old = xb_add(&bar[XB_XSUB(b.x)], 1u);
        const unsigned gen = old / nloc;
        if (old + 1u == (gen + 1u) * nloc) {
            __builtin_amdgcn_fence(__ATOMIC_RELEASE, "agent");
            asm volatile("s_waitcnt vmcnt(0)" ::: "memory");
            const unsigned og = xb_add(&bar[XB_TOP], 1u);
            const unsigned tg = og / nx;
            if (og + 1u == (tg + 1u) * nx) xb_add(&bar[XB_TOPGEN], 1u);
            else XB_SPIN(xb_ld(&bar[XB_TOPGEN]) == tg, bar);
            __builtin_amdgcn_fence(__ATOMIC_ACQUIRE, "agent");
            xb_add(&bar[XB_XGEN(b.x)], 1u);
            asm volatile("s_waitcnt vmcnt(0)" ::: "memory");
        } else {
            XB_SPIN(xb_ld(&bar[XB_XGEN(b.x)]) == gen, bar);
            __builtin_amdgcn_fence(__ATOMIC_ACQUIRE, "agent");
            asm volatile("s_waitcnt vmcnt(0)" ::: "memory");
        }
    }
    __syncthreads();
}

struct Frame { LAS unsigned char* lds; int wave; };
__device__ __forceinline__ int f_G() { int g = (int)gridDim.x; asm volatile("" : "+s"(g)); return g; }
__device__ __forceinline__ int f_bx() { int b = (int)blockIdx.x; asm volatile("" : "+s"(b)); return b; }
__device__ __forceinline__ int f_gw(const Frame& F) { const int g = f_G(), b = f_bx(); return ((g % 8 == 0) ? (b % 8) * (g / 8) + b / 8 : b) * NWAVES + F.wave; }
__device__ __forceinline__ int f_ngw() { return f_G() * NWAVES; }
__device__ __forceinline__ volatile LAS unsigned* f_misc(const Frame& F) { return (volatile LAS unsigned*)(F.lds + LDSCTL_OFF); }
__device__ __forceinline__ int lane_id() { unsigned m; asm volatile("s_mov_b32 %0, -1" : "=s"(m)); return (int)__builtin_amdgcn_mbcnt_hi(m, __builtin_amdgcn_mbcnt_lo(m, 0u)); }
__device__ __forceinline__ int tid_of(int wave) { asm volatile("" : "+s"(wave)); return (wave << 6) | lane_id(); }
#define fresh_tid() tid_of(F.wave)
__device__ __forceinline__ float sx(float v, int o, int ln) { return __builtin_bit_cast(float, __builtin_amdgcn_ds_bpermute((ln ^ o) << 2, __builtin_bit_cast(int, v))); }
__device__ __forceinline__ float wave_sum(float v) {
    const int ln_ = lane_id();
#pragma unroll
    for (int o = 1; o < 64; o <<= 1) v += sx(v, o, ln_);
    return v;
}
__device__ __forceinline__ void transpose_item64(const float* W, int N, bf16* WT, int ldt, int k0, int n0, int drow0, LAS float* scr, int lane) {
    const int rr = lane >> 4, cc = (lane & 15) * 4;
    f32x4 v[16];
#pragma unroll
    for (int i = 0; i < 16; ++i) { const int kk = 4 * i + rr; v[i] = *(const GAS f32x4*)(W + (size_t)(k0 + kk) * N + n0 + cc); }
#pragma unroll
    for (int i = 0; i < 16; ++i) { const int kk = 4 * i + rr; LAS float* d = scr + kk * 65 + cc; d[0] = v[i].x; d[1] = v[i].y; d[2] = v[i].z; d[3] = v[i].w; }
    LDS_WAIT(); asm volatile("" ::: "memory");
    const int c = lane & 7;
#pragma unroll
    for (int j = 0; j < 8; ++j) { const int n = (lane >> 3) + 8 * j; const LAS float* s = scr + (8 * c) * 65 + n;
        v4u o; o.x = pk2(s[0 * 65], s[1 * 65]); o.y = pk2(s[2 * 65], s[3 * 65]); o.z = pk2(s[4 * 65], s[5 * 65]); o.w = pk2(s[6 * 65], s[7 * 65]);
        *(GAS v4u*)(WT + (size_t)(drow0 + n) * ldt + k0 + 8 * c) = o; }
    LDS_WAIT(); asm volatile("" ::: "memory");
}
__device__ __forceinline__ int map_in_a(int n) { return n < 768 ? n : (n < 960 ? n + 256 : (n < 1152 ? n + 256 : n - 384)); }
__device__ __forceinline__ int map_in_b(int n) { return n < 768 ? n : (n < 2304 ? n + 256 : n - 1536); }

struct Args { const float* in[19]; float* out; unsigned char* ws; };
typedef const __attribute__((address_space(4))) Args* ArgsP;
__device__ __forceinline__ ArgsP fresh_args() { ArgsP p = (ArgsP)__builtin_amdgcn_kernarg_segment_ptr(); asm volatile("" : "+s"(p)); return p; }
__device__ __forceinline__ gu32* f_ctl() { return (gu32*)(fresh_args()->ws + WS_CTL); }

__device__ __forceinline__ void p0_small_weights(Frame& F, ArgsP A) {
    const int tid_ = fresh_tid(), lane_ = tid_ & 63; (void)tid_; (void)lane_;
    LAS float* scr = (LAS float*)(F.lds + (F.wave < 7 ? RING_OFF + F.wave * 16640 : IDX_OFF));
    unsigned char* ws = A->ws;
    constexpr int I_A = 16 * 22, I_B = 16 * 40, I_M = 16 * 8, I_O = 16 * 16, I_R = 16;
    constexpr int NITEMS = 2 * I_A + 2 * I_B + 4 * I_M + 4 * I_O + 4 * I_R;
    for (int it = f_gw(F); it < NITEMS; it += f_ngw()) {
        int r = it;
        if (r < 2 * I_A) { const int j = r / I_A; r %= I_A; const int kb = r / 22, nb = r % 22;
            transpose_item64(A->in[2] + (size_t)j * D * 1408, 1408, (bf16*)(ws + WS_WINA) + (size_t)j * NPA * D, D, 64 * kb, 64 * nb, map_in_a(64 * nb), scr, lane_); continue; } r -= 2 * I_A;
        if (r < 2 * I_B) { const int j = r / I_B; r %= I_B; const int kb = r / 40, nb = r % 40;
            transpose_item64(A->in[4] + (size_t)j * D * 2560, 2560, (bf16*)(ws + WS_WINB) + (size_t)j * NPB * D, D, 64 * kb, 64 * nb, map_in_b(64 * nb), scr, lane_); continue; } r -= 2 * I_B;
        if (r < 4 * I_M) { const int l = r / I_M; r %= I_M; const int kb = r / 8, nb = r % 8;
            transpose_item64(A->in[7] + (size_t)l * D * 512, 512, (bf16*)(ws + WS_WMKV), D, 64 * kb, 64 * nb, l * 512 + 64 * nb, scr, lane_); continue; } r -= 4 * I_M;
        if (r < 4 * I_O) { const int l = r / I_O; r %= I_O; const int kb = r / 16, nb = r % 16;
            transpose_item64(A->in[8] + (size_t)l * D * D, D, (bf16*)(ws + WS_WOUT) + (size_t)l * D * D, D, 64 * kb, 64 * nb, 64 * nb, scr, lane_); continue; } r -= 4 * I_O;
        { const int l = r / I_R; const int kb = r % I_R;
            transpose_item64(A->in[11] + (size_t)l * D * 64, 64, (bf16*)(ws + WS_WROUT) + (size_t)l * 256 * D, D, 64 * kb, 0, 0, scr, lane_); }
    }
    for (int it = f_gw(F); it < 2 * 128 + 4 * 192; it += f_ngw()) {
        bf16* row = it < 256 ? (bf16*)(ws + WS_WINA) + ((size_t)(it >> 7) * NPA + 1408 + (it & 127)) * D
                             : (bf16*)(ws + WS_WROUT) + ((size_t)((it - 256) / 192) * 256 + 64 + (it - 256) % 192) * D;
        GAS v4u* o = (GAS v4u*)row + lane_;
        o[0] = (v4u){0u, 0u, 0u, 0u}; o[64] = (v4u){0u, 0u, 0u, 0u};
    }
    for (int m0 = 4 * f_gw(F); m0 < 512 + M; m0 += 4 * f_ngw()) {
        f32x4 v[4][4];
#pragma unroll
        for (int r = 0; r < 4; ++r) { const int m = m0 + r; const float* src = m < 512 ? A->in[1] + (size_t)m * D : A->in[0] + (size_t)(m - 512) * D;
            const GAS f32x4* xr = (const GAS f32x4*)src + lane_;
#pragma unroll
            for (int j = 0; j < 4; ++j) v[r][j] = xr[64 * j]; }
#pragma unroll
        for (int r = 0; r < 4; ++r) { const int m = m0 + r; bf16* dst = m < 512 ? (bf16*)(ws + WS_MEMB) + (size_t)m * D : (bf16*)(ws + WS_XB) + (size_t)(m - 512) * D;
            GAS v2u* o8 = (GAS v2u*)dst + lane_;
#pragma unroll
            for (int j = 0; j < 4; ++j) o8[64 * j] = (v2u){pk2(v[r][j].x, v[r][j].y), pk2(v[r][j].z, v[r][j].w)}; }
    }
}
constexpr int CONV_ITEMS = 65 * 192, CONV_UNITS = CONV_ITEMS / 8;
__device__ __forceinline__ void convert_item(ArgsP A, int layer, int it, LAS float* scr, int lane_) {
    bf16* wexp = (bf16*)(A->ws + WS_WEXP);
    const int e = it / 192, mat = (it % 192) >> 6, r = it & 63;
    bf16* dst = wexp + (size_t)e * (pg8::EXPERT_BYTES / 2);
    if (mat < 2) { const float* W = (e < 64) ? A->in[13 + mat] + ((size_t)layer * 64 + e) * (D * HID) : A->in[16 + mat] + (size_t)layer * (D * HID);
        const int kb = r >> 2, nb = r & 3, n0 = 64 * nb;
        transpose_item64(W, HID, dst, D, 64 * kb, n0, (n0 >> 7) * 256 + mat * 128 + (n0 & 127), scr, lane_); }
    else { const float* W = (e < 64) ? A->in[15] + ((size_t)layer * 64 + e) * (HID * D) : A->in[18] + (size_t)layer * (HID * D);
        const int kb = r >> 4, nb = r & 15;
        transpose_item64(W, D, dst + pg8::EXPERT_DOWN_OFF / 2, HID, 64 * kb, 64 * nb, 64 * nb, scr, lane_); }
}
__device__ __forceinline__ void convert_unit(Frame& F, ArgsP A, int layer, int cu) {
    const int tid_ = fresh_tid(), lane_ = tid_ & 63; (void)tid_;
    LAS float* scr = (LAS float*)(F.lds + (F.wave < 7 ? RING_OFF + F.wave * 16640 : IDX_OFF));
    const int it = 8 * cu + F.wave;
    if (it < CONV_ITEMS) convert_item(A, layer, it, scr, lane_);
    asm volatile("s_waitcnt lgkmcnt(0)\n\ts_barrier" ::: "memory");
}
template <bool LAST> __device__ __forceinline__ void ph_combine_ln2(Frame& F, float* xout, const unsigned char* yt, const float* g, const float* b, bf16* xb) {
    typedef float f32x2c __attribute__((ext_vector_type(2)));
    const int tid_ = fresh_tid(), lane_ = tid_ & 63; (void)tid_;
    for (int m = f_gw(F); m < M; m += f_ngw()) {
        GAS v4u* o8 = (GAS v4u*)(xb + (size_t)m * D) + 2 * lane_; const GAS v4u* yr = (const GAS v4u*)(yt + (size_t)m * 9 * D) + lane_;
        float v[16];
#pragma unroll
        for (int i = 0; i < 16; ++i) v[i] = 0.f;
#pragma unroll
        for (int k = 0; k < 9; ++k) { const v4u w = yr[k * 64];
#pragma unroll
            for (int q = 0; q < 4; ++q) { const f32x2c lo = __builtin_amdgcn_cvt_pk_f32_fp8((int)w[q], false), hi = __builtin_amdgcn_cvt_pk_f32_fp8((int)w[q], true);
                v[4 * q] += lo.x; v[4 * q + 1] += lo.y; v[4 * q + 2] += hi.x; v[4 * q + 3] += hi.y; } }
        float s = 0.f;
#pragma unroll
        for (int h = 0; h < 2; ++h) { const v4u xw = o8[h];
#pragma unroll
            for (int q = 0; q < 4; ++q) { v[8 * h + 2 * q] = v[8 * h + 2 * q] * (1.f / pg8::Y8_SCALE) + DN_ALPHA * bflo(xw[q]); v[8 * h + 2 * q + 1] = v[8 * h + 2 * q + 1] * (1.f / pg8::Y8_SCALE) + DN_ALPHA * bfhi(xw[q]); } }
#pragma unroll
        for (int i = 0; i < 16; ++i) s += v[i];
        const float mean = wave_sum(s) * (1.f / D); float s2 = 0.f;
#pragma unroll
        for (int i = 0; i < 16; ++i) { v[i] -= mean; s2 += v[i] * v[i]; }
        const float rstd = 1.f / sqrtf(wave_sum(s2) * (1.f / D) + LN_EPS);
        const GAS f32x4* gp = (const GAS f32x4*)g + 4 * lane_; const GAS f32x4* bp = (const GAS f32x4*)b + 4 * lane_;
        GAS f32x4* xo = (GAS f32x4*)(xout + (size_t)m * D) + 4 * lane_;
        float o[16];
#pragma unroll
        for (int q = 0; q < 4; ++q) { const f32x4 gv = gp[q], bv = bp[q];
            o[4 * q] = v[4 * q] * rstd * gv.x + bv.x; o[4 * q + 1] = v[4 * q + 1] * rstd * gv.y + bv.y; o[4 * q + 2] = v[4 * q + 2] * rstd * gv.z + bv.z; o[4 * q + 3] = v[4 * q + 3] * rstd * gv.w + bv.w;
            if (LAST) xo[q] = (f32x4){o[4 * q], o[4 * q + 1], o[4 * q + 2], o[4 * q + 3]}; }
        if (!LAST) { o8[0] = (v4u){pk2(o[0], o[1]), pk2(o[2], o[3]), pk2(o[4], o[5]), pk2(o[6], o[7])}; o8[1] = (v4u){pk2(o[8], o[9]), pk2(o[10], o[11]), pk2(o[12], o[13]), pk2(o[14], o[15])}; }
    }
}
__device__ __forceinline__ void ph_diff_combine(Frame& F, const bf16* otmp, const float* lq, const float* subg, float lam_init, bf16* cat) {
    const int tid_ = fresh_tid(), lane_ = tid_ & 63; (void)tid_; (void)lane_;
    float lam;
    { const float a = lq[lane_] * lq[64 + lane_], c = lq[128 + lane_] * lq[192 + lane_]; lam = expf(wave_sum(a)) - expf(wave_sum(c)) + lam_init; }
    const int l32 = lane_ & 31, hh = lane_ >> 5;
    const f32x4 gv = ((const GAS f32x4*)subg)[l32]; const float post = 1.f - lam_init;
    for (int m = f_gw(F); m < M; m += f_ngw()) {
#pragma unroll
        for (int hp = 0; hp < 3; ++hp) { const int h = 2 * hp + hh;
            const v2u a0 = *((const GAS v2u*)(otmp + (size_t)m * 1536 + h * 256) + l32), a1 = *((const GAS v2u*)(otmp + (size_t)m * 1536 + h * 256 + 128) + l32);
            f32x4 o; o.x = bflo(a0.x) - lam * bflo(a1.x); o.y = bfhi(a0.x) - lam * bfhi(a1.x); o.z = bflo(a0.y) - lam * bflo(a1.y); o.w = bfhi(a0.y) - lam * bfhi(a1.y);
            float s2 = (o.x * o.x + o.y * o.y) + (o.z * o.z + o.w * o.w);
#pragma unroll
            for (int sft = 1; sft < 32; sft <<= 1) s2 += sx(s2, sft, lane_);
            const float r = post / sqrtf(s2 * (1.f / 128.f) + LN_EPS);
            o = o * r * gv;
            *((GAS v2u*)(cat + (size_t)m * D + h * 128) + l32) = (v2u){pk2(o.x, o.y), pk2(o.z, o.w)}; }
    }
}
__device__ __forceinline__ float ss8(v4u a) { float s = 0.f;
#pragma unroll
    for (int i = 0; i < 4; ++i) { const float lo = bflo(a[i]), hi = bfhi(a[i]); s += lo * lo + hi * hi; } return s; }
__device__ __forceinline__ void ph_qknorm(Frame& F, const bf16* qkv, gu32* gmax) {
    const int tid_ = fresh_tid(), lane_ = tid_ & 63;
    LAS unsigned* lmax = (LAS unsigned*)(F.lds + LDSCTL_OFF) + 32;
    if (tid_ < 24) lmax[tid_] = 0u;
    __syncthreads();
    float mq0 = 0.f, mq1 = 0.f, mk0 = 0.f, mk1 = 0.f;
    const v4u zero = (v4u){0u, 0u, 0u, 0u};
    for (int m = f_gw(F); m < M; m += f_ngw()) {
        const bf16* row = qkv + (size_t)m * NPB;
        const v4u a = *(const GAS v4u*)(row + 8 * lane_), c = *(const GAS v4u*)(row + 1024 + 8 * lane_);
        v4u b = zero, d = zero; if (lane_ < 32) { b = *(const GAS v4u*)(row + 512 + 8 * lane_); d = *(const GAS v4u*)(row + 1536 + 8 * lane_); }
        float sa = ss8(a), sb = ss8(b), sc = ss8(c), sd = ss8(d);
#pragma unroll
        for (int o = 1; o < 8; o <<= 1) { sa += sx(sa, o, lane_); sb += sx(sb, o, lane_); sc += sx(sc, o, lane_); sd += sx(sd, o, lane_); }
        mq0 = fmaxf(mq0, sa); mq1 = fmaxf(mq1, sb); mk0 = fmaxf(mk0, sc); mk1 = fmaxf(mk1, sd);
    }
    if ((lane_ & 7) == 0) { const int g = lane_ >> 3;
        __hip_atomic_fetch_max(lmax + g, __float_as_uint(mq0), __ATOMIC_RELAXED, __HIP_MEMORY_SCOPE_WORKGROUP); __hip_atomic_fetch_max(lmax + 12 + g, __float_as_uint(mk0), __ATOMIC_RELAXED, __HIP_MEMORY_SCOPE_WORKGROUP);
        if (lane_ < 32) { __hip_atomic_fetch_max(lmax + 8 + g, __float_as_uint(mq1), __ATOMIC_RELAXED, __HIP_MEMORY_SCOPE_WORKGROUP); __hip_atomic_fetch_max(lmax + 20 + g, __float_as_uint(mk1), __ATOMIC_RELAXED, __HIP_MEMORY_SCOPE_WORKGROUP); } }
    __syncthreads();
    if (tid_ < 24) __hip_atomic_fetch_max(gmax + tid_, lmax[tid_], RLX_AGENT);
}
typedef short bf16x8r __attribute__((ext_vector_type(8)));
constexpr int RT_SC_OFF = TAB_OFF, RT_GB_OFF = TAB_OFF + 16384;
static_assert(RT_GB_OFF + 8192 <= LDS_BYTES, "LDS map (route phase)");
template <bool XF32> __device__ __forceinline__ void ph_ln_route(Frame& F, const float* xin, const bf16* y, const float* g, const float* b, bf16* xb, const bf16* wrt, const float* rbias, gu32* cnt, int* rowtok, float* rowgate, float* gtmp) {
    const int tid_ = fresh_tid(), lane_ = tid_ & 63;
    for (int i = tid_; i < 64 * 128; i += NWAVES * 64) { const int e = i >> 7, c = i & 127;
        const v4u v = *(const GAS v4u*)(wrt + (size_t)e * D + c * 8); *(LAS v4u*)(F.lds + e * 2048 + ((c ^ (e & 15)) << 4)) = v; }
    LAS float* lgb = (LAS float*)(F.lds + RT_GB_OFF);
    if (tid_ < 256) { ((LAS f32x4*)lgb)[tid_] = ((const GAS f32x4*)g)[tid_]; ((LAS f32x4*)lgb)[256 + tid_] = ((const GAS f32x4*)b)[tid_]; }
    __syncthreads();
    LAS float* sc = (LAS float*)(F.lds + RT_SC_OFF) + F.wave * 512;
    const int r = lane_ & 15, kq = lane_ >> 4; const float bias = rbias[lane_]; const float NINF = -INFINITY;
    constexpr int RB_ = 8;
    for (int base = f_gw(F) * 16; base < M; base += f_ngw() * 16) {
#pragma unroll 1
        for (int r4 = 0; r4 < 16; r4 += RB_) {
            f32x4 v[RB_][4]; float s1[RB_];
#pragma unroll
            for (int q = 0; q < RB_; ++q) { const size_t mo = (size_t)(base + r4 + q) * D; const GAS v2u* yr = (const GAS v2u*)(y + mo) + lane_; s1[q] = 0.f;
#pragma unroll
                for (int j = 0; j < 4; ++j) { f32x4 xv;
                    if (XF32) xv = ((const GAS f32x4*)(xin + mo) + lane_)[64 * j]; else { const v2u xw = ((const GAS v2u*)(xb + mo) + lane_)[64 * j]; xv = (f32x4){bflo(xw.x), bfhi(xw.x), bflo(xw.y), bfhi(xw.y)}; }
                    const v2u yv = yr[64 * j];
                    v[q][j].x = DN_ALPHA * xv.x + bflo(yv.x); v[q][j].y = DN_ALPHA * xv.y + bfhi(yv.x); v[q][j].z = DN_ALPHA * xv.z + bflo(yv.y); v[q][j].w = DN_ALPHA * xv.w + bfhi(yv.y);
                    s1[q] += (v[q][j].x + v[q][j].y) + (v[q][j].z + v[q][j].w); } }
#pragma unroll
            for (int o = 1; o < 64; o <<= 1) {
#pragma unroll
                for (int q = 0; q < RB_; ++q) s1[q] += sx(s1[q], o, lane_); }
            float s2[RB_];
#pragma unroll
            for (int q = 0; q < RB_; ++q) { const float mean = s1[q] * (1.f / D); s2[q] = 0.f;
#pragma unroll
                for (int j = 0; j < 4; ++j) { v[q][j] = v[q][j] - mean; s2[q] += (v[q][j].x * v[q][j].x + v[q][j].y * v[q][j].y) + (v[q][j].z * v[q][j].z + v[q][j].w * v[q][j].w); } }
#pragma unroll
            for (int o = 1; o < 64; o <<= 1) {
#pragma unroll
                for (int q = 0; q < RB_; ++q) s2[q] += sx(s2[q], o, lane_); }
#pragma unroll
            for (int q = 0; q < RB_; ++q) { const float rstd = 1.f / sqrtf(s2[q] * (1.f / D) + LN_EPS); GAS v2u* o8 = (GAS v2u*)(xb + (size_t)(base + r4 + q) * D) + lane_;
#pragma unroll
                for (int j = 0; j < 4; ++j) { const LAS f32x4* gp = (const LAS f32x4*)lgb + lane_ + 64 * j; const f32x4 gv = gp[0], bv = gp[256];
                    const f32x4 o = v[q][j] * rstd * gv + bv; o8[64 * j] = (v2u){pk2(o.x, o.y), pk2(o.z, o.w)}; } }
        }
        asm volatile("s_waitcnt vmcnt(0)" ::: "memory");
        f32x4 acc[4];
#pragma unroll
        for (int nt = 0; nt < 4; ++nt) acc[nt] = (f32x4){0.f, 0.f, 0.f, 0.f};
        const bf16* arow = xb + (size_t)(base + r) * D + 8 * kq;
#pragma unroll 16
        for (int s = 0; s < 32; ++s) { const v4u aw = __builtin_nontemporal_load((const GAS v4u*)(arow + 32 * s)); const bf16x8r af = __builtin_bit_cast(bf16x8r, aw);
#pragma unroll
            for (int nt = 0; nt < 4; ++nt) { const int e = 16 * nt + r, c = 4 * s + kq;
                const bf16x8r bfr = *(const LAS bf16x8r*)(F.lds + e * 2048 + ((c ^ (e & 15)) << 4));
                acc[nt] = __builtin_amdgcn_mfma_f32_16x16x32_bf16(bfr, af, acc[nt], 0, 0, 0); } }
        unsigned selmask = 0u; unsigned long long slots = 0ull; unsigned mycount = 0u;
#pragma unroll 1
        for (int half = 0; half < 2; ++half) {
            if ((r >> 3) == half) {
#pragma unroll
                for (int nt = 0; nt < 4; ++nt) *(LAS f32x4*)(sc + (r & 7) * 64 + 16 * nt + 4 * kq) = acc[nt]; }
            LDS_WAIT(); asm volatile("" ::: "memory");
#pragma unroll 1
            for (int j8 = 0; j8 < 8; ++j8) { const int j = half * 8 + j8;
                const float logit = sc[j8 * 64 + lane_];
                const float aff = 1.f / (1.f + expf(-logit)); const float sel = aff + bias;
                float m1 = sel; m1 = fmaxf(m1, sx(m1, 1, lane_)); m1 = fmaxf(m1, sx(m1, 2, lane_)); m1 = fmaxf(m1, sx(m1, 4, lane_));
                const unsigned long long bm = __ballot(sel == m1); const unsigned gb = (unsigned)(bm >> (lane_ & 56)) & 0xffu; const int first = __builtin_ctz(gb | 0x100u);
                float m2 = ((lane_ & 7) == first) ? NINF : sel; m2 = fmaxf(m2, sx(m2, 1, lane_)); m2 = fmaxf(m2, sx(m2, 2, lane_)); m2 = fmaxf(m2, sx(m2, 4, lane_));
                const float gs = m1 + m2; int grank = 0;
#pragma unroll
                for (int g2 = 0; g2 < 8; ++g2) { const float o = __builtin_bit_cast(float, __builtin_amdgcn_readlane(__builtin_bit_cast(int, gs), 8 * g2)); grank += (o > gs || (o == gs && g2 < (lane_ >> 3))) ? 1 : 0; }
                const bool gok = grank < 4; const float v = gok ? sel : NINF; int er = 0;
#pragma unroll 8
                for (int e2 = 0; e2 < 64; ++e2) { const float o = __builtin_bit_cast(float, __builtin_amdgcn_readlane(__builtin_bit_cast(int, v), e2)); er += (o > v) ? 1 : 0; }
                bool chosen = gok && er < 8;
                if (__builtin_popcountll(__ballot(chosen)) != 8) {
                    er = 0;
#pragma unroll 8
                    for (int e2 = 0; e2 < 64; ++e2) { const float o = __builtin_bit_cast(float, __builtin_amdgcn_readlane(__builtin_bit_cast(int, v), e2)); er += (o > v || (o == v && e2 < lane_)) ? 1 : 0; }
                    chosen = gok && er < 8; }
                const float ssum = wave_sum(chosen ? aff : 0.f);
                const unsigned long long bal = __ballot(chosen); const unsigned slot = __builtin_amdgcn_mbcnt_hi((unsigned)(bal >> 32), __builtin_amdgcn_mbcnt_lo((unsigned)bal, 0u));
                if (chosen) { selmask |= 1u << j; slots |= (unsigned long long)slot << (4 * j); ++mycount; gtmp[(size_t)(base + j) * 64 + lane_] = aff / ssum * 2.5f; }
            }
            LDS_WAIT(); asm volatile("" ::: "memory");
        }
        unsigned pos = 0u;
        { LAS unsigned* wgc = (LAS unsigned*)(F.lds + LDSCTL_OFF) + 64;
            if (tid_ < 64) wgc[tid_] = 0u;
            __syncthreads();
            if (mycount) pos = __hip_atomic_fetch_add(wgc + lane_, mycount, __ATOMIC_RELAXED, __HIP_MEMORY_SCOPE_WORKGROUP);
            __syncthreads();
            if (tid_ < 64) { const unsigned tot = wgc[tid_]; unsigned gb = 0u; if (tot) gb = __hip_atomic_fetch_add(cnt + 64 * tid_, tot, RLX_AGENT); wgc[tid_] = gb; }
            __syncthreads();
            pos += wgc[lane_];
            __syncthreads(); }
#pragma unroll 1
        for (int j = 0; j < 16; ++j) if ((selmask >> j) & 1u) { const size_t at = (size_t)lane_ * CAP + pos; ++pos;
            rowtok[at] = (base + j) | ((int)((slots >> (4 * j)) & 15ull) << 16); rowgate[at] = gtmp[(size_t)(base + j) * 64 + lane_]; }
    }
}
template <bool M1> __device__ __forceinline__ int build_units(Frame& F, gu32* cnt, const int* rowtok, const float* rowgate) {
    const int tid_ = fresh_tid();
    LAS int* tcnt = (LAS int*)(F.lds + TAB_OFF); LAS int* bst = tcnt + 80; LAS int* utab = tcnt + 160; LAS int* idx = (LAS int*)(F.lds + IDX_OFF); LAS float* lgate = (LAS float*)(F.lds + GATE_OFF);
    if (tid_ < 64) {
        const int c = (int)__hip_atomic_load(cnt + 64 * tid_, RLX_AGENT); const int nb = (c + 255) >> 8; int incl = nb;
#pragma unroll
        for (int o = 1; o < 64; o <<= 1) { const int u = __builtin_amdgcn_ds_bpermute((tid_ - o) << 2, incl); if (tid_ >= o) incl += u; }
        tcnt[tid_] = c; bst[tid_] = incl - nb;
        if (tid_ == 63) { tcnt[64] = M; bst[64] = incl; bst[65] = incl + M / 256; }
    }
    __syncthreads();
    const int nblk = bst[65]; const int bx = blockIdx.x;
    const int per = M1 ? 128 : 64, blk0 = M1 ? (16 * (bx & 7) + (bx >> 4)) : (8 * (bx & 7) + (bx >> 5)), pn = M1 ? ((bx >> 3) & 1) : ((bx >> 3) & 3);
    int nmine = (nblk > blk0) ? (nblk - blk0 + per - 1) / per : 0; if (nmine > (M1 ? 10 : 20)) nmine = M1 ? 10 : 20;
    if (tid_ < nmine) { const int blk = tid_ * per + blk0;
        int e = 0;
#pragma unroll
        for (int st = 64; st > 0; st >>= 1) { const int q = e + st; if (q <= 64 && bst[q] <= blk) e = q; }
        const int j = blk - bst[e]; int nv = tcnt[e] - 256 * j; if (nv > 256) nv = 256;
        LAS int* t = utab + tid_ * 8; t[0] = e; t[1] = blk; t[2] = pn; t[3] = nv; t[4] = e * CAP + 256 * j; t[5] = 256 * j; }
    __syncthreads();
    for (int q = tid_; q < nmine * 256; q += NWAVES * 64) { const int g = q >> 8, i = q & 255;
        const LAS int* t = utab + g * 8; const int e = t[0], nv = t[3];
        if (M1) { int tok = 0; float gt = 0.f;
            if (e == 64) { tok = t[5] + i; gt = 1.f; } else if (i < nv) { tok = rowtok[t[4] + i] & 0xffff; gt = rowgate[t[4] + i]; }
            idx[q] = tok; lgate[q] = gt; }
        else { int dst = M * 9;
            if (e == 64) dst = (t[5] + i) * 9 + 8; else if (i < nv) { const int v = rowtok[t[4] + i]; dst = (v & 0xffff) * 9 + (v >> 16); }
            idx[q] = dst; } }
    __syncthreads();
    return nmine;
}
#define WSP(T, off) ((T*)(A->ws + (off)))
#ifndef REP_P1
#define REP_P1 1
#endif
#ifndef REP_P2
#define REP_P2 1
#endif
#ifndef REP_P3
#define REP_P3 1
#endif
#ifndef REP_P5
#define REP_P5 1
#endif
#ifndef REP_P7
#define REP_P7 1
#endif
#ifndef REP_P8
#define REP_P8 1
#endif
#define REPEAT(n) _Pragma("unroll 1") for (int rep_ = 0; rep_ < (n); ++rep_)
#define OPQ(x) asm volatile("" : "+s"(x))
#define FCTL() f_ctl()
#define FRESH_GB() const int G = f_G(), bx = f_bx(); (void)G; (void)bx
__global__ void __launch_bounds__(NWAVES * 64, 2) mega_fwd(Args args_unused) {
    extern __shared__ __attribute__((aligned(16))) unsigned char lds[];
    Frame F;
    F.lds = (LAS unsigned char*)lds;
    F.wave = __builtin_amdgcn_readfirstlane((int)threadIdx.x >> 6);
    for (int u = fresh_tid(); u < 512 / 4; u += NWAVES * 64) ((LAS unsigned*)(F.lds + LDSCTL_OFF))[u] = 0u;
    __syncthreads();
    (void)xcd_barrier_post((unsigned*)(f_ctl() + CW_BAR), f_misc(F) + 8, fresh_tid() == 0);
#define GRID_BAR() do { XcdBarrier bar_; bar_.bar = (unsigned*)(f_ctl() + CW_BAR); bar_.x = xb_xcc_id(); bar_.st = f_misc(F) + 8; xcd_barrier(bar_, fresh_tid() == 0); } while (0)

    { ArgsP A = fresh_args(); FRESH_GB(); p0_small_weights(F, A); }
    GRID_BAR();
    {   ArgsP A = fresh_args(); FRESH_GB();
        pg8::DenseSched S; S.init(512, 2048, D, G, bx, WSP(const bf16, WS_WMKV));
        pg8::EpiBf16 E{WSP(bf16, WS_MEMKV), 2048, 0, 1.f};
        pg8::gemm_phase<pg8::EpiBf16, pg8::DenseSched>(F.lds + RING_OFF, WSP(const bf16, WS_MEMB), D, S, E, F.wave); }

    for (int layer = 0; layer < DEPTH; ++layer) {
        const int jm = layer >> 1; const bool isB = (layer & 1) != 0;
        REPEAT(REP_P1) {
        if (!isB) { ArgsP A = fresh_args(); FRESH_GB();
            pg8::DenseSched S; S.init(M, NPA, D, G, bx, WSP(const bf16, WS_WINA) + (size_t)jm * NPA * D);
            pg8::EpiBf16 E{WSP(bf16, WS_QKV), NPA, 4, attn_body::C2};
            pg8::gemm_phase<pg8::EpiBf16, pg8::DenseSched>(F.lds + RING_OFF, WSP(const bf16, WS_XB), D, S, E, F.wave); }
        else { ArgsP A = fresh_args(); FRESH_GB();
            pg8::DenseSched S; S.init(M, NPB, D, G, bx, WSP(const bf16, WS_WINB) + (size_t)jm * NPB * D);
            pg8::EpiBf16 E{WSP(bf16, WS_QKV), NPB, 4, attn_body::C2};
            pg8::gemm_phase<pg8::EpiBf16, pg8::DenseSched>(F.lds + RING_OFF, WSP(const bf16, WS_XB), D, S, E, F.wave); }
        GRID_BAR();
        }
        if (isB) {
            ArgsP A = fresh_args();
            ph_qknorm(F, WSP(const bf16, WS_QKV), FCTL() + CW_NORM + 64 * layer);
            GRID_BAR();
        }
        REPEAT(REP_P2) {
        if (!isB) {
            { FRESH_GB();
            for (int L = bx; L < 1536; L += G) {
                ArgsP A = fresh_args(); const bf16* qkv = WSP(const bf16, WS_QKV); const int wave = F.wave;
                const int b = L / 768, rem = L % 768, qblk = rem / 3, kvh = rem % 3;
                const int q0u = qblk * 64, head = kvh * 4 + (wave >> 1); const size_t rowq = (size_t)b * SEQ + q0u + 32 * (wave & 1);
                attn_body::AttnArgs a;
                a.Qw = (const attn_body::bf16*)(qkv + rowq * NPA + head * 64);
                a.K0 = (const attn_body::bf16*)(qkv + ((size_t)b * SEQ + q0u) * NPA + 1024 + kvh * 64); a.V0 = a.K0 + 192;
                a.NT = 4; a.tmax = qblk; a.Ow = (attn_body::bf16*)(WSP(bf16, WS_CAT) + rowq * D + head * 64);
                a.qrel = 32 * (wave & 1) + (fresh_tid() & 31); a.slope2 = SLOPES_A[head] * attn_body::LOG2E; a.sink2 = A->in[3][jm * 12 + head] * attn_body::LOG2E; a.wave = F.wave;
                attn_body::attn_unit<2, 8, NPA, NPA, D>(a, (char*)lds + RING_OFF);
                convert_unit(F, A, layer, L);
            }
            for (int cu = 1536 + bx; cu < CONV_UNITS; cu += G) { ArgsP A = fresh_args(); convert_unit(F, A, layer, cu); } }
            { FRESH_GB();
            for (int L = bx; L < 512; L += G) {
                ArgsP A = fresh_args(); const int wave = F.wave;
                const int b = L / 256, rem = L % 256, qb = rem >> 2, hm = rem & 3;
                const size_t rowq = (size_t)b * SEQ + qb * 256 + 32 * wave;
                attn_body::AttnArgs a;
                a.Qw = (const attn_body::bf16*)(WSP(const bf16, WS_QKV) + rowq * NPA + 768 + hm * 64);
                a.K0 = (const attn_body::bf16*)(WSP(const bf16, WS_MEMKV) + (size_t)b * MEMLEN * 2048 + layer * 512 + hm * 64); a.V0 = a.K0 + 256;
                a.NT = 4; a.tmax = 1 << 30; a.Ow = (attn_body::bf16*)(WSP(bf16, WS_CAT) + rowq * D + 768 + hm * 64);
                a.qrel = 32 * wave + (fresh_tid() & 31); a.slope2 = 0.f; a.sink2 = 0.f; a.wave = F.wave;
                attn_body::attn_unit<0, 8, NPA, 2048, D>(a, (char*)lds + RING_OFF);
            } }
        } else {
            {
                gu32* q0 = FCTL() + CW_Q + 64 * layer + 16 * rep_;
                int turn = 0; bool doneA = false, doneC = false, have = true; unsigned nextL = 0u;
                if (fresh_tid() == 0) nextL = __hip_atomic_fetch_add(q0, 1u, RLX_AGENT);
                for (;;) {
                    if (!have) { if (fresh_tid() == 0) nextL = __hip_atomic_fetch_add(q0 + turn, 1u, RLX_AGENT); }
                    if (fresh_tid() == 0) f_misc(F)[16] = nextL;
                    __syncthreads();
                    const int L = __builtin_amdgcn_readfirstlane((int)f_misc(F)[16]);
                    __syncthreads();
                    have = false;
                    if (L >= (turn ? CONV_UNITS : 1536)) { if (turn) doneC = true; else doneA = true; if (doneA && doneC) break; turn ^= 1; continue; }
                    const int nturn = turn ? (doneA ? 1 : 0) : (doneC ? 0 : 1);
                    if (turn | nturn) { if (fresh_tid() == 0) nextL = __hip_atomic_fetch_add(q0 + nturn, 1u, RLX_AGENT); have = true; }
                    ArgsP A = fresh_args(); const bf16* qkv = WSP(const bf16, WS_QKV); const int wave = F.wave;
                    if (turn) { convert_unit(F, A, layer, L); turn = nturn; continue; }
                    turn = nturn;
                    const int qb = 63 - L / 24, rem = L % 24, b = rem / 12, hc = rem % 12, h = hc >> 1, c = hc & 1;
                    const size_t rowq = (size_t)b * SEQ + qb * 256 + 32 * wave;
                    const float slope2 = SLOPES_B[h] * attn_body::LOG2E;
                    const float q2m = __uint_as_float(__hip_atomic_load(FCTL() + CW_NORM + 64 * layer + hc, RLX_AGENT)), k2m = __uint_as_float(__hip_atomic_load(FCTL() + CW_NORM + 64 * layer + 12 + hc, RLX_AGENT));
                    const float B2 = sqrtf(q2m * k2m) * 1.03f + 0.5f, dcut = (160.f + 2.f * B2) / slope2;
                    int t0 = (int)floorf(((float)(qb * 256 - 63) - dcut) * (1.f / 64.f)); t0 = __builtin_amdgcn_readfirstlane(t0 > 0 ? (t0 & ~1) : 0);
                    attn_body::AttnArgs a;
                    a.Qw = (const attn_body::bf16*)(qkv + rowq * NPB + hc * 64);
                    a.K0 = (const attn_body::bf16*)(qkv + ((size_t)b * SEQ + 64 * t0) * NPB + 1024 + hc * 64); a.V0 = (const attn_body::bf16*)(qkv + ((size_t)b * SEQ + 64 * t0) * NPB + 1792 + h * 128);
                    a.NT = 4 * (qb + 1) - t0; a.tmax = 1 << 30; a.Ow = (attn_body::bf16*)(WSP(bf16, WS_OTMP) + rowq * 1536 + hc * 128);
                    a.qrel = 32 * wave + (fresh_tid() & 31); a.slope2 = slope2; a.sink2 = 0.f; a.wave = F.wave;
                    attn_body::diff_unit<16, NPB, NPB, 1536>(a, (char*)lds + RING_OFF);
                }
            }
            { FRESH_GB();
            for (int L = bx; L < 512; L += G) {
                ArgsP A = fresh_args(); const int wave = F.wave;
                const int b = L / 256, rem = L % 256, qb = rem >> 2, hm = rem & 3;
                const size_t rowq = (size_t)b * SEQ + qb * 256 + 32 * wave;
                attn_body::AttnArgs a;
                a.Qw = (const attn_body::bf16*)(WSP(const bf16, WS_QKV) + rowq * NPB + 768 + hm * 64);
                a.K0 = (const attn_body::bf16*)(WSP(const bf16, WS_MEMKV) + (size_t)b * MEMLEN * 2048 + layer * 512 + hm * 64); a.V0 = a.K0 + 256;
                a.NT = 4; a.tmax = 1 << 30; a.Ow = (attn_body::bf16*)(WSP(bf16, WS_CAT) + rowq * D + 768 + hm * 64);
                a.qrel = 32 * wave + (fresh_tid() & 31); a.slope2 = 0.f; a.sink2 = 0.f; a.wave = F.wave;
                attn_body::attn_unit<0, 8, NPB, 2048, D>(a, (char*)lds + RING_OFF);
            } }
        }
        GRID_BAR();
        }
        if (isB) {
            ArgsP A = fresh_args(); FRESH_GB();
            ph_diff_combine(F, WSP(const bf16, WS_OTMP), A->in[5] + jm * 256, A->in[6] + jm * 128, 0.8f - 0.6f * expf(-0.3f * (float)layer), WSP(bf16, WS_CAT));
            GRID_BAR();
        }
        REPEAT(REP_P3) {
        {   ArgsP A = fresh_args(); FRESH_GB();
            pg8::DenseSched S; S.init(M, D, D, G, bx, WSP(const bf16, WS_WOUT) + (size_t)layer * D * D);
            pg8::EpiBf16 E{WSP(bf16, WS_Y), D, 0, 1.f};
            pg8::gemm_phase<pg8::EpiBf16, pg8::DenseSched>(F.lds + RING_OFF, WSP(const bf16, WS_CAT), D, S, E, F.wave); }
        GRID_BAR();
        }
        {   ArgsP A = fresh_args();
            if (layer == 0) ph_ln_route<true>(F, A->in[0], WSP(const bf16, WS_Y), A->in[9] + (size_t)(layer * 2) * D, A->in[10] + (size_t)(layer * 2) * D, WSP(bf16, WS_XB), WSP(const bf16, WS_WROUT) + (size_t)layer * 256 * D, A->in[12] + layer * 64, FCTL() + CW_CNT + layer * 64 * 64, WSP(int, WS_ROWTOK), WSP(float, WS_ROWGATE), WSP(float, WS_LOGIT));
            else ph_ln_route<false>(F, nullptr, WSP(const bf16, WS_Y), A->in[9] + (size_t)(layer * 2) * D, A->in[10] + (size_t)(layer * 2) * D, WSP(bf16, WS_XB), WSP(const bf16, WS_WROUT) + (size_t)layer * 256 * D, A->in[12] + layer * 64, FCTL() + CW_CNT + layer * 64 * 64, WSP(int, WS_ROWTOK), WSP(float, WS_ROWGATE), WSP(float, WS_LOGIT)); }
        GRID_BAR();
        REPEAT(REP_P7) {
        {   ArgsP A = fresh_args(); FRESH_GB();
            const int nmine = build_units<true>(F, FCTL() + CW_CNT + layer * 64 * 64, WSP(const int, WS_ROWTOK), WSP(const float, WS_ROWGATE));
            pg8::GroupSched<true> S{(const LAS int*)(F.lds + TAB_OFF) + 160, (const LAS int*)(F.lds + IDX_OFF), nmine, D, (const char*)(A->ws + WS_WEXP)};
            pg8::EpiM1 E{WSP(bf16, WS_HB), (const LAS float*)(F.lds + GATE_OFF)};
            pg8::gemm_phase<pg8::EpiM1, pg8::GroupSched<true>>(F.lds + RING_OFF, WSP(const bf16, WS_XB), D, S, E, F.wave); }
        GRID_BAR();
        }
        REPEAT(REP_P8) {
        {   ArgsP A = fresh_args(); FRESH_GB();
            const int nmine = build_units<false>(F, FCTL() + CW_CNT + layer * 64 * 64, WSP(const int, WS_ROWTOK), WSP(const float, WS_ROWGATE));
            pg8::GroupSched<false> S{(const LAS int*)(F.lds + TAB_OFF) + 160, (const LAS int*)(F.lds + IDX_OFF), nmine, HID, (const char*)(A->ws + WS_WEXP) + pg8::EXPERT_DOWN_OFF};
            pg8::EpiM2 E{WSP(unsigned char, WS_BIG), (const LAS int*)(F.lds + IDX_OFF)};
            pg8::gemm_phase<pg8::EpiM2, pg8::GroupSched<false>>(F.lds + RING_OFF, WSP(const bf16, WS_HB), HID, S, E, F.wave); }
        GRID_BAR();
        }
        {   ArgsP A = fresh_args(); FRESH_GB();
            if (layer + 1 < DEPTH) ph_combine_ln2<false>(F, A->out, WSP(const unsigned char, WS_BIG), A->in[9] + (size_t)(layer * 2 + 1) * D, A->in[10] + (size_t)(layer * 2 + 1) * D, WSP(bf16, WS_XB));
            else ph_combine_ln2<true>(F, A->out, WSP(const unsigned char, WS_BIG), A->in[9] + (size_t)(layer * 2 + 1) * D, A->in[10] + (size_t)(layer * 2 + 1) * D, WSP(bf16, WS_XB));
            }
        if (layer + 1 < DEPTH) GRID_BAR();
    }
    if (__hip_atomic_load(FCTL() + CW_BAR + XB_TMO, RLX_AGENT) != 0u) {
        __syncthreads();
        ArgsP A = fresh_args(); FRESH_GB(); float* xf = A->out;
        const float q = __builtin_nanf("");
        for (int m = f_gw(F); m < M; m += f_ngw()) { GAS f32x4* o = (GAS f32x4*)(xf + (size_t)m * D) + (fresh_tid() & 63);
#pragma unroll
            for (int j = 0; j < 4; ++j) o[64 * j] = (f32x4){q, q, q, q}; }
    }
}

extern "C" void kernel_launch(void* const* d_in, const int* in_sizes, int n_in, void* d_out, int out_size, void* d_ws, size_t ws_size, hipStream_t stream) {
    static int grid = 0;
    if (grid == 0) {
        if (n_in != 19 || in_sizes[0] != M * D || out_size != M * D || ws_size < WS_END) { fprintf(stderr, "kernel_launch: shape / workspace mismatch (n_in %d, in0 %d, out %d, ws %zu, need %zu); nothing launched\n", n_in, n_in > 0 ? in_sizes[0] : -1, out_size, ws_size, (size_t)WS_END); grid = -1; return; }
        int dev = 0, cus = 0, per_cu = 0;
        if (hipGetDevice(&dev) != hipSuccess || hipDeviceGetAttribute(&cus, hipDeviceAttributeMultiprocessorCount, dev) != hipSuccess) { grid = -1; return; }
        if (hipFuncSetAttribute((const void*)mega_fwd, hipFuncAttributeMaxDynamicSharedMemorySize, LDS_BYTES) != hipSuccess) { fprintf(stderr, "kernel_launch: hipFuncSetAttribute failed\n"); grid = -1; return; }
        if (hipOccupancyMaxActiveBlocksPerMultiprocessor(&per_cu, (const void*)mega_fwd, NWAVES * 64, LDS_BYTES) != hipSuccess || per_cu < 1) { fprintf(stderr, "kernel_launch: occupancy query reports %d\n", per_cu); }
        (void)hipGetLastError();
        grid = cus;
        if (grid != 256) { fprintf(stderr, "kernel_launch: built for 256 CUs, device has %d; nothing launched\n", cus); grid = -1; return; }
    }
    if (grid < 0) return;
    if (hipMemsetAsync((char*)d_ws + WS_CTL, 0, CTL_ZERO_BYTES, stream) != hipSuccess) return;
    Args a{};
    for (int i = 0; i < 19; ++i) a.in[i] = (const float*)d_in[i];
    a.out = (float*)d_out; a.ws = (unsigned char*)d_ws;
    hipLaunchKernelGGL(mega_fwd, dim3(grid), dim3(NWAVES * 64), LDS_BYTES, stream, a);
}
```

```cpp
#include <hip/hip_runtime.h>
#include <hip/hip_bf16.h>
#include <cstdio>
#include <cstdint>
#include <cmath>

namespace pg8 {
#define PG8_LAS __attribute__((address_space(3)))
typedef unsigned short bf16_t;
typedef short bf16x8 __attribute__((ext_vector_type(8)));
typedef float f32x4 __attribute__((ext_vector_type(4)));
typedef unsigned u32x4 __attribute__((ext_vector_type(4)));
constexpr int BM = 256, BK = 64, HALF = 128, HTB = HALF * BK * 2  , STAGE_BYTES = 8 * HTB, NXCD = 8, WGM = 8;
constexpr int EXPERT_BYTES = 3 * 1024 * 256 * 2;
constexpr int EXPERT_DOWN_OFF = 2 * 1024 * 256 * 2;

__host__ __device__ __forceinline__ int lds_byte(int r, int c) { const int st = (r >> 4) * 2 + (c >> 5), rr = r & 15, cc = c & 31, ob = rr * 64 + cc * 2; return st * 1024 + (ob ^ (((ob >> 9) & 1) << 5)); }
__host__ __device__ __forceinline__ void stage_rc(int b, int& R, int& C) { const int st = b / 1024, sb = b % 1024, swz = sb ^ (((sb >> 9) & 1) << 5); R = (st >> 1) * 16 + swz / 64; C = (st & 1) * 32 + (swz % 64) / 2; }
__host__ __device__ __forceinline__ int perm32(int rho) { const int n = rho >> 4, i = rho & 15; return 8 * (i >> 2) + 4 * n + (i & 3); }

struct Unit { int pm, pn, e, nvalid, lbase, pos0, slot; };

struct StaticOrder {
    int nM, nN, nwg, G, c;
    __device__ __forceinline__ void init(int M, int N, int G_, int c_) { nM = M / BM; nN = N / BM; nwg = nM * nN; G = G_; c = c_; }
    __device__ __forceinline__ bool next(int i, Unit& u) const {
        const long L = (long)i * G + c; if (L >= nwg) return false;
        int wgid = (int)L; { const int q = nwg / NXCD, r = nwg % NXCD, xcd = wgid % NXCD, off = wgid / NXCD; wgid = (xcd < r ? xcd * (q + 1) : r * (q + 1) + (xcd - r) * q) + off; }
        const int nig = WGM * nN, gid = wgid / nig, fm = gid * WGM, gsz = (nM - fm) < WGM ? (nM - fm) : WGM;
        u.pm = fm + ((wgid % nig) % gsz); u.pn = (wgid % nig) / gsz; return true;
    }
};
struct DenseSched {
    StaticOrder o; const char* Bt; int K;
    __device__ __forceinline__ void init(int M, int N, int K_, int G, int c, const bf16_t* Bt_) { o.init(M, N, G, c); Bt = (const char*)Bt_; K = K_; }
    __device__ __forceinline__ bool next(int i, Unit& u) const { u.e = 0; u.nvalid = 256; u.lbase = 0; u.pos0 = 0; u.slot = 0; return o.next(i, u); }
    __device__ __forceinline__ const char* bptr(const Unit& u) const { return Bt + (size_t)u.pn * (BM * 2) * K; }
    __device__ __forceinline__ void avoff(const Unit& u, int tid, unsigned (&v)[2][2]) const {
#pragma unroll
        for (int i = 0; i < 2; ++i) { int R, C; stage_rc(tid * 16 + i * 8192, R, C);
#pragma unroll
            for (int h = 0; h < 2; ++h) v[h][i] = (unsigned)((u.pm * BM + h * HALF + R) * K + C) * 2u; }
    }
};
template <bool GATHER> struct GroupSched {
    const PG8_LAS int* utab; const PG8_LAS int* idx; int nmine, K; const char* W;
    __device__ __forceinline__ bool next(int i, Unit& u) const {
        if (i >= nmine) return false; const PG8_LAS int* t = utab + i * 8;
        u.e = __builtin_amdgcn_readfirstlane(t[0]); u.pm = __builtin_amdgcn_readfirstlane(t[1]); u.pn = __builtin_amdgcn_readfirstlane(t[2]);
        u.nvalid = __builtin_amdgcn_readfirstlane(t[3]); u.lbase = __builtin_amdgcn_readfirstlane(t[4]); u.pos0 = __builtin_amdgcn_readfirstlane(t[5]); u.slot = i; return true;
    }
    __device__ __forceinline__ const char* bptr(const Unit& u) const { return W + (size_t)u.e * EXPERT_BYTES + (size_t)u.pn * (BM * 2) * K; }
    __device__ __forceinline__ void avoff(const Unit& u, int tid, unsigned (&v)[2][2]) const {
#pragma unroll
        for (int i = 0; i < 2; ++i) { int R, C; stage_rc(tid * 16 + i * 8192, R, C);
#pragma unroll
            for (int h = 0; h < 2; ++h) {
                const int row = GATHER ? idx[u.slot * 256 + h * HALF + R] : (u.pm * BM + h * HALF + R);
                v[h][i] = (unsigned)(row * K + C) * 2u; } }
    }
};

typedef float f32x2v __attribute__((ext_vector_type(2))); typedef __bf16 bf16x2v __attribute__((ext_vector_type(2)));
__device__ __forceinline__ unsigned cvt_pk_bf16(float lo, float hi) { f32x2v v = {lo, hi}; bf16x2v b = __builtin_convertvector(v, bf16x2v); return __builtin_bit_cast(unsigned, b); }

struct EpiBf16 {
    static constexpr bool PERM = true; static constexpr int NST = 16;
    bf16_t* O; int ldc; int nsc; float scale;
    __device__ __forceinline__ void operator()(const f32x4 (&acc)[2][2][4][2], const Unit& u, int wr, int wc, int fr, int fq) const {
        const int row0 = u.pm * BM + wr * 64 + fr; const int col0 = u.pn * BM + wc * 32 + 8 * fq; const float sc = (u.pn < nsc) ? scale : 1.f;
#pragma unroll
        for (int ai = 0; ai < 2; ++ai)
#pragma unroll
            for (int m = 0; m < 4; ++m) { bf16_t* rowp = O + (size_t)(row0 + ai * HALF + m * 16) * ldc + col0;
#pragma unroll
                for (int bj = 0; bj < 2; ++bj) { const f32x4 v0 = acc[ai][bj][m][0] * sc, v1 = acc[ai][bj][m][1] * sc;
                    u32x4 w; w.x = cvt_pk_bf16(v0[0], v0[1]); w.y = cvt_pk_bf16(v0[2], v0[3]); w.z = cvt_pk_bf16(v1[0], v1[1]); w.w = cvt_pk_bf16(v1[2], v1[3]);
                    *(u32x4*)(rowp + bj * HALF) = w; } }
    }
};
__device__ __forceinline__ float silu_f(float x) { return x * __builtin_amdgcn_rcpf(1.0f + __builtin_amdgcn_exp2f(-1.4426950408889634f * x)); }
struct EpiM1 {
    static constexpr bool PERM = true; static constexpr int NST = 8;
    bf16_t* H; const PG8_LAS float* lgate;
    __device__ __forceinline__ void operator()(const f32x4 (&acc)[2][2][4][2], const Unit& u, int wr, int wc, int fr, int fq) const {
        const int col0 = u.pn * HALF + wc * 32 + 8 * fq; const PG8_LAS float* lg = lgate + u.slot * 256;
#pragma unroll
        for (int ai = 0; ai < 2; ++ai)
#pragma unroll
            for (int m = 0; m < 4; ++m) { const int r = ai * HALF + wr * 64 + m * 16 + fr;
                const float g = lg[r];
                const f32x4 ga = acc[ai][0][m][0], gb = acc[ai][0][m][1], ua = acc[ai][1][m][0], ub = acc[ai][1][m][1];
                f32x4 v0, v1;
#pragma unroll
                for (int j = 0; j < 4; ++j) { v0[j] = silu_f(ga[j]) * ua[j] * g; v1[j] = silu_f(gb[j]) * ub[j] * g; }
                u32x4 w; w.x = cvt_pk_bf16(v0[0], v0[1]); w.y = cvt_pk_bf16(v0[2], v0[3]); w.z = cvt_pk_bf16(v1[0], v1[1]); w.w = cvt_pk_bf16(v1[2], v1[3]);
                *(u32x4*)(H + (size_t)(u.pm * BM + r) * 256 + col0) = w; }
    }
};
constexpr float Y8_SCALE = 16.f;
typedef unsigned u32x2e __attribute__((ext_vector_type(2)));
struct EpiM2 {
    static constexpr bool PERM = true; static constexpr int NST = 16;
    unsigned char* Y; const PG8_LAS int* ldst;
    __device__ __forceinline__ void operator()(const f32x4 (&acc)[2][2][4][2], const Unit& u, int wr, int wc, int fr, int fq) const {
        const int col0 = u.pn * BM + wc * 32 + 8 * fq; const PG8_LAS int* ld = ldst + u.slot * 256;
#pragma unroll
        for (int ai = 0; ai < 2; ++ai)
#pragma unroll
            for (int m = 0; m < 4; ++m) { const int r = ai * HALF + wr * 64 + m * 16 + fr;
                const int dst = ld[r];
                {
                    unsigned char* rowp = Y + (size_t)dst * 1024 + col0;
#pragma unroll
                    for (int bj = 0; bj < 2; ++bj) { const f32x4 v0 = acc[ai][bj][m][0] * Y8_SCALE, v1 = acc[ai][bj][m][1] * Y8_SCALE;
                        int w0 = __builtin_amdgcn_cvt_pk_fp8_f32(v0[0], v0[1], 0, false); w0 = __builtin_amdgcn_cvt_pk_fp8_f32(v0[2], v0[3], w0, true);
                        int w1 = __builtin_amdgcn_cvt_pk_fp8_f32(v1[0], v1[1], 0, false); w1 = __builtin_amdgcn_cvt_pk_fp8_f32(v1[2], v1[3], w1, true);
                        *(u32x2e*)(rowp + bj * HALF) = (u32x2e){(unsigned)w0, (unsigned)w1}; } } }
    }
};

template <class Epi, class Sched>
__device__ __forceinline__ void gemm_phase(PG8_LAS unsigned char* lds, const bf16_t* Abase, const int K, const Sched& S, const Epi& E, int wave_) {
    asm volatile("" : "+s"(wave_)); unsigned am_; asm volatile("s_mov_b32 %0, -1" : "=s"(am_));
    const int tid = (wave_ << 6) | (int)__builtin_amdgcn_mbcnt_hi(am_, __builtin_amdgcn_mbcnt_lo(am_, 0u));
    const int wid = __builtin_amdgcn_readfirstlane(tid >> 6), lane = tid & 63, wr = wid >> 2, wc = wid & 3, fr = lane & 15, fq = lane >> 4;
    const int nt = K / BK;
    unsigned voffB[2];
#pragma unroll
    for (int i = 0; i < 2; ++i) { int R, C; stage_rc(tid * 16 + i * 8192, R, C); const int Rb = Epi::PERM ? ((R & ~31) + perm32(R & 31)) : R; voffB[i] = (unsigned)(Rb * K + C) * 2u; }
    const size_t kstep = (size_t)(BK * 2);
    const size_t hstep = (size_t)HALF * K * 2;
    const unsigned ldsw = (unsigned)wid * 1024u;
    const int aoff = lds_byte(wr * 64 + fr, fq * 8), boff = lds_byte(wc * 32 + fr, fq * 8);
    const char* Ab = (const char*)Abase;
#define PG8_SA(b, h) (((b) * 2 + (h)) * HTB)
#define PG8_SB(b, h) ((4 + (b) * 2 + (h)) * HTB)
#define PG8_STAGE(bufoff, gbase, voff) do { _Pragma("unroll") for (int _i = 0; _i < 2; ++_i) \
        __builtin_amdgcn_global_load_lds((const unsigned*)((const char*)(gbase) + (voff)[_i]), (PG8_LAS unsigned*)(lds + (bufoff) + ldsw + _i * 8192), 16, 0, 0); } while (0)
#define PG8_STAGEA(bufoff, kb, V, h) do { _Pragma("unroll") for (int _i = 0; _i < 2; ++_i) \
        __builtin_amdgcn_global_load_lds((const unsigned*)(Ab + (kb) + (V)[h][_i]), (PG8_LAS unsigned*)(lds + (bufoff) + ldsw + _i * 8192), 16, 0, 0); } while (0)
#define PG8_LDA(dst, b, h) do { _Pragma("unroll") for (int m = 0; m < 4; ++m) _Pragma("unroll") for (int k = 0; k < 2; ++k) dst[m][k] = *(const PG8_LAS bf16x8*)(lds + PG8_SA(b, h) + aoff + m * 2048 + k * 1024); } while (0)
#define PG8_LDB(dst, b, h) do { _Pragma("unroll") for (int n = 0; n < 2; ++n) _Pragma("unroll") for (int k = 0; k < 2; ++k) dst[n][k] = *(const PG8_LAS bf16x8*)(lds + PG8_SB(b, h) + boff + n * 2048 + k * 1024); } while (0)
#define PG8_MMA(ai, bj, At, Bt) do { __builtin_amdgcn_s_setprio(1); _Pragma("unroll") for (int m = 0; m < 4; ++m) _Pragma("unroll") for (int n = 0; n < 2; ++n) _Pragma("unroll") for (int k = 0; k < 2; ++k) \
        acc[ai][bj][m][n] = __builtin_amdgcn_mfma_f32_16x16x32_bf16(Bt[n][k], At[m][k], acc[ai][bj][m][n], 0, 0, 0); __builtin_amdgcn_s_setprio(0); } while (0)
#define PG8_WAIT_V(n) asm volatile("s_waitcnt vmcnt(" #n ")" ::: "memory")
#define PG8_WAIT_VR(rl) do { if (rl) asm volatile("s_waitcnt vmcnt(%0)" :: "n"(8 + Epi::NST) : "memory"); else asm volatile("s_waitcnt vmcnt(8)" ::: "memory"); } while (0)
#define PG8_WAIT_L(n) asm volatile("s_waitcnt lgkmcnt(" #n ")" ::: "memory")
#define PG8_BAR __builtin_amdgcn_s_barrier()
#define PG8_SCHED __builtin_amdgcn_sched_barrier(0)
    Unit cur, nxt; int ui = 0;
    if (!S.next(0, cur)) return;
    nxt = cur;
    f32x4 acc[2][2][4][2];
#pragma unroll
    for (int a = 0; a < 2; ++a)
#pragma unroll
        for (int b = 0; b < 2; ++b)
#pragma unroll
            for (int m = 0; m < 4; ++m)
#pragma unroll
                for (int n = 0; n < 2; ++n) acc[a][b][m][n] = (f32x4){0.f, 0.f, 0.f, 0.f};
    bf16x8 At[4][2], B0[2][2], B1[2][2];
    unsigned vA[2][2];
    S.avoff(cur, tid, vA);
    const char* cB = S.bptr(cur);
    PG8_STAGE(PG8_SB(0, 0), cB, voffB); PG8_STAGE(PG8_SB(0, 1), cB + hstep, voffB); PG8_STAGEA(PG8_SA(0, 0), 0, vA, 0); PG8_STAGEA(PG8_SA(0, 1), 0, vA, 1);
    if (wr == 1) PG8_BAR;
    PG8_WAIT_V(2); PG8_BAR;
    PG8_STAGE(PG8_SB(1, 0), cB + kstep, voffB); PG8_STAGEA(PG8_SA(1, 0), kstep, vA, 0); PG8_STAGE(PG8_SB(1, 1), cB + hstep + kstep, voffB);
    PG8_WAIT_V(6); PG8_BAR;
    bool relax = false;
    for (;;) {
        const bool has_next = S.next(ui + 1, nxt);
        const char* nB = cB;
        if (has_next) nB = S.bptr(nxt);
#pragma unroll 1
        for (int t = 0; t < nt; t += 2) {
            const bool last = (t == nt - 2); const bool rl = relax && (t == 0);
            const size_t kb1 = (size_t)(t + 1) * kstep;
            const size_t kb2 = last ? (size_t)0 : (size_t)(t + 2) * kstep; const char* b2 = last ? nB : cB + (size_t)(t + 2) * kstep;
            const size_t kb3 = kb2 + kstep; const char* b3 = b2 + kstep;
            PG8_LDB(B0, 0, 0); PG8_LDB(B1, 0, 1); PG8_SCHED; PG8_LDA(At, 0, 0); if (!rl) PG8_STAGEA(PG8_SA(1, 1), kb1, vA, 1);
            if (last && has_next) S.avoff(nxt, tid, vA);
            PG8_WAIT_VR(rl); PG8_WAIT_L(0); PG8_BAR; PG8_MMA(0, 0, At, B0); PG8_MMA(0, 1, At, B1); PG8_BAR; PG8_SCHED;
            PG8_LDA(At, 0, 1); PG8_STAGE(PG8_SB(0, 0), b2, voffB); PG8_STAGE(PG8_SB(0, 1), b2 + hstep, voffB); PG8_STAGEA(PG8_SA(0, 0), kb2, vA, 0);
            PG8_WAIT_VR(rl); PG8_WAIT_L(0); PG8_BAR; PG8_MMA(1, 0, At, B0); PG8_MMA(1, 1, At, B1); PG8_BAR; PG8_SCHED;
            PG8_LDB(B0, 1, 0); PG8_LDB(B1, 1, 1); PG8_SCHED; PG8_LDA(At, 1, 0); PG8_STAGEA(PG8_SA(0, 1), kb2, vA, 1);
            PG8_WAIT_VR(rl); PG8_WAIT_L(0); PG8_BAR; PG8_MMA(0, 0, At, B0); PG8_MMA(0, 1, At, B1); PG8_BAR; PG8_SCHED;
            PG8_LDA(At, 1, 1); PG8_STAGE(PG8_SB(1, 0), b3, voffB); PG8_STAGE(PG8_SB(1, 1), b3 + hstep, voffB); PG8_STAGEA(PG8_SA(1, 0), kb3, vA, 0);
            PG8_WAIT_V(8); PG8_WAIT_L(0); PG8_BAR; PG8_MMA(1, 0, At, B0); PG8_MMA(1, 1, At, B1); PG8_BAR; PG8_SCHED;
        }
        if (wr == 0) PG8_BAR;
        if (has_next) PG8_STAGEA(PG8_SA(1, 1), kstep, vA, 1);
        E(acc, cur, wr, wc, fr, fq);
        if (!has_next) break;
#pragma unroll
        for (int a = 0; a < 2; ++a)
#pragma unroll
            for (int b = 0; b < 2; ++b)
#pragma unroll
                for (int m = 0; m < 4; ++m)
#pragma unroll
                    for (int n = 0; n < 2; ++n) acc[a][b][m][n] = (f32x4){0.f, 0.f, 0.f, 0.f};
        cur = nxt; cB = nB; ++ui; relax = true;
        if (wr == 1) PG8_BAR;
    }
    PG8_WAIT_V(0);
    PG8_BAR;
#undef PG8_SA
#undef PG8_SB
#undef PG8_STAGE
#undef PG8_STAGEA
#undef PG8_LDA
#undef PG8_LDB
#undef PG8_MMA
#undef PG8_WAIT_V
#undef PG8_WAIT_VR
#undef PG8_WAIT_L
#undef PG8_BAR
#undef PG8_SCHED
}
}
namespace attn_body {
using bf16=__hip_bfloat16;
using bf16x8=__attribute__((ext_vector_type(8)))short;
using s16x4=__attribute__((ext_vector_type(4)))short;
using f32x16=__attribute__((ext_vector_type(16)))float;
using u32x4=__attribute__((ext_vector_type(4)))unsigned;
constexpr int D=64,NW=8,QBLK=32,QB=QBLK*NW,KVBLK=64;
__device__ __forceinline__ int crow(int r,int hi){return (r&3)+8*(r>>2)+4*hi;}
#define SBAR() __builtin_amdgcn_sched_barrier(0)
constexpr int NSLOT=3, SLOTB=8192;
constexpr int LDS_K=0, LDS_V=NSLOT*SLOTB, LDS_WS=2*NSLOT*SLOTB, LDS_OST=LDS_WS+NW*64*4, LDS_BYTES=LDS_OST+NW*4096;
constexpr float LOG2E=1.4426950408889634f;
constexpr float C2=0.125f*LOG2E;
__device__ __forceinline__ void glds16(const void*gsrc,unsigned lds_dst){unsigned keep;
  asm volatile("s_mov_b32 %0, m0\n\ts_mov_b32 m0, %2\n\ts_nop 0\n\tglobal_load_lds_dwordx4 %1, off\n\ts_mov_b32 m0, %0":"=&s"(keep):"v"(gsrc),"s"(lds_dst):"memory");}
__device__ __forceinline__ void glds16s(const void*sbase,unsigned voff,unsigned lds_dst){unsigned keep;
  asm volatile("s_mov_b32 %0, m0\n\ts_mov_b32 m0, %3\n\ts_nop 0\n\tglobal_load_lds_dwordx4 %1, %2\n\ts_mov_b32 m0, %0":"=&s"(keep):"v"(voff),"s"(sbase),"s"(lds_dst):"memory");}
__device__ __forceinline__ float max3f(float a,float b,float c){float r;asm("v_max3_f32 %0, %1, %2, %3":"=v"(r):"v"(a),"v"(b),"v"(c));return r;}
__device__ __forceinline__ float max2f(float a,float b){float r;asm("v_max_f32_e32 %0, %1, %2":"=v"(r):"v"(a),"v"(b));return r;}
__device__ __forceinline__ float fadd_s(float a,float b){float r;asm("v_add_f32_e32 %0, %1, %2":"=v"(r):"v"(a),"v"(b));return r;}
__device__ __forceinline__ float fsub_s(float a,float b){float r;asm("v_sub_f32_e32 %0, %1, %2":"=v"(r):"v"(a),"v"(b));return r;}
typedef float f32x2_t __attribute__((ext_vector_type(2))); typedef __bf16 bf16x2_t __attribute__((ext_vector_type(2)));
__device__ __forceinline__ unsigned cvtpk_s(float lo,float hi){f32x2_t v={lo,hi};bf16x2_t b=__builtin_convertvector(v,bf16x2_t);return __builtin_bit_cast(unsigned,b);}
#define WAIT_BAR(N) asm volatile("s_waitcnt vmcnt(" #N ") lgkmcnt(0)\n\ts_barrier":::"memory")

template<int MODE> __device__ __forceinline__ void maskbias(f32x16&p0,f32x16&p1,int kb,int qrel,float slope2,float mhat,bool band,bool tile_ok){
  if(MODE==0)return;
  const float NEG=-INFINITY; const float lb=slope2*(float)(kb-qrel)-mhat;
  #pragma unroll
  for(int r=0;r<16;++r){const int c=(r&3)+8*(r>>2); p0[r]=__builtin_fmaf(slope2,(float)c,p0[r]+lb); p1[r]=__builtin_fmaf(slope2,(float)(c+32),p1[r]+lb);}
  if(MODE==1){ if(band){
    #pragma unroll
    for(int r=0;r<16;++r){const int kv=kb+(r&3)+8*(r>>2); if(kv>qrel)p0[r]=NEG; if(kv+32>qrel)p1[r]=NEG;} } }
  if(MODE==2){
    #pragma unroll
    for(int r=0;r<16;++r){const int d=qrel-kb-((r&3)+8*(r>>2)); if((unsigned)d>=128u||!tile_ok)p0[r]=NEG; if((unsigned)(d-32)>=128u||!tile_ok)p1[r]=NEG;} }
}

__device__ __forceinline__ void qkt(f32x16&p0,f32x16&p1,const char*Kslot,const bf16x8*qr,const f32x16&negm,int r32,int hi){
  const char*kb=Kslot+hi*1024+r32*16;
  #pragma unroll
  for(int d0=0;d0<4;++d0){
    const bf16x8 b0=*reinterpret_cast<const bf16x8*>(kb+d0*2048);
    const bf16x8 b1=*reinterpret_cast<const bf16x8*>(kb+d0*2048+512);
    if(d0==0){p0=__builtin_amdgcn_mfma_f32_32x32x16_bf16(b0,qr[0],negm,0,0,0);p1=__builtin_amdgcn_mfma_f32_32x32x16_bf16(b1,qr[0],negm,0,0,0);}
    else{p0=__builtin_amdgcn_mfma_f32_32x32x16_bf16(b0,qr[d0],p0,0,0,0);p1=__builtin_amdgcn_mfma_f32_32x32x16_bf16(b1,qr[d0],p1,0,0,0);}}
}
template<int C> __device__ __forceinline__ float fmamk_c(float a,float b){float d;asm("v_fmamk_f32 %0, %1, %2, %3":"=v"(d):"v"(a),"n"(__builtin_bit_cast(int,(float)C)),"v"(b));return d;}
typedef __attribute__((address_space(3))) const char* lds_cptr;
typedef short v4i16_t __attribute__((ext_vector_type(4)));
__device__ __forceinline__ void kload8(bf16x8*kf,lds_cptr kp){
  kf[0]=*(const __attribute__((address_space(3))) bf16x8*)(kp);      kf[1]=*(const __attribute__((address_space(3))) bf16x8*)(kp+512);
  kf[2]=*(const __attribute__((address_space(3))) bf16x8*)(kp+2048); kf[3]=*(const __attribute__((address_space(3))) bf16x8*)(kp+2560);
  kf[4]=*(const __attribute__((address_space(3))) bf16x8*)(kp+4096); kf[5]=*(const __attribute__((address_space(3))) bf16x8*)(kp+4608);
  kf[6]=*(const __attribute__((address_space(3))) bf16x8*)(kp+6144); kf[7]=*(const __attribute__((address_space(3))) bf16x8*)(kp+6656);
}
__device__ __forceinline__ void kload2(bf16x8*kf,lds_cptr kp,int j){ kf[2*j]=*(const __attribute__((address_space(3))) bf16x8*)(kp+j*2048); kf[2*j+1]=*(const __attribute__((address_space(3))) bf16x8*)(kp+j*2048+512); }
__device__ __forceinline__ s16x4 vtr(lds_cptr p){ return __builtin_bit_cast(s16x4,__builtin_amdgcn_ds_read_tr16_b64_v4i16((__attribute__((address_space(3))) v4i16_t*)p)); }
__device__ __forceinline__ float rowmax(const f32x16&p0,const f32x16&p1){
  float a=max3f(p0[0],p0[1],p1[0]),b=max3f(p0[2],p0[3],p1[1]);a=max3f(a,p1[2],p1[3]);
  #pragma unroll
  for(int r=4;r<16;r+=4){a=max3f(a,p0[r],p0[r+1]);b=max3f(b,p0[r+2],p0[r+3]);a=max3f(a,p1[r],p1[r+1]);b=max3f(b,p1[r+2],p1[r+3]);}
  const float m=max2f(a,b);
  auto rr=__builtin_amdgcn_permlane32_swap(__float_as_uint(m),__float_as_uint(m),false,false);
  return max2f(__uint_as_float(rr[0]),__uint_as_float(rr[1]));
}
__device__ __forceinline__ void pv(f32x16*o,int vb,bf16x8 pa0,bf16x8 pa1,bf16x8 pa2,bf16x8 pa3){
  #pragma unroll
  for(int d0=0;d0<2;++d0){s16x4 lo[4],hi[4];
    #pragma unroll
    for(int ks=0;ks<4;++ks){
      asm volatile("ds_read_b64_tr_b16 %0,%1 offset:%c2":"=&v"(lo[ks]):"v"(vb),"i"(d0*4096+ks*1024):"memory");
      asm volatile("ds_read_b64_tr_b16 %0,%1 offset:%c2":"=&v"(hi[ks]):"v"(vb),"i"(d0*4096+ks*1024+512):"memory");}
    asm volatile("s_waitcnt lgkmcnt(0)":::"memory");SBAR();
    #define PK(k) (bf16x8){lo[k][0],lo[k][1],lo[k][2],lo[k][3],hi[k][0],hi[k][1],hi[k][2],hi[k][3]}
    o[d0]=__builtin_amdgcn_mfma_f32_32x32x16_bf16(pa0,PK(0),o[d0],0,0,0);
    o[d0]=__builtin_amdgcn_mfma_f32_32x32x16_bf16(pa1,PK(1),o[d0],0,0,0);
    o[d0]=__builtin_amdgcn_mfma_f32_32x32x16_bf16(pa2,PK(2),o[d0],0,0,0);
    o[d0]=__builtin_amdgcn_mfma_f32_32x32x16_bf16(pa3,PK(3),o[d0],0,0,0);
    #undef PK
  }
}
struct AttnArgs {
  const bf16* Qw;
  const bf16* K0; const bf16* V0;
  int NT;
  int tmax;
  bf16* Ow;
  int qrel;
  float slope2, sink2;
  int wave;
};
#define ATTN_STORE16(p,v) (*(u32x4*)(p)=(v))
template<int MODE,int THRL,int QP,int KVP,int OP> __device__ __forceinline__ void attn_unit(const AttnArgs&a,char*shm){
  unsigned am_; asm volatile("s_mov_b32 %0, -1":"=s"(am_)); const int lane=(int)__builtin_amdgcn_mbcnt_hi(am_,__builtin_amdgcn_mbcnt_lo(am_,0u)),r32=lane&31,hi=lane>>5; const int wid=a.wave;
  const bf16*Qw=a.Qw; constexpr int qp=QP; constexpr long kvp=KVP;
  const unsigned lds0=(unsigned)(uintptr_t)shm;
  float*wsf=(float*)(shm+LDS_WS)+wid*64;
  const bf16*ksrc=a.K0+(long)lane*kvp+wid*8;
  const bf16*vsrc=a.V0+(long)(16*(wid&3)+(lane>>2))*kvp+(wid>>2)*32+(lane&3)*8;
  const unsigned kdst=lds0+LDS_K+wid*1024, vdst=lds0+LDS_V+wid*1024;
  const int tmax=a.tmax;
  #define TROW(t) ((MODE==2)?(-64*(((t)<tmax)?(t):tmax)):(64*(t)))
  #define DMA_K(t,slot) glds16(ksrc+(long)TROW(t)*kvp,(unsigned)__builtin_amdgcn_readfirstlane(kdst+(slot)))
  #define DMA_V(t,slot) glds16(vsrc+(long)TROW(t)*kvp,(unsigned)__builtin_amdgcn_readfirstlane(vdst+(slot)))
  const int vb0=(int)(lds0+LDS_V)+((lane>>4)&1)*32+(lane&3)*8+(4*hi+((lane&15)>>2))*64;
  const char*Kbase=shm+LDS_K; bf16x8 kf[8];
  const lds_cptr shm3=(lds_cptr)shm; const lds_cptr kp0=shm3+LDS_K+hi*1024+r32*16; const lds_cptr vp0=shm3+LDS_V+((lane>>4)&1)*32+(lane&3)*8+(4*hi+((lane&15)>>2))*64;
  const int NT=a.NT;
  DMA_K(0,0);DMA_V(0,0);DMA_K(1,SLOTB);
  bf16x8 qr[4];
  #pragma unroll
  for(int d0=0;d0<4;++d0)qr[d0]=*reinterpret_cast<const bf16x8*>(&Qw[(long)r32*qp+d0*16+hi*8]);
  float z0_; asm volatile("v_mov_b32 %0, 0":"=v"(z0_));
  f32x16 zv_; _Pragma("unroll") for(int r=0;r<16;++r)zv_[r]=z0_;
  float mhat=0.f,l_reg=0.f;f32x16 o[2];o[0]=zv_;o[1]=zv_;f32x16 negm=zv_;if(MODE==0)asm volatile("":"+v"(negm));
  const int qrel=a.qrel; const float slope2=a.slope2;
  #define KBREL(t) ((MODE==2)?(-64*(t)):(64*((t)-(NT-4))))
  #define MBIAS(P0,P1,t,BAND) maskbias<MODE>(P0,P1,KBREL(t)+4*hi,qrel,slope2,mhat,(BAND)&&((t)>=NT-4),(t)<=tmax)
  #define CINIT ((MODE==0)?negm:(f32x16{}))
  #define CMASK(P0,P1,t) MBIAS(P0,P1,t,true)
  bool resc=false;
  #define START(P0,P1) do{ const float rm=rowmax(P0,P1); resc=false; \
    { const float dl=rm; mhat=fadd_s(mhat,dl); \
      _Pragma("unroll") for(int r=0;r<16;++r){P0[r]=fsub_s(P0[r],dl);P1[r]=fsub_s(P1[r],dl);} \
      if(MODE==0){ _Pragma("unroll") for(int r=0;r<16;++r)negm[r]=-mhat; asm volatile("":"+v"(negm)); } } \
    _Pragma("unroll") for(int r=0;r<16;++r)P0[r]=__builtin_amdgcn_exp2f(P0[r]); }while(0)
  #define RESC() do{ if(resc){ asm volatile("s_waitcnt lgkmcnt(0)":::"memory"); \
      _Pragma("unroll") for(int d_=0;d_<2;++d_) _Pragma("unroll") for(int r=0;r<16;++r)o[d_][r]*=wsf[crow(r,hi)]; } }while(0)
  f32x16 pA0,pA1,pB0,pB1;
  int sl_prev=0,sl_cur=0,sl_next=SLOTB;
  #define ROT() do{sl_prev=sl_cur;sl_cur=sl_next;sl_next=(sl_next==(NSLOT-1)*SLOTB)?0:sl_next+SLOTB;}while(0)
  DMA_K(2,2*SLOTB);
  WAIT_BAR(3);
  qkt(pA0,pA1,Kbase,qr,negm,r32,hi);asm volatile("s_nop 15\n\ts_nop 7":"+v"(pA0),"+v"(pA1));CMASK(pA0,pA1,0);
  START(pA0,pA1);
  _Pragma("unroll") for(int r=0;r<16;++r)pA1[r]=__builtin_amdgcn_exp2f(pA1[r]);
  WAIT_BAR(0);
  DMA_K(3,0);DMA_V(1,SLOTB);
  ROT();
  kload8(kf,kp0+sl_cur);
  WAIT_BAR(2);
  s16x4 vlo[8],vhi[8]; u32x4 pw0,pw1,pw2,pw3;
  #define PKW(P,B) cvtpk_s(P[B],P[B+1])
  #define PAF(k) __builtin_bit_cast(bf16x8,pw##k)
  #define VFR(i) (bf16x8){vlo[i][0],vlo[i][1],vlo[i][2],vlo[i][3],vhi[i][0],vhi[i][1],vhi[i][2],vhi[i][3]}
  #define PIN(x) asm volatile("":"+v"(x))
  #define MX3(a,b,c) __builtin_fmaxf(__builtin_fmaxf((a),(b)),(c))
  #define GAPA(MF,A0,A1,A2,A3,W0,W1,PW) do{ MF; sacc+=A0; sacc+=A1; sacc+=A2; sacc+=A3; PIN(sacc); W0; W1; PIN(PW); SBAR(); }while(0)
  #define EX(v) __builtin_amdgcn_exp2f(v)
  #define GAPB(MF,X,B) do{ MF; X[B]=EX(X[B]); X[B+1]=EX(X[B+1]); X[B+2]=EX(X[B+2]); X[B+3]=EX(X[B+3]); PIN(X); SBAR(); }while(0)
  #define VRD(i) do{ vlo[i]=vtr(vp_+(((i)>>2)*4096+((i)&3)*1024)); vhi[i]=vtr(vp_+(((i)>>2)*4096+((i)&3)*1024+512)); }while(0)
  #define KRD(G,j) do{ if(G){ kload2(kf,kp0+sl_next,j); SBAR(); } }while(0)
  #define STEP(C0,C1,P0,P1,t,GK,GV,GL) do{ SBAR(); \
    const lds_cptr vp_=vp0+sl_prev; \
    VRD(0); SBAR(); float sacc=(P0[0]+P0[1]); \
    GAPA(C0=__builtin_amdgcn_mfma_f32_32x32x16_bf16(kf[0],qr[0],CINIT,0,0,0), P0[2],P0[3],P0[4],P0[5],     pw0[0]=PKW(P0,0), pw0[1]=PKW(P0,2), pw0); \
    VRD(4); SBAR(); GAPA(C1=__builtin_amdgcn_mfma_f32_32x32x16_bf16(kf[1],qr[0],CINIT,0,0,0), P0[6],P0[7],P0[8],P0[9],     pw0[2]=PKW(P0,4), pw0[3]=PKW(P0,6), pw0); \
    VRD(1); SBAR(); GAPA(C0=__builtin_amdgcn_mfma_f32_32x32x16_bf16(kf[2],qr[1],C0,0,0,0),   P0[10],P0[11],P0[12],P0[13], pw1[0]=PKW(P0,8), pw1[1]=PKW(P0,10), pw1); \
    VRD(5); SBAR(); GAPA(C1=__builtin_amdgcn_mfma_f32_32x32x16_bf16(kf[3],qr[1],C1,0,0,0),   P0[14],P0[15],P1[0],P1[1],   pw1[2]=PKW(P0,12),pw1[3]=PKW(P0,14), pw1); \
    VRD(2); SBAR(); GAPA(C0=__builtin_amdgcn_mfma_f32_32x32x16_bf16(kf[4],qr[2],C0,0,0,0),   P1[2],P1[3],P1[4],P1[5],     pw2[0]=PKW(P1,0), pw2[1]=PKW(P1,2), pw2); \
    VRD(6); SBAR(); GAPA(C1=__builtin_amdgcn_mfma_f32_32x32x16_bf16(kf[5],qr[2],C1,0,0,0),   P1[6],P1[7],P1[8],P1[9],     pw2[2]=PKW(P1,4), pw2[3]=PKW(P1,6), pw2); \
    VRD(3); SBAR(); GAPA(C0=__builtin_amdgcn_mfma_f32_32x32x16_bf16(kf[6],qr[3],C0,0,0,0),   P1[10],P1[11],P1[12],P1[13], pw3[0]=PKW(P1,8), pw3[1]=PKW(P1,10), pw3); \
    VRD(7); SBAR(); GAPA(C1=__builtin_amdgcn_mfma_f32_32x32x16_bf16(kf[7],qr[3],C1,0,0,0),   P1[14],P1[15],0.f,0.f,       pw3[2]=PKW(P1,12),pw3[3]=PKW(P1,14), pw3); \
    l_reg+=sacc; \
    if(GK){DMA_K((t)+3,sl_cur);} if(GV){DMA_V((t)+1,sl_next);} \
    CMASK(C0,C1,t); \
    { float a_=MX3(C0[0],C0[1],C1[0]),b_=MX3(C0[2],C0[3],C1[1]); a_=MX3(a_,C1[2],C1[3]); \
      _Pragma("unroll") for(int r=4;r<16;r+=4){a_=MX3(a_,C0[r],C0[r+1]);b_=MX3(b_,C0[r+2],C0[r+3]);a_=MX3(a_,C1[r],C1[r+1]);b_=MX3(b_,C1[r+2],C1[r+3]);} \
      float rm=__builtin_fmaxf(a_,b_); { auto rr=__builtin_amdgcn_permlane32_swap(__float_as_uint(rm),__float_as_uint(rm),false,false); rm=__builtin_fmaxf(__uint_as_float(rr[0]),__uint_as_float(rr[1])); } \
      resc=false; \
      if(__builtin_expect(__any(rm>(float)THRL),0)){ const float dl=__builtin_fmaxf(rm,0.f); mhat+=dl; \
        _Pragma("unroll") for(int r=0;r<16;++r){C0[r]-=dl;C1[r]-=dl;} \
        if(MODE==0){ _Pragma("unroll") for(int r=0;r<16;++r)negm[r]=-mhat; asm volatile("":"+v"(negm)); } \
        const float f=__builtin_amdgcn_exp2f(-dl); l_reg*=f; if(hi==0)wsf[r32]=f; resc=true; } } \
    SBAR(); \
    GAPB(o[0]=__builtin_amdgcn_mfma_f32_32x32x16_bf16(PAF(0),VFR(0),o[0],0,0,0), C0,0); \
    GAPB(o[1]=__builtin_amdgcn_mfma_f32_32x32x16_bf16(PAF(0),VFR(4),o[1],0,0,0), C0,4); \
    KRD(GL,0); GAPB(o[0]=__builtin_amdgcn_mfma_f32_32x32x16_bf16(PAF(1),VFR(1),o[0],0,0,0), C0,8); \
    KRD(GL,1); GAPB(o[1]=__builtin_amdgcn_mfma_f32_32x32x16_bf16(PAF(1),VFR(5),o[1],0,0,0), C0,12); \
    KRD(GL,2); GAPB(o[0]=__builtin_amdgcn_mfma_f32_32x32x16_bf16(PAF(2),VFR(2),o[0],0,0,0), C1,0); \
    KRD(GL,3); GAPB(o[1]=__builtin_amdgcn_mfma_f32_32x32x16_bf16(PAF(2),VFR(6),o[1],0,0,0), C1,4); \
    GAPB(o[0]=__builtin_amdgcn_mfma_f32_32x32x16_bf16(PAF(3),VFR(3),o[0],0,0,0), C1,8); \
    GAPB(o[1]=__builtin_amdgcn_mfma_f32_32x32x16_bf16(PAF(3),VFR(7),o[1],0,0,0), C1,12); \
    }while(0)
  int t=1;
  #undef CMASK
  #define CMASK(P0,P1,t) MBIAS(P0,P1,t,false)
  for(;t+5<NT;t+=2){
    STEP(pB0,pB1,pA0,pA1,t,true,true,true);     WAIT_BAR(2); RESC(); ROT();
    STEP(pA0,pA1,pB0,pB1,t+1,true,true,true);   WAIT_BAR(2); RESC(); ROT();
  }
  #undef CMASK
  #define CMASK(P0,P1,t) MBIAS(P0,P1,t,true)
  #define ENDW(tt) do{ if((tt)+3<NT){WAIT_BAR(2);} else if((tt)+2<NT){WAIT_BAR(1);} else {WAIT_BAR(0);} }while(0)
  for(;t+1<NT;t+=2){
    STEP(pB0,pB1,pA0,pA1,t,(t+3<NT),(t+1<NT),(t+1<NT));       ENDW(t);   RESC(); ROT();
    STEP(pA0,pA1,pB0,pB1,t+1,(t+4<NT),(t+2<NT),(t+2<NT));     ENDW(t+1); RESC(); ROT();
  }
  STEP(pB0,pB1,pA0,pA1,NT-1,false,false,false); RESC();
  { float sacc=pB0[0]+pB0[1]; _Pragma("unroll") for(int r=2;r<16;++r)sacc+=pB0[r]; _Pragma("unroll") for(int r=0;r<16;++r)sacc+=pB1[r]; l_reg+=sacc;
    pw0=(u32x4){PKW(pB0,0),PKW(pB0,2),PKW(pB0,4),PKW(pB0,6)};pw1=(u32x4){PKW(pB0,8),PKW(pB0,10),PKW(pB0,12),PKW(pB0,14)};pw2=(u32x4){PKW(pB1,0),PKW(pB1,2),PKW(pB1,4),PKW(pB1,6)};pw3=(u32x4){PKW(pB1,8),PKW(pB1,10),PKW(pB1,12),PKW(pB1,14)};
    SBAR(); pv(o,vb0+sl_cur,PAF(0),PAF(1),PAF(2),PAF(3)); }
  #undef PKW
  #undef PAF
  #undef VFR
  #undef PIN
  #undef MX3
  #undef GAPA
  #undef GAPB
  #undef EX
  #undef VRD
  #undef KRD
  #undef STEP
  #undef ENDW
  {auto rr=__builtin_amdgcn_permlane32_swap(__float_as_uint(l_reg),__float_as_uint(l_reg),false,false);l_reg=__uint_as_float(rr[0])+__uint_as_float(rr[1]);}
  if(MODE==2)l_reg+=__builtin_amdgcn_exp2f(a.sink2-mhat);
  if(hi==0)wsf[32+r32]=l_reg;asm volatile("s_waitcnt lgkmcnt(0)":::"memory");
  float rli[16];
  #pragma unroll
  for(int r=0;r<16;++r)rli[r]=__builtin_amdgcn_rcpf(wsf[32+crow(r,hi)]);
  bf16*Ow=a.Ow; constexpr long op=OP;
  { bf16*stg=(bf16*)(shm+LDS_OST)+wid*2048;
    #pragma unroll
    for(int r=0;r<16;++r){const int orow=crow(r,hi);
      #pragma unroll
      for(int d0=0;d0<2;++d0)stg[orow*64+d0*32+r32]=__float2bfloat16(o[d0][r]*rli[r]);}
    asm volatile("s_waitcnt lgkmcnt(0)":::"memory");
    #pragma unroll
    for(int i=0;i<4;++i){const int row=i*8+(lane>>3),ch=lane&7; const u32x4 v=*(const u32x4*)(stg+row*64+ch*8); ATTN_STORE16(Ow+(long)row*op+ch*8,v);} }
  asm volatile("s_waitcnt lgkmcnt(0)\n\ts_barrier":::"memory");
  #undef DMA_K
  #undef DMA_V
  #undef TROW
  #undef KBREL
  #undef MBIAS
  #undef CINIT
  #undef CMASK
  #undef START
  #undef RESC
  #undef ROT
}

constexpr int DP_K=0, DP_V=3*8192, DP_WS=DP_V+3*16384, DP_BYTES=DP_WS+NW*256;
template<int THRL,int QP,int KVP,int OP> __device__ __forceinline__ void diff_unit(const AttnArgs&a,char*shm){
  unsigned am_; asm volatile("s_mov_b32 %0, -1":"=s"(am_)); const int lane=(int)__builtin_amdgcn_mbcnt_hi(am_,__builtin_amdgcn_mbcnt_lo(am_,0u)),r32=lane&31,hi=lane>>5; const int wid=a.wave;
  const bf16*Qw=a.Qw; constexpr int qp=QP; constexpr long kvp=KVP;
  const unsigned lds0=(unsigned)(uintptr_t)shm;
  float*wsf=(float*)(shm+DP_WS)+wid*64;
  const unsigned koff=(unsigned)((lane*KVP+wid*8)*2), voff=(unsigned)(((16*(wid&3)+(lane>>2))*KVP+(wid>>2)*32+(lane&3)*8)*2);
  const char*Kb=(const char*)a.K0; const char*Vb=(const char*)a.V0;
  const unsigned kdst=lds0+DP_K+wid*1024, vdst=lds0+DP_V+wid*1024;
  #define DMA_K(t,slot) glds16s(Kb+(long)(64*(t))*(kvp*2),koff,(unsigned)__builtin_amdgcn_readfirstlane(kdst+(slot)))
  #define DMA_V(t,slot) do{ DMA_VA(t,slot); DMA_VB(t,slot); }while(0)
  #define DMA_VA(t,slot) glds16s(Vb+(long)(64*(t))*(kvp*2),voff,(unsigned)__builtin_amdgcn_readfirstlane(vdst+2*(slot)))
  #define DMA_VB(t,slot) glds16s(Vb+(long)(64*(t))*(kvp*2)+128,voff,(unsigned)__builtin_amdgcn_readfirstlane(vdst+2*(slot)+8192))
  const int vb0=(int)(lds0+DP_V)+((lane>>4)&1)*32+(lane&3)*8+(4*hi+((lane&15)>>2))*64;
  const char*Kbase=shm+DP_K; bf16x8 kf[8];
  const lds_cptr shm3=(lds_cptr)shm; const lds_cptr kp0=shm3+DP_K+hi*1024+r32*16; const lds_cptr vp0=shm3+DP_V+((lane>>4)&1)*32+(lane&3)*8+(4*hi+((lane&15)>>2))*64;
  const int NT=a.NT;
  DMA_K(0,0);DMA_V(0,0);DMA_K(1,SLOTB);
  bf16x8 qr[4];
  #pragma unroll
  for(int d0=0;d0<4;++d0)qr[d0]=*reinterpret_cast<const bf16x8*>(&Qw[(long)r32*qp+d0*16+hi*8]);
  float z0_; asm volatile("v_mov_b32 %0, 0":"=v"(z0_));
  f32x16 zv_; _Pragma("unroll") for(int r=0;r<16;++r)zv_[r]=z0_;
  float mhat=0.f,l_reg=0.f;f32x16 o[4];o[0]=zv_;o[1]=zv_;o[2]=zv_;o[3]=zv_;
  const int qrel=a.qrel; const float slope2=a.slope2;
  float slope2v=slope2; asm volatile("":"+v"(slope2v));
  #define KBREL(t) (64*((t)-(NT-4)))
  #define MBIAS(P0,P1,t,BAND) maskbias<1>(P0,P1,KBREL(t)+4*hi,qrel,slope2,mhat,(BAND)&&((t)>=NT-4),true)
  #define CMASK(P0,P1,t) MBIAS(P0,P1,t,true)
  bool resc=false;
  #define START(P0,P1) do{ const float rm=rowmax(P0,P1); resc=false; \
    { const float dl=rm; mhat=fadd_s(mhat,dl); \
      _Pragma("unroll") for(int r=0;r<16;++r){P0[r]=fsub_s(P0[r],dl);P1[r]=fsub_s(P1[r],dl);} } \
    _Pragma("unroll") for(int r=0;r<16;++r)P0[r]=__builtin_amdgcn_exp2f(P0[r]); }while(0)
  #define RESC() do{ if(resc){ asm volatile("s_waitcnt lgkmcnt(0)":::"memory"); \
      _Pragma("unroll") for(int d_=0;d_<4;++d_) _Pragma("unroll") for(int r=0;r<16;++r)o[d_][r]*=wsf[crow(r,hi)]; } }while(0)
  f32x16 pA0,pA1;
  int sl_prev=0,sl_cur=0,sl_next=SLOTB;
  #define ROT() do{sl_prev=sl_cur;sl_cur=sl_next;sl_next=(sl_next==(NSLOT-1)*SLOTB)?0:sl_next+SLOTB;}while(0)
  DMA_K(2,2*SLOTB);
  WAIT_BAR(4);
  qkt(pA0,pA1,Kbase,qr,zv_,r32,hi);asm volatile("s_nop 15\n\ts_nop 7":"+v"(pA0),"+v"(pA1));CMASK(pA0,pA1,0);
  START(pA0,pA1);
  _Pragma("unroll") for(int r=0;r<16;++r)pA1[r]=__builtin_amdgcn_exp2f(pA1[r]);
  f32x16 pB0,pB1;
  { const float lbn=__builtin_fmaf(slope2,(float)(KBREL(1)+4*hi-qrel),-mhat);
    _Pragma("unroll") for(int r=0;r<16;++r){ const int c=(r&3)+8*(r>>2); pB0[r]=__builtin_fmaf(slope2,(float)c,lbn); pB1[r]=__builtin_fmaf(slope2,(float)(c+32),lbn); } }
  WAIT_BAR(0);
  DMA_K(3,0);DMA_V(1,SLOTB);
  ROT();
  kload8(kf,kp0+sl_cur);
  WAIT_BAR(0);
  s16x4 vlo[8],vhi[8]; u32x4 pw0,pw1,pw2,pw3;
  #define PKW(P,B) cvtpk_s(P[B],P[B+1])
  #define PAF(k) __builtin_bit_cast(bf16x8,pw##k)
  #define VFR(i) (bf16x8){vlo[i][0],vlo[i][1],vlo[i][2],vlo[i][3],vhi[i][0],vhi[i][1],vhi[i][2],vhi[i][3]}
  #define PIN(x) asm volatile("":"+v"(x))
  #define MX3(a,b,c) __builtin_fmaxf(__builtin_fmaxf((a),(b)),(c))
  #define GAPA(MF,A0,A1,A2,A3,W0,W1,PW) do{ MF; sacc+=A0; sacc+=A1; sacc+=A2; sacc+=A3; PIN(sacc); W0; W1; PIN(PW); SBAR(); }while(0)
  #define EX(v) __builtin_amdgcn_exp2f(v)
  #define FILLV(r,OFF) fmamk_c<(((r)&3)+8*((r)>>2))+(OFF)>(slope2v,lbn)
  #define GAPB(MF,X0,X1,E0,E1,E2) do{ MF; E0=EX(E0); E1=EX(E1); E2=EX(E2); PIN(X0); PIN(X1); SBAR(); }while(0)
  #define GAPD(MF,X,E,Y,B,OFF) do{ MF; E=EX(E); Y[B]=FILLV(B,OFF); Y[B+1]=FILLV(B+1,OFF); Y[B+2]=FILLV(B+2,OFF); Y[B+3]=FILLV(B+3,OFF); PIN(X); PIN(Y); SBAR(); }while(0)
  #define GAPC(MF) do{ MF; SBAR(); }while(0)
  #define VRD(i) do{ vlo[i]=vtr(vp_+(((i)>>2)*4096+((i)&3)*1024)); vhi[i]=vtr(vp_+(((i)>>2)*4096+((i)&3)*1024+512)); SBAR(); }while(0)
  #define VRD2(i) do{ vlo[i]=vtr(vp_+(8192+((i)>>2)*4096+((i)&3)*1024)); vhi[i]=vtr(vp_+(8192+((i)>>2)*4096+((i)&3)*1024+512)); SBAR(); }while(0)
  #define KRD(G,j) do{ if(G){ kload2(kf,kp0+sl_next,j); SBAR(); } }while(0)
  #define STEP(C0,C1,P0,P1,t,GK,GV,GL) do{ SBAR(); \
    const lds_cptr vp_=vp0+2*sl_prev; \
    float sacc=(P0[0]+P0[1]); \
    GAPA(C0=__builtin_amdgcn_mfma_f32_32x32x16_bf16(kf[0],qr[0],C0,0,0,0), P0[2],P0[3],P0[4],P0[5],     pw0[0]=PKW(P0,0), pw0[1]=PKW(P0,2), pw0); \
    if(GK){DMA_K((t)+3,sl_cur); SBAR();} \
    GAPA(C1=__builtin_amdgcn_mfma_f32_32x32x16_bf16(kf[1],qr[0],C1,0,0,0), P0[6],P0[7],P0[8],P0[9],     pw0[2]=PKW(P0,4), pw0[3]=PKW(P0,6), pw0); \
    GAPA(C0=__builtin_amdgcn_mfma_f32_32x32x16_bf16(kf[2],qr[1],C0,0,0,0),   P0[10],P0[11],P0[12],P0[13], pw1[0]=PKW(P0,8), pw1[1]=PKW(P0,10), pw1); \
    if(GV){DMA_VA((t)+1,sl_next); SBAR();} \
    GAPA(C1=__builtin_amdgcn_mfma_f32_32x32x16_bf16(kf[3],qr[1],C1,0,0,0),   P0[14],P0[15],P1[0],P1[1],   pw1[2]=PKW(P0,12),pw1[3]=PKW(P0,14), pw1); \
    GAPA(C0=__builtin_amdgcn_mfma_f32_32x32x16_bf16(kf[4],qr[2],C0,0,0,0),   P1[2],P1[3],P1[4],P1[5],     pw2[0]=PKW(P1,0), pw2[1]=PKW(P1,2), pw2); \
    if(GV){DMA_VB((t)+1,sl_next); SBAR();} \
    GAPA(C1=__builtin_amdgcn_mfma_f32_32x32x16_bf16(kf[5],qr[2],C1,0,0,0),   P1[6],P1[7],P1[8],P1[9],     pw2[2]=PKW(P1,4), pw2[3]=PKW(P1,6), pw2); \
    GAPA(C0=__builtin_amdgcn_mfma_f32_32x32x16_bf16(kf[6],qr[3],C0,0,0,0),   P1[10],P1[11],P1[12],P1[13], pw3[0]=PKW(P1,8), pw3[1]=PKW(P1,10), pw3); \
    VRD(0); GAPA(C1=__builtin_amdgcn_mfma_f32_32x32x16_bf16(kf[7],qr[3],C1,0,0,0),   P1[14],P1[15],0.f,0.f,       pw3[2]=PKW(P1,12),pw3[3]=PKW(P1,14), pw3); \
    l_reg+=sacc; \
    VRD(4); VRD(1); VRD(5); \
    SMASK(C0,C1,t); \
    { float a_=MX3(C0[0],C0[1],C1[0]),b_=MX3(C0[2],C0[3],C1[1]); a_=MX3(a_,C1[2],C1[3]); \
      _Pragma("unroll") for(int r=4;r<16;r+=4){a_=MX3(a_,C0[r],C0[r+1]);b_=MX3(b_,C0[r+2],C0[r+3]);a_=MX3(a_,C1[r],C1[r+1]);b_=MX3(b_,C1[r+2],C1[r+3]);} \
      float rm=__builtin_fmaxf(a_,b_); { auto rr=__builtin_amdgcn_permlane32_swap(__float_as_uint(rm),__float_as_uint(rm),false,false); rm=__builtin_fmaxf(__uint_as_float(rr[0]),__uint_as_float(rr[1])); } \
      resc=false; \
      if(__builtin_expect(__any(rm>(float)THRL),0)){ const float dl=__builtin_fmaxf(rm,0.f); mhat+=dl; \
        _Pragma("unroll") for(int r=0;r<16;++r){C0[r]-=dl;C1[r]-=dl;} \
        const float f=__builtin_amdgcn_exp2f(-dl); l_reg*=f; if(hi==0)wsf[r32]=f; resc=true; } } \
    const float lbn=__builtin_fmaf(slope2,(float)(KBREL((t)+1)+4*hi-qrel),-mhat); \
    SBAR(); \
    VRD(2); GAPB(o[0]=__builtin_amdgcn_mfma_f32_32x32x16_bf16(PAF(0),VFR(0),o[0],0,0,0), C0,C1, C0[0],C0[1],C0[2]);    VRD2(0); \
    VRD(6); GAPB(o[1]=__builtin_amdgcn_mfma_f32_32x32x16_bf16(PAF(0),VFR(4),o[1],0,0,0), C0,C1, C0[3],C0[4],C0[5]);    VRD2(4); \
    VRD(3); GAPB(o[0]=__builtin_amdgcn_mfma_f32_32x32x16_bf16(PAF(1),VFR(1),o[0],0,0,0), C0,C1, C0[6],C0[7],C0[8]);    VRD2(1); \
    VRD(7); GAPB(o[1]=__builtin_amdgcn_mfma_f32_32x32x16_bf16(PAF(1),VFR(5),o[1],0,0,0), C0,C1, C0[9],C0[10],C0[11]);  VRD2(5); \
    GAPB(o[0]=__builtin_amdgcn_mfma_f32_32x32x16_bf16(PAF(2),VFR(2),o[0],0,0,0), C0,C1, C0[12],C0[13],C0[14]); VRD2(2); \
    GAPB(o[1]=__builtin_amdgcn_mfma_f32_32x32x16_bf16(PAF(2),VFR(6),o[1],0,0,0), C0,C1, C0[15],C1[0],C1[1]);   VRD2(6); \
    GAPB(o[0]=__builtin_amdgcn_mfma_f32_32x32x16_bf16(PAF(3),VFR(3),o[0],0,0,0), C0,C1, C1[2],C1[3],C1[4]);    VRD2(3); \
    GAPB(o[1]=__builtin_amdgcn_mfma_f32_32x32x16_bf16(PAF(3),VFR(7),o[1],0,0,0), C0,C1, C1[5],C1[6],C1[7]);    VRD2(7); \
    KRD(GL,0); GAPD(o[2]=__builtin_amdgcn_mfma_f32_32x32x16_bf16(PAF(0),VFR(0),o[2],0,0,0), C1,C1[8], P0,0,0); \
    KRD(GL,1); GAPD(o[3]=__builtin_amdgcn_mfma_f32_32x32x16_bf16(PAF(0),VFR(4),o[3],0,0,0), C1,C1[9], P0,4,0); \
    KRD(GL,2); GAPD(o[2]=__builtin_amdgcn_mfma_f32_32x32x16_bf16(PAF(1),VFR(1),o[2],0,0,0), C1,C1[10],P0,8,0); \
    KRD(GL,3); GAPD(o[3]=__builtin_amdgcn_mfma_f32_32x32x16_bf16(PAF(1),VFR(5),o[3],0,0,0), C1,C1[11],P0,12,0); \
    GAPD(o[2]=__builtin_amdgcn_mfma_f32_32x32x16_bf16(PAF(2),VFR(2),o[2],0,0,0), C1,C1[12],P1,0,32); \
    GAPD(o[3]=__builtin_amdgcn_mfma_f32_32x32x16_bf16(PAF(2),VFR(6),o[3],0,0,0), C1,C1[13],P1,4,32); \
    GAPD(o[2]=__builtin_amdgcn_mfma_f32_32x32x16_bf16(PAF(3),VFR(3),o[2],0,0,0), C1,C1[14],P1,8,32); \
    GAPD(o[3]=__builtin_amdgcn_mfma_f32_32x32x16_bf16(PAF(3),VFR(7),o[3],0,0,0), C1,C1[15],P1,12,32); \
    }while(0)
  int t=1;
  #define SMASK(P0,P1,t) do{}while(0)
  for(;t+5<NT;t+=2){
    STEP(pB0,pB1,pA0,pA1,t,true,true,true);     WAIT_BAR(0); RESC(); ROT();
    STEP(pA0,pA1,pB0,pB1,t+1,true,true,true);   WAIT_BAR(0); RESC(); ROT();
  }
  #undef SMASK
  #define SMASK(P0,P1,t) do{ if((t)>=NT-4){ int dq_=qrel-(KBREL(t)+4*hi); asm volatile("":"+v"(dq_));        \
    _Pragma("unroll") for(int r=0;r<16;++r){ const int c_=(r&3)+8*(r>>2); if(c_>dq_)P0[r]=-INFINITY; if(c_+32>dq_)P1[r]=-INFINITY; } } }while(0)
  #define ENDW(tt) do{ WAIT_BAR(0); }while(0)
  for(;t+1<NT;t+=2){
    STEP(pB0,pB1,pA0,pA1,t,(t+3<NT),(t+1<NT),(t+1<NT));       ENDW(t);   RESC(); ROT();
    STEP(pA0,pA1,pB0,pB1,t+1,(t+4<NT),(t+2<NT),(t+2<NT));     ENDW(t+1); RESC(); ROT();
  }
  STEP(pB0,pB1,pA0,pA1,NT-1,false,false,false); RESC();
  { float sacc=pB0[0]+pB0[1]; _Pragma("unroll") for(int r=2;r<16;++r)sacc+=pB0[r]; _Pragma("unroll") for(int r=0;r<16;++r)sacc+=pB1[r]; l_reg+=sacc;
    pw0=(u32x4){PKW(pB0,0),PKW(pB0,2),PKW(pB0,4),PKW(pB0,6)};pw1=(u32x4){PKW(pB0,8),PKW(pB0,10),PKW(pB0,12),PKW(pB0,14)};pw2=(u32x4){PKW(pB1,0),PKW(pB1,2),PKW(pB1,4),PKW(pB1,6)};pw3=(u32x4){PKW(pB1,8),PKW(pB1,10),PKW(pB1,12),PKW(pB1,14)};
    SBAR(); pv(o,vb0+2*sl_cur,PAF(0),PAF(1),PAF(2),PAF(3)); pv(o+2,vb0+2*sl_cur+8192,PAF(0),PAF(1),PAF(2),PAF(3)); }
  #undef PKW
  #undef PAF
  #undef VFR
  #undef PIN
  #undef MX3
  #undef GAPA
  #undef GAPB
  #undef GAPD
  #undef GAPC
  #undef EX
  #undef VRD
  #undef VRD2
  #undef KRD
  #undef STEP
  #undef ENDW
  #undef SMASK
  #undef FILLV
  {auto rr=__builtin_amdgcn_permlane32_swap(__float_as_uint(l_reg),__float_as_uint(l_reg),false,false);l_reg=__uint_as_float(rr[0])+__uint_as_float(rr[1]);}
  if(hi==0)wsf[32+r32]=l_reg;asm volatile("s_waitcnt lgkmcnt(0)":::"memory");
  float rli[16];
  #pragma unroll
  for(int r=0;r<16;++r)rli[r]=__builtin_amdgcn_rcpf(wsf[32+crow(r,hi)]);
  asm volatile("s_waitcnt lgkmcnt(0)\n\ts_barrier":::"memory");
  { bf16*stg=(bf16*)(shm)+wid*4096;
    #pragma unroll
    for(int r=0;r<16;++r){const int orow=crow(r,hi);
      #pragma unroll
      for(int dq=0;dq<4;++dq)stg[orow*128+dq*32+r32]=__float2bfloat16(o[dq][r]*rli[r]);}
    asm volatile("s_waitcnt lgkmcnt(0)":::"memory");
    #pragma unroll
    for(int i=0;i<8;++i){const int row=i*4+(lane>>4),ch=lane&15; const u32x4 v=*(const u32x4*)(stg+row*128+ch*8); *(u32x4*)(a.Ow+(long)row*OP+ch*8)=v;} }
  asm volatile("s_waitcnt lgkmcnt(0)\n\ts_barrier":::"memory");
  #undef DMA_K
  #undef DMA_V
  #undef DMA_VA
  #undef DMA_VB
  #undef KBREL
  #undef MBIAS
  #undef CMASK
  #undef START
  #undef RESC
  #undef ROT
}
constexpr int ATTN_LDS_BYTES=LDS_BYTES;
#undef SBAR
#undef WAIT_BAR
}
constexpr int NWAVES = 8;
constexpr int BATCH = 2, SEQ = 16384, D = 1024, M = BATCH * SEQ, DEPTH = 4, MEMLEN = 256;
constexpr int NPA = 1536, NPB = 2560;
constexpr int NEXP = 64, CAP = 32768, HID = 256;
constexpr int HROWS = (M * 8 / 256 + NEXP + M / 256) * 256;
constexpr float LN_EPS = 1e-5f;
constexpr float DN_ALPHA = 1.681792830507429f;
__device__ const float SLOPES_A[12] = {0.5f, 0.25f, 0.125f, 0.0625f, 0.03125f, 0.015625f, 0.0078125f, 0.00390625f, 0.7071067811865476f, 0.35355339059327384f, 0.17677669529663695f, 0.08838834764831849f};
__device__ const float SLOPES_B[6] = {0.25f, 0.0625f, 0.015625f, 0.00390625f, 0.5f, 0.125f};

constexpr size_t MiB = 1u << 20;
constexpr size_t WS_CTL = 0, CTL_ZERO_BYTES = 1 * MiB;
constexpr size_t WS_MEMKV = 2 * MiB;
constexpr size_t WS_WROUT = 4 * MiB;
constexpr size_t WS_WINA = 6 * MiB, WS_WINB = 12 * MiB;
constexpr size_t WS_WOUT = 22 * MiB;
constexpr size_t WS_WMKV = 30 * MiB;
constexpr size_t WS_MEMB = 34 * MiB;
constexpr size_t WS_LOGIT = 36 * MiB;
constexpr size_t WS_ROWTOK = 44 * MiB, WS_ROWGATE = 52 * MiB;
constexpr size_t WS_WEXP = 60 * MiB;
constexpr size_t WS_XB = 158 * MiB;
constexpr size_t WS_HB = 222 * MiB;
constexpr size_t WS_BIG = 374 * MiB;
constexpr size_t WS_QKV = WS_BIG, WS_OTMP = WS_BIG + 160 * MiB, WS_CAT = WS_BIG + 256 * MiB, WS_Y = WS_BIG + 320 * MiB;
constexpr size_t WS_END = WS_BIG + 576 * MiB;
static_assert(WS_WEXP + 65 * (size_t)pg8::EXPERT_BYTES <= WS_XB && WS_HB + (size_t)HROWS * 512 <= WS_BIG, "d_ws map");
constexpr int CW_TMO = 0;
constexpr int CW_BAR = 4096;
constexpr int CW_CNT = 16384;
constexpr int CW_Q = CW_CNT + DEPTH * 64 * 64;
constexpr int CW_NORM = CW_Q + 64 * DEPTH;
static_assert((CW_NORM + 64 * DEPTH) * 4 <= (int)CTL_ZERO_BYTES, "CTL words inside the memset region");

constexpr int RING_OFF = 0, RING_BYTES = 131072;
constexpr int LDSCTL_OFF = RING_BYTES;
constexpr int TAB_OFF = RING_BYTES + 512;
constexpr int IDX_OFF = RING_BYTES + 2560;
constexpr int GATE_OFF = IDX_OFF + 10 * 1024;
constexpr int LDS_BYTES = 163840;
static_assert(IDX_OFF + 20 * 1024 <= LDS_BYTES, "LDS map");

#define GAS __attribute__((address_space(1)))
#define LAS __attribute__((address_space(3)))
typedef unsigned short bf16;
typedef unsigned v4u __attribute__((ext_vector_type(4)));
typedef unsigned v2u __attribute__((ext_vector_type(2)));
typedef float f32x4 __attribute__((ext_vector_type(4)));
typedef GAS unsigned gu32;
#define RLX_AGENT __ATOMIC_RELAXED, __HIP_MEMORY_SCOPE_AGENT
#define LDS_WAIT() asm volatile("s_waitcnt lgkmcnt(0)" ::: "memory")
__device__ __forceinline__ unsigned f2bf(float f) { unsigned u = __builtin_bit_cast(unsigned, f); return (u + 0x7fffu + ((u >> 16) & 1u)) >> 16; }
__device__ __forceinline__ unsigned pk2(float lo, float hi) { return f2bf(lo) | (f2bf(hi) << 16); }
__device__ __forceinline__ float bflo(unsigned u) { return __builtin_bit_cast(float, u << 16); }
__device__ __forceinline__ float bfhi(unsigned u) { return __builtin_bit_cast(float, u & 0xffff0000u); }

#define XB_TMO      128
#define XB_XCNT(j)  (256  + 64 * (j))
#define XB_XSUB(j)  (1280 + 64 * (j))
#define XB_XGEN(j)  (2304 + 64 * (j))
#define XB_TOP      3328
#define XB_TOPGEN   3392
#define XCD_BAR_WORDS 3456
#define XB_SPIN_CAP (1u << 18)
__device__ __forceinline__ unsigned xb_ld(unsigned* p)              { return __hip_atomic_load(p, __ATOMIC_RELAXED, __HIP_MEMORY_SCOPE_AGENT); }
__device__ __forceinline__ unsigned xb_add(unsigned* p, unsigned v) { return __hip_atomic_fetch_add(p, v, __ATOMIC_RELAXED, __HIP_MEMORY_SCOPE_AGENT); }
__device__ __forceinline__ unsigned xb_xcc_id() { return (unsigned)__builtin_amdgcn_s_getreg((3 << 11) | 20) & 0xFu; }
#define XB_SPIN(cond, bar) do { unsigned _sp = 0; while (cond) { __builtin_amdgcn_s_sleep(1); \
    if ((++_sp & 255u) == 0u) { if (xb_ld(&(bar)[XB_TMO])) break; if (_sp > XB_SPIN_CAP) { atomicAdd(&(bar)[XB_TMO], 1u); break; } } } } while (0)
struct XcdBarrier { unsigned* bar; unsigned x; volatile LAS unsigned* st; };
__device__ __forceinline__ XcdBarrier xcd_barrier_post(unsigned* bar, volatile LAS unsigned* st, const bool t0) {
    XcdBarrier b; b.bar = bar; b.x = xb_xcc_id(); b.st = st;
    if (t0) (void)xb_add(&bar[XB_XCNT(b.x)], 1u);
    return b;
}
__device__ __forceinline__ void xcd_barrier_complete(unsigned* bar, unsigned x, unsigned& nloc, unsigned& nx) {
    const unsigned G = gridDim.x * gridDim.y * gridDim.z;
    unsigned sum, cnt, mine, sp = 0u;
    for (;;) {
        sum = 0u; cnt = 0u; mine = 0u;
#pragma unroll
        for (unsigned j = 0; j < 16; ++j) { const unsigned c = xb_ld(&bar[XB_XCNT(j)]); sum += c; cnt += (c > 0u) ? 1u : 0u; mine = (j == x) ? c : mine; }
        if (sum == G) break;
        __builtin_amdgcn_s_sleep(1);
        if ((++sp & 255u) == 0u) { if (xb_ld(&bar[XB_TMO])) break; if (sp > XB_SPIN_CAP) { atomicAdd(&bar[XB_TMO], 1u); break; } }
    }
    nloc = mine > 0u ? mine : 1u; nx = cnt > 0u ? cnt : 1u;
}
__device__ __forceinline__ void xcd_barrier(const XcdBarrier& b, const bool t0) {
    asm volatile("s_waitcnt vmcnt(0)" ::: "memory");
    __syncthreads();
    if (t0) {
        unsigned* bar = b.bar;
        __builtin_amdgcn_s_waitcnt(0);
        unsigned nloc = b.st[0], nx = b.st[1];
        if (nloc == 0u) { xcd_barrier_complete(bar, b.x, nloc, nx); b.st[0] = nloc; b.st[1] = nx; }
        const unsigned old = xb_add(&bar[XB_XSUB(b.x)], 1u);
        const unsigned gen = old / nloc;
        if (old + 1u == (gen + 1u) * nloc) {
            __builtin_amdgcn_fence(__ATOMIC_RELEASE, "agent");
            asm volatile("s_waitcnt vmcnt(0)" ::: "memory");
            const unsigned og = xb_add(&bar[XB_TOP], 1u);
            const unsigned tg = og / nx;
            if (og + 1u == (tg + 1u) * nx) xb_add(&bar[XB_TOPGEN], 1u);
            else XB_SPIN(xb_ld(&bar[XB_TOPGEN]) == tg, bar);
            __builtin_amdgcn_fence(__ATOMIC_ACQUIRE, "agent");
            xb_add(&bar[XB_XGEN(b.x)], 1u);
            asm volatile("s_waitcnt vmcnt(0)" ::: "memory");
        } else {
            XB_SPIN(xb_ld(&bar[XB_XGEN(b.x)]) == gen, bar);
            __builtin_amdgcn_fence(__ATOMIC_ACQUIRE, "agent");
            asm volatile("s_waitcnt vmcnt(0)" ::: "memory");
        }
    }
    __syncthreads();
}

struct Frame { LAS unsigned char* lds; int wave; };
__device__ __forceinline__ int f_G() { int g = (int)gridDim.x; asm volatile("" : "+s"(g)); return g; }
__device__ __forceinline__ int f_bx() { int b = (int)blockIdx.x; asm volatile("" : "+s"(b)); return b; }
__device__ __forceinline__ int f_gw(const Frame& F) { const int g = f_G(), b = f_bx(); return ((g % 8 == 0) ? (b % 8) * (g / 8) + b / 8 : b) * NWAVES + F.wave; }
__device__ __forceinline__ int f_ngw() { return f_G() * NWAVES; }
__device__ __forceinline__ volatile LAS unsigned* f_misc(const Frame& F) { return (volatile LAS unsigned*)(F.lds + LDSCTL_OFF); }
__device__ __forceinline__ int lane_id() { unsigned m; asm volatile("s_mov_b32 %0, -1" : "=s"(m)); return (int)__builtin_amdgcn_mbcnt_hi(m, __builtin_amdgcn_mbcnt_lo(m, 0u)); }
__device__ __forceinline__ int tid_of(int wave) { asm volatile("" : "+s"(wave)); return (wave << 6) | lane_id(); }
#define fresh_tid() tid_of(F.wave)
__device__ __forceinline__ float sx(float v, int o, int ln) { return __builtin_bit_cast(float, __builtin_amdgcn_ds_bpermute((ln ^ o) << 2, __builtin_bit_cast(int, v))); }
template <int CTRL> __device__ __forceinline__ float dppf(float v) { return __builtin_bit_cast(float, __builtin_amdgcn_update_dpp(0, __builtin_bit_cast(int, v), CTRL, 0xF, 0xF, false)); }
__device__ __forceinline__ float gmax8(float v) { v = fmaxf(v, dppf<0xB1>(v)); v = fmaxf(v, dppf<0x4E>(v)); return fmaxf(v, dppf<0x141>(v)); }
__device__ __forceinline__ float gsum8(float v) { v += dppf<0xB1>(v); v += dppf<0x4E>(v); return v + dppf<0x141>(v); }
__device__ __forceinline__ float wave_sum(float v) {
    const int ln_ = lane_id();
#pragma unroll
    for (int o = 1; o < 64; o <<= 1) v += sx(v, o, ln_);
    return v;
}
__device__ __forceinline__ void transpose_item64(const float* W, int N, bf16* WT, int ldt, int k0, int n0, int drow0, LAS float* scr, int lane) {
    const int rr = lane >> 4, cc = (lane & 15) * 4;
    f32x4 v[16];
#pragma unroll
    for (int i = 0; i < 16; ++i) { const int kk = 4 * i + rr; v[i] = *(const GAS f32x4*)(W + (size_t)(k0 + kk) * N + n0 + cc); }
#pragma unroll
    for (int i = 0; i < 16; ++i) { const int kk = 4 * i + rr; LAS float* d = scr + kk * 65 + cc; d[0] = v[i].x; d[1] = v[i].y; d[2] = v[i].z; d[3] = v[i].w; }
    LDS_WAIT(); asm volatile("" ::: "memory");
    const int c = lane & 7;
#pragma unroll
    for (int j = 0; j < 8; ++j) { const int n = (lane >> 3) + 8 * j; const LAS float* s = scr + (8 * c) * 65 + n;
        v4u o; o.x = pk2(s[0 * 65], s[1 * 65]); o.y = pk2(s[2 * 65], s[3 * 65]); o.z = pk2(s[4 * 65], s[5 * 65]); o.w = pk2(s[6 * 65], s[7 * 65]);
        *(GAS v4u*)(WT + (size_t)(drow0 + n) * ldt + k0 + 8 * c) = o; }
    LDS_WAIT(); asm volatile("" ::: "memory");
}
__device__ __forceinline__ int map_in_a(int n) { return n < 768 ? n : (n < 960 ? n + 256 : (n < 1152 ? n + 256 : n - 384)); }
__device__ __forceinline__ int map_in_b(int n) { return n < 768 ? n : (n < 2304 ? n + 256 : n - 1536); }

struct Args { const float* in[19]; float* out; unsigned char* ws; };
typedef const __attribute__((address_space(4))) Args* ArgsP;
__device__ __forceinline__ ArgsP fresh_args() { ArgsP p = (ArgsP)__builtin_amdgcn_kernarg_segment_ptr(); asm volatile("" : "+s"(p)); return p; }
__device__ __forceinline__ gu32* f_ctl() { return (gu32*)(fresh_args()->ws + WS_CTL); }

__device__ __forceinline__ void p0_small_weights(Frame& F, ArgsP A) {
    const int tid_ = fresh_tid(), lane_ = tid_ & 63; (void)tid_; (void)lane_;
    LAS float* scr = (LAS float*)(F.lds + (F.wave < 7 ? RING_OFF + F.wave * 16640 : IDX_OFF));
    unsigned char* ws = A->ws;
    constexpr int I_A = 16 * 22, I_B = 16 * 40, I_M = 16 * 8, I_O = 16 * 16, I_R = 16;
    constexpr int NITEMS = 2 * I_A + 2 * I_B + 4 * I_M + 4 * I_O + 4 * I_R;
    for (int it = f_gw(F); it < NITEMS; it += f_ngw()) {
        int r = it;
        if (r < 2 * I_A) { const int j = r / I_A; r %= I_A; const int kb = r / 22, nb = r % 22;
            transpose_item64(A->in[2] + (size_t)j * D * 1408, 1408, (bf16*)(ws + WS_WINA) + (size_t)j * NPA * D, D, 64 * kb, 64 * nb, map_in_a(64 * nb), scr, lane_); continue; } r -= 2 * I_A;
        if (r < 2 * I_B) { const int j = r / I_B; r %= I_B; const int kb = r / 40, nb = r % 40;
            transpose_item64(A->in[4] + (size_t)j * D * 2560, 2560, (bf16*)(ws + WS_WINB) + (size_t)j * NPB * D, D, 64 * kb, 64 * nb, map_in_b(64 * nb), scr, lane_); continue; } r -= 2 * I_B;
        if (r < 4 * I_M) { const int l = r / I_M; r %= I_M; const int kb = r / 8, nb = r % 8;
            transpose_item64(A->in[7] + (size_t)l * D * 512, 512, (bf16*)(ws + WS_WMKV), D, 64 * kb, 64 * nb, l * 512 + 64 * nb, scr, lane_); continue; } r -= 4 * I_M;
        if (r < 4 * I_O) { const int l = r / I_O; r %= I_O; const int kb = r / 16, nb = r % 16;
            transpose_item64(A->in[8] + (size_t)l * D * D, D, (bf16*)(ws + WS_WOUT) + (size_t)l * D * D, D, 64 * kb, 64 * nb, 64 * nb, scr, lane_); continue; } r -= 4 * I_O;
        { const int l = r / I_R; const int kb = r % I_R;
            transpose_item64(A->in[11] + (size_t)l * D * 64, 64, (bf16*)(ws + WS_WROUT) + (size_t)l * 256 * D, D, 64 * kb, 0, 0, scr, lane_); }
    }
    for (int it = f_gw(F); it < 2 * 128 + 4 * 192; it += f_ngw()) {
        bf16* row = it < 256 ? (bf16*)(ws + WS_WINA) + ((size_t)(it >> 7) * NPA + 1408 + (it & 127)) * D
                             : (bf16*)(ws + WS_WROUT) + ((size_t)((it - 256) / 192) * 256 + 64 + (it - 256) % 192) * D;
        GAS v4u* o = (GAS v4u*)row + lane_;
        o[0] = (v4u){0u, 0u, 0u, 0u}; o[64] = (v4u){0u, 0u, 0u, 0u};
    }
    for (int m0 = 4 * f_gw(F); m0 < 512 + M; m0 += 4 * f_ngw()) {
        f32x4 v[4][4];
#pragma unroll
        for (int r = 0; r < 4; ++r) { const int m = m0 + r; const float* src = m < 512 ? A->in[1] + (size_t)m * D : A->in[0] + (size_t)(m - 512) * D;
            const GAS f32x4* xr = (const GAS f32x4*)src + lane_;
#pragma unroll
            for (int j = 0; j < 4; ++j) v[r][j] = xr[64 * j]; }
#pragma unroll
        for (int r = 0; r < 4; ++r) { const int m = m0 + r; bf16* dst = m < 512 ? (bf16*)(ws + WS_MEMB) + (size_t)m * D : (bf16*)(ws + WS_XB) + (size_t)(m - 512) * D;
            GAS v2u* o8 = (GAS v2u*)dst + lane_;
#pragma unroll
            for (int j = 0; j < 4; ++j) o8[64 * j] = (v2u){pk2(v[r][j].x, v[r][j].y), pk2(v[r][j].z, v[r][j].w)}; }
    }
}
constexpr int CONV_ITEMS = 65 * 192, CONV_UNITS = CONV_ITEMS / 8;
__device__ __forceinline__ void convert_item(ArgsP A, int layer, int it, LAS float* scr, int lane_) {
    bf16* wexp = (bf16*)(A->ws + WS_WEXP);
    const int e = it / 192, mat = (it % 192) >> 6, r = it & 63;
    bf16* dst = wexp + (size_t)e * (pg8::EXPERT_BYTES / 2);
    if (mat < 2) { const float* W = (e < 64) ? A->in[13 + mat] + ((size_t)layer * 64 + e) * (D * HID) : A->in[16 + mat] + (size_t)layer * (D * HID);
        const int kb = r >> 2, nb = r & 3, n0 = 64 * nb;
        transpose_item64(W, HID, dst, D, 64 * kb, n0, (n0 >> 7) * 256 + mat * 128 + (n0 & 127), scr, lane_); }
    else { const float* W = (e < 64) ? A->in[15] + ((size_t)layer * 64 + e) * (HID * D) : A->in[18] + (size_t)layer * (HID * D);
        const int kb = r >> 4, nb = r & 15;
        transpose_item64(W, D, dst + pg8::EXPERT_DOWN_OFF / 2, HID, 64 * kb, 64 * nb, 64 * nb, scr, lane_); }
}
__device__ __forceinline__ void convert_unit(Frame& F, ArgsP A, int layer, int cu) {
    const int tid_ = fresh_tid(), lane_ = tid_ & 63; (void)tid_;
    LAS float* scr = (LAS float*)(F.lds + (F.wave < 7 ? RING_OFF + F.wave * 16640 : IDX_OFF));
    const int it = 8 * cu + F.wave;
    if (it < CONV_ITEMS) convert_item(A, layer, it, scr, lane_);
    asm volatile("s_waitcnt lgkmcnt(0)\n\ts_barrier" ::: "memory");
}
template <bool LAST> __device__ __forceinline__ void ph_combine_ln2(Frame& F, float* xout, const unsigned char* yt, const float* g, const float* b, bf16* xb) {
    typedef float f32x2c __attribute__((ext_vector_type(2)));
    const int tid_ = fresh_tid(), lane_ = tid_ & 63; (void)tid_;
    for (int m = f_gw(F); m < M; m += f_ngw()) {
        GAS v4u* o8 = (GAS v4u*)(xb + (size_t)m * D) + 2 * lane_; const GAS v4u* yr = (const GAS v4u*)(yt + (size_t)m * 9 * D) + lane_;
        float v[16];
#pragma unroll
        for (int i = 0; i < 16; ++i) v[i] = 0.f;
#pragma unroll
        for (int k = 0; k < 9; ++k) { const v4u w = yr[k * 64];
#pragma unroll
            for (int q = 0; q < 4; ++q) { const f32x2c lo = __builtin_amdgcn_cvt_pk_f32_fp8((int)w[q], false), hi = __builtin_amdgcn_cvt_pk_f32_fp8((int)w[q], true);
                v[4 * q] += lo.x; v[4 * q + 1] += lo.y; v[4 * q + 2] += hi.x; v[4 * q + 3] += hi.y; } }
        float s = 0.f;
#pragma unroll
        for (int h = 0; h < 2; ++h) { const v4u xw = o8[h];
#pragma unroll
            for (int q = 0; q < 4; ++q) { v[8 * h + 2 * q] = v[8 * h + 2 * q] * (1.f / pg8::Y8_SCALE) + DN_ALPHA * bflo(xw[q]); v[8 * h + 2 * q + 1] = v[8 * h + 2 * q + 1] * (1.f / pg8::Y8_SCALE) + DN_ALPHA * bfhi(xw[q]); } }
#pragma unroll
        for (int i = 0; i < 16; ++i) s += v[i];
        const float mean = wave_sum(s) * (1.f / D); float s2 = 0.f;
#pragma unroll
        for (int i = 0; i < 16; ++i) { v[i] -= mean; s2 += v[i] * v[i]; }
        const float rstd = 1.f / sqrtf(wave_sum(s2) * (1.f / D) + LN_EPS);
        const GAS f32x4* gp = (const GAS f32x4*)g + 4 * lane_; const GAS f32x4* bp = (const GAS f32x4*)b + 4 * lane_;
        GAS f32x4* xo = (GAS f32x4*)(xout + (size_t)m * D) + 4 * lane_;
        float o[16];
#pragma unroll
        for (int q = 0; q < 4; ++q) { const f32x4 gv = gp[q], bv = bp[q];
            o[4 * q] = v[4 * q] * rstd * gv.x + bv.x; o[4 * q + 1] = v[4 * q + 1] * rstd * gv.y + bv.y; o[4 * q + 2] = v[4 * q + 2] * rstd * gv.z + bv.z; o[4 * q + 3] = v[4 * q + 3] * rstd * gv.w + bv.w;
            if (LAST) xo[q] = (f32x4){o[4 * q], o[4 * q + 1], o[4 * q + 2], o[4 * q + 3]}; }
        if (!LAST) { o8[0] = (v4u){pk2(o[0], o[1]), pk2(o[2], o[3]), pk2(o[4], o[5]), pk2(o[6], o[7])}; o8[1] = (v4u){pk2(o[8], o[9]), pk2(o[10], o[11]), pk2(o[12], o[13]), pk2(o[14], o[15])}; }
    }
}
__device__ __forceinline__ void ph_diff_combine(Frame& F, const bf16* otmp, const float* lq, const float* subg, float lam_init, bf16* cat) {
    const int tid_ = fresh_tid(), lane_ = tid_ & 63; (void)tid_; (void)lane_;
    float lam;
    { const float a = lq[lane_] * lq[64 + lane_], c = lq[128 + lane_] * lq[192 + lane_]; lam = expf(wave_sum(a)) - expf(wave_sum(c)) + lam_init; }
    const int l32 = lane_ & 31, hh = lane_ >> 5;
    const f32x4 gv = ((const GAS f32x4*)subg)[l32]; const float post = 1.f - lam_init;
    for (int m = f_gw(F); m < M; m += f_ngw()) {
#pragma unroll
        for (int hp = 0; hp < 3; ++hp) { const int h = 2 * hp + hh;
            const v2u a0 = *((const GAS v2u*)(otmp + (size_t)m * 1536 + h * 256) + l32), a1 = *((const GAS v2u*)(otmp + (size_t)m * 1536 + h * 256 + 128) + l32);
            f32x4 o; o.x = bflo(a0.x) - lam * bflo(a1.x); o.y = bfhi(a0.x) - lam * bfhi(a1.x); o.z = bflo(a0.y) - lam * bflo(a1.y); o.w = bfhi(a0.y) - lam * bfhi(a1.y);
            float s2 = (o.x * o.x + o.y * o.y) + (o.z * o.z + o.w * o.w);
#pragma unroll
            for (int sft = 1; sft < 32; sft <<= 1) s2 += sx(s2, sft, lane_);
            const float r = post / sqrtf(s2 * (1.f / 128.f) + LN_EPS);
            o = o * r * gv;
            *((GAS v2u*)(cat + (size_t)m * D + h * 128) + l32) = (v2u){pk2(o.x, o.y), pk2(o.z, o.w)}; }
    }
}
__device__ __forceinline__ float ss8(v4u a) { float s = 0.f;
#pragma unroll
    for (int i = 0; i < 4; ++i) { const float lo = bflo(a[i]), hi = bfhi(a[i]); s += lo * lo + hi * hi; } return s; }
__device__ __forceinline__ void ph_qknorm(Frame& F, const bf16* qkv, gu32* gmax) {
    const int tid_ = fresh_tid(), lane_ = tid_ & 63;
    LAS unsigned* lmax = (LAS unsigned*)(F.lds + LDSCTL_OFF) + 32;
    if (tid_ < 24) lmax[tid_] = 0u;
    __syncthreads();
    float mq0 = 0.f, mq1 = 0.f, mk0 = 0.f, mk1 = 0.f;
    const v4u zero = (v4u){0u, 0u, 0u, 0u};
    for (int m = f_gw(F); m < M; m += f_ngw()) {
        const bf16* row = qkv + (size_t)m * NPB;
        const v4u a = *(const GAS v4u*)(row + 8 * lane_), c = *(const GAS v4u*)(row + 1024 + 8 * lane_);
        v4u b = zero, d = zero; if (lane_ < 32) { b = *(const GAS v4u*)(row + 512 + 8 * lane_); d = *(const GAS v4u*)(row + 1536 + 8 * lane_); }
        float sa = ss8(a), sb = ss8(b), sc = ss8(c), sd = ss8(d);
#pragma unroll
        for (int o = 1; o < 8; o <<= 1) { sa += sx(sa, o, lane_); sb += sx(sb, o, lane_); sc += sx(sc, o, lane_); sd += sx(sd, o, lane_); }
        mq0 = fmaxf(mq0, sa); mq1 = fmaxf(mq1, sb); mk0 = fmaxf(mk0, sc); mk1 = fmaxf(mk1, sd);
    }
    if ((lane_ & 7) == 0) { const int g = lane_ >> 3;
        __hip_atomic_fetch_max(lmax + g, __float_as_uint(mq0), __ATOMIC_RELAXED, __HIP_MEMORY_SCOPE_WORKGROUP); __hip_atomic_fetch_max(lmax + 12 + g, __float_as_uint(mk0), __ATOMIC_RELAXED, __HIP_MEMORY_SCOPE_WORKGROUP);
        if (lane_ < 32) { __hip_atomic_fetch_max(lmax + 8 + g, __float_as_uint(mq1), __ATOMIC_RELAXED, __HIP_MEMORY_SCOPE_WORKGROUP); __hip_atomic_fetch_max(lmax + 20 + g, __float_as_uint(mk1), __ATOMIC_RELAXED, __HIP_MEMORY_SCOPE_WORKGROUP); } }
    __syncthreads();
    if (tid_ < 24) __hip_atomic_fetch_max(gmax + tid_, lmax[tid_], RLX_AGENT);
}
typedef short bf16x8r __attribute__((ext_vector_type(8)));
constexpr int RT_SC_OFF = TAB_OFF, RT_GB_OFF = TAB_OFF + 16384, RT_V_OFF = TAB_OFF + 16384 + 8192;
static_assert(RT_V_OFF + 8 * 256 <= LDS_BYTES, "LDS map (route phase)");
template <bool XF32> __device__ __forceinline__ void ph_ln_route(Frame& F, const float* xin, const bf16* y, const float* g, const float* b, bf16* xb, const bf16* wrt, const float* rbias, gu32* cnt, int* rowtok, float* rowgate, float* gtmp) {
    const int tid_ = fresh_tid(), lane_ = tid_ & 63;
    for (int i = tid_; i < 64 * 128; i += NWAVES * 64) { const int e = i >> 7, c = i & 127;
        const v4u v = *(const GAS v4u*)(wrt + (size_t)e * D + c * 8); *(LAS v4u*)(F.lds + e * 2048 + ((c ^ (e & 15)) << 4)) = v; }
    LAS float* lgb = (LAS float*)(F.lds + RT_GB_OFF);
    if (tid_ < 256) { ((LAS f32x4*)lgb)[tid_] = ((const GAS f32x4*)g)[tid_]; ((LAS f32x4*)lgb)[256 + tid_] = ((const GAS f32x4*)b)[tid_]; }
    __syncthreads();
    LAS float* sc = (LAS float*)(F.lds + RT_SC_OFF) + F.wave * 512;
    LAS float* vs = (LAS float*)(F.lds + RT_V_OFF) + F.wave * 64;
    const int r = lane_ & 15, kq = lane_ >> 4; const float bias = rbias[lane_]; const float NINF = -INFINITY;
    constexpr int RB_ = 8;
    for (int base = f_gw(F) * 16; base < M; base += f_ngw() * 16) {
#pragma unroll 1
        for (int r4 = 0; r4 < 16; r4 += RB_) {
            f32x4 v[RB_][4]; float s1[RB_];
#pragma unroll
            for (int q = 0; q < RB_; ++q) { const size_t mo = (size_t)(base + r4 + q) * D; const GAS v2u* yr = (const GAS v2u*)(y + mo) + lane_; s1[q] = 0.f;
#pragma unroll
                for (int j = 0; j < 4; ++j) { f32x4 xv;
                    if (XF32) xv = ((const GAS f32x4*)(xin + mo) + lane_)[64 * j]; else { const v2u xw = ((const GAS v2u*)(xb + mo) + lane_)[64 * j]; xv = (f32x4){bflo(xw.x), bfhi(xw.x), bflo(xw.y), bfhi(xw.y)}; }
                    const v2u yv = yr[64 * j];
                    v[q][j].x = DN_ALPHA * xv.x + bflo(yv.x); v[q][j].y = DN_ALPHA * xv.y + bfhi(yv.x); v[q][j].z = DN_ALPHA * xv.z + bflo(yv.y); v[q][j].w = DN_ALPHA * xv.w + bfhi(yv.y);
                    s1[q] += (v[q][j].x + v[q][j].y) + (v[q][j].z + v[q][j].w); } }
#pragma unroll
            for (int o = 1; o < 64; o <<= 1) {
#pragma unroll
                for (int q = 0; q < RB_; ++q) s1[q] += sx(s1[q], o, lane_); }
            float s2[RB_];
#pragma unroll
            for (int q = 0; q < RB_; ++q) { const float mean = s1[q] * (1.f / D); s2[q] = 0.f;
#pragma unroll
                for (int j = 0; j < 4; ++j) { v[q][j] = v[q][j] - mean; s2[q] += (v[q][j].x * v[q][j].x + v[q][j].y * v[q][j].y) + (v[q][j].z * v[q][j].z + v[q][j].w * v[q][j].w); } }
#pragma unroll
            for (int o = 1; o < 64; o <<= 1) {
#pragma unroll
                for (int q = 0; q < RB_; ++q) s2[q] += sx(s2[q], o, lane_); }
#pragma unroll
            for (int q = 0; q < RB_; ++q) { const float rstd = 1.f / sqrtf(s2[q] * (1.f / D) + LN_EPS); GAS v2u* o8 = (GAS v2u*)(xb + (size_t)(base + r4 + q) * D) + lane_;
#pragma unroll
                for (int j = 0; j < 4; ++j) { const LAS f32x4* gp = (const LAS f32x4*)lgb + lane_ + 64 * j; const f32x4 gv = gp[0], bv = gp[256];
                    const f32x4 o = v[q][j] * rstd * gv + bv; o8[64 * j] = (v2u){pk2(o.x, o.y), pk2(o.z, o.w)}; } }
        }
        asm volatile("s_waitcnt vmcnt(0)" ::: "memory");
        f32x4 acc[4];
#pragma unroll
        for (int nt = 0; nt < 4; ++nt) acc[nt] = (f32x4){0.f, 0.f, 0.f, 0.f};
        const bf16* arow = xb + (size_t)(base + r) * D + 8 * kq;
#pragma unroll 16
        for (int s = 0; s < 32; ++s) { const v4u aw = *(const GAS v4u*)(arow + 32 * s); const bf16x8r af = __builtin_bit_cast(bf16x8r, aw);
#pragma unroll
            for (int nt = 0; nt < 4; ++nt) { const int e = 16 * nt + r, c = 4 * s + kq;
                const bf16x8r bfr = *(const LAS bf16x8r*)(F.lds + e * 2048 + ((c ^ (e & 15)) << 4));
                acc[nt] = __builtin_amdgcn_mfma_f32_16x16x32_bf16(bfr, af, acc[nt], 0, 0, 0); } }
        unsigned selmask = 0u; unsigned long long slots = 0ull; unsigned mycount = 0u;
#pragma unroll 1
        for (int half = 0; half < 2; ++half) {
            if ((r >> 3) == half) {
#pragma unroll
                for (int nt = 0; nt < 4; ++nt) *(LAS f32x4*)(sc + (r & 7) * 64 + 16 * nt + 4 * kq) = acc[nt]; }
            LDS_WAIT(); asm volatile("" ::: "memory");
#pragma unroll 1
            for (int j8 = 0; j8 < 8; ++j8) { const int j = half * 8 + j8;
                const float logit = sc[j8 * 64 + lane_];
                const float aff = 1.f / (1.f + expf(-logit)); const float sel = aff + bias;
                const float m1 = gmax8(sel);
                const unsigned long long bm = __ballot(sel == m1); const unsigned gb = (unsigned)(bm >> (lane_ & 56)) & 0xffu; const int first = __builtin_ctz(gb | 0x100u);
                const float m2 = gmax8(((lane_ & 7) == first) ? NINF : sel);
                const float gs = m1 + m2; int grank = 0;
#pragma unroll
                for (int g2 = 0; g2 < 8; ++g2) { const float o = __builtin_bit_cast(float, __builtin_amdgcn_readlane(__builtin_bit_cast(int, gs), 8 * g2)); grank += (o > gs || (o == gs && g2 < (lane_ >> 3))) ? 1 : 0; }
                const bool gok = grank < 4; const float v = gok ? sel : NINF; int er = 0;
                vs[lane_] = v; LDS_WAIT(); asm volatile("" ::: "memory");
#pragma unroll
                for (int e4 = 0; e4 < 16; ++e4) { const f32x4 o = ((const LAS f32x4*)vs)[e4]; er += ((o.x > v) ? 1 : 0) + ((o.y > v) ? 1 : 0) + ((o.z > v) ? 1 : 0) + ((o.w > v) ? 1 : 0); }
                bool chosen = gok && er < 8;
                if (__builtin_popcountll(__ballot(chosen)) != 8) {
                    er = 0;
#pragma unroll 4
                    for (int e2 = 0; e2 < 64; ++e2) { const float o = vs[e2]; er += (o > v || (o == v && e2 < lane_)) ? 1 : 0; }
                    chosen = gok && er < 8; }
                asm volatile("" ::: "memory");
                const float cs = gsum8(chosen ? aff : 0.f); float ssum = 0.f;
#pragma unroll
                for (int g2 = 0; g2 < 8; ++g2) ssum += __builtin_bit_cast(float, __builtin_amdgcn_readlane(__builtin_bit_cast(int, cs), 8 * g2));
                const unsigned long long bal = __ballot(chosen); const unsigned slot = __builtin_amdgcn_mbcnt_hi((unsigned)(bal >> 32), __builtin_amdgcn_mbcnt_lo((unsigned)bal, 0u));
                if (chosen) { selmask |= 1u << j; slots |= (unsigned long long)slot << (4 * j); ++mycount; gtmp[(size_t)(base + j) * 64 + lane_] = aff / ssum * 2.5f; }
            }
            LDS_WAIT(); asm volatile("" ::: "memory");
        }
        unsigned pos = 0u;
        { LAS unsigned* wgc = (LAS unsigned*)(F.lds + LDSCTL_OFF) + 64;
            if (tid_ < 64) wgc[tid_] = 0u;
            __syncthreads();
            if (mycount) pos = __hip_atomic_fetch_add(wgc + lane_, mycount, __ATOMIC_RELAXED, __HIP_MEMORY_SCOPE_WORKGROUP);
            __syncthreads();
            if (tid_ < 64) { const unsigned tot = wgc[tid_]; unsigned gb = 0u; if (tot) gb = __hip_atomic_fetch_add(cnt + 64 * tid_, tot, RLX_AGENT); wgc[tid_] = gb; }
            __syncthreads();
            pos += wgc[lane_];
            __syncthreads(); }
#pragma unroll 1
        for (int j = 0; j < 16; ++j) if ((selmask >> j) & 1u) { const size_t at = (size_t)lane_ * CAP + pos; ++pos;
            rowtok[at] = (base + j) | ((int)((slots >> (4 * j)) & 15ull) << 16); rowgate[at] = gtmp[(size_t)(base + j) * 64 + lane_]; }
    }
}
template <bool M1> __device__ __forceinline__ int build_units(Frame& F, gu32* cnt, const int* rowtok, const float* rowgate) {
    const int tid_ = fresh_tid();
    LAS int* tcnt = (LAS int*)(F.lds + TAB_OFF); LAS int* bst = tcnt + 80; LAS int* utab = tcnt + 160; LAS int* idx = (LAS int*)(F.lds + IDX_OFF); LAS float* lgate = (LAS float*)(F.lds + GATE_OFF);
    if (tid_ < 64) {
        const int c = (int)__hip_atomic_load(cnt + 64 * tid_, RLX_AGENT); const int nb = (c + 255) >> 8; int incl = nb;
#pragma unroll
        for (int o = 1; o < 64; o <<= 1) { const int u = __builtin_amdgcn_ds_bpermute((tid_ - o) << 2, incl); if (tid_ >= o) incl += u; }
        tcnt[tid_] = c; bst[tid_] = incl - nb;
        if (tid_ == 63) { tcnt[64] = M; bst[64] = incl; bst[65] = incl + M / 256; }
    }
    __syncthreads();
    const int nblk = bst[65]; const int bx = blockIdx.x;
    const int per = M1 ? 128 : 64, blk0 = M1 ? (16 * (bx & 7) + (bx >> 4)) : (8 * (bx & 7) + (bx >> 5)), pn = M1 ? ((bx >> 3) & 1) : ((bx >> 3) & 3);
    int nmine = (nblk > blk0) ? (nblk - blk0 + per - 1) / per : 0; if (nmine > (M1 ? 10 : 20)) nmine = M1 ? 10 : 20;
    if (tid_ < nmine) { const int blk = tid_ * per + blk0;
        int e = 0;
#pragma unroll
        for (int st = 64; st > 0; st >>= 1) { const int q = e + st; if (q <= 64 && bst[q] <= blk) e = q; }
        const int j = blk - bst[e]; int nv = tcnt[e] - 256 * j; if (nv > 256) nv = 256;
        LAS int* t = utab + tid_ * 8; t[0] = e; t[1] = blk; t[2] = pn; t[3] = nv; t[4] = e * CAP + 256 * j; t[5] = 256 * j; }
    __syncthreads();
    for (int q = tid_; q < nmine * 256; q += NWAVES * 64) { const int g = q >> 8, i = q & 255;
        const LAS int* t = utab + g * 8; const int e = t[0], nv = t[3];
        if (M1) { int tok = 0; float gt = 0.f;
            if (e == 64) { tok = t[5] + i; gt = 1.f; } else if (i < nv) { tok = rowtok[t[4] + i] & 0xffff; gt = rowgate[t[4] + i]; }
            idx[q] = tok; lgate[q] = gt; }
        else { int dst = M * 9;
            if (e == 64) dst = (t[5] + i) * 9 + 8; else if (i < nv) { const int v = rowtok[t[4] + i]; dst = (v & 0xffff) * 9 + (v >> 16); }
            idx[q] = dst; } }
    __syncthreads();
    return nmine;
}
#define WSP(T, off) ((T*)(A->ws + (off)))
#ifndef REP_P1
#define REP_P1 1
#endif
#ifndef REP_P2
#define REP_P2 1
#endif
#ifndef REP_P3
#define REP_P3 1
#endif
#ifndef REP_P5
#define REP_P5 1
#endif
#ifndef REP_P7
#define REP_P7 1
#endif
#ifndef REP_P8
#define REP_P8 1
#endif
#define REPEAT(n) _Pragma("unroll 1") for (int rep_ = 0; rep_ < (n); ++rep_)
#define OPQ(x) asm volatile("" : "+s"(x))
#define FCTL() f_ctl()
#define FRESH_GB() const int G = f_G(), bx = f_bx(); (void)G; (void)bx
__global__ void __launch_bounds__(NWAVES * 64, 2) mega_fwd(Args args_unused) {
    extern __shared__ __attribute__((aligned(16))) unsigned char lds[];
    Frame F;
    F.lds = (LAS unsigned char*)lds;
    F.wave = __builtin_amdgcn_readfirstlane((int)threadIdx.x >> 6);
    for (int u = fresh_tid(); u < 512 / 4; u += NWAVES * 64) ((LAS unsigned*)(F.lds + LDSCTL_OFF))[u] = 0u;
    __syncthreads();
    (void)xcd_barrier_post((unsigned*)(f_ctl() + CW_BAR), f_misc(F) + 8, fresh_tid() == 0);
#define GRID_BAR() do { XcdBarrier bar_; bar_.bar = (unsigned*)(f_ctl() + CW_BAR); bar_.x = xb_xcc_id(); bar_.st = f_misc(F) + 8; xcd_barrier(bar_, fresh_tid() == 0); } while (0)

    { ArgsP A = fresh_args(); FRESH_GB(); p0_small_weights(F, A); }
    GRID_BAR();
    {   ArgsP A = fresh_args(); FRESH_GB();
        pg8::DenseSched S; S.init(512, 2048, D, G, bx, WSP(const bf16, WS_WMKV));
        pg8::EpiBf16 E{WSP(bf16, WS_MEMKV), 2048, 0, 1.f};
        pg8::gemm_phase<pg8::EpiBf16, pg8::DenseSched>(F.lds + RING_OFF, WSP(const bf16, WS_MEMB), D, S, E, F.wave); }

    for (int layer = 0; layer < DEPTH; ++layer) {
        const int jm = layer >> 1; const bool isB = (layer & 1) != 0;
        REPEAT(REP_P1) {
        if (!isB) { ArgsP A = fresh_args(); FRESH_GB();
            pg8::DenseSched S; S.init(M, NPA, D, G, bx, WSP(const bf16, WS_WINA) + (size_t)jm * NPA * D);
            pg8::EpiBf16 E{WSP(bf16, WS_QKV), NPA, 4, attn_body::C2};
            pg8::gemm_phase<pg8::EpiBf16, pg8::DenseSched>(F.lds + RING_OFF, WSP(const bf16, WS_XB), D, S, E, F.wave); }
        else { ArgsP A = fresh_args(); FRESH_GB();
            pg8::DenseSched S; S.init(M, NPB, D, G, bx, WSP(const bf16, WS_WINB) + (size_t)jm * NPB * D);
            pg8::EpiBf16 E{WSP(bf16, WS_QKV), NPB, 4, attn_body::C2};
            pg8::gemm_phase<pg8::EpiBf16, pg8::DenseSched>(F.lds + RING_OFF, WSP(const bf16, WS_XB), D, S, E, F.wave); }
        GRID_BAR();
        }
        if (isB) {
            ArgsP A = fresh_args();
            ph_qknorm(F, WSP(const bf16, WS_QKV), FCTL() + CW_NORM + 64 * layer);
            GRID_BAR();
        }
        REPEAT(REP_P2) {
        if (!isB) {
            { FRESH_GB();
            for (int L = bx; L < 1536; L += G) {
                ArgsP A = fresh_args(); const bf16* qkv = WSP(const bf16, WS_QKV); const int wave = F.wave;
                const int b = L / 768, rem = L % 768, qblk = rem / 3, kvh = rem % 3;
                const int q0u = qblk * 64, head = kvh * 4 + (wave >> 1); const size_t rowq = (size_t)b * SEQ + q0u + 32 * (wave & 1);
                attn_body::AttnArgs a;
                a.Qw = (const attn_body::bf16*)(qkv + rowq * NPA + head * 64);
                a.K0 = (const attn_body::bf16*)(qkv + ((size_t)b * SEQ + q0u) * NPA + 1024 + kvh * 64); a.V0 = a.K0 + 192;
                a.NT = 4; a.tmax = qblk; a.Ow = (attn_body::bf16*)(WSP(bf16, WS_CAT) + rowq * D + head * 64);
                a.qrel = 32 * (wave & 1) + (fresh_tid() & 31); a.slope2 = SLOPES_A[head] * attn_body::LOG2E; a.sink2 = A->in[3][jm * 12 + head] * attn_body::LOG2E; a.wave = F.wave;
                attn_body::attn_unit<2, 8, NPA, NPA, D>(a, (char*)lds + RING_OFF);
                convert_unit(F, A, layer, L);
            }
            for (int cu = 1536 + bx; cu < CONV_UNITS; cu += G) { ArgsP A = fresh_args(); convert_unit(F, A, layer, cu); } }
            { FRESH_GB();
            for (int L = bx; L < 512; L += G) {
                ArgsP A = fresh_args(); const int wave = F.wave;
                const int b = L / 256, rem = L % 256, qb = rem >> 2, hm = rem & 3;
                const size_t rowq = (size_t)b * SEQ + qb * 256 + 32 * wave;
                attn_body::AttnArgs a;
                a.Qw = (const attn_body::bf16*)(WSP(const bf16, WS_QKV) + rowq * NPA + 768 + hm * 64);
                a.K0 = (const attn_body::bf16*)(WSP(const bf16, WS_MEMKV) + (size_t)b * MEMLEN * 2048 + layer * 512 + hm * 64); a.V0 = a.K0 + 256;
                a.NT = 4; a.tmax = 1 << 30; a.Ow = (attn_body::bf16*)(WSP(bf16, WS_CAT) + rowq * D + 768 + hm * 64);
                a.qrel = 32 * wave + (fresh_tid() & 31); a.slope2 = 0.f; a.sink2 = 0.f; a.wave = F.wave;
                attn_body::attn_unit<0, 8, NPA, 2048, D>(a, (char*)lds + RING_OFF);
            } }
        } else {
            {
                gu32* q0 = FCTL() + CW_Q + 64 * layer + 16 * rep_;
                int turn = 0; bool doneA = false, doneC = false, have = true; unsigned nextL = 0u;
                if (fresh_tid() == 0) nextL = __hip_atomic_fetch_add(q0, 1u, RLX_AGENT);
                for (;;) {
                    if (!have) { if (fresh_tid() == 0) nextL = __hip_atomic_fetch_add(q0 + turn, 1u, RLX_AGENT); }
                    if (fresh_tid() == 0) f_misc(F)[16] = nextL;
                    __syncthreads();
                    const int L = __builtin_amdgcn_readfirstlane((int)f_misc(F)[16]);
                    __syncthreads();
                    have = false;
                    if (L >= (turn ? CONV_UNITS : 1536)) { if (turn) doneC = true; else doneA = true; if (doneA && doneC) break; turn ^= 1; continue; }
                    const int nturn = turn ? (doneA ? 1 : 0) : (doneC ? 0 : 1);
                    if (turn | nturn) { if (fresh_tid() == 0) nextL = __hip_atomic_fetch_add(q0 + nturn, 1u, RLX_AGENT); have = true; }
                    ArgsP A = fresh_args(); const bf16* qkv = WSP(const bf16, WS_QKV); const int wave = F.wave;
                    if (turn) { convert_unit(F, A, layer, L); turn = nturn; continue; }
                    turn = nturn;
                    const int qb = 63 - L / 24, rem = L % 24, b = rem / 12, hc = rem % 12, h = hc >> 1, c = hc & 1;
                    const size_t rowq = (size_t)b * SEQ + qb * 256 + 32 * wave;
                    const float slope2 = SLOPES_B[h] * attn_body::LOG2E;
                    const float q2m = __uint_as_float(__hip_atomic_load(FCTL() + CW_NORM + 64 * layer + hc, RLX_AGENT)), k2m = __uint_as_float(__hip_atomic_load(FCTL() + CW_NORM + 64 * layer + 12 + hc, RLX_AGENT));
                    const float B2 = sqrtf(q2m * k2m) * 1.03f + 0.5f, dcut = (160.f + 2.f * B2) / slope2;
                    int t0 = (int)floorf(((float)(qb * 256 - 63) - dcut) * (1.f / 64.f)); t0 = __builtin_amdgcn_readfirstlane(t0 > 0 ? (t0 & ~1) : 0);
                    attn_body::AttnArgs a;
                    a.Qw = (const attn_body::bf16*)(qkv + rowq * NPB + hc * 64);
                    a.K0 = (const attn_body::bf16*)(qkv + ((size_t)b * SEQ + 64 * t0) * NPB + 1024 + hc * 64); a.V0 = (const attn_body::bf16*)(qkv + ((size_t)b * SEQ + 64 * t0) * NPB + 1792 + h * 128);
                    a.NT = 4 * (qb + 1) - t0; a.tmax = 1 << 30; a.Ow = (attn_body::bf16*)(WSP(bf16, WS_OTMP) + rowq * 1536 + hc * 128);
                    a.qrel = 32 * wave + (fresh_tid() & 31); a.slope2 = slope2; a.sink2 = 0.f; a.wave = F.wave;
                    attn_body::diff_unit<16, NPB, NPB, 1536>(a, (char*)lds + RING_OFF);
                }
            }
            { FRESH_GB();
            for (int L = bx; L < 512; L += G) {
                ArgsP A = fresh_args(); const int wave = F.wave;
                const int b = L / 256, rem = L % 256, qb = rem >> 2, hm = rem & 3;
                const size_t rowq = (size_t)b * SEQ + qb * 256 + 32 * wave;
                attn_body::AttnArgs a;
                a.Qw = (const attn_body::bf16*)(WSP(const bf16, WS_QKV) + rowq * NPB + 768 + hm * 64);
                a.K0 = (const attn_body::bf16*)(WSP(const bf16, WS_MEMKV) + (size_t)b * MEMLEN * 2048 + layer * 512 + hm * 64); a.V0 = a.K0 + 256;
                a.NT = 4; a.tmax = 1 << 30; a.Ow = (attn_body::bf16*)(WSP(bf16, WS_CAT) + rowq * D + 768 + hm * 64);
                a.qrel = 32 * wave + (fresh_tid() & 31); a.slope2 = 0.f; a.sink2 = 0.f; a.wave = F.wave;
                attn_body::attn_unit<0, 8, NPB, 2048, D>(a, (char*)lds + RING_OFF);
            } }
        }
        GRID_BAR();
        }
        if (isB) {
            ArgsP A = fresh_args(); FRESH_GB();
            ph_diff_combine(F, WSP(const bf16, WS_OTMP), A->in[5] + jm * 256, A->in[6] + jm * 128, 0.8f - 0.6f * expf(-0.3f * (float)layer), WSP(bf16, WS_CAT));
            GRID_BAR();
        }
        REPEAT(REP_P3) {
        {   ArgsP A = fresh_args(); FRESH_GB();
            pg8::DenseSched S; S.init(M, D, D, G, bx, WSP(const bf16, WS_WOUT) + (size_t)layer * D * D);
            pg8::EpiBf16 E{WSP(bf16, WS_Y), D, 0, 1.f};
            pg8::gemm_phase<pg8::EpiBf16, pg8::DenseSched>(F.lds + RING_OFF, WSP(const bf16, WS_CAT), D, S, E, F.wave); }
        GRID_BAR();
        }
        {   ArgsP A = fresh_args();
            if (layer == 0) ph_ln_route<true>(F, A->in[0], WSP(const bf16, WS_Y), A->in[9] + (size_t)(layer * 2) * D, A->in[10] + (size_t)(layer * 2) * D, WSP(bf16, WS_XB), WSP(const bf16, WS_WROUT) + (size_t)layer * 256 * D, A->in[12] + layer * 64, FCTL() + CW_CNT + layer * 64 * 64, WSP(int, WS_ROWTOK), WSP(float, WS_ROWGATE), WSP(float, WS_LOGIT));
            else ph_ln_route<false>(F, nullptr, WSP(const bf16, WS_Y), A->in[9] + (size_t)(layer * 2) * D, A->in[10] + (size_t)(layer * 2) * D, WSP(bf16, WS_XB), WSP(const bf16, WS_WROUT) + (size_t)layer * 256 * D, A->in[12] + layer * 64, FCTL() + CW_CNT + layer * 64 * 64, WSP(int, WS_ROWTOK), WSP(float, WS_ROWGATE), WSP(float, WS_LOGIT)); }
        GRID_BAR();
        REPEAT(REP_P7) {
        {   ArgsP A = fresh_args(); FRESH_GB();
            const int nmine = build_units<true>(F, FCTL() + CW_CNT + layer * 64 * 64, WSP(const int, WS_ROWTOK), WSP(const float, WS_ROWGATE));
            pg8::GroupSched<true> S{(const LAS int*)(F.lds + TAB_OFF) + 160, (const LAS int*)(F.lds + IDX_OFF), nmine, D, (const char*)(A->ws + WS_WEXP)};
            pg8::EpiM1 E{WSP(bf16, WS_HB), (const LAS float*)(F.lds + GATE_OFF)};
            pg8::gemm_phase<pg8::EpiM1, pg8::GroupSched<true>>(F.lds + RING_OFF, WSP(const bf16, WS_XB), D, S, E, F.wave); }
        GRID_BAR();
        }
        REPEAT(REP_P8) {
        {   ArgsP A = fresh_args(); FRESH_GB();
            const int nmine = build_units<false>(F, FCTL() + CW_CNT + layer * 64 * 64, WSP(const int, WS_ROWTOK), WSP(const float, WS_ROWGATE));
            pg8::GroupSched<false> S{(const LAS int*)(F.lds + TAB_OFF) + 160, (const LAS int*)(F.lds + IDX_OFF), nmine, HID, (const char*)(A->ws + WS_WEXP) + pg8::EXPERT_DOWN_OFF};
            pg8::EpiM2 E{WSP(unsigned char, WS_BIG), (const LAS int*)(F.lds + IDX_OFF)};
            pg8::gemm_phase<pg8::EpiM2, pg8::GroupSched<false>>(F.lds + RING_OFF, WSP(const bf16, WS_HB), HID, S, E, F.wave); }
        GRID_BAR();
        }
        {   ArgsP A = fresh_args(); FRESH_GB();
            if (layer + 1 < DEPTH) ph_combine_ln2<false>(F, A->out, WSP(const unsigned char, WS_BIG), A->in[9] + (size_t)(layer * 2 + 1) * D, A->in[10] + (size_t)(layer * 2 + 1) * D, WSP(bf16, WS_XB));
            else ph_combine_ln2<true>(F, A->out, WSP(const unsigned char, WS_BIG), A->in[9] + (size_t)(layer * 2 + 1) * D, A->in[10] + (size_t)(layer * 2 + 1) * D, WSP(bf16, WS_XB));
            }
        if (layer + 1 < DEPTH) GRID_BAR();
    }
    if (__hip_atomic_load(FCTL() + CW_BAR + XB_TMO, RLX_AGENT) != 0u) {
        __syncthreads();
        ArgsP A = fresh_args(); FRESH_GB(); float* xf = A->out;
        const float q = __builtin_nanf("");
        for (int m = f_gw(F); m < M; m += f_ngw()) { GAS f32x4* o = (GAS f32x4*)(xf + (size_t)m * D) + (fresh_tid() & 63);
#pragma unroll
            for (int j = 0; j < 4; ++j) o[64 * j] = (f32x4){q, q, q, q}; }
    }
}

extern "C" void kernel_launch(void* const* d_in, const int* in_sizes, int n_in, void* d_out, int out_size, void* d_ws, size_t ws_size, hipStream_t stream) {
    static int grid = 0;
    if (grid == 0) {
        if (n_in != 19 || in_sizes[0] != M * D || out_size != M * D || ws_size < WS_END) { fprintf(stderr, "kernel_launch: shape / workspace mismatch (n_in %d, in0 %d, out %d, ws %zu, need %zu); nothing launched\n", n_in, n_in > 0 ? in_sizes[0] : -1, out_size, ws_size, (size_t)WS_END); grid = -1; return; }
        int dev = 0, cus = 0, per_cu = 0;
        if (hipGetDevice(&dev) != hipSuccess || hipDeviceGetAttribute(&cus, hipDeviceAttributeMultiprocessorCount, dev) != hipSuccess) { grid = -1; return; }
        if (hipFuncSetAttribute((const void*)mega_fwd, hipFuncAttributeMaxDynamicSharedMemorySize, LDS_BYTES) != hipSuccess) { fprintf(stderr, "kernel_launch: hipFuncSetAttribute failed\n"); grid = -1; return; }
        if (hipOccupancyMaxActiveBlocksPerMultiprocessor(&per_cu, (const void*)mega_fwd, NWAVES * 64, LDS_BYTES) != hipSuccess || per_cu < 1) { fprintf(stderr, "kernel_launch: occupancy query reports %d\n", per_cu); }
        (void)hipGetLastError();
        grid = cus;
        if (grid != 256) { fprintf(stderr, "kernel_launch: built for 256 CUs, device has %d; nothing launched\n", cus); grid = -1; return; }
    }
    if (grid < 0) return;
    if (hipMemsetAsync((char*)d_ws + WS_CTL, 0, CTL_ZERO_BYTES, stream) != hipSuccess) return;
    Args a{};
    for (int i = 0; i < 19; ++i) a.in[i] = (const float*)d_in[i];
    a.out = (float*)d_out; a.ws = (unsigned char*)d_ws;
    hipLaunchKernelGGL(mega_fwd, dim3(grid), dim3(NWAVES * 64), LDS_BYTES, stream, a);
}
```

```cpp
#include <hip/hip_runtime.h>
#include <hip/hip_bf16.h>
#include <cstdio>
#include <cstdint>
#include <cmath>

namespace pg8 {
#define PG8_LAS __attribute__((address_space(3)))
typedef unsigned short bf16_t;
typedef short bf16x8 __attribute__((ext_vector_type(8)));
typedef float f32x4 __attribute__((ext_vector_type(4)));
typedef unsigned u32x4 __attribute__((ext_vector_type(4)));
constexpr int BM = 256, BK = 64, HALF = 128, HTB = HALF * BK * 2  , STAGE_BYTES = 8 * HTB, NXCD = 8, WGM = 8;
constexpr int EXPERT_BYTES = 3 * 1024 * 256 * 2;
constexpr int EXPERT_DOWN_OFF = 2 * 1024 * 256 * 2;

__host__ __device__ __forceinline__ int lds_byte(int r, int c) { const int st = (r >> 4) * 2 + (c >> 5), rr = r & 15, cc = c & 31, ob = rr * 64 + cc * 2; return st * 1024 + (ob ^ (((ob >> 9) & 1) << 5)); }
__host__ __device__ __forceinline__ void stage_rc(int b, int& R, int& C) { const int st = b / 1024, sb = b % 1024, swz = sb ^ (((sb >> 9) & 1) << 5); R = (st >> 1) * 16 + swz / 64; C = (st & 1) * 32 + (swz % 64) / 2; }
__host__ __device__ __forceinline__ int perm32(int rho) { const int n = rho >> 4, i = rho & 15; return 8 * (i >> 2) + 4 * n + (i & 3); }

struct Unit { int pm, pn, e, nvalid, lbase, pos0, slot; };

struct StaticOrder {
    int nM, nN, nwg, G, c;
    __device__ __forceinline__ void init(int M, int N, int G_, int c_) { nM = M / BM; nN = N / BM; nwg = nM * nN; G = G_; c = c_; }
    __device__ __forceinline__ bool next(int i, Unit& u) const {
        const long L = (long)i * G + c; if (L >= nwg) return false;
        int wgid = (int)L; { const int q = nwg / NXCD, r = nwg % NXCD, xcd = wgid % NXCD, off = wgid / NXCD; wgid = (xcd < r ? xcd * (q + 1) : r * (q + 1) + (xcd - r) * q) + off; }
        const int nig = WGM * nN, gid = wgid / nig, fm = gid * WGM, gsz = (nM - fm) < WGM ? (nM - fm) : WGM;
        u.pm = fm + ((wgid % nig) % gsz); u.pn = (wgid % nig) / gsz; return true;
    }
};
struct DenseSched {
    StaticOrder o; const char* Bt; int K;
    __device__ __forceinline__ void init(int M, int N, int K_, int G, int c, const bf16_t* Bt_) { o.init(M, N, G, c); Bt = (const char*)Bt_; K = K_; }
    __device__ __forceinline__ bool next(int i, Unit& u) const { u.e = 0; u.nvalid = 256; u.lbase = 0; u.pos0 = 0; u.slot = 0; return o.next(i, u); }
    __device__ __forceinline__ const char* bptr(const Unit& u) const { return Bt + (size_t)u.pn * (BM * 2) * K; }
    __device__ __forceinline__ void avoff(const Unit& u, int tid, unsigned (&v)[2][2]) const {
#pragma unroll
        for (int i = 0; i < 2; ++i) { int R, C; stage_rc(tid * 16 + i * 8192, R, C);
#pragma unroll
            for (int h = 0; h < 2; ++h) v[h][i] = (unsigned)((u.pm * BM + h * HALF + R) * K + C) * 2u; }
    }
};
template <bool GATHER> struct GroupSched {
    const PG8_LAS int* utab; const PG8_LAS int* idx; int nmine, K; const char* W;
    __device__ __forceinline__ bool next(int i, Unit& u) const {
        if (i >= nmine) return false; const PG8_LAS int* t = utab + i * 8;
        u.e = __builtin_amdgcn_readfirstlane(t[0]); u.pm = __builtin_amdgcn_readfirstlane(t[1]); u.pn = __builtin_amdgcn_readfirstlane(t[2]);
        u.nvalid = __builtin_amdgcn_readfirstlane(t[3]); u.lbase = __builtin_amdgcn_readfirstlane(t[4]); u.pos0 = __builtin_amdgcn_readfirstlane(t[5]); u.slot = i; return true;
    }
    __device__ __forceinline__ const char* bptr(const Unit& u) const { return W + (size_t)u.e * EXPERT_BYTES + (size_t)u.pn * (BM * 2) * K; }
    __device__ __forceinline__ void avoff(const Unit& u, int tid, unsigned (&v)[2][2]) const {
#pragma unroll
        for (int i = 0; i < 2; ++i) { int R, C; stage_rc(tid * 16 + i * 8192, R, C);
#pragma unroll
            for (int h = 0; h < 2; ++h) {
                const int row = GATHER ? idx[u.slot * 256 + h * HALF + R] : (u.pm * BM + h * HALF + R);
                v[h][i] = (unsigned)(row * K + C) * 2u; } }
    }
};

typedef float f32x2v __attribute__((ext_vector_type(2))); typedef __bf16 bf16x2v __attribute__((ext_vector_type(2)));
__device__ __forceinline__ unsigned cvt_pk_bf16(float lo, float hi) { f32x2v v = {lo, hi}; bf16x2v b = __builtin_convertvector(v, bf16x2v); return __builtin_bit_cast(unsigned, b); }

struct EpiBf16 {
    static constexpr bool PERM = true; static constexpr int NST = 16;
    bf16_t* O; int ldc; int nsc; float scale;
    __device__ __forceinline__ void operator()(const f32x4 (&acc)[2][2][4][2], const Unit& u, int wr, int wc, int fr, int fq) const {
        const int row0 = u.pm * BM + wr * 64 + fr; const int col0 = u.pn * BM + wc * 32 + 8 * fq; const float sc = (u.pn < nsc) ? scale : 1.f;
#pragma unroll
        for (int ai = 0; ai < 2; ++ai)
#pragma unroll
            for (int m = 0; m < 4; ++m) { bf16_t* rowp = O + (size_t)(row0 + ai * HALF + m * 16) * ldc + col0;
#pragma unroll
                for (int bj = 0; bj < 2; ++bj) { const f32x4 v0 = acc[ai][bj][m][0] * sc, v1 = acc[ai][bj][m][1] * sc;
                    u32x4 w; w.x = cvt_pk_bf16(v0[0], v0[1]); w.y = cvt_pk_bf16(v0[2], v0[3]); w.z = cvt_pk_bf16(v1[0], v1[1]); w.w = cvt_pk_bf16(v1[2], v1[3]);
                    *(u32x4*)(rowp + bj * HALF) = w; } }
    }
};
__device__ __forceinline__ float silu_f(float x) { return x * __builtin_amdgcn_rcpf(1.0f + __builtin_amdgcn_exp2f(-1.4426950408889634f * x)); }
struct EpiM1 {
    static constexpr bool PERM = true; static constexpr int NST = 8;
    bf16_t* H; const PG8_LAS float* lgate;
    __device__ __forceinline__ void operator()(const f32x4 (&acc)[2][2][4][2], const Unit& u, int wr, int wc, int fr, int fq) const {
        const int col0 = u.pn * HALF + wc * 32 + 8 * fq; const PG8_LAS float* lg = lgate + u.slot * 256;
#pragma unroll
        for (int ai = 0; ai < 2; ++ai)
#pragma unroll
            for (int m = 0; m < 4; ++m) { const int r = ai * HALF + wr * 64 + m * 16 + fr;
                const float g = lg[r];
                const f32x4 ga = acc[ai][0][m][0], gb = acc[ai][0][m][1], ua = acc[ai][1][m][0], ub = acc[ai][1][m][1];
                f32x4 v0, v1;
#pragma unroll
                for (int j = 0; j < 4; ++j) { v0[j] = silu_f(ga[j]) * ua[j] * g; v1[j] = silu_f(gb[j]) * ub[j] * g; }
                u32x4 w; w.x = cvt_pk_bf16(v0[0], v0[1]); w.y = cvt_pk_bf16(v0[2], v0[3]); w.z = cvt_pk_bf16(v1[0], v1[1]); w.w = cvt_pk_bf16(v1[2], v1[3]);
                *(u32x4*)(H + (size_t)(u.pm * BM + r) * 256 + col0) = w; }
    }
};
constexpr float Y8_SCALE = 16.f;
typedef unsigned u32x2e __attribute__((ext_vector_type(2)));
struct EpiM2 {
    static constexpr bool PERM = true; static constexpr int NST = 16;
    unsigned char* Y; const PG8_LAS int* ldst;
    __device__ __forceinline__ void operator()(const f32x4 (&acc)[2][2][4][2], const Unit& u, int wr, int wc, int fr, int fq) const {
        const int col0 = u.pn * BM + wc * 32 + 8 * fq; const PG8_LAS int* ld = ldst + u.slot * 256;
#pragma unroll
        for (int ai = 0; ai < 2; ++ai)
#pragma unroll
            for (int m = 0; m < 4; ++m) { const int r = ai * HALF + wr * 64 + m * 16 + fr;
                const int dst = ld[r];
                {
                    unsigned char* rowp = Y + (size_t)dst * 1024 + col0;
#pragma unroll
                    for (int bj = 0; bj < 2; ++bj) { const f32x4 v0 = acc[ai][bj][m][0] * Y8_SCALE, v1 = acc[ai][bj][m][1] * Y8_SCALE;
                        int w0 = __builtin_amdgcn_cvt_pk_fp8_f32(v0[0], v0[1], 0, false); w0 = __builtin_amdgcn_cvt_pk_fp8_f32(v0[2], v0[3], w0, true);
                        int w1 = __builtin_amdgcn_cvt_pk_fp8_f32(v1[0], v1[1], 0, false); w1 = __builtin_amdgcn_cvt_pk_fp8_f32(v1[2], v1[3], w1, true);
                        *(u32x2e*)(rowp + bj * HALF) = (u32x2e){(unsigned)w0, (unsigned)w1}; } } }
    }
};

template <class Epi, class Sched>
__device__ __forceinline__ void gemm_phase(PG8_LAS unsigned char* lds, const bf16_t* Abase, const int K, const Sched& S, const Epi& E, int wave_) {
    asm volatile("" : "+s"(wave_)); unsigned am_; asm volatile("s_mov_b32 %0, -1" : "=s"(am_));
    const int tid = (wave_ << 6) | (int)__builtin_amdgcn_mbcnt_hi(am_, __builtin_amdgcn_mbcnt_lo(am_, 0u));
    const int wid = __builtin_amdgcn_readfirstlane(tid >> 6), lane = tid & 63, wr = wid >> 2, wc = wid & 3, fr = lane & 15, fq = lane >> 4;
    const int nt = K / BK;
    unsigned voffB[2];
#pragma unroll
    for (int i = 0; i < 2; ++i) { int R, C; stage_rc(tid * 16 + i * 8192, R, C); const int Rb = Epi::PERM ? ((R & ~31) + perm32(R & 31)) : R; voffB[i] = (unsigned)(Rb * K + C) * 2u; }
    const size_t kstep = (size_t)(BK * 2);
    const size_t hstep = (size_t)HALF * K * 2;
    const unsigned ldsw = (unsigned)wid * 1024u;
    const int aoff = lds_byte(wr * 64 + fr, fq * 8), boff = lds_byte(wc * 32 + fr, fq * 8);
    const char* Ab = (const char*)Abase;
#define PG8_SA(b, h) (((b) * 2 + (h)) * HTB)
#define PG8_SB(b, h) ((4 + (b) * 2 + (h)) * HTB)
#define PG8_STAGE(bufoff, gbase, voff) do { _Pragma("unroll") for (int _i = 0; _i < 2; ++_i) \
        __builtin_amdgcn_global_load_lds((const unsigned*)((const char*)(gbase) + (voff)[_i]), (PG8_LAS unsigned*)(lds + (bufoff) + ldsw + _i * 8192), 16, 0, 0); } while (0)
#define PG8_STAGEA(bufoff, kb, V, h) do { _Pragma("unroll") for (int _i = 0; _i < 2; ++_i) \
        __builtin_amdgcn_global_load_lds((const unsigned*)(Ab + (kb) + (V)[h][_i]), (PG8_LAS unsigned*)(lds + (bufoff) + ldsw + _i * 8192), 16, 0, 0); } while (0)
#define PG8_LDA(dst, b, h) do { _Pragma("unroll") for (int m = 0; m < 4; ++m) _Pragma("unroll") for (int k = 0; k < 2; ++k) dst[m][k] = *(const PG8_LAS bf16x8*)(lds + PG8_SA(b, h) + aoff + m * 2048 + k * 1024); } while (0)
#define PG8_LDB(dst, b, h) do { _Pragma("unroll") for (int n = 0; n < 2; ++n) _Pragma("unroll") for (int k = 0; k < 2; ++k) dst[n][k] = *(const PG8_LAS bf16x8*)(lds + PG8_SB(b, h) + boff + n * 2048 + k * 1024); } while (0)
#define PG8_MMA(ai, bj, At, Bt) do { __builtin_amdgcn_s_setprio(1); _Pragma("unroll") for (int m = 0; m < 4; ++m) _Pragma("unroll") for (int n = 0; n < 2; ++n) _Pragma("unroll") for (int k = 0; k < 2; ++k) \
        acc[ai][bj][m][n] = __builtin_amdgcn_mfma_f32_16x16x32_bf16(Bt[n][k], At[m][k], acc[ai][bj][m][n], 0, 0, 0); __builtin_amdgcn_s_setprio(0); } while (0)
#define PG8_WAIT_V(n) asm volatile("s_waitcnt vmcnt(" #n ")" ::: "memory")
#define PG8_WAIT_VR(rl) do { if (rl) asm volatile("s_waitcnt vmcnt(%0)" :: "n"(8 + Epi::NST) : "memory"); else asm volatile("s_waitcnt vmcnt(8)" ::: "memory"); } while (0)
#define PG8_WAIT_L(n) asm volatile("s_waitcnt lgkmcnt(" #n ")" ::: "memory")
#define PG8_BAR __builtin_amdgcn_s_barrier()
#define PG8_SCHED __builtin_amdgcn_sched_barrier(0)
    Unit cur, nxt; int ui = 0;
    if (!S.next(0, cur)) return;
    nxt = cur;
    f32x4 acc[2][2][4][2];
#pragma unroll
    for (int a = 0; a < 2; ++a)
#pragma unroll
        for (int b = 0; b < 2; ++b)
#pragma unroll
            for (int m = 0; m < 4; ++m)
#pragma unroll
                for (int n = 0; n < 2; ++n) acc[a][b][m][n] = (f32x4){0.f, 0.f, 0.f, 0.f};
    bf16x8 At[4][2], B0[2][2], B1[2][2];
    unsigned vA[2][2];
    S.avoff(cur, tid, vA);
    const char* cB = S.bptr(cur);
    PG8_STAGE(PG8_SB(0, 0), cB, voffB); PG8_STAGE(PG8_SB(0, 1), cB + hstep, voffB); PG8_STAGEA(PG8_SA(0, 0), 0, vA, 0); PG8_STAGEA(PG8_SA(0, 1), 0, vA, 1);
    if (wr == 1) PG8_BAR;
    PG8_WAIT_V(2); PG8_BAR;
    PG8_STAGE(PG8_SB(1, 0), cB + kstep, voffB); PG8_STAGEA(PG8_SA(1, 0), kstep, vA, 0); PG8_STAGE(PG8_SB(1, 1), cB + hstep + kstep, voffB);
    PG8_WAIT_V(6); PG8_BAR;
    bool relax = false;
    for (;;) {
        const bool has_next = S.next(ui + 1, nxt);
        const char* nB = cB;
        if (has_next) nB = S.bptr(nxt);
#pragma unroll 1
        for (int t = 0; t < nt; t += 2) {
            const bool last = (t == nt - 2); const bool rl = relax && (t == 0);
            const size_t kb1 = (size_t)(t + 1) * kstep;
            const size_t kb2 = last ? (size_t)0 : (size_t)(t + 2) * kstep; const char* b2 = last ? nB : cB + (size_t)(t + 2) * kstep;
            const size_t kb3 = kb2 + kstep; const char* b3 = b2 + kstep;
            PG8_LDB(B0, 0, 0); PG8_LDB(B1, 0, 1); PG8_SCHED; PG8_LDA(At, 0, 0); if (!rl) PG8_STAGEA(PG8_SA(1, 1), kb1, vA, 1);
            if (last && has_next) S.avoff(nxt, tid, vA);
            PG8_WAIT_VR(rl); PG8_WAIT_L(0); PG8_BAR; PG8_MMA(0, 0, At, B0); PG8_MMA(0, 1, At, B1); PG8_BAR; PG8_SCHED;
            PG8_LDA(At, 0, 1); PG8_STAGE(PG8_SB(0, 0), b2, voffB); PG8_STAGE(PG8_SB(0, 1), b2 + hstep, voffB); PG8_STAGEA(PG8_SA(0, 0), kb2, vA, 0);
            PG8_WAIT_VR(rl); PG8_WAIT_L(0); PG8_BAR; PG8_MMA(1, 0, At, B0); PG8_MMA(1, 1, At, B1); PG8_BAR; PG8_SCHED;
            PG8_LDB(B0, 1, 0); PG8_LDB(B1, 1, 1); PG8_SCHED; PG8_LDA(At, 1, 0); PG8_STAGEA(PG8_SA(0, 1), kb2, vA, 1);
            PG8_WAIT_VR(rl); PG8_WAIT_L(0); PG8_BAR; PG8_MMA(0, 0, At, B0); PG8_MMA(0, 1, At, B1); PG8_BAR; PG8_SCHED;
            PG8_LDA(At, 1, 1); PG8_STAGE(PG8_SB(1, 0), b3, voffB); PG8_STAGE(PG8_SB(1, 1), b3 + hstep, voffB); PG8_STAGEA(PG8_SA(1, 0), kb3, vA, 0);
            PG8_WAIT_V(8); PG8_WAIT_L(0); PG8_BAR; PG8_MMA(1, 0, At, B0); PG8_MMA(1, 1, At, B1); PG8_BAR; PG8_SCHED;
        }
        if (wr == 0) PG8_BAR;
        if (has_next) PG8_STAGEA(PG8_SA(1, 1), kstep, vA, 1);
        E(acc, cur, wr, wc, fr, fq);
        if (!has_next) break;
#pragma unroll
        for (int a = 0; a < 2; ++a)
#pragma unroll
            for (int b = 0; b < 2; ++b)
#pragma unroll
                for (int m = 0; m < 4; ++m)
#pragma unroll
                    for (int n = 0; n < 2; ++n) acc[a][b][m][n] = (f32x4){0.f, 0.f, 0.f, 0.f};
        cur = nxt; cB = nB; ++ui; relax = true;
        if (wr == 1) PG8_BAR;
    }
    PG8_WAIT_V(0);
    PG8_BAR;
#undef PG8_SA
#undef PG8_SB
#undef PG8_STAGE
#undef PG8_STAGEA
#undef PG8_LDA
#undef PG8_LDB
#undef PG8_MMA
#undef PG8_WAIT_V
#undef PG8_WAIT_VR
#undef PG8_WAIT_L
#undef PG8_BAR
#undef PG8_SCHED
}
}
namespace attn_body {
using bf16=__hip_bfloat16;
using bf16x8=__attribute__((ext_vector_type(8)))short;
using s16x4=__attribute__((ext_vector_type(4)))short;
using f32x16=__attribute__((ext_vector_type(16)))float;
using u32x4=__attribute__((ext_vector_type(4)))unsigned;
constexpr int D=64,NW=8,QBLK=32,QB=QBLK*NW,KVBLK=64;
__device__ __forceinline__ int crow(int r,int hi){return (r&3)+8*(r>>2)+4*hi;}
#define SBAR() __builtin_amdgcn_sched_barrier(0)
constexpr int NSLOT=3, SLOTB=8192;
constexpr int LDS_K=0, LDS_V=NSLOT*SLOTB, LDS_WS=2*NSLOT*SLOTB, LDS_OST=LDS_WS+NW*64*4, LDS_BYTES=LDS_OST+NW*4096;
constexpr float LOG2E=1.4426950408889634f;
constexpr float C2=0.125f*LOG2E;
__device__ __forceinline__ void glds16(const void*gsrc,unsigned lds_dst){unsigned keep;
  asm volatile("s_mov_b32 %0, m0\n\ts_mov_b32 m0, %2\n\ts_nop 0\n\tglobal_load_lds_dwordx4 %1, off\n\ts_mov_b32 m0, %0":"=&s"(keep):"v"(gsrc),"s"(lds_dst):"memory");}
__device__ __forceinline__ void glds16s(const void*sbase,unsigned voff,unsigned lds_dst){unsigned keep;
  asm volatile("s_mov_b32 %0, m0\n\ts_mov_b32 m0, %3\n\ts_nop 0\n\tglobal_load_lds_dwordx4 %1, %2\n\ts_mov_b32 m0, %0":"=&s"(keep):"v"(voff),"s"(sbase),"s"(lds_dst):"memory");}
__device__ __forceinline__ float max3f(float a,float b,float c){float r;asm("v_max3_f32 %0, %1, %2, %3":"=v"(r):"v"(a),"v"(b),"v"(c));return r;}
__device__ __forceinline__ float max2f(float a,float b){float r;asm("v_max_f32_e32 %0, %1, %2":"=v"(r):"v"(a),"v"(b));return r;}
__device__ __forceinline__ float fadd_s(float a,float b){float r;asm("v_add_f32_e32 %0, %1, %2":"=v"(r):"v"(a),"v"(b));return r;}
__device__ __forceinline__ float fsub_s(float a,float b){float r;asm("v_sub_f32_e32 %0, %1, %2":"=v"(r):"v"(a),"v"(b));return r;}
typedef float f32x2_t __attribute__((ext_vector_type(2))); typedef __bf16 bf16x2_t __attribute__((ext_vector_type(2)));
__device__ __forceinline__ unsigned cvtpk_s(float lo,float hi){f32x2_t v={lo,hi};bf16x2_t b=__builtin_convertvector(v,bf16x2_t);return __builtin_bit_cast(unsigned,b);}
#define WAIT_BAR(N) asm volatile("s_waitcnt vmcnt(" #N ") lgkmcnt(0)\n\ts_barrier":::"memory")

template<int MODE> __device__ __forceinline__ void maskbias(f32x16&p0,f32x16&p1,int kb,int qrel,float slope2,float mhat,bool band,bool tile_ok){
  if(MODE==0)return;
  const float NEG=-INFINITY; const float lb=slope2*(float)(kb-qrel)-mhat;
  #pragma unroll
  for(int r=0;r<16;++r){const int c=(r&3)+8*(r>>2); p0[r]=__builtin_fmaf(slope2,(float)c,p0[r]+lb); p1[r]=__builtin_fmaf(slope2,(float)(c+32),p1[r]+lb);}
  if(MODE==1){ if(band){
    #pragma unroll
    for(int r=0;r<16;++r){const int kv=kb+(r&3)+8*(r>>2); if(kv>qrel)p0[r]=NEG; if(kv+32>qrel)p1[r]=NEG;} } }
  if(MODE==2){
    #pragma unroll
    for(int r=0;r<16;++r){const int d=qrel-kb-((r&3)+8*(r>>2)); if((unsigned)d>=128u||!tile_ok)p0[r]=NEG; if((unsigned)(d-32)>=128u||!tile_ok)p1[r]=NEG;} }
}

__device__ __forceinline__ void qkt(f32x16&p0,f32x16&p1,const char*Kslot,const bf16x8*qr,const f32x16&negm,int r32,int hi){
  const char*kb=Kslot+hi*1024+r32*16;
  #pragma unroll
  for(int d0=0;d0<4;++d0){
    const bf16x8 b0=*reinterpret_cast<const bf16x8*>(kb+d0*2048);
    const bf16x8 b1=*reinterpret_cast<const bf16x8*>(kb+d0*2048+512);
    if(d0==0){p0=__builtin_amdgcn_mfma_f32_32x32x16_bf16(b0,qr[0],negm,0,0,0);p1=__builtin_amdgcn_mfma_f32_32x32x16_bf16(b1,qr[0],negm,0,0,0);}
    else{p0=__builtin_amdgcn_mfma_f32_32x32x16_bf16(b0,qr[d0],p0,0,0,0);p1=__builtin_amdgcn_mfma_f32_32x32x16_bf16(b1,qr[d0],p1,0,0,0);}}
}
template<int C> __device__ __forceinline__ float fmamk_c(float a,float b){float d;asm("v_fmamk_f32 %0, %1, %2, %3":"=v"(d):"v"(a),"n"(__builtin_bit_cast(int,(float)C)),"v"(b));return d;}
typedef __attribute__((address_space(3))) const char* lds_cptr;
typedef short v4i16_t __attribute__((ext_vector_type(4)));
__device__ __forceinline__ void kload8(bf16x8*kf,lds_cptr kp){
  kf[0]=*(const __attribute__((address_space(3))) bf16x8*)(kp);      kf[1]=*(const __attribute__((address_space(3))) bf16x8*)(kp+512);
  kf[2]=*(const __attribute__((address_space(3))) bf16x8*)(kp+2048); kf[3]=*(const __attribute__((address_space(3))) bf16x8*)(kp+2560);
  kf[4]=*(const __attribute__((address_space(3))) bf16x8*)(kp+4096); kf[5]=*(const __attribute__((address_space(3))) bf16x8*)(kp+4608);
  kf[6]=*(const __attribute__((address_space(3))) bf16x8*)(kp+6144); kf[7]=*(const __attribute__((address_space(3))) bf16x8*)(kp+6656);
}
__device__ __forceinline__ void kload2(bf16x8*kf,lds_cptr kp,int j){ kf[2*j]=*(const __attribute__((address_space(3))) bf16x8*)(kp+j*2048); kf[2*j+1]=*(const __attribute__((address_space(3))) bf16x8*)(kp+j*2048+512); }
__device__ __forceinline__ s16x4 vtr(lds_cptr p){ return __builtin_bit_cast(s16x4,__builtin_amdgcn_ds_read_tr16_b64_v4i16((__attribute__((address_space(3))) v4i16_t*)p)); }
__device__ __forceinline__ float rowmax(const f32x16&p0,const f32x16&p1){
  float a=max3f(p0[0],p0[1],p1[0]),b=max3f(p0[2],p0[3],p1[1]);a=max3f(a,p1[2],p1[3]);
  #pragma unroll
  for(int r=4;r<16;r+=4){a=max3f(a,p0[r],p0[r+1]);b=max3f(b,p0[r+2],p0[r+3]);a=max3f(a,p1[r],p1[r+1]);b=max3f(b,p1[r+2],p1[r+3]);}
  const float m=max2f(a,b);
  auto rr=__builtin_amdgcn_permlane32_swap(__float_as_uint(m),__float_as_uint(m),false,false);
  return max2f(__uint_as_float(rr[0]),__uint_as_float(rr[1]));
}
__device__ __forceinline__ void pv(f32x16*o,int vb,bf16x8 pa0,bf16x8 pa1,bf16x8 pa2,bf16x8 pa3){
  #pragma unroll
  for(int d0=0;d0<2;++d0){s16x4 lo[4],hi[4];
    #pragma unroll
    for(int ks=0;ks<4;++ks){
      asm volatile("ds_read_b64_tr_b16 %0,%1 offset:%c2":"=&v"(lo[ks]):"v"(vb),"i"(d0*4096+ks*1024):"memory");
      asm volatile("ds_read_b64_tr_b16 %0,%1 offset:%c2":"=&v"(hi[ks]):"v"(vb),"i"(d0*4096+ks*1024+512):"memory");}
    asm volatile("s_waitcnt lgkmcnt(0)":::"memory");SBAR();
    #define PK(k) (bf16x8){lo[k][0],lo[k][1],lo[k][2],lo[k][3],hi[k][0],hi[k][1],hi[k][2],hi[k][3]}
    o[d0]=__builtin_amdgcn_mfma_f32_32x32x16_bf16(pa0,PK(0),o[d0],0,0,0);
    o[d0]=__builtin_amdgcn_mfma_f32_32x32x16_bf16(pa1,PK(1),o[d0],0,0,0);
    o[d0]=__builtin_amdgcn_mfma_f32_32x32x16_bf16(pa2,PK(2),o[d0],0,0,0);
    o[d0]=__builtin_amdgcn_mfma_f32_32x32x16_bf16(pa3,PK(3),o[d0],0,0,0);
    #undef PK
  }
}
struct AttnArgs {
  const bf16* Qw;
  const bf16* K0; const bf16* V0;
  int NT;
  int tmax;
  bf16* Ow;
  int qrel;
  float slope2, sink2;
  int wave;
};
#define ATTN_STORE16(p,v) (*(u32x4*)(p)=(v))
template<int MODE,int THRL,int QP,int KVP,int OP> __device__ __forceinline__ void attn_unit(const AttnArgs&a,char*shm){
  unsigned am_; asm volatile("s_mov_b32 %0, -1":"=s"(am_)); const int lane=(int)__builtin_amdgcn_mbcnt_hi(am_,__builtin_amdgcn_mbcnt_lo(am_,0u)),r32=lane&31,hi=lane>>5; const int wid=a.wave;
  const bf16*Qw=a.Qw; constexpr int qp=QP; constexpr long kvp=KVP;
  const unsigned lds0=(unsigned)(uintptr_t)shm;
  float*wsf=(float*)(shm+LDS_WS)+wid*64;
  const bf16*ksrc=a.K0+(long)lane*kvp+wid*8;
  const bf16*vsrc=a.V0+(long)(16*(wid&3)+(lane>>2))*kvp+(wid>>2)*32+(lane&3)*8;
  const unsigned kdst=lds0+LDS_K+wid*1024, vdst=lds0+LDS_V+wid*1024;
  const int tmax=a.tmax;
  #define TROW(t) ((MODE==2)?(-64*(((t)<tmax)?(t):tmax)):(64*(t)))
  #define DMA_K(t,slot) glds16(ksrc+(long)TROW(t)*kvp,(unsigned)__builtin_amdgcn_readfirstlane(kdst+(slot)))
  #define DMA_V(t,slot) glds16(vsrc+(long)TROW(t)*kvp,(unsigned)__builtin_amdgcn_readfirstlane(vdst+(slot)))
  const int vb0=(int)(lds0+LDS_V)+((lane>>4)&1)*32+(lane&3)*8+(4*hi+((lane&15)>>2))*64;
  const char*Kbase=shm+LDS_K; bf16x8 kf[8];
  const lds_cptr shm3=(lds_cptr)shm; const lds_cptr kp0=shm3+LDS_K+hi*1024+r32*16; const lds_cptr vp0=shm3+LDS_V+((lane>>4)&1)*32+(lane&3)*8+(4*hi+((lane&15)>>2))*64;
  const int NT=a.NT;
  DMA_K(0,0);DMA_V(0,0);DMA_K(1,SLOTB);
  bf16x8 qr[4];
  #pragma unroll
  for(int d0=0;d0<4;++d0)qr[d0]=*reinterpret_cast<const bf16x8*>(&Qw[(long)r32*qp+d0*16+hi*8]);
  float z0_; asm volatile("v_mov_b32 %0, 0":"=v"(z0_));
  f32x16 zv_; _Pragma("unroll") for(int r=0;r<16;++r)zv_[r]=z0_;
  float mhat=0.f,l_reg=0.f;f32x16 o[2];o[0]=zv_;o[1]=zv_;f32x16 negm=zv_;if(MODE==0)asm volatile("":"+v"(negm));
  const int qrel=a.qrel; const float slope2=a.slope2;
  #define KBREL(t) ((MODE==2)?(-64*(t)):(64*((t)-(NT-4))))
  #define MBIAS(P0,P1,t,BAND) maskbias<MODE>(P0,P1,KBREL(t)+4*hi,qrel,slope2,mhat,(BAND)&&((t)>=NT-4),(t)<=tmax)
  #define CINIT ((MODE==0)?negm:(f32x16{}))
  #define CMASK(P0,P1,t) MBIAS(P0,P1,t,true)
  bool resc=false;
  #define START(P0,P1) do{ const float rm=rowmax(P0,P1); resc=false; \
    { const float dl=rm; mhat=fadd_s(mhat,dl); \
      _Pragma("unroll") for(int r=0;r<16;++r){P0[r]=fsub_s(P0[r],dl);P1[r]=fsub_s(P1[r],dl);} \
      if(MODE==0){ _Pragma("unroll") for(int r=0;r<16;++r)negm[r]=-mhat; asm volatile("":"+v"(negm)); } } \
    _Pragma("unroll") for(int r=0;r<16;++r)P0[r]=__builtin_amdgcn_exp2f(P0[r]); }while(0)
  #define RESC() do{ if(resc){ asm volatile("s_waitcnt lgkmcnt(0)":::"memory"); \
      _Pragma("unroll") for(int d_=0;d_<2;++d_) _Pragma("unroll") for(int r=0;r<16;++r)o[d_][r]*=wsf[crow(r,hi)]; } }while(0)
  f32x16 pA0,pA1,pB0,pB1;
  int sl_prev=0,sl_cur=0,sl_next=SLOTB;
  #define ROT() do{sl_prev=sl_cur;sl_cur=sl_next;sl_next=(sl_next==(NSLOT-1)*SLOTB)?0:sl_next+SLOTB;}while(0)
  DMA_K(2,2*SLOTB);
  WAIT_BAR(3);
  qkt(pA0,pA1,Kbase,qr,negm,r32,hi);asm volatile("s_nop 15\n\ts_nop 7":"+v"(pA0),"+v"(pA1));CMASK(pA0,pA1,0);
  START(pA0,pA1);
  _Pragma("unroll") for(int r=0;r<16;++r)pA1[r]=__builtin_amdgcn_exp2f(pA1[r]);
  WAIT_BAR(0);
  DMA_K(3,0);DMA_V(1,SLOTB);
  ROT();
  kload8(kf,kp0+sl_cur);
  WAIT_BAR(2);
  s16x4 vlo[8],vhi[8]; u32x4 pw0,pw1,pw2,pw3;
  #define PKW(P,B) cvtpk_s(P[B],P[B+1])
  #define PAF(k) __builtin_bit_cast(bf16x8,pw##k)
  #define VFR(i) (bf16x8){vlo[i][0],vlo[i][1],vlo[i][2],vlo[i][3],vhi[i][0],vhi[i][1],vhi[i][2],vhi[i][3]}
  #define PIN(x) asm volatile("":"+v"(x))
  #define MX3(a,b,c) __builtin_fmaxf(__builtin_fmaxf((a),(b)),(c))
  #define GAPA(MF,A0,A1,A2,A3,W0,W1,PW) do{ MF; sacc+=A0; sacc+=A1; sacc+=A2; sacc+=A3; PIN(sacc); W0; W1; PIN(PW); SBAR(); }while(0)
  #define EX(v) __builtin_amdgcn_exp2f(v)
  #define GAPB(MF,X,B) do{ MF; X[B]=EX(X[B]); X[B+1]=EX(X[B+1]); X[B+2]=EX(X[B+2]); X[B+3]=EX(X[B+3]); PIN(X); SBAR(); }while(0)
  #define VRD(i) do{ vlo[i]=vtr(vp_+(((i)>>2)*4096+((i)&3)*1024)); vhi[i]=vtr(vp_+(((i)>>2)*4096+((i)&3)*1024+512)); }while(0)
  #define KRD(G,j) do{ if(G){ kload2(kf,kp0+sl_next,j); SBAR(); } }while(0)
  #define STEP(C0,C1,P0,P1,t,GK,GV,GL) do{ SBAR(); \
    const lds_cptr vp_=vp0+sl_prev; \
    VRD(0); SBAR(); float sacc=(P0[0]+P0[1]); \
    GAPA(C0=__builtin_amdgcn_mfma_f32_32x32x16_bf16(kf[0],qr[0],CINIT,0,0,0), P0[2],P0[3],P0[4],P0[5],     pw0[0]=PKW(P0,0), pw0[1]=PKW(P0,2), pw0); \
    VRD(4); SBAR(); GAPA(C1=__builtin_amdgcn_mfma_f32_32x32x16_bf16(kf[1],qr[0],CINIT,0,0,0), P0[6],P0[7],P0[8],P0[9],     pw0[2]=PKW(P0,4), pw0[3]=PKW(P0,6), pw0); \
    VRD(1); SBAR(); GAPA(C0=__builtin_amdgcn_mfma_f32_32x32x16_bf16(kf[2],qr[1],C0,0,0,0),   P0[10],P0[11],P0[12],P0[13], pw1[0]=PKW(P0,8), pw1[1]=PKW(P0,10), pw1); \
    VRD(5); SBAR(); GAPA(C1=__builtin_amdgcn_mfma_f32_32x32x16_bf16(kf[3],qr[1],C1,0,0,0),   P0[14],P0[15],P1[0],P1[1],   pw1[2]=PKW(P0,12),pw1[3]=PKW(P0,14), pw1); \
    VRD(2); SBAR(); GAPA(C0=__builtin_amdgcn_mfma_f32_32x32x16_bf16(kf[4],qr[2],C0,0,0,0),   P1[2],P1[3],P1[4],P1[5],     pw2[0]=PKW(P1,0), pw2[1]=PKW(P1,2), pw2); \
    VRD(6); SBAR(); GAPA(C1=__builtin_amdgcn_mfma_f32_32x32x16_bf16(kf[5],qr[2],C1,0,0,0),   P1[6],P1[7],P1[8],P1[9],     pw2[2]=PKW(P1,4), pw2[3]=PKW(P1,6), pw2); \
    VRD(3); SBAR(); GAPA(C0=__builtin_amdgcn_mfma_f32_32x32x16_bf16(kf[6],qr[3],C0,0,0,0),   P1[10],P1[11],P1[12],P1[13], pw3[0]=PKW(P1,8), pw3[1]=PKW(P1,10), pw3); \
    VRD(7); SBAR(); GAPA(C1=__builtin_amdgcn_mfma_f32_32x32x16_bf16(kf[7],qr[3],C1,0,0,0),   P1[14],P1[15],0.f,0.f,       pw3[2]=PKW(P1,12),pw3[3]=PKW(P1,14), pw3); \
    l_reg+=sacc; \
    if(GK){DMA_K((t)+3,sl_cur);} if(GV){DMA_V((t)+1,sl_next);} \
    CMASK(C0,C1,t); \
    { float a_=MX3(C0[0],C0[1],C1[0]),b_=MX3(C0[2],C0[3],C1[1]); a_=MX3(a_,C1[2],C1[3]); \
      _Pragma("unroll") for(int r=4;r<16;r+=4){a_=MX3(a_,C0[r],C0[r+1]);b_=MX3(b_,C0[r+2],C0[r+3]);a_=MX3(a_,C1[r],C1[r+1]);b_=MX3(b_,C1[r+2],C1[r+3]);} \
      float rm=__builtin_fmaxf(a_,b_); { auto rr=__builtin_amdgcn_permlane32_swap(__float_as_uint(rm),__float_as_uint(rm),false,false); rm=__builtin_fmaxf(__uint_as_float(rr[0]),__uint_as_float(rr[1])); } \
      resc=false; \
      if(__builtin_expect(__any(rm>(float)THRL),0)){ const float dl=__builtin_fmaxf(rm,0.f); mhat+=dl; \
        _Pragma("unroll") for(int r=0;r<16;++r){C0[r]-=dl;C1[r]-=dl;} \
        if(MODE==0){ _Pragma("unroll") for(int r=0;r<16;++r)negm[r]=-mhat; asm volatile("":"+v"(negm)); } \
        const float f=__builtin_amdgcn_exp2f(-dl); l_reg*=f; if(hi==0)wsf[r32]=f; resc=true; } } \
    SBAR(); \
    GAPB(o[0]=__builtin_amdgcn_mfma_f32_32x32x16_bf16(PAF(0),VFR(0),o[0],0,0,0), C0,0); \
    GAPB(o[1]=__builtin_amdgcn_mfma_f32_32x32x16_bf16(PAF(0),VFR(4),o[1],0,0,0), C0,4); \
    KRD(GL,0); GAPB(o[0]=__builtin_amdgcn_mfma_f32_32x32x16_bf16(PAF(1),VFR(1),o[0],0,0,0), C0,8); \
    KRD(GL,1); GAPB(o[1]=__builtin_amdgcn_mfma_f32_32x32x16_bf16(PAF(1),VFR(5),o[1],0,0,0), C0,12); \
    KRD(GL,2); GAPB(o[0]=__builtin_amdgcn_mfma_f32_32x32x16_bf16(PAF(2),VFR(2),o[0],0,0,0), C1,0); \
    KRD(GL,3); GAPB(o[1]=__builtin_amdgcn_mfma_f32_32x32x16_bf16(PAF(2),VFR(6),o[1],0,0,0), C1,4); \
    GAPB(o[0]=__builtin_amdgcn_mfma_f32_32x32x16_bf16(PAF(3),VFR(3),o[0],0,0,0), C1,8); \
    GAPB(o[1]=__builtin_amdgcn_mfma_f32_32x32x16_bf16(PAF(3),VFR(7),o[1],0,0,0), C1,12); \
    }while(0)
  int t=1;
  #undef CMASK
  #define CMASK(P0,P1,t) MBIAS(P0,P1,t,false)
  for(;t+5<NT;t+=2){
    STEP(pB0,pB1,pA0,pA1,t,true,true,true);     WAIT_BAR(2); RESC(); ROT();
    STEP(pA0,pA1,pB0,pB1,t+1,true,true,true);   WAIT_BAR(2); RESC(); ROT();
  }
  #undef CMASK
  #define CMASK(P0,P1,t) MBIAS(P0,P1,t,true)
  #define ENDW(tt) do{ if((tt)+3<NT){WAIT_BAR(2);} else if((tt)+2<NT){WAIT_BAR(1);} else {WAIT_BAR(0);} }while(0)
  for(;t+1<NT;t+=2){
    STEP(pB0,pB1,pA0,pA1,t,(t+3<NT),(t+1<NT),(t+1<NT));       ENDW(t);   RESC(); ROT();
    STEP(pA0,pA1,pB0,pB1,t+1,(t+4<NT),(t+2<NT),(t+2<NT));     ENDW(t+1); RESC(); ROT();
  }
  STEP(pB0,pB1,pA0,pA1,NT-1,false,false,false); RESC();
  { float sacc=pB0[0]+pB0[1]; _Pragma("unroll") for(int r=2;r<16;++r)sacc+=pB0[r]; _Pragma("unroll") for(int r=0;r<16;++r)sacc+=pB1[r]; l_reg+=sacc;
    pw0=(u32x4){PKW(pB0,0),PKW(pB0,2),PKW(pB0,4),PKW(pB0,6)};pw1=(u32x4){PKW(pB0,8),PKW(pB0,10),PKW(pB0,12),PKW(pB0,14)};pw2=(u32x4){PKW(pB1,0),PKW(pB1,2),PKW(pB1,4),PKW(pB1,6)};pw3=(u32x4){PKW(pB1,8),PKW(pB1,10),PKW(pB1,12),PKW(pB1,14)};
    SBAR(); pv(o,vb0+sl_cur,PAF(0),PAF(1),PAF(2),PAF(3)); }
  #undef PKW
  #undef PAF
  #undef VFR
  #undef PIN
  #undef MX3
  #undef GAPA
  #undef GAPB
  #undef EX
  #undef VRD
  #undef KRD
  #undef STEP
  #undef ENDW
  {auto rr=__builtin_amdgcn_permlane32_swap(__float_as_uint(l_reg),__float_as_uint(l_reg),false,false);l_reg=__uint_as_float(rr[0])+__uint_as_float(rr[1]);}
  if(MODE==2)l_reg+=__builtin_amdgcn_exp2f(a.sink2-mhat);
  if(hi==0)wsf[32+r32]=l_reg;asm volatile("s_waitcnt lgkmcnt(0)":::"memory");
  float rli[16];
  #pragma unroll
  for(int r=0;r<16;++r)rli[r]=__builtin_amdgcn_rcpf(wsf[32+crow(r,hi)]);
  bf16*Ow=a.Ow; constexpr long op=OP;
  { bf16*stg=(bf16*)(shm+LDS_OST)+wid*2048;
    #pragma unroll
    for(int r=0;r<16;++r){const int orow=crow(r,hi);
      #pragma unroll
      for(int d0=0;d0<2;++d0)stg[orow*64+d0*32+r32]=__float2bfloat16(o[d0][r]*rli[r]);}
    asm volatile("s_waitcnt lgkmcnt(0)":::"memory");
    #pragma unroll
    for(int i=0;i<4;++i){const int row=i*8+(lane>>3),ch=lane&7; const u32x4 v=*(const u32x4*)(stg+row*64+ch*8); ATTN_STORE16(Ow+(long)row*op+ch*8,v);} }
  asm volatile("s_waitcnt lgkmcnt(0)\n\ts_barrier":::"memory");
  #undef DMA_K
  #undef DMA_V
  #undef TROW
  #undef KBREL
  #undef MBIAS
  #undef CINIT
  #undef CMASK
  #undef START
  #undef RESC
  #undef ROT
}

constexpr int DP_K=0, DP_V=3*8192, DP_WS=DP_V+3*16384, DP_BYTES=DP_WS+NW*256;
template<int THRL,int QP,int KVP,int OP> __device__ __forceinline__ void diff_unit(const AttnArgs&a,char*shm){
  unsigned am_; asm volatile("s_mov_b32 %0, -1":"=s"(am_)); const int lane=(int)__builtin_amdgcn_mbcnt_hi(am_,__builtin_amdgcn_mbcnt_lo(am_,0u)),r32=lane&31,hi=lane>>5; const int wid=a.wave;
  const bf16*Qw=a.Qw; constexpr int qp=QP; constexpr long kvp=KVP;
  const unsigned lds0=(unsigned)(uintptr_t)shm;
  float*wsf=(float*)(shm+DP_WS)+wid*64;
  const unsigned koff=(unsigned)((lane*KVP+wid*8)*2), voff=(unsigned)(((16*(wid&3)+(lane>>2))*KVP+(wid>>2)*32+(lane&3)*8)*2);
  const char*Kb=(const char*)a.K0; const char*Vb=(const char*)a.V0;
  const unsigned kdst=lds0+DP_K+wid*1024, vdst=lds0+DP_V+wid*1024;
  #define DMA_K(t,slot) glds16s(Kb+(long)(64*(t))*(kvp*2),koff,(unsigned)__builtin_amdgcn_readfirstlane(kdst+(slot)))
  #define DMA_V(t,slot) do{ DMA_VA(t,slot); DMA_VB(t,slot); }while(0)
  #define DMA_VA(t,slot) glds16s(Vb+(long)(64*(t))*(kvp*2),voff,(unsigned)__builtin_amdgcn_readfirstlane(vdst+2*(slot)))
  #define DMA_VB(t,slot) glds16s(Vb+(long)(64*(t))*(kvp*2)+128,voff,(unsigned)__builtin_amdgcn_readfirstlane(vdst+2*(slot)+8192))
  const int vb0=(int)(lds0+DP_V)+((lane>>4)&1)*32+(lane&3)*8+(4*hi+((lane&15)>>2))*64;
  const char*Kbase=shm+DP_K; bf16x8 kf[8];
  const lds_cptr shm3=(lds_cptr)shm; const lds_cptr kp0=shm3+DP_K+hi*1024+r32*16; const lds_cptr vp0=shm3+DP_V+((lane>>4)&1)*32+(lane&3)*8+(4*hi+((lane&15)>>2))*64;
  const int NT=a.NT;
  DMA_K(0,0);DMA_V(0,0);DMA_K(1,SLOTB);
  bf16x8 qr[4];
  #pragma unroll
  for(int d0=0;d0<4;++d0)qr[d0]=*reinterpret_cast<const bf16x8*>(&Qw[(long)r32*qp+d0*16+hi*8]);
  float z0_; asm volatile("v_mov_b32 %0, 0":"=v"(z0_));
  f32x16 zv_; _Pragma("unroll") for(int r=0;r<16;++r)zv_[r]=z0_;
  float mhat=0.f,l_reg=0.f;f32x16 o[4];o[0]=zv_;o[1]=zv_;o[2]=zv_;o[3]=zv_;
  const int qrel=a.qrel; const float slope2=a.slope2;
  float slope2v=slope2; asm volatile("":"+v"(slope2v));
  #define KBREL(t) (64*((t)-(NT-4)))
  #define MBIAS(P0,P1,t,BAND) maskbias<1>(P0,P1,KBREL(t)+4*hi,qrel,slope2,mhat,(BAND)&&((t)>=NT-4),true)
  #define CMASK(P0,P1,t) MBIAS(P0,P1,t,true)
  bool resc=false;
  #define START(P0,P1) do{ const float rm=rowmax(P0,P1); resc=false; \
    { const float dl=rm; mhat=fadd_s(mhat,dl); \
      _Pragma("unroll") for(int r=0;r<16;++r){P0[r]=fsub_s(P0[r],dl);P1[r]=fsub_s(P1[r],dl);} } \
    _Pragma("unroll") for(int r=0;r<16;++r)P0[r]=__builtin_amdgcn_exp2f(P0[r]); }while(0)
  #define RESC() do{ if(resc){ asm volatile("s_waitcnt lgkmcnt(0)":::"memory"); \
      _Pragma("unroll") for(int d_=0;d_<4;++d_) _Pragma("unroll") for(int r=0;r<16;++r)o[d_][r]*=wsf[crow(r,hi)]; } }while(0)
  f32x16 pA0,pA1;
  int sl_prev=0,sl_cur=0,sl_next=SLOTB;
  #define ROT() do{sl_prev=sl_cur;sl_cur=sl_next;sl_next=(sl_next==(NSLOT-1)*SLOTB)?0:sl_next+SLOTB;}while(0)
  DMA_K(2,2*SLOTB);
  WAIT_BAR(4);
  qkt(pA0,pA1,Kbase,qr,zv_,r32,hi);asm volatile("s_nop 15\n\ts_nop 7":"+v"(pA0),"+v"(pA1));CMASK(pA0,pA1,0);
  START(pA0,pA1);
  _Pragma("unroll") for(int r=0;r<16;++r)pA1[r]=__builtin_amdgcn_exp2f(pA1[r]);
  f32x16 pB0,pB1;
  { const float lbn=__builtin_fmaf(slope2,(float)(KBREL(1)+4*hi-qrel),-mhat);
    _Pragma("unroll") for(int r=0;r<16;++r){ const int c=(r&3)+8*(r>>2); pB0[r]=__builtin_fmaf(slope2,(float)c,lbn); pB1[r]=__builtin_fmaf(slope2,(float)(c+32),lbn); } }
  WAIT_BAR(0);
  DMA_K(3,0);DMA_V(1,SLOTB);
  ROT();
  kload8(kf,kp0+sl_cur);
  WAIT_BAR(0);
  s16x4 vlo[8],vhi[8]; u32x4 pw0,pw1,pw2,pw3;
  #define PKW(P,B) cvtpk_s(P[B],P[B+1])
  #define PAF(k) __builtin_bit_cast(bf16x8,pw##k)
  #define VFR(i) (bf16x8){vlo[i][0],vlo[i][1],vlo[i][2],vlo[i][3],vhi[i][0],vhi[i][1],vhi[i][2],vhi[i][3]}
  #define PIN(x) asm volatile("":"+v"(x))
  #define MX3(a,b,c) __builtin_fmaxf(__builtin_fmaxf((a),(b)),(c))
  #define GAPA(MF,A0,A1,A2,A3,W0,W1,PW) do{ MF; sacc+=A0; sacc+=A1; sacc+=A2; sacc+=A3; PIN(sacc); W0; W1; PIN(PW); SBAR(); }while(0)
  #define EX(v) __builtin_amdgcn_exp2f(v)
  #define FILLV(r,OFF) fmamk_c<(((r)&3)+8*((r)>>2))+(OFF)>(slope2v,lbn)
  #define GAPB(MF,X0,X1,E0,E1,E2) do{ MF; E0=EX(E0); E1=EX(E1); E2=EX(E2); PIN(X0); PIN(X1); SBAR(); }while(0)
  #define GAPD(MF,X,E,Y,B,OFF) do{ MF; E=EX(E); Y[B]=FILLV(B,OFF); Y[B+1]=FILLV(B+1,OFF); Y[B+2]=FILLV(B+2,OFF); Y[B+3]=FILLV(B+3,OFF); PIN(X); PIN(Y); SBAR(); }while(0)
  #define GAPC(MF) do{ MF; SBAR(); }while(0)
  #define VRD(i) do{ vlo[i]=vtr(vp_+(((i)>>2)*4096+((i)&3)*1024)); vhi[i]=vtr(vp_+(((i)>>2)*4096+((i)&3)*1024+512)); SBAR(); }while(0)
  #define VRD2(i) do{ vlo[i]=vtr(vp_+(8192+((i)>>2)*4096+((i)&3)*1024)); vhi[i]=vtr(vp_+(8192+((i)>>2)*4096+((i)&3)*1024+512)); SBAR(); }while(0)
  #define KRD(G,j) do{ if(G){ kload2(kf,kp0+sl_next,j); SBAR(); } }while(0)
  #define STEP(C0,C1,P0,P1,t,GK,GV,GL) do{ SBAR(); \
    const lds_cptr vp_=vp0+2*sl_prev; \
    float sacc=(P0[0]+P0[1]); \
    GAPA(C0=__builtin_amdgcn_mfma_f32_32x32x16_bf16(kf[0],qr[0],C0,0,0,0), P0[2],P0[3],P0[4],P0[5],     pw0[0]=PKW(P0,0), pw0[1]=PKW(P0,2), pw0); \
    if(GK){DMA_K((t)+3,sl_cur); SBAR();} \
    GAPA(C1=__builtin_amdgcn_mfma_f32_32x32x16_bf16(kf[1],qr[0],C1,0,0,0), P0[6],P0[7],P0[8],P0[9],     pw0[2]=PKW(P0,4), pw0[3]=PKW(P0,6), pw0); \
    GAPA(C0=__builtin_amdgcn_mfma_f32_32x32x16_bf16(kf[2],qr[1],C0,0,0,0),   P0[10],P0[11],P0[12],P0[13], pw1[0]=PKW(P0,8), pw1[1]=PKW(P0,10), pw1); \
    if(GV){DMA_VA((t)+1,sl_next); SBAR();} \
    GAPA(C1=__builtin_amdgcn_mfma_f32_32x32x16_bf16(kf[3],qr[1],C1,0,0,0),   P0[14],P0[15],P1[0],P1[1],   pw1[2]=PKW(P0,12),pw1[3]=PKW(P0,14), pw1); \
    GAPA(C0=__builtin_amdgcn_mfma_f32_32x32x16_bf16(kf[4],qr[2],C0,0,0,0),   P1[2],P1[3],P1[4],P1[5],     pw2[0]=PKW(P1,0), pw2[1]=PKW(P1,2), pw2); \
    if(GV){DMA_VB((t)+1,sl_next); SBAR();} \
    GAPA(C1=__builtin_amdgcn_mfma_f32_32x32x16_bf16(kf[5],qr[2],C1,0,0,0),   P1[6],P1[7],P1[8],P1[9],     pw2[2]=PKW(P1,4), pw2[3]=PKW(P1,6), pw2); \
    GAPA(C0=__builtin_amdgcn_mfma_f32_32x32x16_bf16(kf[6],qr[3],C0,0,0,0),   P1[10],P1[11],P1[12],P1[13], pw3[0]=PKW(P1,8), pw3[1]=PKW(P1,10), pw3); \
    VRD(0); GAPA(C1=__builtin_amdgcn_mfma_f32_32x32x16_bf16(kf[7],qr[3],C1,0,0,0),   P1[14],P1[15],0.f,0.f,       pw3[2]=PKW(P1,12),pw3[3]=PKW(P1,14), pw3); \
    l_reg+=sacc; \
    VRD(4); VRD(1); VRD(5); \
    SMASK(C0,C1,t); \
    { float a_=MX3(C0[0],C0[1],C1[0]),b_=MX3(C0[2],C0[3],C1[1]); a_=MX3(a_,C1[2],C1[3]); \
      _Pragma("unroll") for(int r=4;r<16;r+=4){a_=MX3(a_,C0[r],C0[r+1]);b_=MX3(b_,C0[r+2],C0[r+3]);a_=MX3(a_,C1[r],C1[r+1]);b_=MX3(b_,C1[r+2],C1[r+3]);} \
      float rm=__builtin_fmaxf(a_,b_); { auto rr=__builtin_amdgcn_permlane32_swap(__float_as_uint(rm),__float_as_uint(rm),false,false); rm=__builtin_fmaxf(__uint_as_float(rr[0]),__uint_as_float(rr[1])); } \
      resc=false; \
      if(__builtin_expect(__any(rm>(float)THRL),0)){ const float dl=__builtin_fmaxf(rm,0.f); mhat+=dl; \
        _Pragma("unroll") for(int r=0;r<16;++r){C0[r]-=dl;C1[r]-=dl;} \
        const float f=__builtin_amdgcn_exp2f(-dl); l_reg*=f; if(hi==0)wsf[r32]=f; resc=true; } } \
    const float lbn=__builtin_fmaf(slope2,(float)(KBREL((t)+1)+4*hi-qrel),-mhat); \
    SBAR(); \
    VRD(2); GAPB(o[0]=__builtin_amdgcn_mfma_f32_32x32x16_bf16(PAF(0),VFR(0),o[0],0,0,0), C0,C1, C0[0],C0[1],C0[2]);    VRD2(0); \
    VRD(6); GAPB(o[1]=__builtin_amdgcn_mfma_f32_32x32x16_bf16(PAF(0),VFR(4),o[1],0,0,0), C0,C1, C0[3],C0[4],C0[5]);    VRD2(4); \
    VRD(3); GAPB(o[0]=__builtin_amdgcn_mfma_f32_32x32x16_bf16(PAF(1),VFR(1),o[0],0,0,0), C0,C1, C0[6],C0[7],C0[8]);    VRD2(1); \
    VRD(7); GAPB(o[1]=__builtin_amdgcn_mfma_f32_32x32x16_bf16(PAF(1),VFR(5),o[1],0,0,0), C0,C1, C0[9],C0[10],C0[11]);  VRD2(5); \
    GAPB(o[0]=__builtin_amdgcn_mfma_f32_32x32x16_bf16(PAF(2),VFR(2),o[0],0,0,0), C0,C1, C0[12],C0[13],C0[14]); VRD2(2); \
    GAPB(o[1]=__builtin_amdgcn_mfma_f32_32x32x16_bf16(PAF(2),VFR(6),o[1],0,0,0), C0,C1, C0[15],C1[0],C1[1]);   VRD2(6); \
    GAPB(o[0]=__builtin_amdgcn_mfma_f32_32x32x16_bf16(PAF(3),VFR(3),o[0],0,0,0), C0,C1, C1[2],C1[3],C1[4]);    VRD2(3); \
    GAPB(o[1]=__builtin_amdgcn_mfma_f32_32x32x16_bf16(PAF(3),VFR(7),o[1],0,0,0), C0,C1, C1[5],C1[6],C1[7]);    VRD2(7); \
    KRD(GL,0); GAPD(o[2]=__builtin_amdgcn_mfma_f32_32x32x16_bf16(PAF(0),VFR(0),o[2],0,0,0), C1,C1[8], P0,0,0); \
    KRD(GL,1); GAPD(o[3]=__builtin_amdgcn_mfma_f32_32x32x16_bf16(PAF(0),VFR(4),o[3],0,0,0), C1,C1[9], P0,4,0); \
    KRD(GL,2); GAPD(o[2]=__builtin_amdgcn_mfma_f32_32x32x16_bf16(PAF(1),VFR(1),o[2],0,0,0), C1,C1[10],P0,8,0); \
    KRD(GL,3); GAPD(o[3]=__builtin_amdgcn_mfma_f32_32x32x16_bf16(PAF(1),VFR(5),o[3],0,0,0), C1,C1[11],P0,12,0); \
    GAPD(o[2]=__builtin_amdgcn_mfma_f32_32x32x16_bf16(PAF(2),VFR(2),o[2],0,0,0), C1,C1[12],P1,0,32); \
    GAPD(o[3]=__builtin_amdgcn_mfma_f32_32x32x16_bf16(PAF(2),VFR(6),o[3],0,0,0), C1,C1[13],P1,4,32); \
    GAPD(o[2]=__builtin_amdgcn_mfma_f32_32x32x16_bf16(PAF(3),VFR(3),o[2],0,0,0), C1,C1[14],P1,8,32); \
    GAPD(o[3]=__builtin_amdgcn_mfma_f32_32x32x16_bf16(PAF(3),VFR(7),o[3],0,0,0), C1,C1[15],P1,12,32); \
    }while(0)
  int t=1;
  #define SMASK(P0,P1,t) do{}while(0)
  for(;t+5<NT;t+=2){
    STEP(pB0,pB1,pA0,pA1,t,true,true,true);     WAIT_BAR(0); RESC(); ROT();
    STEP(pA0,pA1,pB0,pB1,t+1,true,true,true);   WAIT_BAR(0); RESC(); ROT();
  }
  #undef SMASK
  #define SMASK(P0,P1,t) do{ if((t)>=NT-4){ int dq_=qrel-(KBREL(t)+4*hi); asm volatile("":"+v"(dq_));        \
    _Pragma("unroll") for(int r=0;r<16;++r){ const int c_=(r&3)+8*(r>>2); if(c_>dq_)P0[r]=-INFINITY; if(c_+32>dq_)P1[r]=-INFINITY; } } }while(0)
  #define ENDW(tt) do{ WAIT_BAR(0); }while(0)
  for(;t+1<NT;t+=2){
    STEP(pB0,pB1,pA0,pA1,t,(t+3<NT),(t+1<NT),(t+1<NT));       ENDW(t);   RESC(); ROT();
    STEP(pA0,pA1,pB0,pB1,t+1,(t+4<NT),(t+2<NT),(t+2<NT));     ENDW(t+1); RESC(); ROT();
  }
  STEP(pB0,pB1,pA0,pA1,NT-1,false,false,false); RESC();
  { float sacc=pB0[0]+pB0[1]; _Pragma("unroll") for(int r=2;r<16;++r)sacc+=pB0[r]; _Pragma("unroll") for(int r=0;r<16;++r)sacc+=pB1[r]; l_reg+=sacc;
    pw0=(u32x4){PKW(pB0,0),PKW(pB0,2),PKW(pB0,4),PKW(pB0,6)};pw1=(u32x4){PKW(pB0,8),PKW(pB0,10),PKW(pB0,12),PKW(pB0,14)};pw2=(u32x4){PKW(pB1,0),PKW(pB1,2),PKW(pB1,4),PKW(pB1,6)};pw3=(u32x4){PKW(pB1,8),PKW(pB1,10),PKW(pB1,12),PKW(pB1,14)};
    SBAR(); pv(o,vb0+2*sl_cur,PAF(0),PAF(1),PAF(2),PAF(3)); pv(o+2,vb0+2*sl_cur+8192,PAF(0),PAF(1),PAF(2),PAF(3)); }
  #undef PKW
  #undef PAF
  #undef VFR
  #undef PIN
  #undef MX3
  #undef GAPA
  #undef GAPB
  #undef GAPD
  #undef GAPC
  #undef EX
  #undef VRD
  #undef VRD2
  #undef KRD
  #undef STEP
  #undef ENDW
  #undef SMASK
  #undef FILLV
  {auto rr=__builtin_amdgcn_permlane32_swap(__float_as_uint(l_reg),__float_as_uint(l_reg),false,false);l_reg=__uint_as_float(rr[0])+__uint_as_float(rr[1]);}
  if(hi==0)wsf[32+r32]=l_reg;asm volatile("s_waitcnt lgkmcnt(0)":::"memory");
  float rli[16];
  #pragma unroll
  for(int r=0;r<16;++r)rli[r]=__builtin_amdgcn_rcpf(wsf[32+crow(r,hi)]);
  asm volatile("s_waitcnt lgkmcnt(0)\n\ts_barrier":::"memory");
  { bf16*stg=(bf16*)(shm)+wid*4096;
    #pragma unroll
    for(int r=0;r<16;++r){const int orow=crow(r,hi);
      #pragma unroll
      for(int dq=0;dq<4;++dq)stg[orow*128+dq*32+r32]=__float2bfloat16(o[dq][r]*rli[r]);}
    asm volatile("s_waitcnt lgkmcnt(0)":::"memory");
    #pragma unroll
    for(int i=0;i<8;++i){const int row=i*4+(lane>>4),ch=lane&15; const u32x4 v=*(const u32x4*)(stg+row*128+ch*8); *(u32x4*)(a.Ow+(long)row*OP+ch*8)=v;} }
  asm volatile("s_waitcnt lgkmcnt(0)\n\ts_barrier":::"memory");
  #undef DMA_K
  #undef DMA_V
  #undef DMA_VA
  #undef DMA_VB
  #undef KBREL
  #undef MBIAS
  #undef CMASK
  #undef START
  #undef RESC
  #undef ROT
}
constexpr int ATTN_LDS_BYTES=LDS_BYTES;
#undef SBAR
#undef WAIT_BAR
}
constexpr int NWAVES = 8;
constexpr int BATCH = 2, SEQ = 16384, D = 1024, M = BATCH * SEQ, DEPTH = 4, MEMLEN = 256;
constexpr int NPA = 1536, NPB = 2560;
constexpr int NEXP = 64, CAP = 32768, HID = 256;
constexpr int HROWS = (M * 8 / 256 + NEXP + M / 256) * 256;
constexpr float LN_EPS = 1e-5f;
constexpr float DN_ALPHA = 1.681792830507429f;
__device__ const float SLOPES_A[12] = {0.5f, 0.25f, 0.125f, 0.0625f, 0.03125f, 0.015625f, 0.0078125f, 0.00390625f, 0.7071067811865476f, 0.35355339059327384f, 0.17677669529663695f, 0.08838834764831849f};
__device__ const float SLOPES_B[6] = {0.25f, 0.0625f, 0.015625f, 0.00390625f, 0.5f, 0.125f};

constexpr size_t MiB = 1u << 20;
constexpr size_t WS_CTL = 0, CTL_ZERO_BYTES = 1 * MiB;
constexpr size_t WS_MEMKV = 2 * MiB;
constexpr size_t WS_WROUT = 4 * MiB;
constexpr size_t WS_WINA = 6 * MiB, WS_WINB = 12 * MiB;
constexpr size_t WS_WOUT = 22 * MiB;
constexpr size_t WS_WMKV = 30 * MiB;
constexpr size_t WS_MEMB = 34 * MiB;
constexpr size_t WS_LOGIT = 36 * MiB;
constexpr size_t WS_ROWTOK = 44 * MiB, WS_ROWGATE = 52 * MiB;
constexpr size_t WS_WEXP = 60 * MiB;
constexpr size_t WS_XB = 158 * MiB;
constexpr size_t WS_HB = 222 * MiB;
constexpr size_t WS_BIG = 374 * MiB;
constexpr size_t WS_QKV = WS_BIG, WS_OTMP = WS_BIG + 160 * MiB, WS_CAT = WS_BIG + 256 * MiB, WS_Y = WS_BIG + 320 * MiB;
constexpr size_t WS_END = WS_BIG + 576 * MiB;
static_assert(WS_WEXP + 65 * (size_t)pg8::EXPERT_BYTES <= WS_XB && WS_HB + (size_t)HROWS * 512 <= WS_BIG, "d_ws map");
constexpr int CW_TMO = 0;
constexpr int CW_BAR = 4096;
constexpr int CW_CNT = 16384;
constexpr int CW_Q = CW_CNT + DEPTH * 64 * 64;
constexpr int CW_NORM = CW_Q + 64 * DEPTH;
static_assert((CW_NORM + 64 * DEPTH) * 4 <= (int)CTL_ZERO_BYTES, "CTL words inside the memset region");

constexpr int RING_OFF = 0, RING_BYTES = 131072;
constexpr int LDSCTL_OFF = RING_BYTES;
constexpr int TAB_OFF = RING_BYTES + 512;
constexpr int IDX_OFF = RING_BYTES + 2560;
constexpr int GATE_OFF = IDX_OFF + 10 * 1024;
constexpr int LDS_BYTES = 163840;
static_assert(IDX_OFF + 20 * 1024 <= LDS_BYTES, "LDS map");

#define GAS __attribute__((address_space(1)))
#define LAS __attribute__((address_space(3)))
typedef unsigned short bf16;
typedef unsigned v4u __attribute__((ext_vector_type(4)));
typedef unsigned v2u __attribute__((ext_vector_type(2)));
typedef float f32x4 __attribute__((ext_vector_type(4)));
typedef GAS unsigned gu32;
#define RLX_AGENT __ATOMIC_RELAXED, __HIP_MEMORY_SCOPE_AGENT
#define LDS_WAIT() asm volatile("s_waitcnt lgkmcnt(0)" ::: "memory")
__device__ __forceinline__ unsigned f2bf(float f) { unsigned u = __builtin_bit_cast(unsigned, f); return (u + 0x7fffu + ((u >> 16) & 1u)) >> 16; }
__device__ __forceinline__ unsigned pk2(float lo, float hi) { return f2bf(lo) | (f2bf(hi) << 16); }
__device__ __forceinline__ float bflo(unsigned u) { return __builtin_bit_cast(float, u << 16); }
__device__ __forceinline__ float bfhi(unsigned u) { return __builtin_bit_cast(float, u & 0xffff0000u); }

#define XB_TMO      128
#define XB_XCNT(j)  (256  + 64 * (j))
#define XB_XSUB(j)  (1280 + 64 * (j))
#define XB_XGEN(j)  (2304 + 64 * (j))
#define XB_TOP      3328
#define XB_TOPGEN   3392
#define XCD_BAR_WORDS 3456
#define XB_SPIN_CAP (1u << 18)
__device__ __forceinline__ unsigned xb_ld(unsigned* p)              { return __hip_atomic_load(p, __ATOMIC_RELAXED, __HIP_MEMORY_SCOPE_AGENT); }
__device__ __forceinline__ unsigned xb_add(unsigned* p, unsigned v) { return __hip_atomic_fetch_add(p, v, __ATOMIC_RELAXED, __HIP_MEMORY_SCOPE_AGENT); }
__device__ __forceinline__ unsigned xb_xcc_id() { return (unsigned)__builtin_amdgcn_s_getreg((3 << 11) | 20) & 0xFu; }
#define XB_SPIN(cond, bar) do { unsigned _sp = 0; while (cond) { __builtin_amdgcn_s_sleep(1); \
    if ((++_sp & 255u) == 0u) { if (xb_ld(&(bar)[XB_TMO])) break; if (_sp > XB_SPIN_CAP) { atomicAdd(&(bar)[XB_TMO], 1u); break; } } } } while (0)
struct XcdBarrier { unsigned* bar; unsigned x; volatile LAS unsigned* st; };
__device__ __forceinline__ XcdBarrier xcd_barrier_post(unsigned* bar, volatile LAS unsigned* st, const bool t0) {
    XcdBarrier b; b.bar = bar; b.x = xb_xcc_id(); b.st = st;
    if (t0) (void)xb_add(&bar[XB_XCNT(b.x)], 1u);
    return b;
}
__device__ __forceinline__ void xcd_barrier_complete(unsigned* bar, unsigned x, unsigned& nloc, unsigned& nx) {
    const unsigned G = gridDim.x * gridDim.y * gridDim.z;
    unsigned sum, cnt, mine, sp = 0u;
    for (;;) {
        sum = 0u; cnt = 0u; mine = 0u;
#pragma unroll
        for (unsigned j = 0; j < 16; ++j) { const unsigned c = xb_ld(&bar[XB_XCNT(j)]); sum += c; cnt += (c > 0u) ? 1u : 0u; mine = (j == x) ? c : mine; }
        if (sum == G) break;
        __builtin_amdgcn_s_sleep(1);
        if ((++sp & 255u) == 0u) { if (xb_ld(&bar[XB_TMO])) break; if (sp > XB_SPIN_CAP) { atomicAdd(&bar[XB_TMO], 1u); break; } }
    }
    nloc = mine > 0u ? mine : 1u; nx = cnt > 0u ? cnt : 1u;
}
__device__ __forceinline__ void xcd_barrier(const XcdBarrier& b, const bool t0) {
    asm volatile("s_waitcnt vmcnt(0)" ::: "memory");
    __syncthreads();
    if (t0) {
        unsigned* bar = b.bar;
        __builtin_amdgcn_s_waitcnt(0);
        unsigned nloc = b.st[0], nx = b.st[1];
        if (nloc == 0u) { xcd_barrier_complete(bar, b.x, nloc, nx); b.st[0] = nloc; b.st[1] = nx; }
        const unsigned old = xb_add(&bar[XB_XSUB(b.x)], 1u);
        const unsigned gen = old / nloc;
        if (old + 1u == (gen + 1u) * nloc) {
            __builtin_amdgcn_fence(__ATOMIC_RELEASE, "agent");
            asm volatile("s_waitcnt vmcnt(0)" ::: "memory");
            const unsigned og = xb_add(&bar[XB_TOP], 1u);
            const unsigned tg = og / nx;
            if (og + 1u == (tg + 1u) * nx) xb_add(&bar[XB_TOPGEN], 1u);
            else XB_SPIN(xb_ld(&bar[XB_TOPGEN]) == tg, bar);
            __builtin_amdgcn_fence(__ATOMIC_ACQUIRE, "agent");
            xb_add(&bar[XB_XGEN(b.x)], 1u);
            asm volatile("s_waitcnt vmcnt(0)" ::: "memory");
        } else {
            XB_SPIN(xb_ld(&bar[XB_XGEN(b.x)]) == gen, bar);
            __builtin_amdgcn_fence(__ATOMIC_ACQUIRE, "agent");
            asm volatile("s_waitcnt vmcnt(0)" ::: "memory");
        }
    }
    __syncthreads();
}

struct Frame { LAS unsigned char* lds; int wave; };
__device__ __forceinline__ int f_G() { int g = (int)gridDim.x; asm volatile("" : "+s"(g)); return g; }
__device__ __forceinline__ int f_bx() { int b = (int)blockIdx.x; asm volatile("" : "+s"(b)); return b; }
__device__ __forceinline__ int f_gw(const Frame& F) { const int g = f_G(), b = f_bx(); return ((g % 8 == 0) ? (b % 8) * (g / 8) + b / 8 : b) * NWAVES + F.wave; }
__device__ __forceinline__ int f_ngw() { return f_G() * NWAVES; }
__device__ __forceinline__ volatile LAS unsigned* f_misc(const Frame& F) { return (volatile LAS unsigned*)(F.lds + LDSCTL_OFF); }
__device__ __forceinline__ int lane_id() { unsigned m; asm volatile("s_mov_b32 %0, -1" : "=s"(m)); return (int)__builtin_amdgcn_mbcnt_hi(m, __builtin_amdgcn_mbcnt_lo(m, 0u)); }
__device__ __forceinline__ int tid_of(int wave) { asm volatile("" : "+s"(wave)); return (wave << 6) | lane_id(); }
#define fresh_tid() tid_of(F.wave)
__device__ __forceinline__ float sx(float v, int o, int ln) { return __builtin_bit_cast(float, __builtin_amdgcn_ds_bpermute((ln ^ o) << 2, __builtin_bit_cast(int, v))); }
template <int CTRL> __device__ __forceinline__ float dppf(float v) { return __builtin_bit_cast(float, __builtin_amdgcn_update_dpp(0, __builtin_bit_cast(int, v), CTRL, 0xF, 0xF, false)); }
__device__ __forceinline__ float gmax8(float v) { v = fmaxf(v, dppf<0xB1>(v)); v = fmaxf(v, dppf<0x4E>(v)); return fmaxf(v, dppf<0x141>(v)); }
__device__ __forceinline__ float gsum8(float v) { v += dppf<0xB1>(v); v += dppf<0x4E>(v); return v + dppf<0x141>(v); }
__device__ __forceinline__ float wave_sum(float v) {
    const int ln_ = lane_id();
#pragma unroll
    for (int o = 1; o < 64; o <<= 1) v += sx(v, o, ln_);
    return v;
}
__device__ __forceinline__ void transpose_item64(const float* W, int N, bf16* WT, int ldt, int k0, int n0, int drow0, LAS float* scr, int lane) {
    const int rr = lane >> 4, cc = (lane & 15) * 4;
    f32x4 v[16];
#pragma unroll
    for (int i = 0; i < 16; ++i) { const int kk = 4 * i + rr; v[i] = *(const GAS f32x4*)(W + (size_t)(k0 + kk) * N + n0 + cc); }
#pragma unroll
    for (int i = 0; i < 16; ++i) { const int kk = 4 * i + rr; LAS float* d = scr + kk * 65 + cc; d[0] = v[i].x; d[1] = v[i].y; d[2] = v[i].z; d[3] = v[i].w; }
    LDS_WAIT(); asm volatile("" ::: "memory");
    const int c = lane & 7;
#pragma unroll
    for (int j = 0; j < 8; ++j) { const int n = (lane >> 3) + 8 * j; const LAS float* s = scr + (8 * c) * 65 + n;
        v4u o; o.x = pk2(s[0 * 65], s[1 * 65]); o.y = pk2(s[2 * 65], s[3 * 65]); o.z = pk2(s[4 * 65], s[5 * 65]); o.w = pk2(s[6 * 65], s[7 * 65]);
        *(GAS v4u*)(WT + (size_t)(drow0 + n) * ldt + k0 + 8 * c) = o; }
    LDS_WAIT(); asm volatile("" ::: "memory");
}
__device__ __forceinline__ int map_in_a(int n) { return n < 768 ? n : (n < 960 ? n + 256 : (n < 1152 ? n + 256 : n - 384)); }
__device__ __forceinline__ int map_in_b(int n) { return n < 768 ? n : (n < 2304 ? n + 256 : n - 1536); }

struct Args { const float* in[19]; float* out; unsigned char* ws; };
typedef const __attribute__((address_space(4))) Args* ArgsP;
__device__ __forceinline__ ArgsP fresh_args() { ArgsP p = (ArgsP)__builtin_amdgcn_kernarg_segment_ptr(); asm volatile("" : "+s"(p)); return p; }
__device__ __forceinline__ gu32* f_ctl() { return (gu32*)(fresh_args()->ws + WS_CTL); }

__device__ __forceinline__ void p0_small_weights(Frame& F, ArgsP A) {
    const int tid_ = fresh_tid(), lane_ = tid_ & 63; (void)tid_; (void)lane_;
    LAS float* scr = (LAS float*)(F.lds + (F.wave < 7 ? RING_OFF + F.wave * 16640 : IDX_OFF));
    unsigned char* ws = A->ws;
    constexpr int I_A = 16 * 22, I_B = 16 * 40, I_M = 16 * 8, I_O = 16 * 16, I_R = 16;
    constexpr int NITEMS = 2 * I_A + 2 * I_B + 4 * I_M + 4 * I_O + 4 * I_R;
    for (int it = f_gw(F); it < NITEMS; it += f_ngw()) {
        int r = it;
        if (r < 2 * I_A) { const int j = r / I_A; r %= I_A; const int kb = r / 22, nb = r % 22;
            transpose_item64(A->in[2] + (size_t)j * D * 1408, 1408, (bf16*)(ws + WS_WINA) + (size_t)j * NPA * D, D, 64 * kb, 64 * nb, map_in_a(64 * nb), scr, lane_); continue; } r -= 2 * I_A;
        if (r < 2 * I_B) { const int j = r / I_B; r %= I_B; const int kb = r / 40, nb = r % 40;
            transpose_item64(A->in[4] + (size_t)j * D * 2560, 2560, (bf16*)(ws + WS_WINB) + (size_t)j * NPB * D, D, 64 * kb, 64 * nb, map_in_b(64 * nb), scr, lane_); continue; } r -= 2 * I_B;
        if (r < 4 * I_M) { const int l = r / I_M; r %= I_M; const int kb = r / 8, nb = r % 8;
            transpose_item64(A->in[7] + (size_t)l * D * 512, 512, (bf16*)(ws + WS_WMKV), D, 64 * kb, 64 * nb, l * 512 + 64 * nb, scr, lane_); continue; } r -= 4 * I_M;
        if (r < 4 * I_O) { const int l = r / I_O; r %= I_O; const int kb = r / 16, nb = r % 16;
            transpose_item64(A->in[8] + (size_t)l * D * D, D, (bf16*)(ws + WS_WOUT) + (size_t)l * D * D, D, 64 * kb, 64 * nb, 64 * nb, scr, lane_); continue; } r -= 4 * I_O;
        { const int l = r / I_R; const int kb = r % I_R;
            transpose_item64(A->in[11] + (size_t)l * D * 64, 64, (bf16*)(ws + WS_WROUT) + (size_t)l * 256 * D, D, 64 * kb, 0, 0, scr, lane_); }
    }
    for (int it = f_gw(F); it < 2 * 128 + 4 * 192; it += f_ngw()) {
        bf16* row = it < 256 ? (bf16*)(ws + WS_WINA) + ((size_t)(it >> 7) * NPA + 1408 + (it & 127)) * D
                             : (bf16*)(ws + WS_WROUT) + ((size_t)((it - 256) / 192) * 256 + 64 + (it - 256) % 192) * D;
        GAS v4u* o = (GAS v4u*)row + lane_;
        o[0] = (v4u){0u, 0u, 0u, 0u}; o[64] = (v4u){0u, 0u, 0u, 0u};
    }
    for (int m0 = 4 * f_gw(F); m0 < 512 + M; m0 += 4 * f_ngw()) {
        f32x4 v[4][4];
#pragma unroll
        for (int r = 0; r < 4; ++r) { const int m = m0 + r; const float* src = m < 512 ? A->in[1] + (size_t)m * D : A->in[0] + (size_t)(m - 512) * D;
            const GAS f32x4* xr = (const GAS f32x4*)src + lane_;
#pragma unroll
            for (int j = 0; j < 4; ++j) v[r][j] = xr[64 * j]; }
#pragma unroll
        for (int r = 0; r < 4; ++r) { const int m = m0 + r; bf16* dst = m < 512 ? (bf16*)(ws + WS_MEMB) + (size_t)m * D : (bf16*)(ws + WS_XB) + (size_t)(m - 512) * D;
            GAS v2u* o8 = (GAS v2u*)dst + lane_;
#pragma unroll
            for (int j = 0; j < 4; ++j) o8[64 * j] = (v2u){pk2(v[r][j].x, v[r][j].y), pk2(v[r][j].z, v[r][j].w)}; }
    }
}
constexpr int CONV_ITEMS = 65 * 192, CONV_UNITS = CONV_ITEMS / 8;
__device__ __forceinline__ void convert_item(ArgsP A, int layer, int it, LAS float* scr, int lane_) {
    bf16* wexp = (bf16*)(A->ws + WS_WEXP);
    const int e = it / 192, mat = (it % 192) >> 6, r = it & 63;
    bf16* dst = wexp + (size_t)e * (pg8::EXPERT_BYTES / 2);
    if (mat < 2) { const float* W = (e < 64) ? A->in[13 + mat] + ((size_t)layer * 64 + e) * (D * HID) : A->in[16 + mat] + (size_t)layer * (D * HID);
        const int kb = r >> 2, nb = r & 3, n0 = 64 * nb;
        transpose_item64(W, HID, dst, D, 64 * kb, n0, (n0 >> 7) * 256 + mat * 128 + (n0 & 127), scr, lane_); }
    else { const float* W = (e < 64) ? A->in[15] + ((size_t)layer * 64 + e) * (HID * D) : A->in[18] + (size_t)layer * (HID * D);
        const int kb = r >> 4, nb = r & 15;
        transpose_item64(W, D, dst + pg8::EXPERT_DOWN_OFF / 2, HID, 64 * kb, 64 * nb, 64 * nb, scr, lane_); }
}
__device__ __forceinline__ void convert_unit(Frame& F, ArgsP A, int layer, int cu) {
    const int tid_ = fresh_tid(), lane_ = tid_ & 63; (void)tid_;
    LAS float* scr = (LAS float*)(F.lds + (F.wave < 7 ? RING_OFF + F.wave * 16640 : IDX_OFF));
    const int it = 8 * cu + F.wave;
    if (it < CONV_ITEMS) convert_item(A, layer, it, scr, lane_);
    asm volatile("s_waitcnt lgkmcnt(0)\n\ts_barrier" ::: "memory");
}
template <bool LAST> __device__ __forceinline__ void ph_combine_ln2(Frame& F, float* xout, const unsigned char* yt, const float* g, const float* b, bf16* xb) {
    typedef float f32x2c __attribute__((ext_vector_type(2)));
    const int tid_ = fresh_tid(), lane_ = tid_ & 63; (void)tid_;
    for (int m = f_gw(F); m < M; m += f_ngw()) {
        GAS v4u* o8 = (GAS v4u*)(xb + (size_t)m * D) + 2 * lane_; const GAS v4u* yr = (const GAS v4u*)(yt + (size_t)m * 9 * D) + lane_;
        float v[16];
#pragma unroll
        for (int i = 0; i < 16; ++i) v[i] = 0.f;
#pragma unroll
        for (int k = 0; k < 9; ++k) { const v4u w = yr[k * 64];
#pragma unroll
            for (int q = 0; q < 4; ++q) { const f32x2c lo = __builtin_amdgcn_cvt_pk_f32_fp8((int)w[q], false), hi = __builtin_amdgcn_cvt_pk_f32_fp8((int)w[q], true);
                v[4 * q] += lo.x; v[4 * q + 1] += lo.y; v[4 * q + 2] += hi.x; v[4 * q + 3] += hi.y; } }
        float s = 0.f;
#pragma unroll
        for (int h = 0; h < 2; ++h) { const v4u xw = o8[h];
#pragma unroll
            for (int q = 0; q < 4; ++q) { v[8 * h + 2 * q] = v[8 * h + 2 * q] * (1.f / pg8::Y8_SCALE) + DN_ALPHA * bflo(xw[q]); v[8 * h + 2 * q + 1] = v[8 * h + 2 * q + 1] * (1.f / pg8::Y8_SCALE) + DN_ALPHA * bfhi(xw[q]); } }
#pragma unroll
        for (int i = 0; i < 16; ++i) s += v[i];
        const float mean = wave_sum(s) * (1.f / D); float s2 = 0.f;
#pragma unroll
        for (int i = 0; i < 16; ++i) { v[i] -= mean; s2 += v[i] * v[i]; }
        const float rstd = 1.f / sqrtf(wave_sum(s2) * (1.f / D) + LN_EPS);
        const GAS f32x4* gp = (const GAS f32x4*)g + 4 * lane_; const GAS f32x4* bp = (const GAS f32x4*)b + 4 * lane_;
        GAS f32x4* xo = (GAS f32x4*)(xout + (size_t)m * D) + 4 * lane_;
        float o[16];
#pragma unroll
        for (int q = 0; q < 4; ++q) { const f32x4 gv = gp[q], bv = bp[q];
            o[4 * q] = v[4 * q] * rstd * gv.x + bv.x; o[4 * q + 1] = v[4 * q + 1] * rstd * gv.y + bv.y; o[4 * q + 2] = v[4 * q + 2] * rstd * gv.z + bv.z; o[4 * q + 3] = v[4 * q + 3] * rstd * gv.w + bv.w;
            if (LAST) xo[q] = (f32x4){o[4 * q], o[4 * q + 1], o[4 * q + 2], o[4 * q + 3]}; }
        if (!LAST) { o8[0] = (v4u){pk2(o[0], o[1]), pk2(o[2], o[3]), pk2(o[4], o[5]), pk2(o[6], o[7])}; o8[1] = (v4u){pk2(o[8], o[9]), pk2(o[10], o[11]), pk2(o[12], o[13]), pk2(o[14], o[15])}; }
    }
}
__device__ __forceinline__ void ph_diff_combine(Frame& F, const bf16* otmp, const float* lq, const float* subg, float lam_init, bf16* cat) {
    const int tid_ = fresh_tid(), lane_ = tid_ & 63; (void)tid_; (void)lane_;
    float lam;
    { const float a = lq[lane_] * lq[64 + lane_], c = lq[128 + lane_] * lq[192 + lane_]; lam = expf(wave_sum(a)) - expf(wave_sum(c)) + lam_init; }
    const int l32 = lane_ & 31, hh = lane_ >> 5;
    const f32x4 gv = ((const GAS f32x4*)subg)[l32]; const float post = 1.f - lam_init;
    for (int m = f_gw(F); m < M; m += f_ngw()) {
#pragma unroll
        for (int hp = 0; hp < 3; ++hp) { const int h = 2 * hp + hh;
            const v2u a0 = *((const GAS v2u*)(otmp + (size_t)m * 1536 + h * 256) + l32), a1 = *((const GAS v2u*)(otmp + (size_t)m * 1536 + h * 256 + 128) + l32);
            f32x4 o; o.x = bflo(a0.x) - lam * bflo(a1.x); o.y = bfhi(a0.x) - lam * bfhi(a1.x); o.z = bflo(a0.y) - lam * bflo(a1.y); o.w = bfhi(a0.y) - lam * bfhi(a1.y);
            float s2 = (o.x * o.x + o.y * o.y) + (o.z * o.z + o.w * o.w);
#pragma unroll
            for (int sft = 1; sft < 32; sft <<= 1) s2 += sx(s2, sft, lane_);
            const float r = post / sqrtf(s2 * (1.f / 128.f) + LN_EPS);
            o = o * r * gv;
            *((GAS v2u*)(cat + (size_t)m * D + h * 128) + l32) = (v2u){pk2(o.x, o.y), pk2(o.z, o.w)}; }
    }
}
__device__ __forceinline__ float ss8(v4u a) { float s = 0.f;
#pragma unroll
    for (int i = 0; i < 4; ++i) { const float lo = bflo(a[i]), hi = bfhi(a[i]); s += lo * lo + hi * hi; } return s; }
__device__ __forceinline__ void ph_qknorm(Frame& F, const bf16* qkv, gu32* gmax) {
    const int tid_ = fresh_tid(), lane_ = tid_ & 63;
    LAS unsigned* lmax = (LAS unsigned*)(F.lds + LDSCTL_OFF) + 32;
    if (tid_ < 24) lmax[tid_] = 0u;
    __syncthreads();
    float mq0 = 0.f, mq1 = 0.f, mk0 = 0.f, mk1 = 0.f;
    const v4u zero = (v4u){0u, 0u, 0u, 0u};
    for (int m = f_gw(F); m < M; m += f_ngw()) {
        const bf16* row = qkv + (size_t)m * NPB;
        const v4u a = *(const GAS v4u*)(row + 8 * lane_), c = *(const GAS v4u*)(row + 1024 + 8 * lane_);
        v4u b = zero, d = zero; if (lane_ < 32) { b = *(const GAS v4u*)(row + 512 + 8 * lane_); d = *(const GAS v4u*)(row + 1536 + 8 * lane_); }
        float sa = ss8(a), sb = ss8(b), sc = ss8(c), sd = ss8(d);
#pragma unroll
        for (int o = 1; o < 8; o <<= 1) { sa += sx(sa, o, lane_); sb += sx(sb, o, lane_); sc += sx(sc, o, lane_); sd += sx(sd, o, lane_); }
        mq0 = fmaxf(mq0, sa); mq1 = fmaxf(mq1, sb); mk0 = fmaxf(mk0, sc); mk1 = fmaxf(mk1, sd);
    }
    if ((lane_ & 7) == 0) { const int g = lane_ >> 3;
        __hip_atomic_fetch_max(lmax + g, __float_as_uint(mq0), __ATOMIC_RELAXED, __HIP_MEMORY_SCOPE_WORKGROUP); __hip_atomic_fetch_max(lmax + 12 + g, __float_as_uint(mk0), __ATOMIC_RELAXED, __HIP_MEMORY_SCOPE_WORKGROUP);
        if (lane_ < 32) { __hip_atomic_fetch_max(lmax + 8 + g, __float_as_uint(mq1), __ATOMIC_RELAXED, __HIP_MEMORY_SCOPE_WORKGROUP); __hip_atomic_fetch_max(lmax + 20 + g, __float_as_uint(mk1), __ATOMIC_RELAXED, __HIP_MEMORY_SCOPE_WORKGROUP); } }
    __syncthreads();
    if (tid_ < 24) __hip_atomic_fetch_max(gmax + tid_, lmax[tid_], RLX_AGENT);
}
typedef short bf16x8r __attribute__((ext_vector_type(8)));
constexpr int RT_SC_OFF = TAB_OFF, RT_GB_OFF = TAB_OFF + 16384, RT_V_OFF = TAB_OFF + 16384 + 8192;
static_assert(RT_V_OFF + 8 * 256 <= LDS_BYTES, "LDS map (route phase)");
template <bool XF32> __device__ __forceinline__ void ph_ln_route(Frame& F, const float* xin, const bf16* y, const float* g, const float* b, bf16* xb, const bf16* wrt, const float* rbias, gu32* cnt, int* rowtok, float* rowgate, float* gtmp) {
    const int tid_ = fresh_tid(), lane_ = tid_ & 63;
    for (int i = tid_; i < 64 * 128; i += NWAVES * 64) { const int e = i >> 7, c = i & 127;
        const v4u v = *(const GAS v4u*)(wrt + (size_t)e * D + c * 8); *(LAS v4u*)(F.lds + e * 2048 + ((c ^ (e & 15)) << 4)) = v; }
    LAS float* lgb = (LAS float*)(F.lds + RT_GB_OFF);
    if (tid_ < 256) { ((LAS f32x4*)lgb)[tid_] = ((const GAS f32x4*)g)[tid_]; ((LAS f32x4*)lgb)[256 + tid_] = ((const GAS f32x4*)b)[tid_]; }
    __syncthreads();
    LAS float* sc = (LAS float*)(F.lds + RT_SC_OFF) + F.wave * 512;
    LAS float* vs = (LAS float*)(F.lds + RT_V_OFF) + F.wave * 64;
    const int r = lane_ & 15, kq = lane_ >> 4; const float bias = rbias[lane_]; const float NINF = -INFINITY;
    for (int base = f_gw(F) * 16; base < M; base += f_ngw() * 16) {
        v2u ry[4][4]; v2u rxb[4][4]; f32x4 rxf[4][4];
#define LN_LOAD(R4) do { _Pragma("unroll") for (int q = 0; q < 4; ++q) { const size_t mo = (size_t)(base + (R4) + q) * D; const GAS v2u* yr = (const GAS v2u*)(y + mo) + lane_; \
            _Pragma("unroll") for (int j = 0; j < 4; ++j) { if (XF32) rxf[q][j] = ((const GAS f32x4*)(xin + mo) + lane_)[64 * j]; else rxb[q][j] = ((const GAS v2u*)(xb + mo) + lane_)[64 * j]; ry[q][j] = yr[64 * j]; } } } while (0)
        LN_LOAD(0);
#pragma unroll
        for (int r4 = 0; r4 < 16; r4 += 4) {
            f32x4 v[4][4]; float s1[4];
#pragma unroll
            for (int q = 0; q < 4; ++q) { s1[q] = 0.f;
#pragma unroll
                for (int j = 0; j < 4; ++j) { f32x4 xv; if (XF32) xv = rxf[q][j]; else { const v2u xw = rxb[q][j]; xv = (f32x4){bflo(xw.x), bfhi(xw.x), bflo(xw.y), bfhi(xw.y)}; }
                    const v2u yv = ry[q][j];
                    v[q][j].x = DN_ALPHA * xv.x + bflo(yv.x); v[q][j].y = DN_ALPHA * xv.y + bfhi(yv.x); v[q][j].z = DN_ALPHA * xv.z + bflo(yv.y); v[q][j].w = DN_ALPHA * xv.w + bfhi(yv.y);
                    s1[q] += (v[q][j].x + v[q][j].y) + (v[q][j].z + v[q][j].w); } }
            if (r4 + 4 < 16) LN_LOAD(r4 + 4);
#pragma unroll
            for (int o = 1; o < 64; o <<= 1) {
#pragma unroll
                for (int q = 0; q < 4; ++q) s1[q] += sx(s1[q], o, lane_); }
            float s2[4];
#pragma unroll
            for (int q = 0; q < 4; ++q) { const float mean = s1[q] * (1.f / D); s2[q] = 0.f;
#pragma unroll
                for (int j = 0; j < 4; ++j) { v[q][j] = v[q][j] - mean; s2[q] += (v[q][j].x * v[q][j].x + v[q][j].y * v[q][j].y) + (v[q][j].z * v[q][j].z + v[q][j].w * v[q][j].w); } }
#pragma unroll
            for (int o = 1; o < 64; o <<= 1) {
#pragma unroll
                for (int q = 0; q < 4; ++q) s2[q] += sx(s2[q], o, lane_); }
#pragma unroll
            for (int q = 0; q < 4; ++q) { const float rstd = 1.f / sqrtf(s2[q] * (1.f / D) + LN_EPS); GAS v2u* o8 = (GAS v2u*)(xb + (size_t)(base + r4 + q) * D) + lane_;
#pragma unroll
                for (int j = 0; j < 4; ++j) { const LAS f32x4* gp = (const LAS f32x4*)lgb + lane_ + 64 * j; const f32x4 gv = gp[0], bv = gp[256];
                    const f32x4 o = v[q][j] * rstd * gv + bv; o8[64 * j] = (v2u){pk2(o.x, o.y), pk2(o.z, o.w)}; } }
        }
#undef LN_LOAD
        asm volatile("s_waitcnt vmcnt(0)" ::: "memory");
        f32x4 acc[4];
#pragma unroll
        for (int nt = 0; nt < 4; ++nt) acc[nt] = (f32x4){0.f, 0.f, 0.f, 0.f};
        const bf16* arow = xb + (size_t)(base + r) * D + 8 * kq;
#pragma unroll 16
        for (int s = 0; s < 32; ++s) { const v4u aw = *(const GAS v4u*)(arow + 32 * s); const bf16x8r af = __builtin_bit_cast(bf16x8r, aw);
#pragma unroll
            for (int nt = 0; nt < 4; ++nt) { const int e = 16 * nt + r, c = 4 * s + kq;
                const bf16x8r bfr = *(const LAS bf16x8r*)(F.lds + e * 2048 + ((c ^ (e & 15)) << 4));
                acc[nt] = __builtin_amdgcn_mfma_f32_16x16x32_bf16(bfr, af, acc[nt], 0, 0, 0); } }
        unsigned selmask = 0u; unsigned long long slots = 0ull; unsigned mycount = 0u;
#pragma unroll 1
        for (int half = 0; half < 2; ++half) {
            if ((r >> 3) == half) {
#pragma unroll
                for (int nt = 0; nt < 4; ++nt) *(LAS f32x4*)(sc + (r & 7) * 64 + 16 * nt + 4 * kq) = acc[nt]; }
            LDS_WAIT(); asm volatile("" ::: "memory");
#pragma unroll 1
            for (int j8 = 0; j8 < 8; ++j8) { const int j = half * 8 + j8;
                const float logit = sc[j8 * 64 + lane_];
                const float aff = 1.f / (1.f + expf(-logit)); const float sel = aff + bias;
                const float m1 = gmax8(sel);
                const unsigned long long bm = __ballot(sel == m1); const unsigned gb = (unsigned)(bm >> (lane_ & 56)) & 0xffu; const int first = __builtin_ctz(gb | 0x100u);
                const float m2 = gmax8(((lane_ & 7) == first) ? NINF : sel);
                const float gs = m1 + m2; int grank = 0;
#pragma unroll
                for (int g2 = 0; g2 < 8; ++g2) { const float o = __builtin_bit_cast(float, __builtin_amdgcn_readlane(__builtin_bit_cast(int, gs), 8 * g2)); grank += (o > gs || (o == gs && g2 < (lane_ >> 3))) ? 1 : 0; }
                const bool gok = grank < 4; const float v = gok ? sel : NINF; int er = 0;
                vs[lane_] = v; LDS_WAIT(); asm volatile("" ::: "memory");
#pragma unroll
                for (int e4 = 0; e4 < 16; ++e4) { const f32x4 o = ((const LAS f32x4*)vs)[e4]; er += ((o.x > v) ? 1 : 0) + ((o.y > v) ? 1 : 0) + ((o.z > v) ? 1 : 0) + ((o.w > v) ? 1 : 0); }
                bool chosen = gok && er < 8;
                if (__builtin_popcountll(__ballot(chosen)) != 8) {
                    er = 0;
#pragma unroll 4
                    for (int e2 = 0; e2 < 64; ++e2) { const float o = vs[e2]; er += (o > v || (o == v && e2 < lane_)) ? 1 : 0; }
                    chosen = gok && er < 8; }
                asm volatile("" ::: "memory");
                const float cs = gsum8(chosen ? aff : 0.f); float ssum = 0.f;
#pragma unroll
                for (int g2 = 0; g2 < 8; ++g2) ssum += __builtin_bit_cast(float, __builtin_amdgcn_readlane(__builtin_bit_cast(int, cs), 8 * g2));
                const unsigned long long bal = __ballot(chosen); const unsigned slot = __builtin_amdgcn_mbcnt_hi((unsigned)(bal >> 32), __builtin_amdgcn_mbcnt_lo((unsigned)bal, 0u));
                if (chosen) { selmask |= 1u << j; slots |= (unsigned long long)slot << (4 * j); ++mycount; gtmp[(size_t)(base + j) * 64 + lane_] = aff / ssum * 2.5f; }
            }
            LDS_WAIT(); asm volatile("" ::: "memory");
        }
        unsigned pos = 0u;
        { LAS unsigned* wgc = (LAS unsigned*)(F.lds + LDSCTL_OFF) + 64;
            if (tid_ < 64) wgc[tid_] = 0u;
            __syncthreads();
            if (mycount) pos = __hip_atomic_fetch_add(wgc + lane_, mycount, __ATOMIC_RELAXED, __HIP_MEMORY_SCOPE_WORKGROUP);
            __syncthreads();
            if (tid_ < 64) { const unsigned tot = wgc[tid_]; unsigned gb = 0u; if (tot) gb = __hip_atomic_fetch_add(cnt + 64 * tid_, tot, RLX_AGENT); wgc[tid_] = gb; }
            __syncthreads();
            pos += wgc[lane_];
            __syncthreads(); }
#pragma unroll 1
        for (int j = 0; j < 16; ++j) if ((selmask >> j) & 1u) { const size_t at = (size_t)lane_ * CAP + pos; ++pos;
            rowtok[at] = (base + j) | ((int)((slots >> (4 * j)) & 15ull) << 16); rowgate[at] = gtmp[(size_t)(base + j) * 64 + lane_]; }
    }
}
template <bool M1> __device__ __forceinline__ int build_units(Frame& F, gu32* cnt, const int* rowtok, const float* rowgate) {
    const int tid_ = fresh_tid();
    LAS int* tcnt = (LAS int*)(F.lds + TAB_OFF); LAS int* bst = tcnt + 80; LAS int* utab = tcnt + 160; LAS int* idx = (LAS int*)(F.lds + IDX_OFF); LAS float* lgate = (LAS float*)(F.lds + GATE_OFF);
    if (tid_ < 64) {
        const int c = (int)__hip_atomic_load(cnt + 64 * tid_, RLX_AGENT); const int nb = (c + 255) >> 8; int incl = nb;
#pragma unroll
        for (int o = 1; o < 64; o <<= 1) { const int u = __builtin_amdgcn_ds_bpermute((tid_ - o) << 2, incl); if (tid_ >= o) incl += u; }
        tcnt[tid_] = c; bst[tid_] = incl - nb;
        if (tid_ == 63) { tcnt[64] = M; bst[64] = incl; bst[65] = incl + M / 256; }
    }
    __syncthreads();
    const int nblk = bst[65]; const int bx = blockIdx.x;
    const int per = M1 ? 128 : 64, blk0 = M1 ? (16 * (bx & 7) + (bx >> 4)) : (8 * (bx & 7) + (bx >> 5)), pn = M1 ? ((bx >> 3) & 1) : ((bx >> 3) & 3);
    int nmine = (nblk > blk0) ? (nblk - blk0 + per - 1) / per : 0; if (nmine > (M1 ? 10 : 20)) nmine = M1 ? 10 : 20;
    if (tid_ < nmine) { const int blk = tid_ * per + blk0;
        int e = 0;
#pragma unroll
        for (int st = 64; st > 0; st >>= 1) { const int q = e + st; if (q <= 64 && bst[q] <= blk) e = q; }
        const int j = blk - bst[e]; int nv = tcnt[e] - 256 * j; if (nv > 256) nv = 256;
        LAS int* t = utab + tid_ * 8; t[0] = e; t[1] = blk; t[2] = pn; t[3] = nv; t[4] = e * CAP + 256 * j; t[5] = 256 * j; }
    __syncthreads();
    for (int q = tid_; q < nmine * 256; q += NWAVES * 64) { const int g = q >> 8, i = q & 255;
        const LAS int* t = utab + g * 8; const int e = t[0], nv = t[3];
        if (M1) { int tok = 0; float gt = 0.f;
            if (e == 64) { tok = t[5] + i; gt = 1.f; } else if (i < nv) { tok = rowtok[t[4] + i] & 0xffff; gt = rowgate[t[4] + i]; }
            idx[q] = tok; lgate[q] = gt; }
        else { int dst = M * 9;
            if (e == 64) dst = (t[5] + i) * 9 + 8; else if (i < nv) { const int v = rowtok[t[4] + i]; dst = (v & 0xffff) * 9 + (v >> 16); }
            idx[q] = dst; } }
    __syncthreads();
    return nmine;
}
#define WSP(T, off) ((T*)(A->ws + (off)))
#ifndef REP_P1
#define REP_P1 1
#endif
#ifndef REP_P2
#define REP_P2 1
#endif
#ifndef REP_P3
#define REP_P3 1
#endif
#ifndef REP_P5
#define REP_P5 1
#endif
#ifndef REP_P7
#define REP_P7 1
#endif
#ifndef REP_P8
#define REP_P8 1
#endif
#define REPEAT(n) _Pragma("unroll 1") for (int rep_ = 0; rep_ < (n); ++rep_)
#define OPQ(x) asm volatile("" : "+s"(x))
#define FCTL() f_ctl()
#define FRESH_GB() const int G = f_G(), bx = f_bx(); (void)G; (void)bx
__global__ void __launch_bounds__(NWAVES * 64, 2) mega_fwd(Args args_unused) {
    extern __shared__ __attribute__((aligned(16))) unsigned char lds[];
    Frame F;
    F.lds = (LAS unsigned char*)lds;
    F.wave = __builtin_amdgcn_readfirstlane((int)threadIdx.x >> 6);
    for (int u = fresh_tid(); u < 512 / 4; u += NWAVES * 64) ((LAS unsigned*)(F.lds + LDSCTL_OFF))[u] = 0u;
    __syncthreads();
    (void)xcd_barrier_post((unsigned*)(f_ctl() + CW_BAR), f_misc(F) + 8, fresh_tid() == 0);
#define GRID_BAR() do { XcdBarrier bar_; bar_.bar = (unsigned*)(f_ctl() + CW_BAR); bar_.x = xb_xcc_id(); bar_.st = f_misc(F) + 8; xcd_barrier(bar_, fresh_tid() == 0); } while (0)

    { ArgsP A = fresh_args(); FRESH_GB(); p0_small_weights(F, A); }
    GRID_BAR();
    {   ArgsP A = fresh_args(); FRESH_GB();
        pg8::DenseSched S; S.init(512, 2048, D, G, bx, WSP(const bf16, WS_WMKV));
        pg8::EpiBf16 E{WSP(bf16, WS_MEMKV), 2048, 0, 1.f};
        pg8::gemm_phase<pg8::EpiBf16, pg8::DenseSched>(F.lds + RING_OFF, WSP(const bf16, WS_MEMB), D, S, E, F.wave); }

    for (int layer = 0; layer < DEPTH; ++layer) {
        const int jm = layer >> 1; const bool isB = (layer & 1) != 0;
        REPEAT(REP_P1) {
        if (!isB) { ArgsP A = fresh_args(); FRESH_GB();
            pg8::DenseSched S; S.init(M, NPA, D, G, bx, WSP(const bf16, WS_WINA) + (size_t)jm * NPA * D);
            pg8::EpiBf16 E{WSP(bf16, WS_QKV), NPA, 4, attn_body::C2};
            pg8::gemm_phase<pg8::EpiBf16, pg8::DenseSched>(F.lds + RING_OFF, WSP(const bf16, WS_XB), D, S, E, F.wave); }
        else { ArgsP A = fresh_args(); FRESH_GB();
            pg8::DenseSched S; S.init(M, NPB, D, G, bx, WSP(const bf16, WS_WINB) + (size_t)jm * NPB * D);
            pg8::EpiBf16 E{WSP(bf16, WS_QKV), NPB, 4, attn_body::C2};
            pg8::gemm_phase<pg8::EpiBf16, pg8::DenseSched>(F.lds + RING_OFF, WSP(const bf16, WS_XB), D, S, E, F.wave); }
        GRID_BAR();
        }
        if (isB) {
            ArgsP A = fresh_args();
            ph_qknorm(F, WSP(const bf16, WS_QKV), FCTL() + CW_NORM + 64 * layer);
            GRID_BAR();
        }
        REPEAT(REP_P2) {
        if (!isB) {
            { FRESH_GB();
            for (int L = bx; L < 1536; L += G) {
                ArgsP A = fresh_args(); const bf16* qkv = WSP(const bf16, WS_QKV); const int wave = F.wave;
                const int b = L / 768, rem = L % 768, qblk = rem / 3, kvh = rem % 3;
                const int q0u = qblk * 64, head = kvh * 4 + (wave >> 1); const size_t rowq = (size_t)b * SEQ + q0u + 32 * (wave & 1);
                attn_body::AttnArgs a;
                a.Qw = (const attn_body::bf16*)(qkv + rowq * NPA + head * 64);
                a.K0 = (const attn_body::bf16*)(qkv + ((size_t)b * SEQ + q0u) * NPA + 1024 + kvh * 64); a.V0 = a.K0 + 192;
                a.NT = 4; a.tmax = qblk; a.Ow = (attn_body::bf16*)(WSP(bf16, WS_CAT) + rowq * D + head * 64);
                a.qrel = 32 * (wave & 1) + (fresh_tid() & 31); a.slope2 = SLOPES_A[head] * attn_body::LOG2E; a.sink2 = A->in[3][jm * 12 + head] * attn_body::LOG2E; a.wave = F.wave;
                attn_body::attn_unit<2, 8, NPA, NPA, D>(a, (char*)lds + RING_OFF);
                convert_unit(F, A, layer, L);
            }
            for (int cu = 1536 + bx; cu < CONV_UNITS; cu += G) { ArgsP A = fresh_args(); convert_unit(F, A, layer, cu); } }
            { FRESH_GB();
            for (int L = bx; L < 512; L += G) {
                ArgsP A = fresh_args(); const int wave = F.wave;
                const int b = L / 256, rem = L % 256, qb = rem >> 2, hm = rem & 3;
                const size_t rowq = (size_t)b * SEQ + qb * 256 + 32 * wave;
                attn_body::AttnArgs a;
                a.Qw = (const attn_body::bf16*)(WSP(const bf16, WS_QKV) + rowq * NPA + 768 + hm * 64);
                a.K0 = (const attn_body::bf16*)(WSP(const bf16, WS_MEMKV) + (size_t)b * MEMLEN * 2048 + layer * 512 + hm * 64); a.V0 = a.K0 + 256;
                a.NT = 4; a.tmax = 1 << 30; a.Ow = (attn_body::bf16*)(WSP(bf16, WS_CAT) + rowq * D + 768 + hm * 64);
                a.qrel = 32 * wave + (fresh_tid() & 31); a.slope2 = 0.f; a.sink2 = 0.f; a.wave = F.wave;
                attn_body::attn_unit<0, 8, NPA, 2048, D>(a, (char*)lds + RING_OFF);
            } }
        } else {
            {
                gu32* q0 = FCTL() + CW_Q + 64 * layer + 16 * rep_;
                int turn = 0; bool doneA = false, doneC = false, have = true; unsigned nextL = 0u;
                if (fresh_tid() == 0) nextL = __hip_atomic_fetch_add(q0, 1u, RLX_AGENT);
                for (;;) {
                    if (!have) { if (fresh_tid() == 0) nextL = __hip_atomic_fetch_add(q0 + turn, 1u, RLX_AGENT); }
                    if (fresh_tid() == 0) f_misc(F)[16] = nextL;
                    __syncthreads();
                    const int L = __builtin_amdgcn_readfirstlane((int)f_misc(F)[16]);
                    __syncthreads();
                    have = false;
                    if (L >= (turn ? CONV_UNITS : 1536)) { if (turn) doneC = true; else doneA = true; if (doneA && doneC) break; turn ^= 1; continue; }
                    const int nturn = turn ? (doneA ? 1 : 0) : (doneC ? 0 : 1);
                    if (turn | nturn) { if (fresh_tid() == 0) nextL = __hip_atomic_fetch_add(q0 + nturn, 1u, RLX_AGENT); have = true; }
                    ArgsP A = fresh_args(); const bf16* qkv = WSP(const bf16, WS_QKV); const int wave = F.wave;
                    if (turn) { convert_unit(F, A, layer, L); turn = nturn; continue; }
                    turn = nturn;
                    const int qb = 63 - L / 24, rem = L % 24, b = rem / 12, hc = rem % 12, h = hc >> 1, c = hc & 1;
                    const size_t rowq = (size_t)b * SEQ + qb * 256 + 32 * wave;
                    const float slope2 = SLOPES_B[h] * attn_body::LOG2E;
                    const float q2m = __uint_as_float(__hip_atomic_load(FCTL() + CW_NORM + 64 * layer + hc, RLX_AGENT)), k2m = __uint_as_float(__hip_atomic_load(FCTL() + CW_NORM + 64 * layer + 12 + hc, RLX_AGENT));
                    const float B2 = sqrtf(q2m * k2m) * 1.03f + 0.5f, dcut = (160.f + 2.f * B2) / slope2;
                    int t0 = (int)floorf(((float)(qb * 256 - 63) - dcut) * (1.f / 64.f)); t0 = __builtin_amdgcn_readfirstlane(t0 > 0 ? (t0 & ~1) : 0);
                    attn_body::AttnArgs a;
                    a.Qw = (const attn_body::bf16*)(qkv + rowq * NPB + hc * 64);
                    a.K0 = (const attn_body::bf16*)(qkv + ((size_t)b * SEQ + 64 * t0) * NPB + 1024 + hc * 64); a.V0 = (const attn_body::bf16*)(qkv + ((size_t)b * SEQ + 64 * t0) * NPB + 1792 + h * 128);
                    a.NT = 4 * (qb + 1) - t0; a.tmax = 1 << 30; a.Ow = (attn_body::bf16*)(WSP(bf16, WS_OTMP) + rowq * 1536 + hc * 128);
                    a.qrel = 32 * wave + (fresh_tid() & 31); a.slope2 = slope2; a.sink2 = 0.f; a.wave = F.wave;
                    attn_body::diff_unit<16, NPB, NPB, 1536>(a, (char*)lds + RING_OFF);
                }
            }
            { FRESH_GB();
            for (int L = bx; L < 512; L += G) {
                ArgsP A = fresh_args(); const int wave = F.wave;
                const int b = L / 256, rem = L % 256, qb = rem >> 2, hm = rem & 3;
                const size_t rowq = (size_t)b * SEQ + qb * 256 + 32 * wave;
                attn_body::AttnArgs a;
                a.Qw = (const attn_body::bf16*)(WSP(const bf16, WS_QKV) + rowq * NPB + 768 + hm * 64);
                a.K0 = (const attn_body::bf16*)(WSP(const bf16, WS_MEMKV) + (size_t)b * MEMLEN * 2048 + layer * 512 + hm * 64); a.V0 = a.K0 + 256;
                a.NT = 4; a.tmax = 1 << 30; a.Ow = (attn_body::bf16*)(WSP(bf16, WS_CAT) + rowq * D + 768 + hm * 64);
                a.qrel = 32 * wave + (fresh_tid() & 31); a.slope2 = 0.f; a.sink2 = 0.f; a.wave = F.wave;
                attn_body::attn_unit<0, 8, NPB, 2048, D>(a, (char*)lds + RING_OFF);
            } }
        }
        GRID_BAR();
        }
        if (isB) {
            ArgsP A = fresh_args(); FRESH_GB();
            ph_diff_combine(F, WSP(const bf16, WS_OTMP), A->in[5] + jm * 256, A->in[6] + jm * 128, 0.8f - 0.6f * expf(-0.3f * (float)layer), WSP(bf16, WS_CAT));
            GRID_BAR();
        }
        REPEAT(REP_P3) {
        {   ArgsP A = fresh_args(); FRESH_GB();
            pg8::DenseSched S; S.init(M, D, D, G, bx, WSP(const bf16, WS_WOUT) + (size_t)layer * D * D);
            pg8::EpiBf16 E{WSP(bf16, WS_Y), D, 0, 1.f};
            pg8::gemm_phase<pg8::EpiBf16, pg8::DenseSched>(F.lds + RING_OFF, WSP(const bf16, WS_CAT), D, S, E, F.wave); }
        GRID_BAR();
        }
        {   ArgsP A = fresh_args();
            if (layer == 0) ph_ln_route<true>(F, A->in[0], WSP(const bf16, WS_Y), A->in[9] + (size_t)(layer * 2) * D, A->in[10] + (size_t)(layer * 2) * D, WSP(bf16, WS_XB), WSP(const bf16, WS_WROUT) + (size_t)layer * 256 * D, A->in[12] + layer * 64, FCTL() + CW_CNT + layer * 64 * 64, WSP(int, WS_ROWTOK), WSP(float, WS_ROWGATE), WSP(float, WS_LOGIT));
            else ph_ln_route<false>(F, nullptr, WSP(const bf16, WS_Y), A->in[9] + (size_t)(layer * 2) * D, A->in[10] + (size_t)(layer * 2) * D, WSP(bf16, WS_XB), WSP(const bf16, WS_WROUT) + (size_t)layer * 256 * D, A->in[12] + layer * 64, FCTL() + CW_CNT + layer * 64 * 64, WSP(int, WS_ROWTOK), WSP(float, WS_ROWGATE), WSP(float, WS_LOGIT)); }
        GRID_BAR();
        REPEAT(REP_P7) {
        {   ArgsP A = fresh_args(); FRESH_GB();
            const int nmine = build_units<true>(F, FCTL() + CW_CNT + layer * 64 * 64, WSP(const int, WS_ROWTOK), WSP(const float, WS_ROWGATE));
            pg8::GroupSched<true> S{(const LAS int*)(F.lds + TAB_OFF) + 160, (const LAS int*)(F.lds + IDX_OFF), nmine, D, (const char*)(A->ws + WS_WEXP)};
            pg8::EpiM1 E{WSP(bf16, WS_HB), (const LAS float*)(F.lds + GATE_OFF)};
            pg8::gemm_phase<pg8::EpiM1, pg8::GroupSched<true>>(F.lds + RING_OFF, WSP(const bf16, WS_XB), D, S, E, F.wave); }
        GRID_BAR();
        }
        REPEAT(REP_P8) {
        {   ArgsP A = fresh_args(); FRESH_GB();
            const int nmine = build_units<false>(F, FCTL() + CW_CNT + layer * 64 * 64, WSP(const int, WS_ROWTOK), WSP(const float, WS_ROWGATE));
            pg8::GroupSched<false> S{(const LAS int*)(F.lds + TAB_OFF) + 160, (const LAS int*)(F.lds + IDX_OFF), nmine, HID, (const char*)(A->ws + WS_WEXP) + pg8::EXPERT_DOWN_OFF};
            pg8::EpiM2 E{WSP(unsigned char, WS_BIG), (const LAS int*)(F.lds + IDX_OFF)};
            pg8::gemm_phase<pg8::EpiM2, pg8::GroupSched<false>>(F.lds + RING_OFF, WSP(const bf16, WS_HB), HID, S, E, F.wave); }
        GRID_BAR();
        }
        {   ArgsP A = fresh_args(); FRESH_GB();
            if (layer + 1 < DEPTH) ph_combine_ln2<false>(F, A->out, WSP(const unsigned char, WS_BIG), A->in[9] + (size_t)(layer * 2 + 1) * D, A->in[10] + (size_t)(layer * 2 + 1) * D, WSP(bf16, WS_XB));
            else ph_combine_ln2<true>(F, A->out, WSP(const unsigned char, WS_BIG), A->in[9] + (size_t)(layer * 2 + 1) * D, A->in[10] + (size_t)(layer * 2 + 1) * D, WSP(bf16, WS_XB));
            }
        if (layer + 1 < DEPTH) GRID_BAR();
    }
    if (__hip_atomic_load(FCTL() + CW_BAR + XB_TMO, RLX_AGENT) != 0u) {
        __syncthreads();
        ArgsP A = fresh_args(); FRESH_GB(); float* xf = A->out;
        const float q = __builtin_nanf("");
        for (int m = f_gw(F); m < M; m += f_ngw()) { GAS f32x4* o = (GAS f32x4*)(xf + (size_t)m * D) + (fresh_tid() & 63);
#pragma unroll
            for (int j = 0; j < 4; ++j) o[64 * j] = (f32x4){q, q, q, q}; }
    }
}

extern "C" void kernel_launch(void* const* d_in, const int* in_sizes, int n_in, void* d_out, int out_size, void* d_ws, size_t ws_size, hipStream_t stream) {
    static int grid = 0;
    if (grid == 0) {
        if (n_in != 19 || in_sizes[0] != M * D || out_size != M * D || ws_size < WS_END) { fprintf(stderr, "kernel_launch: shape / workspace mismatch (n_in %d, in0 %d, out %d, ws %zu, need %zu); nothing launched\n", n_in, n_in > 0 ? in_sizes[0] : -1, out_size, ws_size, (size_t)WS_END); grid = -1; return; }
        int dev = 0, cus = 0, per_cu = 0;
        if (hipGetDevice(&dev) != hipSuccess || hipDeviceGetAttribute(&cus, hipDeviceAttributeMultiprocessorCount, dev) != hipSuccess) { grid = -1; return; }
        if (hipFuncSetAttribute((const void*)mega_fwd, hipFuncAttributeMaxDynamicSharedMemorySize, LDS_BYTES) != hipSuccess) { fprintf(stderr, "kernel_launch: hipFuncSetAttribute failed\n"); grid = -1; return; }
        if (hipOccupancyMaxActiveBlocksPerMultiprocessor(&per_cu, (const void*)mega_fwd, NWAVES * 64, LDS_BYTES) != hipSuccess || per_cu < 1) { fprintf(stderr, "kernel_launch: occupancy query reports %d\n", per_cu); }
        (void)hipGetLastError();
        grid = cus;
        if (grid != 256) { fprintf(stderr, "kernel_launch: built for 256 CUs, device has %d; nothing launched\n", cus); grid = -1; return; }
    }
    if (grid < 0) return;
    if (hipMemsetAsync((char*)d_ws + WS_CTL, 0, CTL_ZERO_BYTES, stream) != hipSuccess) return;
    Args a{};
    for (int i = 0; i < 19; ++i) a.in[i] = (const float*)d_in[i];
    a.out = (float*)d_out; a.ws = (unsigned char*)d_ws;
    hipLaunchKernelGGL(mega_fwd, dim3(grid), dim3(NWAVES * 64), LDS_BYTES, stream, a);
}
```

```cpp
#include <hip/hip_runtime.h>
#include <hip/hip_bf16.h>
#include <cstdio>
#include <cstdint>
#include <cmath>

namespace pg8 {
#define PG8_LAS __attribute__((address_space(3)))
typedef unsigned short bf16_t;
typedef short bf16x8 __attribute__((ext_vector_type(8)));
typedef float f32x4 __attribute__((ext_vector_type(4)));
typedef unsigned u32x4 __attribute__((ext_vector_type(4)));
constexpr int BM = 256, BK = 64, HALF = 128, HTB = HALF * BK * 2  , STAGE_BYTES = 8 * HTB, NXCD = 8, WGM = 8;
constexpr int EXPERT_BYTES = 3 * 1024 * 256 * 2;
constexpr int EXPERT_DOWN_OFF = 2 * 1024 * 256 * 2;

__host__ __device__ __forceinline__ int lds_byte(int r, int c) { const int st = (r >> 4) * 2 + (c >> 5), rr = r & 15, cc = c & 31, ob = rr * 64 + cc * 2; return st * 1024 + (ob ^ (((ob >> 9) & 1) << 5)); }
__host__ __device__ __forceinline__ void stage_rc(int b, int& R, int& C) { const int st = b / 1024, sb = b % 1024, swz = sb ^ (((sb >> 9) & 1) << 5); R = (st >> 1) * 16 + swz / 64; C = (st & 1) * 32 + (swz % 64) / 2; }
__host__ __device__ __forceinline__ int perm32(int rho) { const int n = rho >> 4, i = rho & 15; return 8 * (i >> 2) + 4 * n + (i & 3); }

struct Unit { int pm, pn, e, nvalid, lbase, pos0, slot; };

struct StaticOrder {
    int nM, nN, nwg, G, c;
    __device__ __forceinline__ void init(int M, int N, int G_, int c_) { nM = M / BM; nN = N / BM; nwg = nM * nN; G = G_; c = c_; }
    __device__ __forceinline__ bool next(int i, Unit& u) const {
        const long L = (long)i * G + c; if (L >= nwg) return false;
        int wgid = (int)L; { const int q = nwg / NXCD, r = nwg % NXCD, xcd = wgid % NXCD, off = wgid / NXCD; wgid = (xcd < r ? xcd * (q + 1) : r * (q + 1) + (xcd - r) * q) + off; }
        const int nig = WGM * nN, gid = wgid / nig, fm = gid * WGM, gsz = (nM - fm) < WGM ? (nM - fm) : WGM;
        u.pm = fm + ((wgid % nig) % gsz); u.pn = (wgid % nig) / gsz; return true;
    }
};
struct DenseSched {
    StaticOrder o; const char* Bt; int K;
    __device__ __forceinline__ void init(int M, int N, int K_, int G, int c, const bf16_t* Bt_) { o.init(M, N, G, c); Bt = (const char*)Bt_; K = K_; }
    __device__ __forceinline__ bool next(int i, Unit& u) const { u.e = 0; u.nvalid = 256; u.lbase = 0; u.pos0 = 0; u.slot = 0; return o.next(i, u); }
    __device__ __forceinline__ const char* bptr(const Unit& u) const { return Bt + (size_t)u.pn * (BM * 2) * K; }
    __device__ __forceinline__ void avoff(const Unit& u, int tid, unsigned (&v)[2][2]) const {
#pragma unroll
        for (int i = 0; i < 2; ++i) { int R, C; stage_rc(tid * 16 + i * 8192, R, C);
#pragma unroll
            for (int h = 0; h < 2; ++h) v[h][i] = (unsigned)((u.pm * BM + h * HALF + R) * K + C) * 2u; }
    }
};
template <bool GATHER> struct GroupSched {
    const PG8_LAS int* utab; const PG8_LAS int* idx; int nmine, K; const char* W;
    __device__ __forceinline__ bool next(int i, Unit& u) const {
        if (i >= nmine) return false; const PG8_LAS int* t = utab + i * 8;
        u.e = __builtin_amdgcn_readfirstlane(t[0]); u.pm = __builtin_amdgcn_readfirstlane(t[1]); u.pn = __builtin_amdgcn_readfirstlane(t[2]);
        u.nvalid = __builtin_amdgcn_readfirstlane(t[3]); u.lbase = __builtin_amdgcn_readfirstlane(t[4]); u.pos0 = __builtin_amdgcn_readfirstlane(t[5]); u.slot = i; return true;
    }
    __device__ __forceinline__ const char* bptr(const Unit& u) const { return W + (size_t)u.e * EXPERT_BYTES + (size_t)u.pn * (BM * 2) * K; }
    __device__ __forceinline__ void avoff(const Unit& u, int tid, unsigned (&v)[2][2]) const {
#pragma unroll
        for (int i = 0; i < 2; ++i) { int R, C; stage_rc(tid * 16 + i * 8192, R, C);
#pragma unroll
            for (int h = 0; h < 2; ++h) {
                const int row = GATHER ? idx[u.slot * 256 + h * HALF + R] : (u.pm * BM + h * HALF + R);
                v[h][i] = (unsigned)(row * K + C) * 2u; } }
    }
};

typedef float f32x2v __attribute__((ext_vector_type(2))); typedef __bf16 bf16x2v __attribute__((ext_vector_type(2)));
__device__ __forceinline__ unsigned cvt_pk_bf16(float lo, float hi) { f32x2v v = {lo, hi}; bf16x2v b = __builtin_convertvector(v, bf16x2v); return __builtin_bit_cast(unsigned, b); }

struct EpiBf16 {
    static constexpr bool PERM = true; static constexpr int NST = 16;
    bf16_t* O; int ldc; int nsc; float scale;
    __device__ __forceinline__ void operator()(const f32x4 (&acc)[2][2][4][2], const Unit& u, int wr, int wc, int fr, int fq) const {
        const int row0 = u.pm * BM + wr * 64 + fr; const int col0 = u.pn * BM + wc * 32 + 8 * fq; const float sc = (u.pn < nsc) ? scale : 1.f;
#pragma unroll
        for (int ai = 0; ai < 2; ++ai)
#pragma unroll
            for (int m = 0; m < 4; ++m) { bf16_t* rowp = O + (size_t)(row0 + ai * HALF + m * 16) * ldc + col0;
#pragma unroll
                for (int bj = 0; bj < 2; ++bj) { const f32x4 v0 = acc[ai][bj][m][0] * sc, v1 = acc[ai][bj][m][1] * sc;
                    u32x4 w; w.x = cvt_pk_bf16(v0[0], v0[1]); w.y = cvt_pk_bf16(v0[2], v0[3]); w.z = cvt_pk_bf16(v1[0], v1[1]); w.w = cvt_pk_bf16(v1[2], v1[3]);
                    *(u32x4*)(rowp + bj * HALF) = w; } }
    }
};
__device__ __forceinline__ float silu_f(float x) { return x * __builtin_amdgcn_rcpf(1.0f + __builtin_amdgcn_exp2f(-1.4426950408889634f * x)); }
struct EpiM1 {
    static constexpr bool PERM = true; static constexpr int NST = 8;
    bf16_t* H; const PG8_LAS float* lgate;
    __device__ __forceinline__ void operator()(const f32x4 (&acc)[2][2][4][2], const Unit& u, int wr, int wc, int fr, int fq) const {
        const int col0 = u.pn * HALF + wc * 32 + 8 * fq; const PG8_LAS float* lg = lgate + u.slot * 256;
#pragma unroll
        for (int ai = 0; ai < 2; ++ai)
#pragma unroll
            for (int m = 0; m < 4; ++m) { const int r = ai * HALF + wr * 64 + m * 16 + fr;
                const float g = lg[r];
                const f32x4 ga = acc[ai][0][m][0], gb = acc[ai][0][m][1], ua = acc[ai][1][m][0], ub = acc[ai][1][m][1];
                f32x4 v0, v1;
#pragma unroll
                for (int j = 0; j < 4; ++j) { v0[j] = silu_f(ga[j]) * ua[j] * g; v1[j] = silu_f(gb[j]) * ub[j] * g; }
                u32x4 w; w.x = cvt_pk_bf16(v0[0], v0[1]); w.y = cvt_pk_bf16(v0[2], v0[3]); w.z = cvt_pk_bf16(v1[0], v1[1]); w.w = cvt_pk_bf16(v1[2], v1[3]);
                *(u32x4*)(H + (size_t)(u.pm * BM + r) * 256 + col0) = w; }
    }
};
constexpr float Y8_SCALE = 16.f;
typedef unsigned u32x2e __attribute__((ext_vector_type(2)));
struct EpiM2 {
    static constexpr bool PERM = true; static constexpr int NST = 16;
    unsigned char* Y; const PG8_LAS int* ldst;
    __device__ __forceinline__ void operator()(const f32x4 (&acc)[2][2][4][2], const Unit& u, int wr, int wc, int fr, int fq) const {
        const int col0 = u.pn * BM + wc * 32 + 8 * fq; const PG8_LAS int* ld = ldst + u.slot * 256;
#pragma unroll
        for (int ai = 0; ai < 2; ++ai)
#pragma unroll
            for (int m = 0; m < 4; ++m) { const int r = ai * HALF + wr * 64 + m * 16 + fr;
                const int dst = ld[r];
                {
                    unsigned char* rowp = Y + (size_t)dst * 1024 + col0;
#pragma unroll
                    for (int bj = 0; bj < 2; ++bj) { const f32x4 v0 = acc[ai][bj][m][0] * Y8_SCALE, v1 = acc[ai][bj][m][1] * Y8_SCALE;
                        int w0 = __builtin_amdgcn_cvt_pk_fp8_f32(v0[0], v0[1], 0, false); w0 = __builtin_amdgcn_cvt_pk_fp8_f32(v0[2], v0[3], w0, true);
                        int w1 = __builtin_amdgcn_cvt_pk_fp8_f32(v1[0], v1[1], 0, false); w1 = __builtin_amdgcn_cvt_pk_fp8_f32(v1[2], v1[3], w1, true);
                        *(u32x2e*)(rowp + bj * HALF) = (u32x2e){(unsigned)w0, (unsigned)w1}; } } }
    }
};

template <class Epi, class Sched>
__device__ __forceinline__ void gemm_phase(PG8_LAS unsigned char* lds, const bf16_t* Abase, const int K, const Sched& S, const Epi& E, int wave_) {
    asm volatile("" : "+s"(wave_)); unsigned am_; asm volatile("s_mov_b32 %0, -1" : "=s"(am_));
    const int tid = (wave_ << 6) | (int)__builtin_amdgcn_mbcnt_hi(am_, __builtin_amdgcn_mbcnt_lo(am_, 0u));
    const int wid = __builtin_amdgcn_readfirstlane(tid >> 6), lane = tid & 63, wr = wid >> 2, wc = wid & 3, fr = lane & 15, fq = lane >> 4;
    const int nt = K / BK;
    unsigned voffB[2];
#pragma unroll
    for (int i = 0; i < 2; ++i) { int R, C; stage_rc(tid * 16 + i * 8192, R, C); const int Rb = Epi::PERM ? ((R & ~31) + perm32(R & 31)) : R; voffB[i] = (unsigned)(Rb * K + C) * 2u; }
    const size_t kstep = (size_t)(BK * 2);
    const size_t hstep = (size_t)HALF * K * 2;
    const unsigned ldsw = (unsigned)wid * 1024u;
    const int aoff = lds_byte(wr * 64 + fr, fq * 8), boff = lds_byte(wc * 32 + fr, fq * 8);
    const char* Ab = (const char*)Abase;
#define PG8_SA(b, h) (((b) * 2 + (h)) * HTB)
#define PG8_SB(b, h) ((4 + (b) * 2 + (h)) * HTB)
#define PG8_STAGE(bufoff, gbase, voff) do { _Pragma("unroll") for (int _i = 0; _i < 2; ++_i) \
        __builtin_amdgcn_global_load_lds((const unsigned*)((const char*)(gbase) + (voff)[_i]), (PG8_LAS unsigned*)(lds + (bufoff) + ldsw + _i * 8192), 16, 0, 0); } while (0)
#define PG8_STAGEA(bufoff, kb, V, h) do { _Pragma("unroll") for (int _i = 0; _i < 2; ++_i) \
        __builtin_amdgcn_global_load_lds((const unsigned*)(Ab + (kb) + (V)[h][_i]), (PG8_LAS unsigned*)(lds + (bufoff) + ldsw + _i * 8192), 16, 0, 0); } while (0)
#define PG8_LDA(dst, b, h) do { _Pragma("unroll") for (int m = 0; m < 4; ++m) _Pragma("unroll") for (int k = 0; k < 2; ++k) dst[m][k] = *(const PG8_LAS bf16x8*)(lds + PG8_SA(b, h) + aoff + m * 2048 + k * 1024); } while (0)
#define PG8_LDB(dst, b, h) do { _Pragma("unroll") for (int n = 0; n < 2; ++n) _Pragma("unroll") for (int k = 0; k < 2; ++k) dst[n][k] = *(const PG8_LAS bf16x8*)(lds + PG8_SB(b, h) + boff + n * 2048 + k * 1024); } while (0)
#define PG8_MMA(ai, bj, At, Bt) do { __builtin_amdgcn_s_setprio(1); _Pragma("unroll") for (int m = 0; m < 4; ++m) _Pragma("unroll") for (int n = 0; n < 2; ++n) _Pragma("unroll") for (int k = 0; k < 2; ++k) \
        acc[ai][bj][m][n] = __builtin_amdgcn_mfma_f32_16x16x32_bf16(Bt[n][k], At[m][k], acc[ai][bj][m][n], 0, 0, 0); __builtin_amdgcn_s_setprio(0); } while (0)
#define PG8_WAIT_V(n) asm volatile("s_waitcnt vmcnt(" #n ")" ::: "memory")
#define PG8_WAIT_VR(rl) do { if (rl) asm volatile("s_waitcnt vmcnt(%0)" :: "n"(8 + Epi::NST) : "memory"); else asm volatile("s_waitcnt vmcnt(8)" ::: "memory"); } while (0)
#define PG8_WAIT_L(n) asm volatile("s_waitcnt lgkmcnt(" #n ")" ::: "memory")
#define PG8_BAR __builtin_amdgcn_s_barrier()
#define PG8_SCHED __builtin_amdgcn_sched_barrier(0)
    Unit cur, nxt; int ui = 0;
    if (!S.next(0, cur)) return;
    nxt = cur;
    f32x4 acc[2][2][4][2];
#pragma unroll
    for (int a = 0; a < 2; ++a)
#pragma unroll
        for (int b = 0; b < 2; ++b)
#pragma unroll
            for (int m = 0; m < 4; ++m)
#pragma unroll
                for (int n = 0; n < 2; ++n) acc[a][b][m][n] = (f32x4){0.f, 0.f, 0.f, 0.f};
    bf16x8 At[4][2], B0[2][2], B1[2][2];
    unsigned vA[2][2];
    S.avoff(cur, tid, vA);
    const char* cB = S.bptr(cur);
    PG8_STAGE(PG8_SB(0, 0), cB, voffB); PG8_STAGE(PG8_SB(0, 1), cB + hstep, voffB); PG8_STAGEA(PG8_SA(0, 0), 0, vA, 0); PG8_STAGEA(PG8_SA(0, 1), 0, vA, 1);
    if (wr == 1) PG8_BAR;
    PG8_WAIT_V(2); PG8_BAR;
    PG8_STAGE(PG8_SB(1, 0), cB + kstep, voffB); PG8_STAGEA(PG8_SA(1, 0), kstep, vA, 0); PG8_STAGE(PG8_SB(1, 1), cB + hstep + kstep, voffB);
    PG8_WAIT_V(6); PG8_BAR;
    bool relax = false;
    for (;;) {
        const bool has_next = S.next(ui + 1, nxt);
        const char* nB = cB;
        if (has_next) nB = S.bptr(nxt);
#pragma unroll 1
        for (int t = 0; t < nt; t += 2) {
            const bool last = (t == nt - 2); const bool rl = relax && (t == 0);
            const size_t kb1 = (size_t)(t + 1) * kstep;
            const size_t kb2 = last ? (size_t)0 : (size_t)(t + 2) * kstep; const char* b2 = last ? nB : cB + (size_t)(t + 2) * kstep;
            const size_t kb3 = kb2 + kstep; const char* b3 = b2 + kstep;
            PG8_LDB(B0, 0, 0); PG8_LDB(B1, 0, 1); PG8_SCHED; PG8_LDA(At, 0, 0); if (!rl) PG8_STAGEA(PG8_SA(1, 1), kb1, vA, 1);
            if (last && has_next) S.avoff(nxt, tid, vA);
            PG8_WAIT_VR(rl); PG8_WAIT_L(0); PG8_BAR; PG8_MMA(0, 0, At, B0); PG8_MMA(0, 1, At, B1); PG8_BAR; PG8_SCHED;
            PG8_LDA(At, 0, 1); PG8_STAGE(PG8_SB(0, 0), b2, voffB); PG8_STAGE(PG8_SB(0, 1), b2 + hstep, voffB); PG8_STAGEA(PG8_SA(0, 0), kb2, vA, 0);
            PG8_WAIT_VR(rl); PG8_WAIT_L(0); PG8_BAR; PG8_MMA(1, 0, At, B0); PG8_MMA(1, 1, At, B1); PG8_BAR; PG8_SCHED;
            PG8_LDB(B0, 1, 0); PG8_LDB(B1, 1, 1); PG8_SCHED; PG8_LDA(At, 1, 0); PG8_STAGEA(PG8_SA(0, 1), kb2, vA, 1);
            PG8_WAIT_VR(rl); PG8_WAIT_L(0); PG8_BAR; PG8_MMA(0, 0, At, B0); PG8_MMA(0, 1, At, B1); PG8_BAR; PG8_SCHED;
            PG8_LDA(At, 1, 1); PG8_STAGE(PG8_SB(1, 0), b3, voffB); PG8_STAGE(PG8_SB(1, 1), b3 + hstep, voffB); PG8_STAGEA(PG8_SA(1, 0), kb3, vA, 0);
            PG8_WAIT_V(8); PG8_WAIT_L(0); PG8_BAR; PG8_MMA(1, 0, At, B0); PG8_MMA(1, 1, At, B1); PG8_BAR; PG8_SCHED;
        }
        if (wr == 0) PG8_BAR;
        if (has_next) PG8_STAGEA(PG8_SA(1, 1), kstep, vA, 1);
        E(acc, cur, wr, wc, fr, fq);
        if (!has_next) break;
#pragma unroll
        for (int a = 0; a < 2; ++a)
#pragma unroll
            for (int b = 0; b < 2; ++b)
#pragma unroll
                for (int m = 0; m < 4; ++m)
#pragma unroll
                    for (int n = 0; n < 2; ++n) acc[a][b][m][n] = (f32x4){0.f, 0.f, 0.f, 0.f};
        cur = nxt; cB = nB; ++ui; relax = true;
        if (wr == 1) PG8_BAR;
    }
    PG8_WAIT_V(0);
    PG8_BAR;
#undef PG8_SA
#undef PG8_SB
#undef PG8_STAGE
#undef PG8_STAGEA
#undef PG8_LDA
#undef PG8_LDB
#undef PG8_MMA
#undef PG8_WAIT_V
#undef PG8_WAIT_VR
#undef PG8_WAIT_L
#undef PG8_BAR
#undef PG8_SCHED
}
}
namespace attn_body {
using bf16=__hip_bfloat16;
using bf16x8=__attribute__((ext_vector_type(8)))short;
using s16x4=__attribute__((ext_vector_type(4)))short;
using f32x16=__attribute__((ext_vector_type(16)))float;
using u32x4=__attribute__((ext_vector_type(4)))unsigned;
constexpr int D=64,NW=8,QBLK=32,QB=QBLK*NW,KVBLK=64;
__device__ __forceinline__ int crow(int r,int hi){return (r&3)+8*(r>>2)+4*hi;}
#define SBAR() __builtin_amdgcn_sched_barrier(0)
constexpr int NSLOT=3, SLOTB=8192;
constexpr int LDS_K=0, LDS_V=NSLOT*SLOTB, LDS_WS=2*NSLOT*SLOTB, LDS_OST=LDS_WS+NW*64*4, LDS_BYTES=LDS_OST+NW*4096;
constexpr float LOG2E=1.4426950408889634f;
constexpr float C2=0.125f*LOG2E;
__device__ __forceinline__ void glds16(const void*gsrc,unsigned lds_dst){unsigned keep;
  asm volatile("s_mov_b32 %0, m0\n\ts_mov_b32 m0, %2\n\ts_nop 0\n\tglobal_load_lds_dwordx4 %1, off\n\ts_mov_b32 m0, %0":"=&s"(keep):"v"(gsrc),"s"(lds_dst):"memory");}
__device__ __forceinline__ void glds16s(const void*sbase,unsigned voff,unsigned lds_dst){unsigned keep;
  asm volatile("s_mov_b32 %0, m0\n\ts_mov_b32 m0, %3\n\ts_nop 0\n\tglobal_load_lds_dwordx4 %1, %2\n\ts_mov_b32 m0, %0":"=&s"(keep):"v"(voff),"s"(sbase),"s"(lds_dst):"memory");}
__device__ __forceinline__ float max3f(float a,float b,float c){float r;asm("v_max3_f32 %0, %1, %2, %3":"=v"(r):"v"(a),"v"(b),"v"(c));return r;}
__device__ __forceinline__ float max2f(float a,float b){float r;asm("v_max_f32_e32 %0, %1, %2":"=v"(r):"v"(a),"v"(b));return r;}
__device__ __forceinline__ float fadd_s(float a,float b){float r;asm("v_add_f32_e32 %0, %1, %2":"=v"(r):"v"(a),"v"(b));return r;}
__device__ __forceinline__ float fsub_s(float a,float b){float r;asm("v_sub_f32_e32 %0, %1, %2":"=v"(r):"v"(a),"v"(b));return r;}
typedef float f32x2_t __attribute__((ext_vector_type(2))); typedef __bf16 bf16x2_t __attribute__((ext_vector_type(2)));
__device__ __forceinline__ unsigned cvtpk_s(float lo,float hi){f32x2_t v={lo,hi};bf16x2_t b=__builtin_convertvector(v,bf16x2_t);return __builtin_bit_cast(unsigned,b);}
#define WAIT_BAR(N) asm volatile("s_waitcnt vmcnt(" #N ") lgkmcnt(0)\n\ts_barrier":::"memory")

template<int MODE> __device__ __forceinline__ void maskbias(f32x16&p0,f32x16&p1,int kb,int qrel,float slope2,float mhat,bool band,bool tile_ok){
  if(MODE==0)return;
  const float NEG=-INFINITY; const float lb=slope2*(float)(kb-qrel)-mhat;
  #pragma unroll
  for(int r=0;r<16;++r){const int c=(r&3)+8*(r>>2); p0[r]=__builtin_fmaf(slope2,(float)c,p0[r]+lb); p1[r]=__builtin_fmaf(slope2,(float)(c+32),p1[r]+lb);}
  if(MODE==1){ if(band){
    #pragma unroll
    for(int r=0;r<16;++r){const int kv=kb+(r&3)+8*(r>>2); if(kv>qrel)p0[r]=NEG; if(kv+32>qrel)p1[r]=NEG;} } }
  if(MODE==2){
    #pragma unroll
    for(int r=0;r<16;++r){const int d=qrel-kb-((r&3)+8*(r>>2)); if((unsigned)d>=128u||!tile_ok)p0[r]=NEG; if((unsigned)(d-32)>=128u||!tile_ok)p1[r]=NEG;} }
}

__device__ __forceinline__ void qkt(f32x16&p0,f32x16&p1,const char*Kslot,const bf16x8*qr,const f32x16&negm,int r32,int hi){
  const char*kb=Kslot+hi*1024+r32*16;
  #pragma unroll
  for(int d0=0;d0<4;++d0){
    const bf16x8 b0=*reinterpret_cast<const bf16x8*>(kb+d0*2048);
    const bf16x8 b1=*reinterpret_cast<const bf16x8*>(kb+d0*2048+512);
    if(d0==0){p0=__builtin_amdgcn_mfma_f32_32x32x16_bf16(b0,qr[0],negm,0,0,0);p1=__builtin_amdgcn_mfma_f32_32x32x16_bf16(b1,qr[0],negm,0,0,0);}
    else{p0=__builtin_amdgcn_mfma_f32_32x32x16_bf16(b0,qr[d0],p0,0,0,0);p1=__builtin_amdgcn_mfma_f32_32x32x16_bf16(b1,qr[d0],p1,0,0,0);}}
}
template<int C> __device__ __forceinline__ float fmamk_c(float a,float b){float d;asm("v_fmamk_f32 %0, %1, %2, %3":"=v"(d):"v"(a),"n"(__builtin_bit_cast(int,(float)C)),"v"(b));return d;}
typedef __attribute__((address_space(3))) const char* lds_cptr;
typedef short v4i16_t __attribute__((ext_vector_type(4)));
__device__ __forceinline__ void kload8(bf16x8*kf,lds_cptr kp){
  kf[0]=*(const __attribute__((address_space(3))) bf16x8*)(kp);      kf[1]=*(const __attribute__((address_space(3))) bf16x8*)(kp+512);
  kf[2]=*(const __attribute__((address_space(3))) bf16x8*)(kp+2048); kf[3]=*(const __attribute__((address_space(3))) bf16x8*)(kp+2560);
  kf[4]=*(const __attribute__((address_space(3))) bf16x8*)(kp+4096); kf[5]=*(const __attribute__((address_space(3))) bf16x8*)(kp+4608);
  kf[6]=*(const __attribute__((address_space(3))) bf16x8*)(kp+6144); kf[7]=*(const __attribute__((address_space(3))) bf16x8*)(kp+6656);
}
__device__ __forceinline__ void kload2(bf16x8*kf,lds_cptr kp,int j){ kf[2*j]=*(const __attribute__((address_space(3))) bf16x8*)(kp+j*2048); kf[2*j+1]=*(const __attribute__((address_space(3))) bf16x8*)(kp+j*2048+512); }
__device__ __forceinline__ s16x4 vtr(lds_cptr p){ return __builtin_bit_cast(s16x4,__builtin_amdgcn_ds_read_tr16_b64_v4i16((__attribute__((address_space(3))) v4i16_t*)p)); }
__device__ __forceinline__ float rowmax(const f32x16&p0,const f32x16&p1){
  float a=max3f(p0[0],p0[1],p1[0]),b=max3f(p0[2],p0[3],p1[1]);a=max3f(a,p1[2],p1[3]);
  #pragma unroll
  for(int r=4;r<16;r+=4){a=max3f(a,p0[r],p0[r+1]);b=max3f(b,p0[r+2],p0[r+3]);a=max3f(a,p1[r],p1[r+1]);b=max3f(b,p1[r+2],p1[r+3]);}
  const float m=max2f(a,b);
  auto rr=__builtin_amdgcn_permlane32_swap(__float_as_uint(m),__float_as_uint(m),false,false);
  return max2f(__uint_as_float(rr[0]),__uint_as_float(rr[1]));
}
__device__ __forceinline__ void pv(f32x16*o,int vb,bf16x8 pa0,bf16x8 pa1,bf16x8 pa2,bf16x8 pa3){
  #pragma unroll
  for(int d0=0;d0<2;++d0){s16x4 lo[4],hi[4];
    #pragma unroll
    for(int ks=0;ks<4;++ks){
      asm volatile("ds_read_b64_tr_b16 %0,%1 offset:%c2":"=&v"(lo[ks]):"v"(vb),"i"(d0*4096+ks*1024):"memory");
      asm volatile("ds_read_b64_tr_b16 %0,%1 offset:%c2":"=&v"(hi[ks]):"v"(vb),"i"(d0*4096+ks*1024+512):"memory");}
    asm volatile("s_waitcnt lgkmcnt(0)":::"memory");SBAR();
    #define PK(k) (bf16x8){lo[k][0],lo[k][1],lo[k][2],lo[k][3],hi[k][0],hi[k][1],hi[k][2],hi[k][3]}
    o[d0]=__builtin_amdgcn_mfma_f32_32x32x16_bf16(pa0,PK(0),o[d0],0,0,0);
    o[d0]=__builtin_amdgcn_mfma_f32_32x32x16_bf16(pa1,PK(1),o[d0],0,0,0);
    o[d0]=__builtin_amdgcn_mfma_f32_32x32x16_bf16(pa2,PK(2),o[d0],0,0,0);
    o[d0]=__builtin_amdgcn_mfma_f32_32x32x16_bf16(pa3,PK(3),o[d0],0,0,0);
    #undef PK
  }
}
struct AttnArgs {
  const bf16* Qw;
  const bf16* K0; const bf16* V0;
  int NT;
  int tmax;
  bf16* Ow;
  int qrel;
  float slope2, sink2;
  int wave;
};
#define ATTN_STORE16(p,v) (*(u32x4*)(p)=(v))
template<int MODE,int THRL,int QP,int KVP,int OP> __device__ __forceinline__ void attn_unit(const AttnArgs&a,char*shm){
  unsigned am_; asm volatile("s_mov_b32 %0, -1":"=s"(am_)); const int lane=(int)__builtin_amdgcn_mbcnt_hi(am_,__builtin_amdgcn_mbcnt_lo(am_,0u)),r32=lane&31,hi=lane>>5; const int wid=a.wave;
  const bf16*Qw=a.Qw; constexpr int qp=QP; constexpr long kvp=KVP;
  const unsigned lds0=(unsigned)(uintptr_t)shm;
  float*wsf=(float*)(shm+LDS_WS)+wid*64;
  const bf16*ksrc=a.K0+(long)lane*kvp+wid*8;
  const bf16*vsrc=a.V0+(long)(16*(wid&3)+(lane>>2))*kvp+(wid>>2)*32+(lane&3)*8;
  const unsigned kdst=lds0+LDS_K+wid*1024, vdst=lds0+LDS_V+wid*1024;
  const int tmax=a.tmax;
  #define TROW(t) ((MODE==2)?(-64*(((t)<tmax)?(t):tmax)):(64*(t)))
  #define DMA_K(t,slot) glds16(ksrc+(long)TROW(t)*kvp,(unsigned)__builtin_amdgcn_readfirstlane(kdst+(slot)))
  #define DMA_V(t,slot) glds16(vsrc+(long)TROW(t)*kvp,(unsigned)__builtin_amdgcn_readfirstlane(vdst+(slot)))
  const int vb0=(int)(lds0+LDS_V)+((lane>>4)&1)*32+(lane&3)*8+(4*hi+((lane&15)>>2))*64;
  const char*Kbase=shm+LDS_K; bf16x8 kf[8];
  const lds_cptr shm3=(lds_cptr)shm; const lds_cptr kp0=shm3+LDS_K+hi*1024+r32*16; const lds_cptr vp0=shm3+LDS_V+((lane>>4)&1)*32+(lane&3)*8+(4*hi+((lane&15)>>2))*64;
  const int NT=a.NT;
  DMA_K(0,0);DMA_V(0,0);DMA_K(1,SLOTB);
  bf16x8 qr[4];
  #pragma unroll
  for(int d0=0;d0<4;++d0)qr[d0]=*reinterpret_cast<const bf16x8*>(&Qw[(long)r32*qp+d0*16+hi*8]);
  float z0_; asm volatile("v_mov_b32 %0, 0":"=v"(z0_));
  f32x16 zv_; _Pragma("unroll") for(int r=0;r<16;++r)zv_[r]=z0_;
  float mhat=0.f,l_reg=0.f;f32x16 o[2];o[0]=zv_;o[1]=zv_;f32x16 negm=zv_;if(MODE==0)asm volatile("":"+v"(negm));
  const int qrel=a.qrel; const float slope2=a.slope2;
  #define KBREL(t) ((MODE==2)?(-64*(t)):(64*((t)-(NT-4))))
  #define MBIAS(P0,P1,t,BAND) maskbias<MODE>(P0,P1,KBREL(t)+4*hi,qrel,slope2,mhat,(BAND)&&((t)>=NT-4),(t)<=tmax)
  #define CINIT ((MODE==0)?negm:(f32x16{}))
  #define CMASK(P0,P1,t) MBIAS(P0,P1,t,true)
  bool resc=false;
  #define START(P0,P1) do{ const float rm=rowmax(P0,P1); resc=false; \
    { const float dl=rm; mhat=fadd_s(mhat,dl); \
      _Pragma("unroll") for(int r=0;r<16;++r){P0[r]=fsub_s(P0[r],dl);P1[r]=fsub_s(P1[r],dl);} \
      if(MODE==0){ _Pragma("unroll") for(int r=0;r<16;++r)negm[r]=-mhat; asm volatile("":"+v"(negm)); } } \
    _Pragma("unroll") for(int r=0;r<16;++r)P0[r]=__builtin_amdgcn_exp2f(P0[r]); }while(0)
  #define RESC() do{ if(resc){ asm volatile("s_waitcnt lgkmcnt(0)":::"memory"); \
      _Pragma("unroll") for(int d_=0;d_<2;++d_) _Pragma("unroll") for(int r=0;r<16;++r)o[d_][r]*=wsf[crow(r,hi)]; } }while(0)
  f32x16 pA0,pA1,pB0,pB1;
  int sl_prev=0,sl_cur=0,sl_next=SLOTB;
  #define ROT() do{sl_prev=sl_cur;sl_cur=sl_next;sl_next=(sl_next==(NSLOT-1)*SLOTB)?0:sl_next+SLOTB;}while(0)
  DMA_K(2,2*SLOTB);
  WAIT_BAR(3);
  qkt(pA0,pA1,Kbase,qr,negm,r32,hi);asm volatile("s_nop 15\n\ts_nop 7":"+v"(pA0),"+v"(pA1));CMASK(pA0,pA1,0);
  START(pA0,pA1);
  _Pragma("unroll") for(int r=0;r<16;++r)pA1[r]=__builtin_amdgcn_exp2f(pA1[r]);
  WAIT_BAR(0);
  DMA_K(3,0);DMA_V(1,SLOTB);
  ROT();
  kload8(kf,kp0+sl_cur);
  WAIT_BAR(2);
  s16x4 vlo[8],vhi[8]; u32x4 pw0,pw1,pw2,pw3;
  #define PKW(P,B) cvtpk_s(P[B],P[B+1])
  #define PAF(k) __builtin_bit_cast(bf16x8,pw##k)
  #define VFR(i) (bf16x8){vlo[i][0],vlo[i][1],vlo[i][2],vlo[i][3],vhi[i][0],vhi[i][1],vhi[i][2],vhi[i][3]}
  #define PIN(x) asm volatile("":"+v"(x))
  #define MX3(a,b,c) __builtin_fmaxf(__builtin_fmaxf((a),(b)),(c))
  #define GAPA(MF,A0,A1,A2,A3,W0,W1,PW) do{ MF; sacc+=A0; sacc+=A1; sacc+=A2; sacc+=A3; PIN(sacc); W0; W1; PIN(PW); SBAR(); }while(0)
  #define EX(v) __builtin_amdgcn_exp2f(v)
  #define GAPB(MF,X,B) do{ MF; X[B]=EX(X[B]); X[B+1]=EX(X[B+1]); X[B+2]=EX(X[B+2]); X[B+3]=EX(X[B+3]); PIN(X); SBAR(); }while(0)
  #define VRD(i) do{ vlo[i]=vtr(vp_+(((i)>>2)*4096+((i)&3)*1024)); vhi[i]=vtr(vp_+(((i)>>2)*4096+((i)&3)*1024+512)); }while(0)
  #define KRD(G,j) do{ if(G){ kload2(kf,kp0+sl_next,j); SBAR(); } }while(0)
  #define STEP(C0,C1,P0,P1,t,GK,GV,GL) do{ SBAR(); \
    const lds_cptr vp_=vp0+sl_prev; \
    VRD(0); SBAR(); float sacc=(P0[0]+P0[1]); \
    GAPA(C0=__builtin_amdgcn_mfma_f32_32x32x16_bf16(kf[0],qr[0],CINIT,0,0,0), P0[2],P0[3],P0[4],P0[5],     pw0[0]=PKW(P0,0), pw0[1]=PKW(P0,2), pw0); \
    VRD(4); SBAR(); GAPA(C1=__builtin_amdgcn_mfma_f32_32x32x16_bf16(kf[1],qr[0],CINIT,0,0,0), P0[6],P0[7],P0[8],P0[9],     pw0[2]=PKW(P0,4), pw0[3]=PKW(P0,6), pw0); \
    VRD(1); SBAR(); GAPA(C0=__builtin_amdgcn_mfma_f32_32x32x16_bf16(kf[2],qr[1],C0,0,0,0),   P0[10],P0[11],P0[12],P0[13], pw1[0]=PKW(P0,8), pw1[1]=PKW(P0,10), pw1); \
    VRD(5); SBAR(); GAPA(C1=__builtin_amdgcn_mfma_f32_32x32x16_bf16(kf[3],qr[1],C1,0,0,0),   P0[14],P0[15],P1[0],P1[1],   pw1[2]=PKW(P0,12),pw1[3]=PKW(P0,14), pw1); \
    VRD(2); SBAR(); GAPA(C0=__builtin_amdgcn_mfma_f32_32x32x16_bf16(kf[4],qr[2],C0,0,0,0),   P1[2],P1[3],P1[4],P1[5],     pw2[0]=PKW(P1,0), pw2[1]=PKW(P1,2), pw2); \
    VRD(6); SBAR(); GAPA(C1=__builtin_amdgcn_mfma_f32_32x32x16_bf16(kf[5],qr[2],C1,0,0,0),   P1[6],P1[7],P1[8],P1[9],     pw2[2]=PKW(P1,4), pw2[3]=PKW(P1,6), pw2); \
    VRD(3); SBAR(); GAPA(C0=__builtin_amdgcn_mfma_f32_32x32x16_bf16(kf[6],qr[3],C0,0,0,0),   P1[10],P1[11],P1[12],P1[13], pw3[0]=PKW(P1,8), pw3[1]=PKW(P1,10), pw3); \
    VRD(7); SBAR(); GAPA(C1=__builtin_amdgcn_mfma_f32_32x32x16_bf16(kf[7],qr[3],C1,0,0,0),   P1[14],P1[15],0.f,0.f,       pw3[2]=PKW(P1,12),pw3[3]=PKW(P1,14), pw3); \
    l_reg+=sacc; \
    if(GK){DMA_K((t)+3,sl_cur);} if(GV){DMA_V((t)+1,sl_next);} \
    CMASK(C0,C1,t); \
    { float a_=MX3(C0[0],C0[1],C1[0]),b_=MX3(C0[2],C0[3],C1[1]); a_=MX3(a_,C1[2],C1[3]); \
      _Pragma("unroll") for(int r=4;r<16;r+=4){a_=MX3(a_,C0[r],C0[r+1]);b_=MX3(b_,C0[r+2],C0[r+3]);a_=MX3(a_,C1[r],C1[r+1]);b_=MX3(b_,C1[r+2],C1[r+3]);} \
      float rm=__builtin_fmaxf(a_,b_); { auto rr=__builtin_amdgcn_permlane32_swap(__float_as_uint(rm),__float_as_uint(rm),false,false); rm=__builtin_fmaxf(__uint_as_float(rr[0]),__uint_as_float(rr[1])); } \
      resc=false; \
      if(__builtin_expect(__any(rm>(float)THRL),0)){ const float dl=__builtin_fmaxf(rm,0.f); mhat+=dl; \
        _Pragma("unroll") for(int r=0;r<16;++r){C0[r]-=dl;C1[r]-=dl;} \
        if(MODE==0){ _Pragma("unroll") for(int r=0;r<16;++r)negm[r]=-mhat; asm volatile("":"+v"(negm)); } \
        const float f=__builtin_amdgcn_exp2f(-dl); l_reg*=f; if(hi==0)wsf[r32]=f; resc=true; } } \
    SBAR(); \
    GAPB(o[0]=__builtin_amdgcn_mfma_f32_32x32x16_bf16(PAF(0),VFR(0),o[0],0,0,0), C0,0); \
    GAPB(o[1]=__builtin_amdgcn_mfma_f32_32x32x16_bf16(PAF(0),VFR(4),o[1],0,0,0), C0,4); \
    KRD(GL,0); GAPB(o[0]=__builtin_amdgcn_mfma_f32_32x32x16_bf16(PAF(1),VFR(1),o[0],0,0,0), C0,8); \
    KRD(GL,1); GAPB(o[1]=__builtin_amdgcn_mfma_f32_32x32x16_bf16(PAF(1),VFR(5),o[1],0,0,0), C0,12); \
    KRD(GL,2); GAPB(o[0]=__builtin_amdgcn_mfma_f32_32x32x16_bf16(PAF(2),VFR(2),o[0],0,0,0), C1,0); \
    KRD(GL,3); GAPB(o[1]=__builtin_amdgcn_mfma_f32_32x32x16_bf16(PAF(2),VFR(6),o[1],0,0,0), C1,4); \
    GAPB(o[0]=__builtin_amdgcn_mfma_f32_32x32x16_bf16(PAF(3),VFR(3),o[0],0,0,0), C1,8); \
    GAPB(o[1]=__builtin_amdgcn_mfma_f32_32x32x16_bf16(PAF(3),VFR(7),o[1],0,0,0), C1,12); \
    }while(0)
  int t=1;
  #undef CMASK
  #define CMASK(P0,P1,t) MBIAS(P0,P1,t,false)
  for(;t+5<NT;t+=2){
    STEP(pB0,pB1,pA0,pA1,t,true,true,true);     WAIT_BAR(2); RESC(); ROT();
    STEP(pA0,pA1,pB0,pB1,t+1,true,true,true);   WAIT_BAR(2); RESC(); ROT();
  }
  #undef CMASK
  #define CMASK(P0,P1,t) MBIAS(P0,P1,t,true)
  #define ENDW(tt) do{ if((tt)+3<NT){WAIT_BAR(2);} else if((tt)+2<NT){WAIT_BAR(1);} else {WAIT_BAR(0);} }while(0)
  for(;t+1<NT;t+=2){
    STEP(pB0,pB1,pA0,pA1,t,(t+3<NT),(t+1<NT),(t+1<NT));       ENDW(t);   RESC(); ROT();
    STEP(pA0,pA1,pB0,pB1,t+1,(t+4<NT),(t+2<NT),(t+2<NT));     ENDW(t+1); RESC(); ROT();
  }
  STEP(pB0,pB1,pA0,pA1,NT-1,false,false,false); RESC();
  { float sacc=pB0[0]+pB0[1]; _Pragma("unroll") for(int r=2;r<16;++r)sacc+=pB0[r]; _Pragma("unroll") for(int r=0;r<16;++r)sacc+=pB1[r]; l_reg+=sacc;
    pw0=(u32x4){PKW(pB0,0),PKW(pB0,2),PKW(pB0,4),PKW(pB0,6)};pw1=(u32x4){PKW(pB0,8),PKW(pB0,10),PKW(pB0,12),PKW(pB0,14)};pw2=(u32x4){PKW(pB1,0),PKW(pB1,2),PKW(pB1,4),PKW(pB1,6)};pw3=(u32x4){PKW(pB1,8),PKW(pB1,10),PKW(pB1,12),PKW(pB1,14)};
    SBAR(); pv(o,vb0+sl_cur,PAF(0),PAF(1),PAF(2),PAF(3)); }
  #undef PKW
  #undef PAF
  #undef VFR
  #undef PIN
  #undef MX3
  #undef GAPA
  #undef GAPB
  #undef EX
  #undef VRD
  #undef KRD
  #undef STEP
  #undef ENDW
  {auto rr=__builtin_amdgcn_permlane32_swap(__float_as_uint(l_reg),__float_as_uint(l_reg),false,false);l_reg=__uint_as_float(rr[0])+__uint_as_float(rr[1]);}
  if(MODE==2)l_reg+=__builtin_amdgcn_exp2f(a.sink2-mhat);
  if(hi==0)wsf[32+r32]=l_reg;asm volatile("s_waitcnt lgkmcnt(0)":::"memory");
  float rli[16];
  #pragma unroll
  for(int r=0;r<16;++r)rli[r]=__builtin_amdgcn_rcpf(wsf[32+crow(r,hi)]);
  bf16*Ow=a.Ow; constexpr long op=OP;
  { bf16*stg=(bf16*)(shm+LDS_OST)+wid*2048;
    #pragma unroll
    for(int r=0;r<16;++r){const int orow=crow(r,hi);
      #pragma unroll
      for(int d0=0;d0<2;++d0)stg[orow*64+d0*32+r32]=__float2bfloat16(o[d0][r]*rli[r]);}
    asm volatile("s_waitcnt lgkmcnt(0)":::"memory");
    #pragma unroll
    for(int i=0;i<4;++i){const int row=i*8+(lane>>3),ch=lane&7; const u32x4 v=*(const u32x4*)(stg+row*64+ch*8); ATTN_STORE16(Ow+(long)row*op+ch*8,v);} }
  asm volatile("s_waitcnt lgkmcnt(0)\n\ts_barrier":::"memory");
  #undef DMA_K
  #undef DMA_V
  #undef TROW
  #undef KBREL
  #undef MBIAS
  #undef CINIT
  #undef CMASK
  #undef START
  #undef RESC
  #undef ROT
}

constexpr int DP_K=0, DP_V=3*8192, DP_WS=DP_V+3*16384, DP_BYTES=DP_WS+NW*256;
template<int THRL,int QP,int KVP,int OP> __device__ __forceinline__ void diff_unit(const AttnArgs&a,char*shm){
  unsigned am_; asm volatile("s_mov_b32 %0, -1":"=s"(am_)); const int lane=(int)__builtin_amdgcn_mbcnt_hi(am_,__builtin_amdgcn_mbcnt_lo(am_,0u)),r32=lane&31,hi=lane>>5; const int wid=a.wave;
  const bf16*Qw=a.Qw; constexpr int qp=QP; constexpr long kvp=KVP;
  const unsigned lds0=(unsigned)(uintptr_t)shm;
  float*wsf=(float*)(shm+DP_WS)+wid*64;
  const unsigned koff=(unsigned)((lane*KVP+wid*8)*2), voff=(unsigned)(((16*(wid&3)+(lane>>2))*KVP+(wid>>2)*32+(lane&3)*8)*2);
  const char*Kb=(const char*)a.K0; const char*Vb=(const char*)a.V0;
  const unsigned kdst=lds0+DP_K+wid*1024, vdst=lds0+DP_V+wid*1024;
  #define DMA_K(t,slot) glds16s(Kb+(long)(64*(t))*(kvp*2),koff,(unsigned)__builtin_amdgcn_readfirstlane(kdst+(slot)))
  #define DMA_V(t,slot) do{ DMA_VA(t,slot); DMA_VB(t,slot); }while(0)
  #define DMA_VA(t,slot) glds16s(Vb+(long)(64*(t))*(kvp*2),voff,(unsigned)__builtin_amdgcn_readfirstlane(vdst+2*(slot)))
  #define DMA_VB(t,slot) glds16s(Vb+(long)(64*(t))*(kvp*2)+128,voff,(unsigned)__builtin_amdgcn_readfirstlane(vdst+2*(slot)+8192))
  const int vb0=(int)(lds0+DP_V)+((lane>>4)&1)*32+(lane&3)*8+(4*hi+((lane&15)>>2))*64;
  const char*Kbase=shm+DP_K; bf16x8 kf[8];
  const lds_cptr shm3=(lds_cptr)shm; const lds_cptr kp0=shm3+DP_K+hi*1024+r32*16; const lds_cptr vp0=shm3+DP_V+((lane>>4)&1)*32+(lane&3)*8+(4*hi+((lane&15)>>2))*64;
  const int NT=a.NT;
  DMA_K(0,0);DMA_V(0,0);DMA_K(1,SLOTB);
  bf16x8 qr[4];
  #pragma unroll
  for(int d0=0;d0<4;++d0)qr[d0]=*reinterpret_cast<const bf16x8*>(&Qw[(long)r32*qp+d0*16+hi*8]);
  float z0_; asm volatile("v_mov_b32 %0, 0":"=v"(z0_));
  f32x16 zv_; _Pragma("unroll") for(int r=0;r<16;++r)zv_[r]=z0_;
  float mhat=0.f,l_reg=0.f;f32x16 o[4];o[0]=zv_;o[1]=zv_;o[2]=zv_;o[3]=zv_;
  const int qrel=a.qrel; const float slope2=a.slope2;
  float slope2v=slope2; asm volatile("":"+v"(slope2v));
  #define KBREL(t) (64*((t)-(NT-4)))
  #define MBIAS(P0,P1,t,BAND) maskbias<1>(P0,P1,KBREL(t)+4*hi,qrel,slope2,mhat,(BAND)&&((t)>=NT-4),true)
  #define CMASK(P0,P1,t) MBIAS(P0,P1,t,true)
  bool resc=false;
  #define START(P0,P1) do{ const float rm=rowmax(P0,P1); resc=false; \
    { const float dl=rm; mhat=fadd_s(mhat,dl); \
      _Pragma("unroll") for(int r=0;r<16;++r){P0[r]=fsub_s(P0[r],dl);P1[r]=fsub_s(P1[r],dl);} } \
    _Pragma("unroll") for(int r=0;r<16;++r)P0[r]=__builtin_amdgcn_exp2f(P0[r]); }while(0)
  #define RESC() do{ if(resc){ asm volatile("s_waitcnt lgkmcnt(0)":::"memory"); \
      _Pragma("unroll") for(int d_=0;d_<4;++d_) _Pragma("unroll") for(int r=0;r<16;++r)o[d_][r]*=wsf[crow(r,hi)]; } }while(0)
  f32x16 pA0,pA1;
  int sl_prev=0,sl_cur=0,sl_next=SLOTB;
  #define ROT() do{sl_prev=sl_cur;sl_cur=sl_next;sl_next=(sl_next==(NSLOT-1)*SLOTB)?0:sl_next+SLOTB;}while(0)
  DMA_K(2,2*SLOTB);
  WAIT_BAR(4);
  qkt(pA0,pA1,Kbase,qr,zv_,r32,hi);asm volatile("s_nop 15\n\ts_nop 7":"+v"(pA0),"+v"(pA1));CMASK(pA0,pA1,0);
  START(pA0,pA1);
  _Pragma("unroll") for(int r=0;r<16;++r)pA1[r]=__builtin_amdgcn_exp2f(pA1[r]);
  f32x16 pB0,pB1;
  { const float lbn=__builtin_fmaf(slope2,(float)(KBREL(1)+4*hi-qrel),-mhat);
    _Pragma("unroll") for(int r=0;r<16;++r){ const int c=(r&3)+8*(r>>2); pB0[r]=__builtin_fmaf(slope2,(float)c,lbn); pB1[r]=__builtin_fmaf(slope2,(float)(c+32),lbn); } }
  WAIT_BAR(0);
  DMA_K(3,0);DMA_V(1,SLOTB);
  ROT();
  kload8(kf,kp0+sl_cur);
  WAIT_BAR(0);
  s16x4 vlo[8],vhi[8]; u32x4 pw0,pw1,pw2,pw3;
  #define PKW(P,B) cvtpk_s(P[B],P[B+1])
  #define PAF(k) __builtin_bit_cast(bf16x8,pw##k)
  #define VFR(i) (bf16x8){vlo[i][0],vlo[i][1],vlo[i][2],vlo[i][3],vhi[i][0],vhi[i][1],vhi[i][2],vhi[i][3]}
  #define PIN(x) asm volatile("":"+v"(x))
  #define MX3(a,b,c) __builtin_fmaxf(__builtin_fmaxf((a),(b)),(c))
  #define GAPA(MF,A0,A1,A2,A3,W0,W1,PW) do{ MF; sacc+=A0; sacc+=A1; sacc+=A2; sacc+=A3; PIN(sacc); W0; W1; PIN(PW); SBAR(); }while(0)
  #define EX(v) __builtin_amdgcn_exp2f(v)
  #define FILLV(r,OFF) fmamk_c<(((r)&3)+8*((r)>>2))+(OFF)>(slope2v,lbn)
  #define GAPB(MF,X0,X1,E0,E1,E2) do{ MF; E0=EX(E0); E1=EX(E1); E2=EX(E2); PIN(X0); PIN(X1); SBAR(); }while(0)
  #define GAPD(MF,X,E,Y,B,OFF) do{ MF; E=EX(E); Y[B]=FILLV(B,OFF); Y[B+1]=FILLV(B+1,OFF); Y[B+2]=FILLV(B+2,OFF); Y[B+3]=FILLV(B+3,OFF); PIN(X); PIN(Y); SBAR(); }while(0)
  #define GAPC(MF) do{ MF; SBAR(); }while(0)
  #define VRD(i) do{ vlo[i]=vtr(vp_+(((i)>>2)*4096+((i)&3)*1024)); vhi[i]=vtr(vp_+(((i)>>2)*4096+((i)&3)*1024+512)); SBAR(); }while(0)
  #define VRD2(i) do{ vlo[i]=vtr(vp_+(8192+((i)>>2)*4096+((i)&3)*1024)); vhi[i]=vtr(vp_+(8192+((i)>>2)*4096+((i)&3)*1024+512)); SBAR(); }while(0)
  #define KRD(G,j) do{ if(G){ kload2(kf,kp0+sl_next,j); SBAR(); } }while(0)
  #define STEP(C0,C1,P0,P1,t,GK,GV,GL) do{ SBAR(); \
    const lds_cptr vp_=vp0+2*sl_prev; \
    float sacc=(P0[0]+P0[1]); \
    GAPA(C0=__builtin_amdgcn_mfma_f32_32x32x16_bf16(kf[0],qr[0],C0,0,0,0), P0[2],P0[3],P0[4],P0[5],     pw0[0]=PKW(P0,0), pw0[1]=PKW(P0,2), pw0); \
    if(GK){DMA_K((t)+3,sl_cur); SBAR();} \
    GAPA(C1=__builtin_amdgcn_mfma_f32_32x32x16_bf16(kf[1],qr[0],C1,0,0,0), P0[6],P0[7],P0[8],P0[9],     pw0[2]=PKW(P0,4), pw0[3]=PKW(P0,6), pw0); \
    GAPA(C0=__builtin_amdgcn_mfma_f32_32x32x16_bf16(kf[2],qr[1],C0,0,0,0),   P0[10],P0[11],P0[12],P0[13], pw1[0]=PKW(P0,8), pw1[1]=PKW(P0,10), pw1); \
    if(GV){DMA_VA((t)+1,sl_next); SBAR();} \
    GAPA(C1=__builtin_amdgcn_mfma_f32_32x32x16_bf16(kf[3],qr[1],C1,0,0,0),   P0[14],P0[15],P1[0],P1[1],   pw1[2]=PKW(P0,12),pw1[3]=PKW(P0,14), pw1); \
    GAPA(C0=__builtin_amdgcn_mfma_f32_32x32x16_bf16(kf[4],qr[2],C0,0,0,0),   P1[2],P1[3],P1[4],P1[5],     pw2[0]=PKW(P1,0), pw2[1]=PKW(P1,2), pw2); \
    if(GV){DMA_VB((t)+1,sl_next); SBAR();} \
    GAPA(C1=__builtin_amdgcn_mfma_f32_32x32x16_bf16(kf[5],qr[2],C1,0,0,0),   P1[6],P1[7],P1[8],P1[9],     pw2[2]=PKW(P1,4), pw2[3]=PKW(P1,6), pw2); \
    GAPA(C0=__builtin_amdgcn_mfma_f32_32x32x16_bf16(kf[6],qr[3],C0,0,0,0),   P1[10],P1[11],P1[12],P1[13], pw3[0]=PKW(P1,8), pw3[1]=PKW(P1,10), pw3); \
    VRD(0); GAPA(C1=__builtin_amdgcn_mfma_f32_32x32x16_bf16(kf[7],qr[3],C1,0,0,0),   P1[14],P1[15],0.f,0.f,       pw3[2]=PKW(P1,12),pw3[3]=PKW(P1,14), pw3); \
    l_reg+=sacc; \
    VRD(4); VRD(1); VRD(5); \
    SMASK(C0,C1,t); \
    { float a_=MX3(C0[0],C0[1],C1[0]),b_=MX3(C0[2],C0[3],C1[1]); a_=MX3(a_,C1[2],C1[3]); \
      _Pragma("unroll") for(int r=4;r<16;r+=4){a_=MX3(a_,C0[r],C0[r+1]);b_=MX3(b_,C0[r+2],C0[r+3]);a_=MX3(a_,C1[r],C1[r+1]);b_=MX3(b_,C1[r+2],C1[r+3]);} \
      float rm=__builtin_fmaxf(a_,b_); { auto rr=__builtin_amdgcn_permlane32_swap(__float_as_uint(rm),__float_as_uint(rm),false,false); rm=__builtin_fmaxf(__uint_as_float(rr[0]),__uint_as_float(rr[1])); } \
      resc=false; \
      if(__builtin_expect(__any(rm>(float)THRL),0)){ const float dl=__builtin_fmaxf(rm,0.f); mhat+=dl; \
        _Pragma("unroll") for(int r=0;r<16;++r){C0[r]-=dl;C1[r]-=dl;} \
        const float f=__builtin_amdgcn_exp2f(-dl); l_reg*=f; if(hi==0)wsf[r32]=f; resc=true; } } \
    const float lbn=__builtin_fmaf(slope2,(float)(KBREL((t)+1)+4*hi-qrel),-mhat); \
    SBAR(); \
    VRD(2); GAPB(o[0]=__builtin_amdgcn_mfma_f32_32x32x16_bf16(PAF(0),VFR(0),o[0],0,0,0), C0,C1, C0[0],C0[1],C0[2]);    VRD2(0); \
    VRD(6); GAPB(o[1]=__builtin_amdgcn_mfma_f32_32x32x16_bf16(PAF(0),VFR(4),o[1],0,0,0), C0,C1, C0[3],C0[4],C0[5]);    VRD2(4); \
    VRD(3); GAPB(o[0]=__builtin_amdgcn_mfma_f32_32x32x16_bf16(PAF(1),VFR(1),o[0],0,0,0), C0,C1, C0[6],C0[7],C0[8]);    VRD2(1); \
    VRD(7); GAPB(o[1]=__builtin_amdgcn_mfma_f32_32x32x16_bf16(PAF(1),VFR(5),o[1],0,0,0), C0,C1, C0[9],C0[10],C0[11]);  VRD2(5); \
    GAPB(o[0]=__builtin_amdgcn_mfma_f32_32x32x16_bf16(PAF(2),VFR(2),o[0],0,0,0), C0,C1, C0[12],C0[13],C0[14]); VRD2(2); \
    GAPB(o[1]=__builtin_amdgcn_mfma_f32_32x32x16_bf16(PAF(2),VFR(6),o[1],0,0,0), C0,C1, C0[15],C1[0],C1[1]);   VRD2(6); \
    GAPB(o[0]=__builtin_amdgcn_mfma_f32_32x32x16_bf16(PAF(3),VFR(3),o[0],0,0,0), C0,C1, C1[2],C1[3],C1[4]);    VRD2(3); \
    GAPB(o[1]=__builtin_amdgcn_mfma_f32_32x32x16_bf16(PAF(3),VFR(7),o[1],0,0,0), C0,C1, C1[5],C1[6],C1[7]);    VRD2(7); \
    KRD(GL,0); GAPD(o[2]=__builtin_amdgcn_mfma_f32_32x32x16_bf16(PAF(0),VFR(0),o[2],0,0,0), C1,C1[8], P0,0,0); \
    KRD(GL,1); GAPD(o[3]=__builtin_amdgcn_mfma_f32_32x32x16_bf16(PAF(0),VFR(4),o[3],0,0,0), C1,C1[9], P0,4,0); \
    KRD(GL,2); GAPD(o[2]=__builtin_amdgcn_mfma_f32_32x32x16_bf16(PAF(1),VFR(1),o[2],0,0,0), C1,C1[10],P0,8,0); \
    KRD(GL,3); GAPD(o[3]=__builtin_amdgcn_mfma_f32_32x32x16_bf16(PAF(1),VFR(5),o[3],0,0,0), C1,C1[11],P0,12,0); \
    GAPD(o[2]=__builtin_amdgcn_mfma_f32_32x32x16_bf16(PAF(2),VFR(2),o[2],0,0,0), C1,C1[12],P1,0,32); \
    GAPD(o[3]=__builtin_amdgcn_mfma_f32_32x32x16_bf16(PAF(2),VFR(6),o[3],0,0,0), C1,C1[13],P1,4,32); \
    GAPD(o[2]=__builtin_amdgcn_mfma_f32_32x32x16_bf16(PAF(3),VFR(3),o[2],0,0,0), C1,C1[14],P1,8,32); \
    GAPD(o[3]=__builtin_amdgcn_mfma_f32_32x32x16_bf16(PAF(3),VFR(7),o[3],0,0,0), C1,C1[15],P1,12,32); \
    }while(0)
  int t=1;
  #define SMASK(P0,P1,t) do{}while(0)
  for(;t+5<NT;t+=2){
    STEP(pB0,pB1,pA0,pA1,t,true,true,true);     WAIT_BAR(0); RESC(); ROT();
    STEP(pA0,pA1,pB0,pB1,t+1,true,true,true);   WAIT_BAR(0); RESC(); ROT();
  }
  #undef SMASK
  #define SMASK(P0,P1,t) do{ if((t)>=NT-4){ int dq_=qrel-(KBREL(t)+4*hi); asm volatile("":"+v"(dq_));        \
    _Pragma("unroll") for(int r=0;r<16;++r){ const int c_=(r&3)+8*(r>>2); if(c_>dq_)P0[r]=-INFINITY; if(c_+32>dq_)P1[r]=-INFINITY; } } }while(0)
  #define ENDW(tt) do{ WAIT_BAR(0); }while(0)
  for(;t+1<NT;t+=2){
    STEP(pB0,pB1,pA0,pA1,t,(t+3<NT),(t+1<NT),(t+1<NT));       ENDW(t);   RESC(); ROT();
    STEP(pA0,pA1,pB0,pB1,t+1,(t+4<NT),(t+2<NT),(t+2<NT));     ENDW(t+1); RESC(); ROT();
  }
  STEP(pB0,pB1,pA0,pA1,NT-1,false,false,false); RESC();
  { float sacc=pB0[0]+pB0[1]; _Pragma("unroll") for(int r=2;r<16;++r)sacc+=pB0[r]; _Pragma("unroll") for(int r=0;r<16;++r)sacc+=pB1[r]; l_reg+=sacc;
    pw0=(u32x4){PKW(pB0,0),PKW(pB0,2),PKW(pB0,4),PKW(pB0,6)};pw1=(u32x4){PKW(pB0,8),PKW(pB0,10),PKW(pB0,12),PKW(pB0,14)};pw2=(u32x4){PKW(pB1,0),PKW(pB1,2),PKW(pB1,4),PKW(pB1,6)};pw3=(u32x4){PKW(pB1,8),PKW(pB1,10),PKW(pB1,12),PKW(pB1,14)};
    SBAR(); pv(o,vb0+2*sl_cur,PAF(0),PAF(1),PAF(2),PAF(3)); pv(o+2,vb0+2*sl_cur+8192,PAF(0),PAF(1),PAF(2),PAF(3)); }
  #undef PKW
  #undef PAF
  #undef VFR
  #undef PIN
  #undef MX3
  #undef GAPA
  #undef GAPB
  #undef GAPD
  #undef GAPC
  #undef EX
  #undef VRD
  #undef VRD2
  #undef KRD
  #undef STEP
  #undef ENDW
  #undef SMASK
  #undef FILLV
  {auto rr=__builtin_amdgcn_permlane32_swap(__float_as_uint(l_reg),__float_as_uint(l_reg),false,false);l_reg=__uint_as_float(rr[0])+__uint_as_float(rr[1]);}
  if(hi==0)wsf[32+r32]=l_reg;asm volatile("s_waitcnt lgkmcnt(0)":::"memory");
  float rli[16];
  #pragma unroll
  for(int r=0;r<16;++r)rli[r]=__builtin_amdgcn_rcpf(wsf[32+crow(r,hi)]);
  asm volatile("s_waitcnt lgkmcnt(0)\n\ts_barrier":::"memory");
  { bf16*stg=(bf16*)(shm)+wid*4096;
    #pragma unroll
    for(int r=0;r<16;++r){const int orow=crow(r,hi);
      #pragma unroll
      for(int dq=0;dq<4;++dq)stg[orow*128+dq*32+r32]=__float2bfloat16(o[dq][r]*rli[r]);}
    asm volatile("s_waitcnt lgkmcnt(0)":::"memory");
    #pragma unroll
    for(int i=0;i<8;++i){const int row=i*4+(lane>>4),ch=lane&15; const u32x4 v=*(const u32x4*)(stg+row*128+ch*8); *(u32x4*)(a.Ow+(long)row*OP+ch*8)=v;} }
  asm volatile("s_waitcnt lgkmcnt(0)\n\ts_barrier":::"memory");
  #undef DMA_K
  #undef DMA_V
  #undef DMA_VA
  #undef DMA_VB
  #undef KBREL
  #undef MBIAS
  #undef CMASK
  #undef START
  #undef RESC
  #undef ROT
}
constexpr int ATTN_LDS_BYTES=LDS_BYTES;
#undef SBAR
#undef WAIT_BAR
}
constexpr int NWAVES = 8;
constexpr int BATCH = 2, SEQ = 16384, D = 1024, M = BATCH * SEQ, DEPTH = 4, MEMLEN = 256;
constexpr int NPA = 1536, NPB = 2560;
constexpr int NEXP = 64, CAP = 32768, HID = 256;
constexpr int HROWS = (M * 8 / 256 + NEXP + M / 256) * 256;
constexpr float LN_EPS = 1e-5f;
constexpr float DN_ALPHA = 1.681792830507429f;
__device__ const float SLOPES_A[12] = {0.5f, 0.25f, 0.125f, 0.0625f, 0.03125f, 0.015625f, 0.0078125f, 0.00390625f, 0.7071067811865476f, 0.35355339059327384f, 0.17677669529663695f, 0.08838834764831849f};
__device__ const float SLOPES_B[6] = {0.25f, 0.0625f, 0.015625f, 0.00390625f, 0.5f, 0.125f};

constexpr size_t MiB = 1u << 20;
constexpr size_t WS_CTL = 0, CTL_ZERO_BYTES = 1 * MiB;
constexpr size_t WS_MEMKV = 2 * MiB;
constexpr size_t WS_WROUT = 4 * MiB;
constexpr size_t WS_WINA = 6 * MiB, WS_WINB = 12 * MiB;
constexpr size_t WS_WOUT = 22 * MiB;
constexpr size_t WS_WMKV = 30 * MiB;
constexpr size_t WS_MEMB = 34 * MiB;
constexpr size_t WS_LOGIT = 36 * MiB;
constexpr size_t WS_ROWTOK = 44 * MiB, WS_ROWGATE = 52 * MiB;
constexpr size_t WS_WEXP = 60 * MiB;
constexpr size_t WS_XB = 158 * MiB;
constexpr size_t WS_HB = 222 * MiB;
constexpr size_t WS_BIG = 374 * MiB;
constexpr size_t WS_QKV = WS_BIG, WS_OTMP = WS_BIG + 160 * MiB, WS_CAT = WS_BIG + 256 * MiB, WS_Y = WS_BIG + 320 * MiB;
constexpr size_t WS_END = WS_BIG + 576 * MiB;
static_assert(WS_WEXP + 65 * (size_t)pg8::EXPERT_BYTES <= WS_XB && WS_HB + (size_t)HROWS * 512 <= WS_BIG, "d_ws map");
constexpr int CW_TMO = 0;
constexpr int CW_BAR = 4096;
constexpr int CW_CNT = 16384;
constexpr int CW_Q = CW_CNT + DEPTH * 64 * 64;
constexpr int CW_NORM = CW_Q + 64 * DEPTH;
static_assert((CW_NORM + 64 * DEPTH) * 4 <= (int)CTL_ZERO_BYTES, "CTL words inside the memset region");

constexpr int RING_OFF = 0, RING_BYTES = 131072;
constexpr int LDSCTL_OFF = RING_BYTES;
constexpr int TAB_OFF = RING_BYTES + 512;
constexpr int IDX_OFF = RING_BYTES + 2560;
constexpr int GATE_OFF = IDX_OFF + 10 * 1024;
constexpr int LDS_BYTES = 163840;
static_assert(IDX_OFF + 20 * 1024 <= LDS_BYTES, "LDS map");

#define GAS __attribute__((address_space(1)))
#define LAS __attribute__((address_space(3)))
typedef unsigned short bf16;
typedef unsigned v4u __attribute__((ext_vector_type(4)));
typedef unsigned v2u __attribute__((ext_vector_type(2)));
typedef float f32x4 __attribute__((ext_vector_type(4)));
typedef GAS unsigned gu32;
#define RLX_AGENT __ATOMIC_RELAXED, __HIP_MEMORY_SCOPE_AGENT
#define LDS_WAIT() asm volatile("s_waitcnt lgkmcnt(0)" ::: "memory")
__device__ __forceinline__ unsigned f2bf(float f) { unsigned u = __builtin_bit_cast(unsigned, f); return (u + 0x7fffu + ((u >> 16) & 1u)) >> 16; }
__device__ __forceinline__ unsigned pk2(float lo, float hi) { return f2bf(lo) | (f2bf(hi) << 16); }
__device__ __forceinline__ float bflo(unsigned u) { return __builtin_bit_cast(float, u << 16); }
__device__ __forceinline__ float bfhi(unsigned u) { return __builtin_bit_cast(float, u & 0xffff0000u); }

#define XB_TMO      128
#define XB_XCNT(j)  (256  + 64 * (j))
#define XB_XSUB(j)  (1280 + 64 * (j))
#define XB_XGEN(j)  (2304 + 64 * (j))
#define XB_TOP      3328
#define XB_TOPGEN   3392
#define XCD_BAR_WORDS 3456
#define XB_SPIN_CAP (1u << 18)
__device__ __forceinline__ unsigned xb_ld(unsigned* p)              { return __hip_atomic_load(p, __ATOMIC_RELAXED, __HIP_MEMORY_SCOPE_AGENT); }
__device__ __forceinline__ unsigned xb_add(unsigned* p, unsigned v) { return __hip_atomic_fetch_add(p, v, __ATOMIC_RELAXED, __HIP_MEMORY_SCOPE_AGENT); }
__device__ __forceinline__ unsigned xb_xcc_id() { return (unsigned)__builtin_amdgcn_s_getreg((3 << 11) | 20) & 0xFu; }
#define XB_SPIN(cond, bar) do { unsigned _sp = 0; while (cond) { __builtin_amdgcn_s_sleep(1); \
    if ((++_sp & 255u) == 0u) { if (xb_ld(&(bar)[XB_TMO])) break; if (_sp > XB_SPIN_CAP) { atomicAdd(&(bar)[XB_TMO], 1u); break; } } } } while (0)
struct XcdBarrier { unsigned* bar; unsigned x; volatile LAS unsigned* st; };
__device__ __forceinline__ XcdBarrier xcd_barrier_post(unsigned* bar, volatile LAS unsigned* st, const bool t0) {
    XcdBarrier b; b.bar = bar; b.x = xb_xcc_id(); b.st = st;
    if (t0) (void)xb_add(&bar[XB_XCNT(b.x)], 1u);
    return b;
}
__device__ __forceinline__ void xcd_barrier_complete(unsigned* bar, unsigned x, unsigned& nloc, unsigned& nx) {
    const unsigned G = gridDim.x * gridDim.y * gridDim.z;
    unsigned sum, cnt, mine, sp = 0u;
    for (;;) {
        sum = 0u; cnt = 0u; mine = 0u;
#pragma unroll
        for (unsigned j = 0; j < 16; ++j) { const unsigned c = xb_ld(&bar[XB_XCNT(j)]); sum += c; cnt += (c > 0u) ? 1u : 0u; mine = (j == x) ? c : mine; }
        if (sum == G) break;
        __builtin_amdgcn_s_sleep(1);
        if ((++sp & 255u) == 0u) { if (xb_ld(&bar[XB_TMO])) break; if (sp > XB_SPIN_CAP) { atomicAdd(&bar[XB_TMO], 1u); break; } }
    }
    nloc = mine > 0u ? mine : 1u; nx = cnt > 0u ? cnt : 1u;
}
__device__ __forceinline__ void xcd_barrier(const XcdBarrier& b, const bool t0) {
    asm volatile("s_waitcnt vmcnt(0)" ::: "memory");
    __syncthreads();
    if (t0) {
        unsigned* bar = b.bar;
        __builtin_amdgcn_s_waitcnt(0);
        unsigned nloc = b.st[0], nx = b.st[1];
        if (nloc == 0u) { xcd_barrier_complete(bar, b.x, nloc, nx); b.st[0] = nloc; b.st[1] = nx; }
        const unsigned old = xb_add(&bar[XB_XSUB(b.x)], 1u);
        const unsigned gen = old / nloc;
        if (old + 1u == (gen + 1u) * nloc) {
            __builtin_amdgcn_fence(__ATOMIC_RELEASE, "agent");
            asm volatile("s_waitcnt vmcnt(0)" ::: "memory");
            const unsigned og = xb_add(&bar[XB_TOP], 1u);
            const unsigned tg = og / nx;
            if (og + 1u == (tg + 1u) * nx) xb_add(&bar[XB_TOPGEN], 1u);
            else XB_SPIN(xb_ld(&bar[XB_TOPGEN]) == tg, bar);
            __builtin_amdgcn_fence(__ATOMIC_ACQUIRE, "agent");
            xb_add(&bar[XB_XGEN(b.x)], 1u);
            asm volatile("s_waitcnt vmcnt(0)" ::: "memory");
        } else {
            XB_SPIN(xb_ld(&bar[XB_XGEN(b.x)]) == gen, bar);
            __builtin_amdgcn_fence(__ATOMIC_ACQUIRE, "agent");
            asm volatile("s_waitcnt vmcnt(0)" ::: "memory");
        }
    }
    __syncthreads();
}

struct Frame { LAS unsigned char* lds; int wave; };
__device__ __forceinline__ int f_G() { int g = (int)gridDim.x; asm volatile("" : "+s"(g)); return g; }
__device__ __forceinline__ int f_bx() { int b = (int)blockIdx.x; asm volatile("" : "+s"(b)); return b; }
__device__ __forceinline__ int f_gw(const Frame& F) { const int g = f_G(), b = f_bx(); return ((g % 8 == 0) ? (b % 8) * (g / 8) + b / 8 : b) * NWAVES + F.wave; }
__device__ __forceinline__ int f_ngw() { return f_G() * NWAVES; }
__device__ __forceinline__ volatile LAS unsigned* f_misc(const Frame& F) { return (volatile LAS unsigned*)(F.lds + LDSCTL_OFF); }
__device__ __forceinline__ int lane_id() { unsigned m; asm volatile("s_mov_b32 %0, -1" : "=s"(m)); return (int)__builtin_amdgcn_mbcnt_hi(m, __builtin_amdgcn_mbcnt_lo(m, 0u)); }
__device__ __forceinline__ int tid_of(int wave) { asm volatile("" : "+s"(wave)); return (wave << 6) | lane_id(); }
#define fresh_tid() tid_of(F.wave)
__device__ __forceinline__ float sx(float v, int o, int ln) { return __builtin_bit_cast(float, __builtin_amdgcn_ds_bpermute((ln ^ o) << 2, __builtin_bit_cast(int, v))); }
template <int CTRL> __device__ __forceinline__ float dppf(float v) { return __builtin_bit_cast(float, __builtin_amdgcn_update_dpp(0, __builtin_bit_cast(int, v), CTRL, 0xF, 0xF, false)); }
__device__ __forceinline__ float gmax8(float v) { v = fmaxf(v, dppf<0xB1>(v)); v = fmaxf(v, dppf<0x4E>(v)); return fmaxf(v, dppf<0x141>(v)); }
__device__ __forceinline__ float gsum8(float v) { v += dppf<0xB1>(v); v += dppf<0x4E>(v); return v + dppf<0x141>(v); }
__device__ __forceinline__ float wave_sum(float v) {
    v += dppf<0xB1>(v); v += dppf<0x4E>(v); v += dppf<0x141>(v); v += dppf<0x140>(v);
    const int iv = __builtin_bit_cast(int, v);
    return (__builtin_bit_cast(float, __builtin_amdgcn_readlane(iv, 0)) + __builtin_bit_cast(float, __builtin_amdgcn_readlane(iv, 16))) + (__builtin_bit_cast(float, __builtin_amdgcn_readlane(iv, 32)) + __builtin_bit_cast(float, __builtin_amdgcn_readlane(iv, 48)));
}
__device__ __forceinline__ void transpose_item64(const float* W, int N, bf16* WT, int ldt, int k0, int n0, int drow0, LAS float* scr, int lane) {
    const int rr = lane >> 4, cc = (lane & 15) * 4;
    f32x4 v[16];
#pragma unroll
    for (int i = 0; i < 16; ++i) { const int kk = 4 * i + rr; v[i] = *(const GAS f32x4*)(W + (size_t)(k0 + kk) * N + n0 + cc); }
#pragma unroll
    for (int i = 0; i < 16; ++i) { const int kk = 4 * i + rr; LAS float* d = scr + kk * 65 + cc; d[0] = v[i].x; d[1] = v[i].y; d[2] = v[i].z; d[3] = v[i].w; }
    LDS_WAIT(); asm volatile("" ::: "memory");
    const int c = lane & 7;
#pragma unroll
    for (int j = 0; j < 8; ++j) { const int n = (lane >> 3) + 8 * j; const LAS float* s = scr + (8 * c) * 65 + n;
        v4u o; o.x = pk2(s[0 * 65], s[1 * 65]); o.y = pk2(s[2 * 65], s[3 * 65]); o.z = pk2(s[4 * 65], s[5 * 65]); o.w = pk2(s[6 * 65], s[7 * 65]);
        *(GAS v4u*)(WT + (size_t)(drow0 + n) * ldt + k0 + 8 * c) = o; }
    LDS_WAIT(); asm volatile("" ::: "memory");
}
__device__ __forceinline__ int map_in_a(int n) { return n < 768 ? n : (n < 960 ? n + 256 : (n < 1152 ? n + 256 : n - 384)); }
__device__ __forceinline__ int map_in_b(int n) { return n < 768 ? n : (n < 2304 ? n + 256 : n - 1536); }

struct Args { const float* in[19]; float* out; unsigned char* ws; };
typedef const __attribute__((address_space(4))) Args* ArgsP;
__device__ __forceinline__ ArgsP fresh_args() { ArgsP p = (ArgsP)__builtin_amdgcn_kernarg_segment_ptr(); asm volatile("" : "+s"(p)); return p; }
__device__ __forceinline__ gu32* f_ctl() { return (gu32*)(fresh_args()->ws + WS_CTL); }

__device__ __forceinline__ void p0_small_weights(Frame& F, ArgsP A) {
    const int tid_ = fresh_tid(), lane_ = tid_ & 63; (void)tid_; (void)lane_;
    LAS float* scr = (LAS float*)(F.lds + (F.wave < 7 ? RING_OFF + F.wave * 16640 : IDX_OFF));
    unsigned char* ws = A->ws;
    constexpr int I_A = 16 * 22, I_B = 16 * 40, I_M = 16 * 8, I_O = 16 * 16, I_R = 16;
    constexpr int NITEMS = 2 * I_A + 2 * I_B + 4 * I_M + 4 * I_O + 4 * I_R;
    for (int it = f_gw(F); it < NITEMS; it += f_ngw()) {
        int r = it;
        if (r < 2 * I_A) { const int j = r / I_A; r %= I_A; const int kb = r / 22, nb = r % 22;
            transpose_item64(A->in[2] + (size_t)j * D * 1408, 1408, (bf16*)(ws + WS_WINA) + (size_t)j * NPA * D, D, 64 * kb, 64 * nb, map_in_a(64 * nb), scr, lane_); continue; } r -= 2 * I_A;
        if (r < 2 * I_B) { const int j = r / I_B; r %= I_B; const int kb = r / 40, nb = r % 40;
            transpose_item64(A->in[4] + (size_t)j * D * 2560, 2560, (bf16*)(ws + WS_WINB) + (size_t)j * NPB * D, D, 64 * kb, 64 * nb, map_in_b(64 * nb), scr, lane_); continue; } r -= 2 * I_B;
        if (r < 4 * I_M) { const int l = r / I_M; r %= I_M; const int kb = r / 8, nb = r % 8;
            transpose_item64(A->in[7] + (size_t)l * D * 512, 512, (bf16*)(ws + WS_WMKV), D, 64 * kb, 64 * nb, l * 512 + 64 * nb, scr, lane_); continue; } r -= 4 * I_M;
        if (r < 4 * I_O) { const int l = r / I_O; r %= I_O; const int kb = r / 16, nb = r % 16;
            transpose_item64(A->in[8] + (size_t)l * D * D, D, (bf16*)(ws + WS_WOUT) + (size_t)l * D * D, D, 64 * kb, 64 * nb, 64 * nb, scr, lane_); continue; } r -= 4 * I_O;
        { const int l = r / I_R; const int kb = r % I_R;
            transpose_item64(A->in[11] + (size_t)l * D * 64, 64, (bf16*)(ws + WS_WROUT) + (size_t)l * 256 * D, D, 64 * kb, 0, 0, scr, lane_); }
    }
    for (int it = f_gw(F); it < 2 * 128 + 4 * 192; it += f_ngw()) {
        bf16* row = it < 256 ? (bf16*)(ws + WS_WINA) + ((size_t)(it >> 7) * NPA + 1408 + (it & 127)) * D
                             : (bf16*)(ws + WS_WROUT) + ((size_t)((it - 256) / 192) * 256 + 64 + (it - 256) % 192) * D;
        GAS v4u* o = (GAS v4u*)row + lane_;
        o[0] = (v4u){0u, 0u, 0u, 0u}; o[64] = (v4u){0u, 0u, 0u, 0u};
    }
    f32x4 v[4][4];
#define P0_LOAD(M0) do { _Pragma("unroll") for (int r = 0; r < 4; ++r) { const int m = (M0) + r; const float* src = m < 512 ? A->in[1] + (size_t)m * D : A->in[0] + (size_t)(m - 512) * D; \
        const GAS f32x4* xr = (const GAS f32x4*)src + lane_; _Pragma("unroll") for (int j = 0; j < 4; ++j) v[r][j] = xr[64 * j]; } } while (0)
    if (4 * f_gw(F) < 512 + M) P0_LOAD(4 * f_gw(F));
    for (int m0 = 4 * f_gw(F); m0 < 512 + M; m0 += 4 * f_ngw()) {
        v2u o[4][4];
#pragma unroll
        for (int r = 0; r < 4; ++r)
#pragma unroll
            for (int j = 0; j < 4; ++j) o[r][j] = (v2u){pk2(v[r][j].x, v[r][j].y), pk2(v[r][j].z, v[r][j].w)};
        if (m0 + 4 * f_ngw() < 512 + M) P0_LOAD(m0 + 4 * f_ngw());
#pragma unroll
        for (int r = 0; r < 4; ++r) { const int m = m0 + r; bf16* dst = m < 512 ? (bf16*)(ws + WS_MEMB) + (size_t)m * D : (bf16*)(ws + WS_XB) + (size_t)(m - 512) * D;
            GAS v2u* o8 = (GAS v2u*)dst + lane_;
#pragma unroll
            for (int j = 0; j < 4; ++j) o8[64 * j] = o[r][j]; }
    }
#undef P0_LOAD
}
constexpr int CONV_ITEMS = 65 * 192, CONV_UNITS = CONV_ITEMS / 8;
__device__ __forceinline__ void convert_item(ArgsP A, int layer, int it, LAS float* scr, int lane_) {
    bf16* wexp = (bf16*)(A->ws + WS_WEXP);
    const int e = it / 192, mat = (it % 192) >> 6, r = it & 63;
    bf16* dst = wexp + (size_t)e * (pg8::EXPERT_BYTES / 2);
    if (mat < 2) { const float* W = (e < 64) ? A->in[13 + mat] + ((size_t)layer * 64 + e) * (D * HID) : A->in[16 + mat] + (size_t)layer * (D * HID);
        const int kb = r >> 2, nb = r & 3, n0 = 64 * nb;
        transpose_item64(W, HID, dst, D, 64 * kb, n0, (n0 >> 7) * 256 + mat * 128 + (n0 & 127), scr, lane_); }
    else { const float* W = (e < 64) ? A->in[15] + ((size_t)layer * 64 + e) * (HID * D) : A->in[18] + (size_t)layer * (HID * D);
        const int kb = r >> 4, nb = r & 15;
        transpose_item64(W, D, dst + pg8::EXPERT_DOWN_OFF / 2, HID, 64 * kb, 64 * nb, 64 * nb, scr, lane_); }
}
__device__ __forceinline__ void convert_unit(Frame& F, ArgsP A, int layer, int cu) {
    const int tid_ = fresh_tid(), lane_ = tid_ & 63; (void)tid_;
    LAS float* scr = (LAS float*)(F.lds + (F.wave < 7 ? RING_OFF + F.wave * 16640 : IDX_OFF));
    const int it = 8 * cu + F.wave;
    if (it < CONV_ITEMS) convert_item(A, layer, it, scr, lane_);
    asm volatile("s_waitcnt lgkmcnt(0)\n\ts_barrier" ::: "memory");
}
template <bool LAST> __device__ __forceinline__ void ph_combine_ln2(Frame& F, float* xout, const unsigned char* yt, const float* g, const float* b, bf16* xb) {
    typedef float f32x2c __attribute__((ext_vector_type(2)));
    const int tid_ = fresh_tid(), lane_ = tid_ & 63; (void)tid_;
    v4u rw[9], rx[2];
#define P9_LOAD(MM) do { const GAS v4u* yr_ = (const GAS v4u*)(yt + (size_t)(MM) * 9 * D) + lane_; const GAS v4u* xr_ = (const GAS v4u*)(xb + (size_t)(MM) * D) + 2 * lane_; \
        _Pragma("unroll") for (int k = 0; k < 9; ++k) rw[k] = yr_[k * 64]; rx[0] = xr_[0]; rx[1] = xr_[1]; } while (0)
    if (f_gw(F) < M) P9_LOAD(f_gw(F));
    for (int m = f_gw(F); m < M; m += f_ngw()) {
        GAS v4u* o8 = (GAS v4u*)(xb + (size_t)m * D) + 2 * lane_;
        float v[16];
#pragma unroll
        for (int i = 0; i < 16; ++i) v[i] = 0.f;
#pragma unroll
        for (int k = 0; k < 9; ++k) { const v4u w = rw[k];
#pragma unroll
            for (int q = 0; q < 4; ++q) { const f32x2c lo = __builtin_amdgcn_cvt_pk_f32_fp8((int)w[q], false), hi = __builtin_amdgcn_cvt_pk_f32_fp8((int)w[q], true);
                v[4 * q] += lo.x; v[4 * q + 1] += lo.y; v[4 * q + 2] += hi.x; v[4 * q + 3] += hi.y; } }
#pragma unroll
        for (int h = 0; h < 2; ++h) { const v4u xw = rx[h];
#pragma unroll
            for (int q = 0; q < 4; ++q) { v[8 * h + 2 * q] = v[8 * h + 2 * q] * (1.f / pg8::Y8_SCALE) + DN_ALPHA * bflo(xw[q]); v[8 * h + 2 * q + 1] = v[8 * h + 2 * q + 1] * (1.f / pg8::Y8_SCALE) + DN_ALPHA * bfhi(xw[q]); } }
        if (m + f_ngw() < M) P9_LOAD(m + f_ngw());
        float s = 0.f;
#pragma unroll
        for (int i = 0; i < 16; ++i) s += v[i];
        const float mean = wave_sum(s) * (1.f / D); float s2 = 0.f;
#pragma unroll
        for (int i = 0; i < 16; ++i) { v[i] -= mean; s2 += v[i] * v[i]; }
        const float rstd = 1.f / sqrtf(wave_sum(s2) * (1.f / D) + LN_EPS);
        const GAS f32x4* gp = (const GAS f32x4*)g + 4 * lane_; const GAS f32x4* bp = (const GAS f32x4*)b + 4 * lane_;
        GAS f32x4* xo = (GAS f32x4*)(xout + (size_t)m * D) + 4 * lane_;
        float o[16];
#pragma unroll
        for (int q = 0; q < 4; ++q) { const f32x4 gv = gp[q], bv = bp[q];
            o[4 * q] = v[4 * q] * rstd * gv.x + bv.x; o[4 * q + 1] = v[4 * q + 1] * rstd * gv.y + bv.y; o[4 * q + 2] = v[4 * q + 2] * rstd * gv.z + bv.z; o[4 * q + 3] = v[4 * q + 3] * rstd * gv.w + bv.w;
            if (LAST) xo[q] = (f32x4){o[4 * q], o[4 * q + 1], o[4 * q + 2], o[4 * q + 3]}; }
        if (!LAST) { o8[0] = (v4u){pk2(o[0], o[1]), pk2(o[2], o[3]), pk2(o[4], o[5]), pk2(o[6], o[7])}; o8[1] = (v4u){pk2(o[8], o[9]), pk2(o[10], o[11]), pk2(o[12], o[13]), pk2(o[14], o[15])}; }
    }
#undef P9_LOAD
}
__device__ __forceinline__ void ph_diff_combine(Frame& F, const bf16* otmp, const float* lq, const float* subg, float lam_init, bf16* cat) {
    const int tid_ = fresh_tid(), lane_ = tid_ & 63; (void)tid_; (void)lane_;
    float lam;
    { const float a = lq[lane_] * lq[64 + lane_], c = lq[128 + lane_] * lq[192 + lane_]; lam = expf(wave_sum(a)) - expf(wave_sum(c)) + lam_init; }
    const int l32 = lane_ & 31, hh = lane_ >> 5;
    const f32x4 gv = ((const GAS f32x4*)subg)[l32]; const float post = 1.f - lam_init;
    for (int m0 = f_gw(F); m0 < M; m0 += 4 * f_ngw()) {
        v2u a0[4][3], a1[4][3];
#pragma unroll
        for (int r = 0; r < 4; ++r) { const int m = m0 + r * f_ngw(); const size_t mo = (size_t)(m < M ? m : m0) * 1536;
#pragma unroll
            for (int hp = 0; hp < 3; ++hp) { const int h = 2 * hp + hh; a0[r][hp] = *((const GAS v2u*)(otmp + mo + h * 256) + l32); a1[r][hp] = *((const GAS v2u*)(otmp + mo + h * 256 + 128) + l32); } }
#pragma unroll
        for (int r = 0; r < 4; ++r) { const int m = m0 + r * f_ngw();
#pragma unroll
            for (int hp = 0; hp < 3; ++hp) { const int h = 2 * hp + hh; const v2u x0 = a0[r][hp], x1 = a1[r][hp];
                f32x4 o; o.x = bflo(x0.x) - lam * bflo(x1.x); o.y = bfhi(x0.x) - lam * bfhi(x1.x); o.z = bflo(x0.y) - lam * bflo(x1.y); o.w = bfhi(x0.y) - lam * bfhi(x1.y);
                float s2 = (o.x * o.x + o.y * o.y) + (o.z * o.z + o.w * o.w);
                s2 += dppf<0xB1>(s2); s2 += dppf<0x4E>(s2); s2 += dppf<0x141>(s2); s2 += dppf<0x140>(s2); s2 += sx(s2, 16, lane_);
                const float rr = post / sqrtf(s2 * (1.f / 128.f) + LN_EPS);
                o = o * rr * gv;
                if (m < M) *((GAS v2u*)(cat + (size_t)m * D + h * 128) + l32) = (v2u){pk2(o.x, o.y), pk2(o.z, o.w)}; } }
    }
}
__device__ __forceinline__ float ss8(v4u a) { float s = 0.f;
#pragma unroll
    for (int i = 0; i < 4; ++i) { const float lo = bflo(a[i]), hi = bfhi(a[i]); s += lo * lo + hi * hi; } return s; }
__device__ __forceinline__ void ph_qknorm(Frame& F, const bf16* qkv, gu32* gmax) {
    const int tid_ = fresh_tid(), lane_ = tid_ & 63;
    LAS unsigned* lmax = (LAS unsigned*)(F.lds + LDSCTL_OFF) + 32;
    if (tid_ < 24) lmax[tid_] = 0u;
    __syncthreads();
    float mq0 = 0.f, mq1 = 0.f, mk0 = 0.f, mk1 = 0.f;
    const v4u zero = (v4u){0u, 0u, 0u, 0u};
    const int hsel = lane_ < 32 ? 8 * lane_ : 8 * (lane_ - 32);
    for (int m0 = f_gw(F); m0 < M; m0 += 4 * f_ngw()) {
        v4u a[4], b[4], c[4], d[4];
#pragma unroll
        for (int r = 0; r < 4; ++r) { const int m = m0 + r * f_ngw(); const bf16* row = qkv + (size_t)(m < M ? m : m0) * NPB;
            a[r] = *(const GAS v4u*)(row + 8 * lane_); c[r] = *(const GAS v4u*)(row + 1024 + 8 * lane_); b[r] = *(const GAS v4u*)(row + 512 + hsel); d[r] = *(const GAS v4u*)(row + 1536 + hsel); }
#pragma unroll
        for (int r = 0; r < 4; ++r) { const float sa = gsum8(ss8(a[r])), sb = gsum8(ss8(b[r])), sc = gsum8(ss8(c[r])), sd = gsum8(ss8(d[r]));
            mq0 = fmaxf(mq0, sa); mq1 = fmaxf(mq1, sb); mk0 = fmaxf(mk0, sc); mk1 = fmaxf(mk1, sd); }
    }
    if ((lane_ & 7) == 0) { const int g = lane_ >> 3;
        __hip_atomic_fetch_max(lmax + g, __float_as_uint(mq0), __ATOMIC_RELAXED, __HIP_MEMORY_SCOPE_WORKGROUP); __hip_atomic_fetch_max(lmax + 12 + g, __float_as_uint(mk0), __ATOMIC_RELAXED, __HIP_MEMORY_SCOPE_WORKGROUP);
        if (lane_ < 32) { __hip_atomic_fetch_max(lmax + 8 + g, __float_as_uint(mq1), __ATOMIC_RELAXED, __HIP_MEMORY_SCOPE_WORKGROUP); __hip_atomic_fetch_max(lmax + 20 + g, __float_as_uint(mk1), __ATOMIC_RELAXED, __HIP_MEMORY_SCOPE_WORKGROUP); } }
    __syncthreads();
    if (tid_ < 24) __hip_atomic_fetch_max(gmax + tid_, lmax[tid_], RLX_AGENT);
}
typedef short bf16x8r __attribute__((ext_vector_type(8)));
constexpr int RT_SC_OFF = TAB_OFF, RT_GB_OFF = TAB_OFF + 16384, RT_V_OFF = TAB_OFF + 16384 + 8192;
static_assert(RT_V_OFF + 8 * 256 <= LDS_BYTES, "LDS map (route phase)");
template <bool XF32> __device__ __forceinline__ void ph_ln_route(Frame& F, const float* xin, const bf16* y, const float* g, const float* b, bf16* xb, const bf16* wrt, const float* rbias, gu32* cnt, int* rowtok, float* rowgate, float* gtmp) {
    const int tid_ = fresh_tid(), lane_ = tid_ & 63;
    for (int i = tid_; i < 64 * 128; i += NWAVES * 64) { const int e = i >> 7, c = i & 127;
        const v4u v = *(const GAS v4u*)(wrt + (size_t)e * D + c * 8); *(LAS v4u*)(F.lds + e * 2048 + ((c ^ (e & 15)) << 4)) = v; }
    LAS float* lgb = (LAS float*)(F.lds + RT_GB_OFF);
    if (tid_ < 256) { ((LAS f32x4*)lgb)[tid_] = ((const GAS f32x4*)g)[tid_]; ((LAS f32x4*)lgb)[256 + tid_] = ((const GAS f32x4*)b)[tid_]; }
    __syncthreads();
    LAS float* sc = (LAS float*)(F.lds + RT_SC_OFF) + F.wave * 512;
    LAS float* vs = (LAS float*)(F.lds + RT_V_OFF) + F.wave * 64;
    const int r = lane_ & 15, kq = lane_ >> 4; const float bias = rbias[lane_]; const float NINF = -INFINITY;
    for (int base = f_gw(F) * 16; base < M; base += f_ngw() * 16) {
        v2u ry[4][4]; v2u rxb[4][4]; f32x4 rxf[4][4];
#define LN_LOAD(R4) do { _Pragma("unroll") for (int q = 0; q < 4; ++q) { const size_t mo = (size_t)(base + (R4) + q) * D; const GAS v2u* yr = (const GAS v2u*)(y + mo) + lane_; \
            _Pragma("unroll") for (int j = 0; j < 4; ++j) { if (XF32) rxf[q][j] = ((const GAS f32x4*)(xin + mo) + lane_)[64 * j]; else rxb[q][j] = ((const GAS v2u*)(xb + mo) + lane_)[64 * j]; ry[q][j] = yr[64 * j]; } } } while (0)
        LN_LOAD(0);
#pragma unroll
        for (int r4 = 0; r4 < 16; r4 += 4) {
            f32x4 v[4][4]; float s1[4];
#pragma unroll
            for (int q = 0; q < 4; ++q) { s1[q] = 0.f;
#pragma unroll
                for (int j = 0; j < 4; ++j) { f32x4 xv; if (XF32) xv = rxf[q][j]; else { const v2u xw = rxb[q][j]; xv = (f32x4){bflo(xw.x), bfhi(xw.x), bflo(xw.y), bfhi(xw.y)}; }
                    const v2u yv = ry[q][j];
                    v[q][j].x = DN_ALPHA * xv.x + bflo(yv.x); v[q][j].y = DN_ALPHA * xv.y + bfhi(yv.x); v[q][j].z = DN_ALPHA * xv.z + bflo(yv.y); v[q][j].w = DN_ALPHA * xv.w + bfhi(yv.y);
                    s1[q] += (v[q][j].x + v[q][j].y) + (v[q][j].z + v[q][j].w); } }
            if (r4 + 4 < 16) LN_LOAD(r4 + 4);
#pragma unroll
            for (int q = 0; q < 4; ++q) s1[q] = wave_sum(s1[q]);
            float s2[4];
#pragma unroll
            for (int q = 0; q < 4; ++q) { const float mean = s1[q] * (1.f / D); s2[q] = 0.f;
#pragma unroll
                for (int j = 0; j < 4; ++j) { v[q][j] = v[q][j] - mean; s2[q] += (v[q][j].x * v[q][j].x + v[q][j].y * v[q][j].y) + (v[q][j].z * v[q][j].z + v[q][j].w * v[q][j].w); } }
#pragma unroll
            for (int q = 0; q < 4; ++q) s2[q] = wave_sum(s2[q]);
#pragma unroll
            for (int q = 0; q < 4; ++q) { const float rstd = 1.f / sqrtf(s2[q] * (1.f / D) + LN_EPS); GAS v2u* o8 = (GAS v2u*)(xb + (size_t)(base + r4 + q) * D) + lane_;
#pragma unroll
                for (int j = 0; j < 4; ++j) { const LAS f32x4* gp = (const LAS f32x4*)lgb + lane_ + 64 * j; const f32x4 gv = gp[0], bv = gp[256];
                    const f32x4 o = v[q][j] * rstd * gv + bv; o8[64 * j] = (v2u){pk2(o.x, o.y), pk2(o.z, o.w)}; } }
        }
#undef LN_LOAD
        asm volatile("s_waitcnt vmcnt(0)" ::: "memory");
        f32x4 acc[4];
#pragma unroll
        for (int nt = 0; nt < 4; ++nt) acc[nt] = (f32x4){0.f, 0.f, 0.f, 0.f};
        const bf16* arow = xb + (size_t)(base + r) * D + 8 * kq;
#pragma unroll 16
        for (int s = 0; s < 32; ++s) { const v4u aw = *(const GAS v4u*)(arow + 32 * s); const bf16x8r af = __builtin_bit_cast(bf16x8r, aw);
#pragma unroll
            for (int nt = 0; nt < 4; ++nt) { const int e = 16 * nt + r, c = 4 * s + kq;
                const bf16x8r bfr = *(const LAS bf16x8r*)(F.lds + e * 2048 + ((c ^ (e & 15)) << 4));
                acc[nt] = __builtin_amdgcn_mfma_f32_16x16x32_bf16(bfr, af, acc[nt], 0, 0, 0); } }
        unsigned selmask = 0u; unsigned long long slots = 0ull; unsigned mycount = 0u;
#pragma unroll 1
        for (int half = 0; half < 2; ++half) {
            if ((r >> 3) == half) {
#pragma unroll
                for (int nt = 0; nt < 4; ++nt) *(LAS f32x4*)(sc + (r & 7) * 64 + 16 * nt + 4 * kq) = acc[nt]; }
            LDS_WAIT(); asm volatile("" ::: "memory");
#pragma unroll 1
            for (int j8 = 0; j8 < 8; ++j8) { const int j = half * 8 + j8;
                const float logit = sc[j8 * 64 + lane_];
                const float aff = 1.f / (1.f + expf(-logit)); const float sel = aff + bias;
                const float m1 = gmax8(sel);
                const unsigned long long bm = __ballot(sel == m1); const unsigned gb = (unsigned)(bm >> (lane_ & 56)) & 0xffu; const int first = __builtin_ctz(gb | 0x100u);
                const float m2 = gmax8(((lane_ & 7) == first) ? NINF : sel);
                const float gs = m1 + m2; int grank = 0;
#pragma unroll
                for (int g2 = 0; g2 < 8; ++g2) { const float o = __builtin_bit_cast(float, __builtin_amdgcn_readlane(__builtin_bit_cast(int, gs), 8 * g2)); grank += (o > gs || (o == gs && g2 < (lane_ >> 3))) ? 1 : 0; }
                const bool gok = grank < 4; const float v = gok ? sel : NINF; int er = 0;
                vs[lane_] = v; LDS_WAIT(); asm volatile("" ::: "memory");
#pragma unroll
                for (int e4 = 0; e4 < 16; ++e4) { const f32x4 o = ((const LAS f32x4*)vs)[e4]; er += ((o.x > v) ? 1 : 0) + ((o.y > v) ? 1 : 0) + ((o.z > v) ? 1 : 0) + ((o.w > v) ? 1 : 0); }
                bool chosen = gok && er < 8;
                if (__builtin_popcountll(__ballot(chosen)) != 8) {
                    er = 0;
#pragma unroll 4
                    for (int e2 = 0; e2 < 64; ++e2) { const float o = vs[e2]; er += (o > v || (o == v && e2 < lane_)) ? 1 : 0; }
                    chosen = gok && er < 8; }
                asm volatile("" ::: "memory");
                const float cs = gsum8(chosen ? aff : 0.f); float ssum = 0.f;
#pragma unroll
                for (int g2 = 0; g2 < 8; ++g2) ssum += __builtin_bit_cast(float, __builtin_amdgcn_readlane(__builtin_bit_cast(int, cs), 8 * g2));
                const unsigned long long bal = __ballot(chosen); const unsigned slot = __builtin_amdgcn_mbcnt_hi((unsigned)(bal >> 32), __builtin_amdgcn_mbcnt_lo((unsigned)bal, 0u));
                if (chosen) { selmask |= 1u << j; slots |= (unsigned long long)slot << (4 * j); ++mycount; gtmp[(size_t)(base + j) * 64 + lane_] = aff / ssum * 2.5f; }
            }
            LDS_WAIT(); asm volatile("" ::: "memory");
        }
        unsigned pos = 0u;
        { LAS unsigned* wgc = (LAS unsigned*)(F.lds + LDSCTL_OFF) + 64;
            if (tid_ < 64) wgc[tid_] = 0u;
            __syncthreads();
            if (mycount) pos = __hip_atomic_fetch_add(wgc + lane_, mycount, __ATOMIC_RELAXED, __HIP_MEMORY_SCOPE_WORKGROUP);
            __syncthreads();
            if (tid_ < 64) { const unsigned tot = wgc[tid_]; unsigned gb = 0u; if (tot) gb = __hip_atomic_fetch_add(cnt + 64 * tid_, tot, RLX_AGENT); wgc[tid_] = gb; }
            __syncthreads();
            pos += wgc[lane_];
            __syncthreads(); }
#pragma unroll 1
        for (int j = 0; j < 16; ++j) if ((selmask >> j) & 1u) { const size_t at = (size_t)lane_ * CAP + pos; ++pos;
            rowtok[at] = (base + j) | ((int)((slots >> (4 * j)) & 15ull) << 16); rowgate[at] = gtmp[(size_t)(base + j) * 64 + lane_]; }
    }
}
template <bool M1> __device__ __forceinline__ int build_units(Frame& F, gu32* cnt, const int* rowtok, const float* rowgate) {
    const int tid_ = fresh_tid();
    LAS int* tcnt = (LAS int*)(F.lds + TAB_OFF); LAS int* bst = tcnt + 80; LAS int* utab = tcnt + 160; LAS int* idx = (LAS int*)(F.lds + IDX_OFF); LAS float* lgate = (LAS float*)(F.lds + GATE_OFF);
    if (tid_ < 64) {
        const int c = (int)__hip_atomic_load(cnt + 64 * tid_, RLX_AGENT); const int nb = (c + 255) >> 8; int incl = nb;
#pragma unroll
        for (int o = 1; o < 64; o <<= 1) { const int u = __builtin_amdgcn_ds_bpermute((tid_ - o) << 2, incl); if (tid_ >= o) incl += u; }
        tcnt[tid_] = c; bst[tid_] = incl - nb;
        if (tid_ == 63) { tcnt[64] = M; bst[64] = incl; bst[65] = incl + M / 256; }
    }
    __syncthreads();
    const int nblk = bst[65]; const int bx = blockIdx.x;
    const int per = M1 ? 128 : 64, blk0 = M1 ? (16 * (bx & 7) + (bx >> 4)) : (8 * (bx & 7) + (bx >> 5)), pn = M1 ? ((bx >> 3) & 1) : ((bx >> 3) & 3);
    int nmine = (nblk > blk0) ? (nblk - blk0 + per - 1) / per : 0; if (nmine > (M1 ? 10 : 20)) nmine = M1 ? 10 : 20;
    if (tid_ < nmine) { const int blk = tid_ * per + blk0;
        int e = 0;
#pragma unroll
        for (int st = 64; st > 0; st >>= 1) { const int q = e + st; if (q <= 64 && bst[q] <= blk) e = q; }
        const int j = blk - bst[e]; int nv = tcnt[e] - 256 * j; if (nv > 256) nv = 256;
        LAS int* t = utab + tid_ * 8; t[0] = e; t[1] = blk; t[2] = pn; t[3] = nv; t[4] = e * CAP + 256 * j; t[5] = 256 * j; }
    __syncthreads();
    for (int q = tid_; q < nmine * 256; q += NWAVES * 64) { const int g = q >> 8, i = q & 255;
        const LAS int* t = utab + g * 8; const int e = t[0], nv = t[3];
        if (M1) { int tok = 0; float gt = 0.f;
            if (e == 64) { tok = t[5] + i; gt = 1.f; } else if (i < nv) { tok = rowtok[t[4] + i] & 0xffff; gt = rowgate[t[4] + i]; }
            idx[q] = tok; lgate[q] = gt; }
        else { int dst = M * 9;
            if (e == 64) dst = (t[5] + i) * 9 + 8; else if (i < nv) { const int v = rowtok[t[4] + i]; dst = (v & 0xffff) * 9 + (v >> 16); }
            idx[q] = dst; } }
    __syncthreads();
    return nmine;
}
#define WSP(T, off) ((T*)(A->ws + (off)))
#ifndef REP_P1
#define REP_P1 1
#endif
#ifndef REP_P2
#define REP_P2 1
#endif
#ifndef REP_P3
#define REP_P3 1
#endif
#ifndef REP_P5
#define REP_P5 1
#endif
#ifndef REP_P7
#define REP_P7 1
#endif
#ifndef REP_P8
#define REP_P8 1
#endif
#define REPEAT(n) _Pragma("unroll 1") for (int rep_ = 0; rep_ < (n); ++rep_)
#define OPQ(x) asm volatile("" : "+s"(x))
#define FCTL() f_ctl()
#define FRESH_GB() const int G = f_G(), bx = f_bx(); (void)G; (void)bx
__global__ void __launch_bounds__(NWAVES * 64, 2) mega_fwd(Args args_unused) {
    extern __shared__ __attribute__((aligned(16))) unsigned char lds[];
    Frame F;
    F.lds = (LAS unsigned char*)lds;
    F.wave = __builtin_amdgcn_readfirstlane((int)threadIdx.x >> 6);
    for (int u = fresh_tid(); u < 512 / 4; u += NWAVES * 64) ((LAS unsigned*)(F.lds + LDSCTL_OFF))[u] = 0u;
    __syncthreads();
    (void)xcd_barrier_post((unsigned*)(f_ctl() + CW_BAR), f_misc(F) + 8, fresh_tid() == 0);
#define GRID_BAR() do { XcdBarrier bar_; bar_.bar = (unsigned*)(f_ctl() + CW_BAR); bar_.x = xb_xcc_id(); bar_.st = f_misc(F) + 8; xcd_barrier(bar_, fresh_tid() == 0); } while (0)

    { ArgsP A = fresh_args(); FRESH_GB(); p0_small_weights(F, A); }
    GRID_BAR();
    {   ArgsP A = fresh_args(); FRESH_GB();
        pg8::DenseSched S; S.init(512, 2048, D, G, bx, WSP(const bf16, WS_WMKV));
        pg8::EpiBf16 E{WSP(bf16, WS_MEMKV), 2048, 0, 1.f};
        pg8::gemm_phase<pg8::EpiBf16, pg8::DenseSched>(F.lds + RING_OFF, WSP(const bf16, WS_MEMB), D, S, E, F.wave); }

    for (int layer = 0; layer < DEPTH; ++layer) {
        const int jm = layer >> 1; const bool isB = (layer & 1) != 0;
        REPEAT(REP_P1) {
        if (!isB) { ArgsP A = fresh_args(); FRESH_GB();
            pg8::DenseSched S; S.init(M, NPA, D, G, bx, WSP(const bf16, WS_WINA) + (size_t)jm * NPA * D);
            pg8::EpiBf16 E{WSP(bf16, WS_QKV), NPA, 4, attn_body::C2};
            pg8::gemm_phase<pg8::EpiBf16, pg8::DenseSched>(F.lds + RING_OFF, WSP(const bf16, WS_XB), D, S, E, F.wave); }
        else { ArgsP A = fresh_args(); FRESH_GB();
            pg8::DenseSched S; S.init(M, NPB, D, G, bx, WSP(const bf16, WS_WINB) + (size_t)jm * NPB * D);
            pg8::EpiBf16 E{WSP(bf16, WS_QKV), NPB, 4, attn_body::C2};
            pg8::gemm_phase<pg8::EpiBf16, pg8::DenseSched>(F.lds + RING_OFF, WSP(const bf16, WS_XB), D, S, E, F.wave); }
        GRID_BAR();
        }
        if (isB) {
            ArgsP A = fresh_args();
            ph_qknorm(F, WSP(const bf16, WS_QKV), FCTL() + CW_NORM + 64 * layer);
            GRID_BAR();
        }
        REPEAT(REP_P2) {
        if (!isB) {
            { FRESH_GB();
            for (int L = bx; L < 1536; L += G) {
                ArgsP A = fresh_args(); const bf16* qkv = WSP(const bf16, WS_QKV); const int wave = F.wave;
                const int b = L / 768, rem = L % 768, qblk = rem / 3, kvh = rem % 3;
                const int q0u = qblk * 64, head = kvh * 4 + (wave >> 1); const size_t rowq = (size_t)b * SEQ + q0u + 32 * (wave & 1);
                attn_body::AttnArgs a;
                a.Qw = (const attn_body::bf16*)(qkv + rowq * NPA + head * 64);
                a.K0 = (const attn_body::bf16*)(qkv + ((size_t)b * SEQ + q0u) * NPA + 1024 + kvh * 64); a.V0 = a.K0 + 192;
                a.NT = 4; a.tmax = qblk; a.Ow = (attn_body::bf16*)(WSP(bf16, WS_CAT) + rowq * D + head * 64);
                a.qrel = 32 * (wave & 1) + (fresh_tid() & 31); a.slope2 = SLOPES_A[head] * attn_body::LOG2E; a.sink2 = A->in[3][jm * 12 + head] * attn_body::LOG2E; a.wave = F.wave;
                attn_body::attn_unit<2, 8, NPA, NPA, D>(a, (char*)lds + RING_OFF);
                convert_unit(F, A, layer, L);
            }
            for (int cu = 1536 + bx; cu < CONV_UNITS; cu += G) { ArgsP A = fresh_args(); convert_unit(F, A, layer, cu); } }
            { FRESH_GB();
            for (int L = bx; L < 512; L += G) {
                ArgsP A = fresh_args(); const int wave = F.wave;
                const int b = L / 256, rem = L % 256, qb = rem >> 2, hm = rem & 3;
                const size_t rowq = (size_t)b * SEQ + qb * 256 + 32 * wave;
                attn_body::AttnArgs a;
                a.Qw = (const attn_body::bf16*)(WSP(const bf16, WS_QKV) + rowq * NPA + 768 + hm * 64);
                a.K0 = (const attn_body::bf16*)(WSP(const bf16, WS_MEMKV) + (size_t)b * MEMLEN * 2048 + layer * 512 + hm * 64); a.V0 = a.K0 + 256;
                a.NT = 4; a.tmax = 1 << 30; a.Ow = (attn_body::bf16*)(WSP(bf16, WS_CAT) + rowq * D + 768 + hm * 64);
                a.qrel = 32 * wave + (fresh_tid() & 31); a.slope2 = 0.f; a.sink2 = 0.f; a.wave = F.wave;
                attn_body::attn_unit<0, 8, NPA, 2048, D>(a, (char*)lds + RING_OFF);
            } }
        } else {
            {
                gu32* q0 = FCTL() + CW_Q + 64 * layer + 16 * rep_;
                int turn = 0; bool doneA = false, doneC = false, have = true; unsigned nextL = 0u;
                if (fresh_tid() == 0) nextL = __hip_atomic_fetch_add(q0, 1u, RLX_AGENT);
                for (;;) {
                    if (!have) { if (fresh_tid() == 0) nextL = __hip_atomic_fetch_add(q0 + turn, 1u, RLX_AGENT); }
                    if (fresh_tid() == 0) f_misc(F)[16] = nextL;
                    __syncthreads();
                    const int L = __builtin_amdgcn_readfirstlane((int)f_misc(F)[16]);
                    __syncthreads();
                    have = false;
                    if (L >= (turn ? CONV_UNITS : 1536)) { if (turn) doneC = true; else doneA = true; if (doneA && doneC) break; turn ^= 1; continue; }
                    const int nturn = turn ? (doneA ? 1 : 0) : (doneC ? 0 : 1);
                    if (turn | nturn) { if (fresh_tid() == 0) nextL = __hip_atomic_fetch_add(q0 + nturn, 1u, RLX_AGENT); have = true; }
                    ArgsP A = fresh_args(); const bf16* qkv = WSP(const bf16, WS_QKV); const int wave = F.wave;
                    if (turn) { convert_unit(F, A, layer, L); turn = nturn; continue; }
                    turn = nturn;
                    const int qb = 63 - L / 24, rem = L % 24, b = rem / 12, hc = rem % 12, h = hc >> 1, c = hc & 1;
                    const size_t rowq = (size_t)b * SEQ + qb * 256 + 32 * wave;
                    const float slope2 = SLOPES_B[h] * attn_body::LOG2E;
                    const float q2m = __uint_as_float(__hip_atomic_load(FCTL() + CW_NORM + 64 * layer + hc, RLX_AGENT)), k2m = __uint_as_float(__hip_atomic_load(FCTL() + CW_NORM + 64 * layer + 12 + hc, RLX_AGENT));
                    const float B2 = sqrtf(q2m * k2m) * 1.03f + 0.5f, dcut = (160.f + 2.f * B2) / slope2;
                    int t0 = (int)floorf(((float)(qb * 256 - 63) - dcut) * (1.f / 64.f)); t0 = __builtin_amdgcn_readfirstlane(t0 > 0 ? (t0 & ~1) : 0);
                    attn_body::AttnArgs a;
                    a.Qw = (const attn_body::bf16*)(qkv + rowq * NPB + hc * 64);
                    a.K0 = (const attn_body::bf16*)(qkv + ((size_t)b * SEQ + 64 * t0) * NPB + 1024 + hc * 64); a.V0 = (const attn_body::bf16*)(qkv + ((size_t)b * SEQ + 64 * t0) * NPB + 1792 + h * 128);
                    a.NT = 4 * (qb + 1) - t0; a.tmax = 1 << 30; a.Ow = (attn_body::bf16*)(WSP(bf16, WS_OTMP) + rowq * 1536 + hc * 128);
                    a.qrel = 32 * wave + (fresh_tid() & 31); a.slope2 = slope2; a.sink2 = 0.f; a.wave = F.wave;
                    attn_body::diff_unit<16, NPB, NPB, 1536>(a, (char*)lds + RING_OFF);
                }
            }
            { FRESH_GB();
            for (int L = bx; L < 512; L += G) {
                ArgsP A = fresh_args(); const int wave = F.wave;
                const int b = L / 256, rem = L % 256, qb = rem >> 2, hm = rem & 3;
                const size_t rowq = (size_t)b * SEQ + qb * 256 + 32 * wave;
                attn_body::AttnArgs a;
                a.Qw = (const attn_body::bf16*)(WSP(const bf16, WS_QKV) + rowq * NPB + 768 + hm * 64);
                a.K0 = (const attn_body::bf16*)(WSP(const bf16, WS_MEMKV) + (size_t)b * MEMLEN * 2048 + layer * 512 + hm * 64); a.V0 = a.K0 + 256;
                a.NT = 4; a.tmax = 1 << 30; a.Ow = (attn_body::bf16*)(WSP(bf16, WS_CAT) + rowq * D + 768 + hm * 64);
                a.qrel = 32 * wave + (fresh_tid() & 31); a.slope2 = 0.f; a.sink2 = 0.f; a.wave = F.wave;
                attn_body::attn_unit<0, 8, NPB, 2048, D>(a, (char*)lds + RING_OFF);
            } }
        }
        GRID_BAR();
        }
        if (isB) {
            ArgsP A = fresh_args(); FRESH_GB();
            ph_diff_combine(F, WSP(const bf16, WS_OTMP), A->in[5] + jm * 256, A->in[6] + jm * 128, 0.8f - 0.6f * expf(-0.3f * (float)layer), WSP(bf16, WS_CAT));
            GRID_BAR();
        }
        REPEAT(REP_P3) {
        {   ArgsP A = fresh_args(); FRESH_GB();
            pg8::DenseSched S; S.init(M, D, D, G, bx, WSP(const bf16, WS_WOUT) + (size_t)layer * D * D);
            pg8::EpiBf16 E{WSP(bf16, WS_Y), D, 0, 1.f};
            pg8::gemm_phase<pg8::EpiBf16, pg8::DenseSched>(F.lds + RING_OFF, WSP(const bf16, WS_CAT), D, S, E, F.wave); }
        GRID_BAR();
        }
        {   ArgsP A = fresh_args();
            if (layer == 0) ph_ln_route<true>(F, A->in[0], WSP(const bf16, WS_Y), A->in[9] + (size_t)(layer * 2) * D, A->in[10] + (size_t)(layer * 2) * D, WSP(bf16, WS_XB), WSP(const bf16, WS_WROUT) + (size_t)layer * 256 * D, A->in[12] + layer * 64, FCTL() + CW_CNT + layer * 64 * 64, WSP(int, WS_ROWTOK), WSP(float, WS_ROWGATE), WSP(float, WS_LOGIT));
            else ph_ln_route<false>(F, nullptr, WSP(const bf16, WS_Y), A->in[9] + (size_t)(layer * 2) * D, A->in[10] + (size_t)(layer * 2) * D, WSP(bf16, WS_XB), WSP(const bf16, WS_WROUT) + (size_t)layer * 256 * D, A->in[12] + layer * 64, FCTL() + CW_CNT + layer * 64 * 64, WSP(int, WS_ROWTOK), WSP(float, WS_ROWGATE), WSP(float, WS_LOGIT)); }
        GRID_BAR();
        REPEAT(REP_P7) {
        {   ArgsP A = fresh_args(); FRESH_GB();
            const int nmine = build_units<true>(F, FCTL() + CW_CNT + layer * 64 * 64, WSP(const int, WS_ROWTOK), WSP(const float, WS_ROWGATE));
            pg8::GroupSched<true> S{(const LAS int*)(F.lds + TAB_OFF) + 160, (const LAS int*)(F.lds + IDX_OFF), nmine, D, (const char*)(A->ws + WS_WEXP)};
            pg8::EpiM1 E{WSP(bf16, WS_HB), (const LAS float*)(F.lds + GATE_OFF)};
            pg8::gemm_phase<pg8::EpiM1, pg8::GroupSched<true>>(F.lds + RING_OFF, WSP(const bf16, WS_XB), D, S, E, F.wave); }
        GRID_BAR();
        }
        REPEAT(REP_P8) {
        {   ArgsP A = fresh_args(); FRESH_GB();
            const int nmine = build_units<false>(F, FCTL() + CW_CNT + layer * 64 * 64, WSP(const int, WS_ROWTOK), WSP(const float, WS_ROWGATE));
            pg8::GroupSched<false> S{(const LAS int*)(F.lds + TAB_OFF) + 160, (const LAS int*)(F.lds + IDX_OFF), nmine, HID, (const char*)(A->ws + WS_WEXP) + pg8::EXPERT_DOWN_OFF};
            pg8::EpiM2 E{WSP(unsigned char, WS_BIG), (const LAS int*)(F.lds + IDX_OFF)};
            pg8::gemm_phase<pg8::EpiM2, pg8::GroupSched<false>>(F.lds + RING_OFF, WSP(const bf16, WS_HB), HID, S, E, F.wave); }
        GRID_BAR();
        }
        {   ArgsP A = fresh_args(); FRESH_GB();
            if (layer + 1 < DEPTH) ph_combine_ln2<false>(F, A->out, WSP(const unsigned char, WS_BIG), A->in[9] + (size_t)(layer * 2 + 1) * D, A->in[10] + (size_t)(layer * 2 + 1) * D, WSP(bf16, WS_XB));
            else ph_combine_ln2<true>(F, A->out, WSP(const unsigned char, WS_BIG), A->in[9] + (size_t)(layer * 2 + 1) * D, A->in[10] + (size_t)(layer * 2 + 1) * D, WSP(bf16, WS_XB));
            }
        if (layer + 1 < DEPTH) GRID_BAR();
    }
    if (__hip_atomic_load(FCTL() + CW_BAR + XB_TMO, RLX_AGENT) != 0u) {
        __syncthreads();
        ArgsP A = fresh_args(); FRESH_GB(); float* xf = A->out;
        const float q = __builtin_nanf("");
        for (int m = f_gw(F); m < M; m += f_ngw()) { GAS f32x4* o = (GAS f32x4*)(xf + (size_t)m * D) + (fresh_tid() & 63);
#pragma unroll
            for (int j = 0; j < 4; ++j) o[64 * j] = (f32x4){q, q, q, q}; }
    }
}

extern "C" void kernel_launch(void* const* d_in, const int* in_sizes, int n_in, void* d_out, int out_size, void* d_ws, size_t ws_size, hipStream_t stream) {
    static int grid = 0;
    if (grid == 0) {
        if (n_in != 19 || in_sizes[0] != M * D || out_size != M * D || ws_size < WS_END) { fprintf(stderr, "kernel_launch: shape / workspace mismatch (n_in %d, in0 %d, out %d, ws %zu, need %zu); nothing launched\n", n_in, n_in > 0 ? in_sizes[0] : -1, out_size, ws_size, (size_t)WS_END); grid = -1; return; }
        int dev = 0, cus = 0, per_cu = 0;
        if (hipGetDevice(&dev) != hipSuccess || hipDeviceGetAttribute(&cus, hipDeviceAttributeMultiprocessorCount, dev) != hipSuccess) { grid = -1; return; }
        if (hipFuncSetAttribute((const void*)mega_fwd, hipFuncAttributeMaxDynamicSharedMemorySize, LDS_BYTES) != hipSuccess) { fprintf(stderr, "kernel_launch: hipFuncSetAttribute failed\n"); grid = -1; return; }
        if (hipOccupancyMaxActiveBlocksPerMultiprocessor(&per_cu, (const void*)mega_fwd, NWAVES * 64, LDS_BYTES) != hipSuccess || per_cu < 1) { fprintf(stderr, "kernel_launch: occupancy query reports %d\n", per_cu); }
        (void)hipGetLastError();
        grid = cus;
        if (grid != 256) { fprintf(stderr, "kernel_launch: built for 256 CUs, device has %d; nothing launched\n", cus); grid = -1; return; }
    }
    if (grid < 0) return;
    if (hipMemsetAsync((char*)d_ws + WS_CTL, 0, CTL_ZERO_BYTES, stream) != hipSuccess) return;
    Args a{};
    for (int i = 0; i < 19; ++i) a.in[i] = (const float*)d_in[i];
    a.out = (float*)d_out; a.ws = (unsigned char*)d_ws;
    hipLaunchKernelGGL(mega_fwd, dim3(grid), dim3(NWAVES * 64), LDS_BYTES, stream, a);
}
```
